# Optimizing an MI355X kernel written in HIP

```python
import math
import jax, jax.numpy as jnp
from jax import lax
import numpy as np

D_MODEL = 1024
BATCH = 32
SEQ = 2048
DEPTH = 1
DEC_BATCH = 4
DEC_SEQ = 4096
PAST_LEN = 128

HEAD_DIM = 64
N_Q_A = 8
N_KV_A = 2
GROUP_A = N_Q_A // N_KV_A
N_HEADS_B = 8
WIDTH_A = N_Q_A * HEAD_DIM
WIDTH_B = N_HEADS_B * HEAD_DIM
MIX_WIDTH = WIDTH_A + WIDTH_B
KV_WIDTH_A = N_KV_A * HEAD_DIM
IN_PROJ_WIDTH = WIDTH_A + 2 * KV_WIDTH_A + 3 * WIDTH_B
Q_BLOCK = 128
GRID_W = 64
ROPE_AXIS_DIM = HEAD_DIM // 2
ROPE_THETA = 10000.0
NA_KH = 8
NA_KW = 16
D_FF = 2816
CONV_W = 3
PLE_DIM = 256
EPS = 1e-6

kernel_name = "hymba_gqa_natten_convffn_ple_encoder"


def _rmsnorm(x, g):
    x32 = x.astype(jnp.float32)
    y = x32 * lax.rsqrt(jnp.mean(x32 * x32, axis=-1, keepdims=True) + EPS)
    return (y * g.astype(jnp.float32)).astype(x.dtype)


def _rope_tables(seq):
    t = jnp.arange(seq)
    row = (t // GRID_W).astype(jnp.float32)
    col = (t % GRID_W).astype(jnp.float32)
    freqs = ROPE_THETA ** (-jnp.arange(0, ROPE_AXIS_DIM, 2, dtype=jnp.float32) / ROPE_AXIS_DIM)
    ang_r = row[:, None] * freqs[None]
    ang_c = col[:, None] * freqs[None]
    return jnp.cos(ang_r), jnp.sin(ang_r), jnp.cos(ang_c), jnp.sin(ang_c)


def _rotate(x, cos, sin):
    cos = cos[None, :, None, :].astype(x.dtype)
    sin = sin[None, :, None, :].astype(x.dtype)
    x1, x2 = jnp.split(x, 2, axis=-1)
    return jnp.concatenate([x1 * cos - x2 * sin, x2 * cos + x1 * sin], axis=-1)


def _axial_rope(x, tables):
    cos_r, sin_r, cos_c, sin_c = tables
    xr, xc = x[..., :ROPE_AXIS_DIM], x[..., ROPE_AXIS_DIM:]
    return jnp.concatenate([_rotate(xr, cos_r, sin_r), _rotate(xc, cos_c, sin_c)], axis=-1)


def _gqa_blocked(q, k, v):
    b, s, _, dh = q.shape
    nb = s // Q_BLOCK
    scale = 1.0 / math.sqrt(dh)
    qb = q.reshape(b, nb, Q_BLOCK, N_KV_A, GROUP_A, dh).transpose(1, 0, 2, 3, 4, 5)

    def block(qblk):
        sc = jnp.einsum('bqkgd,bskd->bkgqs', qblk, k, preferred_element_type=jnp.float32) * scale
        p = jax.nn.softmax(sc, axis=-1).astype(v.dtype)
        return jnp.einsum('bkgqs,bskd->bqkgd', p, v)

    o = lax.map(block, qb)
    return o.transpose(1, 0, 2, 3, 4, 5).reshape(b, s, WIDTH_A)


def _neighbourhood_attention(q, k, v, rpb):
    b, s, h, dh = q.shape
    rows = s // GRID_W
    kh = min(NA_KH, rows)
    scale = 1.0 / math.sqrt(dh)
    qg = q.reshape(b, rows, GRID_W, h, dh)
    kg = k.reshape(b, rows, GRID_W, h, dh)
    vg = v.reshape(b, rows, GRID_W, h, dh)
    r_idx = jnp.arange(rows)
    r_start = jnp.clip(r_idx - kh // 2, 0, rows - kh)
    c = jnp.arange(GRID_W)
    c_start = jnp.clip(c - NA_KW // 2, 0, GRID_W - NA_KW)
    kc = c
    col_ok = (kc[None, :] >= c_start[:, None]) & (kc[None, :] < c_start[:, None] + NA_KW)
    dc_idx = jnp.clip(kc[None, :] - c[:, None] + NA_KW - 1, 0, 2 * NA_KW - 2)
    rpb_c = rpb[:, :, dc_idx].astype(jnp.float32)

    def row_fn(args):
        r, r0, q_row = args
        k_strip = lax.dynamic_slice_in_dim(kg, r0, kh, axis=1)
        v_strip = lax.dynamic_slice_in_dim(vg, r0, kh, axis=1)
        dr_idx = r0 + jnp.arange(kh) - r + NA_KH - 1
        bias = rpb_c[:, dr_idx].transpose(0, 2, 1, 3)
        sc = jnp.einsum('bqhd,bikhd->bhqik', q_row, k_strip,
                        preferred_element_type=jnp.float32) * scale + bias[None]
        sc = jnp.where(col_ok[None, None, :, None, :], sc, -jnp.inf)
        p = jax.nn.softmax(sc.reshape(b, h, GRID_W, kh * GRID_W), axis=-1)
        p = p.reshape(b, h, GRID_W, kh, GRID_W).astype(v.dtype)
        return jnp.einsum('bhqik,bikhd->bqhd', p, v_strip)

    o = lax.map(row_fn, (r_idx, r_start, qg.transpose(1, 0, 2, 3, 4)))
    return o.transpose(1, 0, 2, 3, 4).reshape(b, s, WIDTH_B)


def _dwconv_centred(u, w, bias):
    up = jnp.pad(u, ((0, 0), (1, 1), (0, 0)))
    return up[:, :-2] * w[0] + up[:, 1:-1] * w[1] + up[:, 2:] * w[2] + bias


def _trunk(x, p, attn_norm, w_in, q_norm_a, k_norm_a, rpb_b, out_norm_a, out_norm_b,
           w_out, ffn_norm, w_up, conv_w, conv_b, w_down, ple_norm, w_ple_gate, w_ple,
           final_norm):
    b, s, _ = x.shape
    tables = _rope_tables(s)
    h = x
    for i in range(DEPTH):
        n = _rmsnorm(h, attn_norm[i])
        proj = n @ w_in[i]
        splits = np.cumsum([WIDTH_A, KV_WIDTH_A, KV_WIDTH_A, WIDTH_B, WIDTH_B])
        qa, ka, va, qb, kb, vb = jnp.split(proj, splits, axis=-1)
        qa = _rmsnorm(qa.reshape(b, s, N_Q_A, HEAD_DIM), q_norm_a[i])
        ka = _rmsnorm(ka.reshape(b, s, N_KV_A, HEAD_DIM), k_norm_a[i])
        va = va.reshape(b, s, N_KV_A, HEAD_DIM)
        qa = _axial_rope(qa, tables)
        ka = _axial_rope(ka, tables)
        out_a = _gqa_blocked(qa, ka, va)
        out_b = _neighbourhood_attention(qb.reshape(b, s, N_HEADS_B, HEAD_DIM),
                                         kb.reshape(b, s, N_HEADS_B, HEAD_DIM),
                                         vb.reshape(b, s, N_HEADS_B, HEAD_DIM), rpb_b[i])
        mixed = jnp.concatenate([_rmsnorm(out_a, out_norm_a[i]),
                                 _rmsnorm(out_b, out_norm_b[i])], axis=-1)
        h = h + mixed @ w_out[i]
        n2 = _rmsnorm(h, ffn_norm[i])
        u = _dwconv_centred(n2 @ w_up[i], conv_w[i], conv_b[i])
        a, g = jnp.split(u, 2, axis=-1)
        h = h + (a * jax.nn.gelu(g, approximate=True)) @ w_down[i]
        gate = jax.nn.sigmoid(_rmsnorm(h, ple_norm[i]) @ w_ple_gate[i])
        h = h + gate * (p[i] @ w_ple[i])
    return _rmsnorm(h, final_norm)


def setup_inputs(seed: int = 0) -> dict:
    key = jax.random.key(seed)
    ks = jax.random.split(key, 24)
    f32 = jnp.float32

    def nrm(k, shape, scale):
        return jax.random.normal(k, shape, f32) * scale

    def gain(k, shape):
        return 1.0 + 0.05 * jax.random.normal(k, shape, f32)

    return {
        "x_prompt": nrm(ks[0], (BATCH, SEQ, D_MODEL), 1.0),
        "x_sample": nrm(ks[1], (DEC_BATCH, DEC_SEQ, D_MODEL), 1.0),
        "p_prompt": nrm(ks[2], (DEPTH, BATCH, SEQ, PLE_DIM), 1.0),
        "p_sample": nrm(ks[3], (DEPTH, DEC_BATCH, DEC_SEQ, PLE_DIM), 1.0),
        "attn_norm": gain(ks[4], (DEPTH, D_MODEL)),
        "w_in": nrm(ks[5], (DEPTH, D_MODEL, IN_PROJ_WIDTH), D_MODEL ** -0.5),
        "q_norm_a": gain(ks[6], (DEPTH, HEAD_DIM)),
        "k_norm_a": gain(ks[7], (DEPTH, HEAD_DIM)),
        "rpb_b": nrm(ks[8], (DEPTH, N_HEADS_B, 2 * NA_KH - 1, 2 * NA_KW - 1), 0.1),
        "out_norm_a": gain(ks[9], (DEPTH, WIDTH_A)),
        "out_norm_b": gain(ks[10], (DEPTH, WIDTH_B)),
        "w_out": nrm(ks[11], (DEPTH, MIX_WIDTH, D_MODEL), MIX_WIDTH ** -0.5),
        "ffn_norm": gain(ks[12], (DEPTH, D_MODEL)),
        "w_up": nrm(ks[13], (DEPTH, D_MODEL, 2 * D_FF), D_MODEL ** -0.5),
        "conv_w": nrm(ks[14], (DEPTH, CONV_W, 2 * D_FF), CONV_W ** -0.5),
        "conv_b": nrm(ks[15], (DEPTH, 2 * D_FF), 0.02),
        "w_down": nrm(ks[16], (DEPTH, D_FF, D_MODEL), D_FF ** -0.5),
        "ple_norm": gain(ks[17], (DEPTH, D_MODEL)),
        "w_ple_gate": nrm(ks[18], (DEPTH, D_MODEL, D_MODEL), D_MODEL ** -0.5),
        "w_ple": nrm(ks[19], (DEPTH, PLE_DIM, D_MODEL), PLE_DIM ** -0.5),
        "final_norm": gain(ks[20], (D_MODEL,)),
    }


def reference(x_prompt, x_sample, p_prompt, p_sample, attn_norm, w_in, q_norm_a, k_norm_a,
              rpb_b, out_norm_a, out_norm_b, w_out, ffn_norm, w_up, conv_w, conv_b, w_down,
              ple_norm, w_ple_gate, w_ple, final_norm):
    y_prompt = _trunk(x_prompt, p_prompt, attn_norm, w_in, q_norm_a, k_norm_a, rpb_b,
                      out_norm_a, out_norm_b, w_out, ffn_norm, w_up, conv_w, conv_b, w_down,
                      ple_norm, w_ple_gate, w_ple, final_norm)
    y_sample = _trunk(x_sample, p_sample, attn_norm, w_in, q_norm_a, k_norm_a, rpb_b,
                      out_norm_a, out_norm_b, w_out, ffn_norm, w_up, conv_w, conv_b, w_down,
                      ple_norm, w_ple_gate, w_ple, final_norm)
    return (y_prompt, y_sample)
```

```cpp
#include <hip/hip_cooperative_groups.h>
#include <hip/hip_runtime.h>
#include <cstdio>
#include <cstdint>
namespace pg8 {
#define PG8_LAS __attribute__((address_space(3)))
typedef unsigned short bf16_t;
typedef short bf16x8 __attribute__((ext_vector_type(8)));
typedef float f32x4 __attribute__((ext_vector_type(4)));
typedef unsigned u32x4 __attribute__((ext_vector_type(4)));
constexpr int BM = 256, BK = 64, HALF = 128, HTB = HALF * BK * 2  , STAGE_BYTES = 8 * HTB, NXCD = 8, WGM = 8;

__host__ __device__ __forceinline__ int lds_byte(int r, int c) { const int st = (r >> 4) * 2 + (c >> 5), rr = r & 15, cc = c & 31, ob = rr * 64 + cc * 2; return st * 1024 + (ob ^ (((ob >> 9) & 1) << 5)); }
__host__ __device__ __forceinline__ void stage_rc(int b, int& R, int& C) { const int st = b / 1024, sb = b % 1024, swz = sb ^ (((sb >> 9) & 1) << 5); R = (st >> 1) * 16 + swz / 64; C = (st & 1) * 32 + (swz % 64) / 2; }
__host__ __device__ __forceinline__ int perm32(int rho) { const int n = rho >> 4, i = rho & 15; return 8 * (i >> 2) + 4 * n + (i & 3); }

struct Unit { int pm, pn; };
struct Gemm { const bf16_t* A; const bf16_t* Bt; int M, N, K; };

struct StaticOrder {
    int nM, nN, nwg, G, c;
    __host__ __device__ void init(int M, int N, int G_, int c_) { nM = M / BM; nN = N / BM; nwg = nM * nN; G = G_; c = c_; }
    __host__ __device__ bool next(int i, Unit& u) const {
        const long L = (long)i * G + c; if (L >= nwg) return false;
        int wgid = (int)L; { const int q = nwg / NXCD, r = nwg % NXCD, xcd = wgid % NXCD, off = wgid / NXCD; wgid = (xcd < r ? xcd * (q + 1) : r * (q + 1) + (xcd - r) * q) + off; }
        const int nig = WGM * nN, gid = wgid / nig, fm = gid * WGM, gsz = (nM - fm) < WGM ? (nM - fm) : WGM;
        u.pm = fm + ((wgid % nig) % gsz); u.pn = (wgid % nig) / gsz; return true;
    }
    __device__ __forceinline__ void a_ready(const Unit&) const {}
    __device__ __forceinline__ void done(const Unit&) const {}
};

__device__ __forceinline__ unsigned cvt_pk_bf16(float lo, float hi) { unsigned r; asm volatile("v_cvt_pk_bf16_f32 %0, %1, %2" : "=v"(r) : "v"(lo), "v"(hi)); return r; }
typedef float f32x2 __attribute__((ext_vector_type(2)));
__device__ __forceinline__ f32x2 gelu_pk(f32x2 v) {
    const f32x2 av = __builtin_elementwise_abs(v), d = av * 0.2316418882f + 1.0f;
    f32x2 t; t.x = __builtin_amdgcn_rcpf(d.x); t.y = __builtin_amdgcn_rcpf(d.y);
    f32x2 q = t * 0.5307027145f + (-0.7265760135f); q = q * t + 0.7107068705f; q = q * t + (-0.142248368f); q = q * t + 0.127414796f; q = q * t;
    const f32x2 s = (v * v) * (-0.72134752044f);
    f32x2 e; e.x = __builtin_amdgcn_exp2f(s.x); e.y = __builtin_amdgcn_exp2f(s.y);
    const f32x2 m = v * (q * e), r = v - m;
    f32x2 o; o.x = v.x < 0.f ? m.x : r.x; o.y = v.y < 0.f ? m.y : r.y; return o;
}

template <int ACT  > struct EpiBf16 {
    static constexpr bool PERM = true, AFTER_DRAIN = false; static_assert(ACT == 0 || ACT == 1, "EpiBf16: ACT is 0 (none) or 1 (gelu_pk)");
    bf16_t* O; int ldc; const float* bias; int split_cols; size_t split_stride; float scale0;
    __device__ __forceinline__ void operator()(const f32x4 (&acc)[2][2][4][2], const Unit& u, int wr, int wc, int fr, int fq) const {
        const int row0 = u.pm * BM + wr * 64 + fr; int colt = u.pn * BM; bf16_t* base = O;
        float sc = 1.f; if (split_cols) { const int t = colt / split_cols; base += (size_t)t * split_stride; colt -= t * split_cols; if (t == 0) sc = scale0; }
        const int col0 = colt + wc * 32 + 8 * fq, bcol0 = u.pn * BM + wc * 32 + 8 * fq;
        f32x4 bv[2][2];
#pragma unroll
        for (int bj = 0; bj < 2; ++bj)
#pragma unroll
            for (int n = 0; n < 2; ++n) bv[bj][n] = bias ? *(const f32x4*)(bias + bcol0 + bj * HALF + 4 * n) : (f32x4){0.f, 0.f, 0.f, 0.f};
#pragma unroll
        for (int ai = 0; ai < 2; ++ai)
#pragma unroll
            for (int m = 0; m < 4; ++m) { bf16_t* rowp = base + (size_t)(row0 + ai * HALF + m * 16) * ldc + col0;
#pragma unroll
                for (int bj = 0; bj < 2; ++bj) { f32x4 v0 = acc[ai][bj][m][0] + bv[bj][0], v1 = acc[ai][bj][m][1] + bv[bj][1];
                    if (ACT == 1) { f32x2 a = gelu_pk((f32x2){v0[0], v0[1]}), b = gelu_pk((f32x2){v0[2], v0[3]}), c = gelu_pk((f32x2){v1[0], v1[1]}), d = gelu_pk((f32x2){v1[2], v1[3]});
                        v0 = (f32x4){a.x, a.y, b.x, b.y}; v1 = (f32x4){c.x, c.y, d.x, d.y}; }
                    v0 = v0 * sc; v1 = v1 * sc; u32x4 w; w.x = cvt_pk_bf16(v0[0], v0[1]); w.y = cvt_pk_bf16(v0[2], v0[3]); w.z = cvt_pk_bf16(v1[0], v1[1]); w.w = cvt_pk_bf16(v1[2], v1[3]);
                    *(u32x4*)(rowp + bj * HALF) = w; } }
    }
};
constexpr float RMS_EPS = 1e-6f;
__device__ __forceinline__ float f32_atomic_add(float* p, float v) { return __hip_atomic_fetch_add(p, v, __ATOMIC_RELAXED, __HIP_MEMORY_SCOPE_AGENT); }
struct EpiBf16Rs {
    static constexpr bool PERM = true, AFTER_DRAIN = false;
    bf16_t* O; int ldc; const float* ssq;
    __device__ __forceinline__ void operator()(const f32x4 (&acc)[2][2][4][2], const Unit& u, int wr, int wc, int fr, int fq) const {
        const int row0 = u.pm * BM + wr * 64 + fr, col0 = u.pn * BM + wc * 32 + 8 * fq;
#pragma unroll
        for (int ai = 0; ai < 2; ++ai)
#pragma unroll
            for (int m = 0; m < 4; ++m) { const int row = row0 + ai * HALF + m * 16; bf16_t* rowp = O + (size_t)row * ldc + col0;
                const float rs = ssq ? __builtin_amdgcn_rsqf(ssq[row] * (1.0f / 1024.0f) + RMS_EPS) : 1.0f;
#pragma unroll
                for (int bj = 0; bj < 2; ++bj) { const f32x4 v0 = acc[ai][bj][m][0] * rs, v1 = acc[ai][bj][m][1] * rs;
                    u32x4 w; w.x = cvt_pk_bf16(v0[0], v0[1]); w.y = cvt_pk_bf16(v0[2], v0[3]); w.z = cvt_pk_bf16(v1[0], v1[1]); w.w = cvt_pk_bf16(v1[2], v1[3]);
                    *(u32x4*)(rowp + bj * HALF) = w; } }
    }
};
struct EpiRes {
    static constexpr bool PERM = true, AFTER_DRAIN = false;
    const float* base0; const float* base1; int split;
    float* out; bf16_t* hb; float* ssq;
    __device__ __forceinline__ void operator()(const f32x4 (&acc)[2][2][4][2], const Unit& u, int wr, int wc, int fr, int fq) const {
        const int row0 = u.pm * BM + wr * 64 + fr, col0 = u.pn * BM + wc * 32 + 8 * fq;
#pragma unroll
        for (int ai = 0; ai < 2; ++ai)
#pragma unroll
            for (int m = 0; m < 4; ++m) { const int row = row0 + ai * HALF + m * 16;
                const float* bp = (row < split ? base0 + (size_t)row * 1024 : base1 + (size_t)(row - split) * 1024) + col0;
                float* op = out + (size_t)row * 1024 + col0; bf16_t* hp = hb + (size_t)row * 1024 + col0; float s = 0.f;
#pragma unroll
                for (int bj = 0; bj < 2; ++bj) { const f32x4 b0 = *(const f32x4*)(bp + bj * HALF), b1 = *(const f32x4*)(bp + bj * HALF + 4);
                    const f32x4 v0 = acc[ai][bj][m][0] + b0, v1 = acc[ai][bj][m][1] + b1;
                    *(f32x4*)(op + bj * HALF) = v0; *(f32x4*)(op + bj * HALF + 4) = v1;
                    u32x4 w; w.x = cvt_pk_bf16(v0[0], v0[1]); w.y = cvt_pk_bf16(v0[2], v0[3]); w.z = cvt_pk_bf16(v1[0], v1[1]); w.w = cvt_pk_bf16(v1[2], v1[3]);
                    *(u32x4*)(hp + bj * HALF) = w;
                    s += (v0[0] * v0[0] + v0[1] * v0[1]) + (v0[2] * v0[2] + v0[3] * v0[3]) + (v1[0] * v1[0] + v1[1] * v1[1]) + (v1[2] * v1[2] + v1[3] * v1[3]); }
                s += __shfl_xor(s, 16); s += __shfl_xor(s, 32);
                if (fq == 0) f32_atomic_add(ssq + row, s); }
    }
};
struct EpiGate {
    static constexpr bool PERM = true, AFTER_DRAIN = false;
    float* h; const bf16_t* E; const float* ssq_in; float* ssq_out;
    __device__ __forceinline__ void operator()(const f32x4 (&acc)[2][2][4][2], const Unit& u, int wr, int wc, int fr, int fq) const {
        const int row0 = u.pm * BM + wr * 64 + fr, col0 = u.pn * BM + wc * 32 + 8 * fq;
#pragma unroll
        for (int ai = 0; ai < 2; ++ai)
#pragma unroll
            for (int m = 0; m < 4; ++m) { const int row = row0 + ai * HALF + m * 16;
                float* hp = h + (size_t)row * 1024 + col0; const bf16_t* ep = E + (size_t)row * 1024 + col0; float s = 0.f;
                const float rs = __builtin_amdgcn_rsqf(ssq_in[row] * (1.0f / 1024.0f) + RMS_EPS) * -1.4426950408889634f;
#pragma unroll
                for (int bj = 0; bj < 2; ++bj) { const f32x4 b0 = *(const f32x4*)(hp + bj * HALF), b1 = *(const f32x4*)(hp + bj * HALF + 4);
                    const u32x4 ew = *(const u32x4*)(ep + bj * HALF);
                    f32x4 e0, e1; e0[0] = __uint_as_float(ew.x << 16); e0[1] = __uint_as_float(ew.x & 0xffff0000u); e0[2] = __uint_as_float(ew.y << 16); e0[3] = __uint_as_float(ew.y & 0xffff0000u);
                    e1[0] = __uint_as_float(ew.z << 16); e1[1] = __uint_as_float(ew.z & 0xffff0000u); e1[2] = __uint_as_float(ew.w << 16); e1[3] = __uint_as_float(ew.w & 0xffff0000u);
                    f32x4 v0, v1;
#pragma unroll
                    for (int k = 0; k < 4; ++k) { const float g0 = __builtin_amdgcn_rcpf(1.0f + __builtin_amdgcn_exp2f(acc[ai][bj][m][0][k] * rs)), g1 = __builtin_amdgcn_rcpf(1.0f + __builtin_amdgcn_exp2f(acc[ai][bj][m][1][k] * rs));
                        v0[k] = b0[k] + g0 * e0[k]; v1[k] = b1[k] + g1 * e1[k]; }
                    *(f32x4*)(hp + bj * HALF) = v0; *(f32x4*)(hp + bj * HALF + 4) = v1;
                    s += (v0[0] * v0[0] + v0[1] * v0[1]) + (v0[2] * v0[2] + v0[3] * v0[3]) + (v1[0] * v1[0] + v1[1] * v1[1]) + (v1[2] * v1[2] + v1[3] * v1[3]); }
                s += __shfl_xor(s, 16); s += __shfl_xor(s, 32);
                if (fq == 0) f32_atomic_add(ssq_out + row, s); }
    }
};

template <class Epi, class Sched, bool ALIGN_EPI = false, bool SP2 = false>
__device__ __forceinline__ void gemm_phase(PG8_LAS unsigned char* lds, const Gemm g, const Sched& S, const Epi& E) {
    int tid = threadIdx.x; asm volatile("" : "+v"(tid));
    const int wid = __builtin_amdgcn_readfirstlane(tid >> 6), lane = tid & 63, wr = wid >> 2, wc = wid & 3, fr = lane & 15, fq = lane >> 4;
    const int K = g.K, nt = K / BK;
    unsigned voffA[2], voffB[2];
#pragma unroll
    for (int i = 0; i < 2; ++i) { int R, C; stage_rc(tid * 16 + i * 8192, R, C); const int Rb = Epi::PERM ? ((R & ~31) + perm32(R & 31)) : R;
        voffA[i] = (unsigned)(R * K + C) * 2u; voffB[i] = (unsigned)(Rb * K + C) * 2u; }
    const size_t kstep = (size_t)(BK * 2);
    const size_t hstep = (size_t)HALF * K * 2;
    const size_t tstep = 2 * hstep;
    const unsigned ldsw = (unsigned)wid * 1024u;
    const int aoff = lds_byte(wr * 64 + fr, fq * 8), boff = lds_byte(wc * 32 + fr, fq * 8);
#define PG8_SA(b, h) (((b) * 2 + (h)) * HTB)
#define PG8_SB(b, h) ((4 + (b) * 2 + (h)) * HTB)
#define PG8_STAGE(bufoff, gbase, voff) do { _Pragma("unroll") for (int _i = 0; _i < 2; ++_i) \
        __builtin_amdgcn_global_load_lds((const unsigned*)((const char*)(gbase) + (voff)[_i]), (PG8_LAS unsigned*)(lds + (bufoff) + ldsw + _i * 8192), 16, 0, 0); } while (0)
#define PG8_LDA(dst, b, h) do { _Pragma("unroll") for (int m = 0; m < 4; ++m) _Pragma("unroll") for (int k = 0; k < 2; ++k) dst[m][k] = *(const PG8_LAS bf16x8*)(lds + PG8_SA(b, h) + aoff + m * 2048 + k * 1024); } while (0)
#define PG8_LDB(dst, b, h) do { _Pragma("unroll") for (int n = 0; n < 2; ++n) _Pragma("unroll") for (int k = 0; k < 2; ++k) dst[n][k] = *(const PG8_LAS bf16x8*)(lds + PG8_SB(b, h) + boff + n * 2048 + k * 1024); } while (0)
#define PG8_MMA(ai, bj, At, Bt) do { __builtin_amdgcn_s_setprio(1); _Pragma("unroll") for (int m = 0; m < 4; ++m) _Pragma("unroll") for (int n = 0; n < 2; ++n) _Pragma("unroll") for (int k = 0; k < 2; ++k) \
        acc[ai][bj][m][n] = __builtin_amdgcn_mfma_f32_16x16x32_bf16(Bt[n][k], At[m][k], acc[ai][bj][m][n], 0, 0, 0); __builtin_amdgcn_s_setprio(0); } while (0)
#define PG8_WAIT_V(n) asm volatile("s_waitcnt vmcnt(" #n ")" ::: "memory")
#define PG8_WAIT_L(n) asm volatile("s_waitcnt lgkmcnt(" #n ")" ::: "memory")
#define PG8_BAR __builtin_amdgcn_s_barrier()
#define PG8_SCHED __builtin_amdgcn_sched_barrier(0)
    Unit cur, nxt; int ui = 0;
    if (!S.next(0, cur)) return;
    f32x4 acc[2][2][4][2];
#pragma unroll
    for (int a = 0; a < 2; ++a)
#pragma unroll
        for (int b = 0; b < 2; ++b)
#pragma unroll
            for (int m = 0; m < 4; ++m)
#pragma unroll
                for (int n = 0; n < 2; ++n) acc[a][b][m][n] = (f32x4){0.f, 0.f, 0.f, 0.f};
    bf16x8 At[4][2], B0[2][2], B1[2][2];
    const char* cA = (const char*)g.A + (size_t)cur.pm * tstep; const char* cB = (const char*)g.Bt + (size_t)cur.pn * tstep;
    S.a_ready(cur);
    if constexpr (SP2) {
        PG8_STAGE(PG8_SB(0, 0), cB, voffB); PG8_STAGE(PG8_SB(0, 1), cB + hstep, voffB); PG8_STAGE(PG8_SA(0, 0), cA, voffA); PG8_STAGE(PG8_SA(0, 1), cA + hstep, voffA);
        if (wr == 1) PG8_BAR;
        PG8_WAIT_V(2); PG8_BAR;
        PG8_STAGE(PG8_SB(1, 0), cB + kstep, voffB); PG8_STAGE(PG8_SA(1, 0), cA + kstep, voffA); PG8_STAGE(PG8_SB(1, 1), cB + hstep + kstep, voffB);
        PG8_WAIT_V(6); PG8_BAR;
    } else {
        PG8_STAGE(PG8_SB(0, 0), cB, voffB); PG8_STAGE(PG8_SA(0, 0), cA, voffA); PG8_STAGE(PG8_SB(0, 1), cB + hstep, voffB); PG8_STAGE(PG8_SA(0, 1), cA + hstep, voffA);
        if (wr == 1) PG8_BAR;
        PG8_WAIT_V(4); PG8_BAR;
        PG8_STAGE(PG8_SB(1, 0), cB + kstep, voffB); PG8_STAGE(PG8_SA(1, 0), cA + kstep, voffA); PG8_STAGE(PG8_SB(1, 1), cB + hstep + kstep, voffB);
        PG8_WAIT_V(6); PG8_BAR;
    }
    for (;;) {
        const bool has_next = S.next(ui + 1, nxt);
        const char* nA = has_next ? (const char*)g.A + (size_t)nxt.pm * tstep : cA; const char* nB = has_next ? (const char*)g.Bt + (size_t)nxt.pn * tstep : cB;
        for (int t = 0; t < nt; t += 2) {
            const bool last = (t == nt - 2);
            const char* a1 = cA + (size_t)(t + 1) * kstep;
            const char* a2 = last ? nA : cA + (size_t)(t + 2) * kstep; const char* b2 = last ? nB : cB + (size_t)(t + 2) * kstep;
            const char* a3 = a2 + kstep; const char* b3 = b2 + kstep;
            if (last && has_next) S.a_ready(nxt);
            if constexpr (SP2) {
            PG8_LDB(B0, 0, 0); PG8_LDB(B1, 0, 1); PG8_SCHED; PG8_LDA(At, 0, 0); PG8_STAGE(PG8_SA(1, 1), a1 + hstep, voffA);
            PG8_WAIT_V(8); PG8_WAIT_L(0); PG8_BAR; PG8_MMA(0, 0, At, B0); PG8_MMA(0, 1, At, B1); PG8_BAR; PG8_SCHED;
            PG8_LDA(At, 0, 1); PG8_STAGE(PG8_SB(0, 0), b2, voffB); PG8_STAGE(PG8_SB(0, 1), b2 + hstep, voffB); PG8_STAGE(PG8_SA(0, 0), a2, voffA);
            PG8_WAIT_V(8); PG8_WAIT_L(0); PG8_BAR; PG8_MMA(1, 0, At, B0); PG8_MMA(1, 1, At, B1); PG8_BAR; PG8_SCHED;
            PG8_LDB(B0, 1, 0); PG8_LDB(B1, 1, 1); PG8_SCHED; PG8_LDA(At, 1, 0); PG8_STAGE(PG8_SA(0, 1), a2 + hstep, voffA);
            PG8_WAIT_V(8); PG8_WAIT_L(0); PG8_BAR; PG8_MMA(0, 0, At, B0); PG8_MMA(0, 1, At, B1); PG8_BAR; PG8_SCHED;
            PG8_LDA(At, 1, 1); PG8_STAGE(PG8_SB(1, 0), b3, voffB); PG8_STAGE(PG8_SB(1, 1), b3 + hstep, voffB); PG8_STAGE(PG8_SA(1, 0), a3, voffA);
            PG8_WAIT_V(8); PG8_WAIT_L(0); PG8_BAR; PG8_MMA(1, 0, At, B0); PG8_MMA(1, 1, At, B1); PG8_BAR; PG8_SCHED;
            } else {
            PG8_LDB(B0, 0, 0); PG8_SCHED; PG8_LDA(At, 0, 0); PG8_STAGE(PG8_SA(1, 1), a1 + hstep, voffA);
            PG8_WAIT_L(8); PG8_BAR; PG8_WAIT_L(0); PG8_MMA(0, 0, At, B0); PG8_BAR; PG8_SCHED;
            PG8_LDB(B1, 0, 1); PG8_STAGE(PG8_SB(0, 0), b2, voffB);
            PG8_BAR; PG8_WAIT_L(0); PG8_MMA(0, 1, At, B1); PG8_BAR;
            PG8_LDA(At, 0, 1); PG8_STAGE(PG8_SA(0, 0), a2, voffA);
            PG8_BAR; PG8_WAIT_L(0); PG8_MMA(1, 0, At, B0); PG8_BAR; PG8_SCHED;
            PG8_STAGE(PG8_SB(0, 1), b2 + hstep, voffB);
            PG8_WAIT_V(6); PG8_BAR; PG8_MMA(1, 1, At, B1); PG8_BAR;
            PG8_LDB(B0, 1, 0); PG8_SCHED; PG8_LDA(At, 1, 0); PG8_STAGE(PG8_SA(0, 1), a2 + hstep, voffA);
            PG8_WAIT_L(8); PG8_BAR; PG8_WAIT_L(0); PG8_MMA(0, 0, At, B0); PG8_BAR; PG8_SCHED;
            PG8_LDB(B1, 1, 1); PG8_STAGE(PG8_SB(1, 0), b3, voffB);
            PG8_BAR; PG8_WAIT_L(0); PG8_MMA(0, 1, At, B1); PG8_BAR;
            PG8_LDA(At, 1, 1); PG8_STAGE(PG8_SA(1, 0), a3, voffA);
            PG8_BAR; PG8_WAIT_L(0); PG8_MMA(1, 0, At, B0); PG8_BAR; PG8_SCHED;
            PG8_STAGE(PG8_SB(1, 1), b3 + hstep, voffB);
            PG8_WAIT_V(6); PG8_BAR; PG8_MMA(1, 1, At, B1); PG8_BAR;
            }
        }
        if constexpr (ALIGN_EPI) { if (wr == 0) PG8_BAR; }
        if constexpr (!Epi::AFTER_DRAIN) { E(acc, cur, wr, wc, fr, fq); S.done(cur); }
        if (!has_next) break;
#pragma unroll
        for (int a = 0; a < 2; ++a)
#pragma unroll
            for (int b = 0; b < 2; ++b)
#pragma unroll
                for (int m = 0; m < 4; ++m)
#pragma unroll
                    for (int n = 0; n < 2; ++n) acc[a][b][m][n] = (f32x4){0.f, 0.f, 0.f, 0.f};
        cur = nxt; cA = nA; cB = nB; ++ui;
        if constexpr (ALIGN_EPI) { if (wr == 1) PG8_BAR; }
    }
    PG8_WAIT_V(0);
    if constexpr (!ALIGN_EPI) { if (wr == 0) PG8_BAR; }
    PG8_BAR;
    if constexpr (Epi::AFTER_DRAIN) { E.fused(acc, cur, wr, wc, fr, fq, lds, wid, lane); S.done(cur); }
#undef PG8_SA
#undef PG8_SB
#undef PG8_STAGE
#undef PG8_LDA
#undef PG8_LDB
#undef PG8_MMA
#undef PG8_WAIT_V
#undef PG8_WAIT_L
#undef PG8_BAR
#undef PG8_SCHED
}
}
#include <hip/hip_bf16.h>
#include <cmath>
namespace attn_body {
using bf16=__hip_bfloat16;
using bf16x8=__attribute__((ext_vector_type(8)))short;
using s16x4=__attribute__((ext_vector_type(4)))short;
using f32x16=__attribute__((ext_vector_type(16)))float;
using u32x4=__attribute__((ext_vector_type(4)))unsigned;
constexpr int D=64,PQ=2304,PO=1024;
constexpr int NW=8,QBLK=32,QB=QBLK*NW,KVBLK=64;
__device__ __forceinline__ int crow(int r,int hi){return (r&3)+8*(r>>2)+4*hi;}
#define SBAR() __builtin_amdgcn_sched_barrier(0)
__device__ __forceinline__ void cmask(f32x16&p0,f32x16&p1,int jb,int qrel,int hi){
  const float NEG=-INFINITY; int kb=64*jb+4*hi;
  #pragma unroll
  for(int r=0;r<16;++r){int kv=kb+(r&3)+8*(r>>2); if(kv>qrel)p0[r]=NEG; if(kv+32>qrel)p1[r]=NEG;}
}

constexpr int NSLOT=3, SLOTB=8192;
constexpr int LDS_K=0, LDS_V=NSLOT*SLOTB, LDS_WS=2*NSLOT*SLOTB, LDS_OST=LDS_WS+NW*64*4, LDS_BYTES=LDS_OST+NW*4096;
constexpr float C2=0.125f*1.4426950408889634f;
__device__ __forceinline__ void glds16(const void*gsrc,unsigned lds_dst){unsigned keep;
  asm volatile("s_mov_b32 %0, m0\n\ts_mov_b32 m0, %2\n\ts_nop 0\n\tglobal_load_lds_dwordx4 %1, off\n\ts_mov_b32 m0, %0":"=&s"(keep):"v"(gsrc),"s"(lds_dst):"memory");}
__device__ __forceinline__ float max3f(float a,float b,float c){float r;asm("v_max3_f32 %0, %1, %2, %3":"=v"(r):"v"(a),"v"(b),"v"(c));return r;}
__device__ __forceinline__ float max2f(float a,float b){float r;asm("v_max_f32_e32 %0, %1, %2":"=v"(r):"v"(a),"v"(b));return r;}
__device__ __forceinline__ float fadd_s(float a,float b){float r;asm("v_add_f32_e32 %0, %1, %2":"=v"(r):"v"(a),"v"(b));return r;}
__device__ __forceinline__ float fsub_s(float a,float b){float r;asm("v_sub_f32_e32 %0, %1, %2":"=v"(r):"v"(a),"v"(b));return r;}
typedef float f32x2_t __attribute__((ext_vector_type(2))); typedef __bf16 bf16x2_t __attribute__((ext_vector_type(2)));
__device__ __forceinline__ unsigned cvtpk_s(float lo,float hi){f32x2_t v={lo,hi};bf16x2_t b=__builtin_convertvector(v,bf16x2_t);return __builtin_bit_cast(unsigned,b);}
#define WAIT_BAR(N) asm volatile("s_waitcnt vmcnt(" #N ") lgkmcnt(0)\n\ts_barrier":::"memory")

__device__ __forceinline__ void qkt(f32x16&p0,f32x16&p1,const char*Kslot,const bf16x8*qr,const f32x16&negm,int r32,int hi){
  const char*kb=Kslot+hi*1024+r32*16;
  #pragma unroll
  for(int d0=0;d0<4;++d0){
    const bf16x8 b0=*reinterpret_cast<const bf16x8*>(kb+d0*2048);
    const bf16x8 b1=*reinterpret_cast<const bf16x8*>(kb+d0*2048+512);
    if(d0==0){p0=__builtin_amdgcn_mfma_f32_32x32x16_bf16(b0,qr[0],negm,0,0,0);p1=__builtin_amdgcn_mfma_f32_32x32x16_bf16(b1,qr[0],negm,0,0,0);}
    else{p0=__builtin_amdgcn_mfma_f32_32x32x16_bf16(b0,qr[d0],p0,0,0,0);p1=__builtin_amdgcn_mfma_f32_32x32x16_bf16(b1,qr[d0],p1,0,0,0);}}
}
typedef __attribute__((address_space(3))) const char* lds_cptr;
typedef short v4i16_t __attribute__((ext_vector_type(4)));
__device__ __forceinline__ void kload8(bf16x8*kf,lds_cptr kp){
  kf[0]=*(const __attribute__((address_space(3))) bf16x8*)(kp);      kf[1]=*(const __attribute__((address_space(3))) bf16x8*)(kp+512);
  kf[2]=*(const __attribute__((address_space(3))) bf16x8*)(kp+2048); kf[3]=*(const __attribute__((address_space(3))) bf16x8*)(kp+2560);
  kf[4]=*(const __attribute__((address_space(3))) bf16x8*)(kp+4096); kf[5]=*(const __attribute__((address_space(3))) bf16x8*)(kp+4608);
  kf[6]=*(const __attribute__((address_space(3))) bf16x8*)(kp+6144); kf[7]=*(const __attribute__((address_space(3))) bf16x8*)(kp+6656);
}
__device__ __forceinline__ void kload2(bf16x8*kf,lds_cptr kp,int j){ kf[2*j]=*(const __attribute__((address_space(3))) bf16x8*)(kp+j*2048); kf[2*j+1]=*(const __attribute__((address_space(3))) bf16x8*)(kp+j*2048+512); }
__device__ __forceinline__ s16x4 vtr(lds_cptr p){ return __builtin_bit_cast(s16x4,__builtin_amdgcn_ds_read_tr16_b64_v4i16((__attribute__((address_space(3))) v4i16_t*)p)); }
__device__ __forceinline__ float rowmax(const f32x16&p0,const f32x16&p1){
  float a=max3f(p0[0],p0[1],p1[0]),b=max3f(p0[2],p0[3],p1[1]);a=max3f(a,p1[2],p1[3]);
  #pragma unroll
  for(int r=4;r<16;r+=4){a=max3f(a,p0[r],p0[r+1]);b=max3f(b,p0[r+2],p0[r+3]);a=max3f(a,p1[r],p1[r+1]);b=max3f(b,p1[r+2],p1[r+3]);}
  const float m=max2f(a,b);
  auto rr=__builtin_amdgcn_permlane32_swap(__float_as_uint(m),__float_as_uint(m),false,false);
  return max2f(__uint_as_float(rr[0]),__uint_as_float(rr[1]));
}
__device__ __forceinline__ void pv(f32x16*o,int vb,bf16x8 pa0,bf16x8 pa1,bf16x8 pa2,bf16x8 pa3){
  #pragma unroll
  for(int d0=0;d0<2;++d0){s16x4 lo[4],hi[4];
    #pragma unroll
    for(int ks=0;ks<4;++ks){
      asm volatile("ds_read_b64_tr_b16 %0,%1 offset:%c2":"=&v"(lo[ks]):"v"(vb),"i"(d0*4096+ks*1024):"memory");
      asm volatile("ds_read_b64_tr_b16 %0,%1 offset:%c2":"=&v"(hi[ks]):"v"(vb),"i"(d0*4096+ks*1024+512):"memory");}
    asm volatile("s_waitcnt lgkmcnt(0)":::"memory");SBAR();
    #define PK(k) (bf16x8){lo[k][0],lo[k][1],lo[k][2],lo[k][3],hi[k][0],hi[k][1],hi[k][2],hi[k][3]}
    o[d0]=__builtin_amdgcn_mfma_f32_32x32x16_bf16(pa0,PK(0),o[d0],0,0,0);
    o[d0]=__builtin_amdgcn_mfma_f32_32x32x16_bf16(pa1,PK(1),o[d0],0,0,0);
    o[d0]=__builtin_amdgcn_mfma_f32_32x32x16_bf16(pa2,PK(2),o[d0],0,0,0);
    o[d0]=__builtin_amdgcn_mfma_f32_32x32x16_bf16(pa3,PK(3),o[d0],0,0,0);
    #undef PK
  }
}

#ifndef ATTN_STORE16
#define ATTN_STORE16(p,v) (*(u32x4*)(p)=(v))
#endif
template<int THRL> __device__ __forceinline__ void attn_unit(long rowbase,int NT,int h,int kvh,int qb,const bf16*Q,const bf16*__restrict__ K,const bf16*__restrict__ V,bf16*O,char*shm){
  int tid=threadIdx.x; asm volatile("":"+v"(tid)); const int lane=tid&63,r32=lane&31,hi=lane>>5; const int wid=__builtin_amdgcn_readfirstlane(tid>>6);
  const int q0=qb*QB;
  const bf16*Qw=Q+(rowbase+q0+wid*QBLK)*PQ+h*D;
  const bf16*Kh=K+rowbase*PQ+kvh*D,*Vh=V+rowbase*PQ+kvh*D;
  const unsigned lds0=(unsigned)(uintptr_t)shm;
  float*wsf=(float*)(shm+LDS_WS)+wid*64;
  const bf16*ksrc=Kh+(long)lane*PQ+wid*8;
  const bf16*vsrc=Vh+(long)(16*(wid&3)+(lane>>2))*PQ+(wid>>2)*32+(lane&3)*8;
  const unsigned kdst=lds0+LDS_K+wid*1024, vdst=lds0+LDS_V+wid*1024;
  #define DMA_K(t,slot) glds16(ksrc+(long)(t)*KVBLK*PQ,(unsigned)__builtin_amdgcn_readfirstlane(kdst+(slot)))
  #define DMA_V(t,slot) glds16(vsrc+(long)(t)*KVBLK*PQ,(unsigned)__builtin_amdgcn_readfirstlane(vdst+(slot)))
  const int vb0=(int)(lds0+LDS_V)+((lane>>4)&1)*32+(lane&3)*8+(4*hi+((lane&15)>>2))*64;
  const char*Kbase=shm+LDS_K; bf16x8 kf[8];
  const lds_cptr shm3=(lds_cptr)shm; const lds_cptr kp0=shm3+LDS_K+hi*1024+r32*16; const lds_cptr vp0=shm3+LDS_V+((lane>>4)&1)*32+(lane&3)*8+(4*hi+((lane&15)>>2))*64;
  DMA_K(0,0);DMA_V(0,0);DMA_K(1,SLOTB);
  bf16x8 qr[4];
  #pragma unroll
  for(int d0=0;d0<4;++d0)qr[d0]=*reinterpret_cast<const bf16x8*>(&Qw[(long)r32*PQ+d0*16+hi*8]);
  float mhat=0.f,l_reg=0.f;f32x16 o[2];o[0]=f32x16{};o[1]=f32x16{};f32x16 negm=f32x16{};asm volatile("":"+v"(negm));
  const int qrel=wid*QBLK+r32;
  #define CMASK(P0,P1,t) do{int jb_=(t)-(NT-4); (void)jb_;(void)qrel;}while(0)
  bool resc=false;
  #define START(P0,P1) do{ const float rm=rowmax(P0,P1); resc=false; \
    { const float dl=rm; mhat=fadd_s(mhat,dl); \
      _Pragma("unroll") for(int r=0;r<16;++r){P0[r]=fsub_s(P0[r],dl);P1[r]=fsub_s(P1[r],dl);} \
      _Pragma("unroll") for(int r=0;r<16;++r)negm[r]=-mhat; asm volatile("":"+v"(negm)); } \
    _Pragma("unroll") for(int r=0;r<16;++r)P0[r]=__builtin_amdgcn_exp2f(P0[r]); }while(0)
  #define RESC() do{ if(resc){ asm volatile("s_waitcnt lgkmcnt(0)":::"memory"); \
      _Pragma("unroll") for(int d_=0;d_<2;++d_) _Pragma("unroll") for(int r=0;r<16;++r)o[d_][r]*=wsf[crow(r,hi)]; } }while(0)
  f32x16 pA0,pA1,pB0,pB1;
  int sl_prev=0,sl_cur=0,sl_next=SLOTB;
  #define ROT() do{sl_prev=sl_cur;sl_cur=sl_next;sl_next=(sl_next==(NSLOT-1)*SLOTB)?0:sl_next+SLOTB;}while(0)
  DMA_K(2,2*SLOTB);
  WAIT_BAR(3);
  qkt(pA0,pA1,Kbase,qr,negm,r32,hi);asm volatile("s_nop 15\n\ts_nop 7":"+v"(pA0),"+v"(pA1));CMASK(pA0,pA1,0);
  START(pA0,pA1);
  _Pragma("unroll") for(int r=0;r<16;++r)pA1[r]=__builtin_amdgcn_exp2f(pA1[r]);
  WAIT_BAR(0);
  DMA_K(3,0);DMA_V(1,SLOTB);
  ROT();
  kload8(kf,kp0+sl_cur);
  WAIT_BAR(2);
  s16x4 vlo[8],vhi[8]; u32x4 pw0,pw1,pw2,pw3;
  #define PKW(P,B) cvtpk_s(P[B],P[B+1])
  #define PAF(k) __builtin_bit_cast(bf16x8,pw##k)
  #define VFR(i) (bf16x8){vlo[i][0],vlo[i][1],vlo[i][2],vlo[i][3],vhi[i][0],vhi[i][1],vhi[i][2],vhi[i][3]}
  #define PIN(x) asm volatile("":"+v"(x))
  #define MX3(a,b,c) __builtin_fmaxf(__builtin_fmaxf((a),(b)),(c))
  #define GAPA(MF,A0,A1,A2,A3,W0,W1,PW) do{ MF; sacc+=A0; sacc+=A1; sacc+=A2; sacc+=A3; PIN(sacc); W0; W1; PIN(PW); SBAR(); }while(0)
  #define EX(v) __builtin_amdgcn_exp2f(v)
  #define GAPB(MF,X,B) do{ MF; X[B]=EX(X[B]); X[B+1]=EX(X[B+1]); X[B+2]=EX(X[B+2]); X[B+3]=EX(X[B+3]); PIN(X); SBAR(); }while(0)
  #define VRD(i) do{ vlo[i]=vtr(vp_+(((i)>>2)*4096+((i)&3)*1024)); vhi[i]=vtr(vp_+(((i)>>2)*4096+((i)&3)*1024+512)); }while(0)
  #define KRD(G,j) do{ if(G){ kload2(kf,kp0+sl_next,j); SBAR(); } }while(0)
  #define STEP(C0,C1,P0,P1,t,GK,GV,GL) do{ SBAR(); \
    const lds_cptr vp_=vp0+sl_prev; \
    VRD(0); SBAR(); float sacc=(P0[0]+P0[1]); \
    GAPA(C0=__builtin_amdgcn_mfma_f32_32x32x16_bf16(kf[0],qr[0],negm,0,0,0), P0[2],P0[3],P0[4],P0[5],     pw0[0]=PKW(P0,0), pw0[1]=PKW(P0,2), pw0); \
    VRD(4); SBAR(); GAPA(C1=__builtin_amdgcn_mfma_f32_32x32x16_bf16(kf[1],qr[0],negm,0,0,0), P0[6],P0[7],P0[8],P0[9],     pw0[2]=PKW(P0,4), pw0[3]=PKW(P0,6), pw0); \
    VRD(1); SBAR(); GAPA(C0=__builtin_amdgcn_mfma_f32_32x32x16_bf16(kf[2],qr[1],C0,0,0,0),   P0[10],P0[11],P0[12],P0[13], pw1[0]=PKW(P0,8), pw1[1]=PKW(P0,10), pw1); \
    VRD(5); SBAR(); GAPA(C1=__builtin_amdgcn_mfma_f32_32x32x16_bf16(kf[3],qr[1],C1,0,0,0),   P0[14],P0[15],P1[0],P1[1],   pw1[2]=PKW(P0,12),pw1[3]=PKW(P0,14), pw1); \
    VRD(2); SBAR(); GAPA(C0=__builtin_amdgcn_mfma_f32_32x32x16_bf16(kf[4],qr[2],C0,0,0,0),   P1[2],P1[3],P1[4],P1[5],     pw2[0]=PKW(P1,0), pw2[1]=PKW(P1,2), pw2); \
    VRD(6); SBAR(); GAPA(C1=__builtin_amdgcn_mfma_f32_32x32x16_bf16(kf[5],qr[2],C1,0,0,0),   P1[6],P1[7],P1[8],P1[9],     pw2[2]=PKW(P1,4), pw2[3]=PKW(P1,6), pw2); \
    VRD(3); SBAR(); GAPA(C0=__builtin_amdgcn_mfma_f32_32x32x16_bf16(kf[6],qr[3],C0,0,0,0),   P1[10],P1[11],P1[12],P1[13], pw3[0]=PKW(P1,8), pw3[1]=PKW(P1,10), pw3); \
    VRD(7); SBAR(); GAPA(C1=__builtin_amdgcn_mfma_f32_32x32x16_bf16(kf[7],qr[3],C1,0,0,0),   P1[14],P1[15],0.f,0.f,       pw3[2]=PKW(P1,12),pw3[3]=PKW(P1,14), pw3); \
    l_reg+=sacc; \
    if(GK){DMA_K((t)+3,sl_cur);} if(GV){DMA_V((t)+1,sl_next);} \
    CMASK(C0,C1,t); \
    { float a=MX3(C0[0],C0[1],C1[0]),b=MX3(C0[2],C0[3],C1[1]); a=MX3(a,C1[2],C1[3]); \
      _Pragma("unroll") for(int r=4;r<16;r+=4){a=MX3(a,C0[r],C0[r+1]);b=MX3(b,C0[r+2],C0[r+3]);a=MX3(a,C1[r],C1[r+1]);b=MX3(b,C1[r+2],C1[r+3]);} \
      float rm=__builtin_fmaxf(a,b); { auto rr=__builtin_amdgcn_permlane32_swap(__float_as_uint(rm),__float_as_uint(rm),false,false); rm=__builtin_fmaxf(__uint_as_float(rr[0]),__uint_as_float(rr[1])); } \
      resc=false; \
      if(__builtin_expect(__any(rm>(float)THRL),0)){ const float dl=__builtin_fmaxf(rm,0.f); mhat+=dl; \
        _Pragma("unroll") for(int r=0;r<16;++r){C0[r]-=dl;C1[r]-=dl;} \
        _Pragma("unroll") for(int r=0;r<16;++r)negm[r]=-mhat; asm volatile("":"+v"(negm)); \
        const float f=__builtin_amdgcn_exp2f(-dl); l_reg*=f; if(hi==0)wsf[r32]=f; resc=true; } } \
    SBAR(); \
    GAPB(o[0]=__builtin_amdgcn_mfma_f32_32x32x16_bf16(PAF(0),VFR(0),o[0],0,0,0), C0,0); \
    GAPB(o[1]=__builtin_amdgcn_mfma_f32_32x32x16_bf16(PAF(0),VFR(4),o[1],0,0,0), C0,4); \
    KRD(GL,0); GAPB(o[0]=__builtin_amdgcn_mfma_f32_32x32x16_bf16(PAF(1),VFR(1),o[0],0,0,0), C0,8); \
    KRD(GL,1); GAPB(o[1]=__builtin_amdgcn_mfma_f32_32x32x16_bf16(PAF(1),VFR(5),o[1],0,0,0), C0,12); \
    KRD(GL,2); GAPB(o[0]=__builtin_amdgcn_mfma_f32_32x32x16_bf16(PAF(2),VFR(2),o[0],0,0,0), C1,0); \
    KRD(GL,3); GAPB(o[1]=__builtin_amdgcn_mfma_f32_32x32x16_bf16(PAF(2),VFR(6),o[1],0,0,0), C1,4); \
    GAPB(o[0]=__builtin_amdgcn_mfma_f32_32x32x16_bf16(PAF(3),VFR(3),o[0],0,0,0), C1,8); \
    GAPB(o[1]=__builtin_amdgcn_mfma_f32_32x32x16_bf16(PAF(3),VFR(7),o[1],0,0,0), C1,12); \
    }while(0)
  int t=1;
  #undef CMASK
  #define CMASK(P0,P1,t) do{}while(0)
  for(;t+5<NT;t+=2){
    STEP(pB0,pB1,pA0,pA1,t,true,true,true);     WAIT_BAR(2); RESC(); ROT();
    STEP(pA0,pA1,pB0,pB1,t+1,true,true,true);   WAIT_BAR(2); RESC(); ROT();
  }
  #undef CMASK
  #define CMASK(P0,P1,t) do{int jb_=(t)-(NT-4); (void)jb_;(void)qrel;}while(0)
  #define ENDW(tt) do{ if((tt)+3<NT){WAIT_BAR(2);} else if((tt)+2<NT){WAIT_BAR(1);} else {WAIT_BAR(0);} }while(0)
  for(;t+1<NT;t+=2){
    STEP(pB0,pB1,pA0,pA1,t,(t+3<NT),(t+1<NT),(t+1<NT));       ENDW(t);   RESC(); ROT();
    STEP(pA0,pA1,pB0,pB1,t+1,(t+4<NT),(t+2<NT),(t+2<NT));     ENDW(t+1); RESC(); ROT();
  }
  STEP(pB0,pB1,pA0,pA1,NT-1,false,false,false); RESC();
  { float sacc=pB0[0]+pB0[1]; _Pragma("unroll") for(int r=2;r<16;++r)sacc+=pB0[r]; _Pragma("unroll") for(int r=0;r<16;++r)sacc+=pB1[r]; l_reg+=sacc;
    pw0=(u32x4){PKW(pB0,0),PKW(pB0,2),PKW(pB0,4),PKW(pB0,6)};pw1=(u32x4){PKW(pB0,8),PKW(pB0,10),PKW(pB0,12),PKW(pB0,14)};pw2=(u32x4){PKW(pB1,0),PKW(pB1,2),PKW(pB1,4),PKW(pB1,6)};pw3=(u32x4){PKW(pB1,8),PKW(pB1,10),PKW(pB1,12),PKW(pB1,14)};
    SBAR(); pv(o,vb0+sl_cur,PAF(0),PAF(1),PAF(2),PAF(3)); }
  #undef PKW
  #undef PAF
  #undef VFR
  #undef PIN
  #undef MX3
  #undef GAPA
  #undef GAPB
  #undef EX
  #undef VRD
  #undef KRD
  #undef STEP
  #undef ENDW
  {auto rr=__builtin_amdgcn_permlane32_swap(__float_as_uint(l_reg),__float_as_uint(l_reg),false,false);l_reg=__uint_as_float(rr[0])+__uint_as_float(rr[1]);}
  if(hi==0)wsf[32+r32]=l_reg;asm volatile("s_waitcnt lgkmcnt(0)":::"memory");
  float rli[16];
  #pragma unroll
  for(int r=0;r<16;++r)rli[r]=__builtin_amdgcn_rcpf(wsf[32+crow(r,hi)]);
  bf16*Ow=O+(rowbase+q0+wid*QBLK)*PO+h*D;
  { bf16*stg=(bf16*)(shm+LDS_OST)+wid*2048;
    #pragma unroll
    for(int r=0;r<16;++r){const int orow=crow(r,hi);
      #pragma unroll
      for(int d0=0;d0<2;++d0)stg[orow*64+d0*32+r32]=__float2bfloat16(o[d0][r]*rli[r]);}
    asm volatile("s_waitcnt lgkmcnt(0)":::"memory");
    #pragma unroll
    for(int i=0;i<4;++i){const int row=i*8+(lane>>3),ch=lane&7; const u32x4 v=*(const u32x4*)(stg+row*64+ch*8); ATTN_STORE16(Ow+(long)row*PO+ch*8,v);} }
  asm volatile("s_waitcnt lgkmcnt(0)\n\ts_barrier":::"memory");
  #undef DMA_K
  #undef DMA_V
  #undef CMASK
  #undef START
  #undef RESC
  #undef ROT
}
constexpr int ATTN_LDS_BYTES=LDS_BYTES;
#undef SBAR
#undef WAIT_BAR
}
namespace na_body {
using attn_body::bf16x8; using attn_body::s16x4; using attn_body::f32x16; using attn_body::u32x4;
#define NA_LAS __attribute__((address_space(3)))
constexpr int PQ = 2304, PO = 1024;
constexpr int COL_QB = 768, COL_KB = 1280, COL_VB = 1792, COL_OB = 512;
constexpr int T_GUARD = 48, T_FLOATS = T_GUARD + 15 * 32 + 48;
__device__ __forceinline__ int crow(int r, int hi) { return (r & 3) + 8 * (r >> 2) + 4 * hi; }
__device__ __forceinline__ unsigned cvtpk(float lo, float hi) { return attn_body::cvtpk_s(lo, hi); }

__device__ __forceinline__ void na_unit(const unsigned short* __restrict__ PROJ, unsigned short* __restrict__ O, long rowbase, int rows, int r, int h,
                                        NA_LAS unsigned char* wl, unsigned wl_addr, const NA_LAS float* T, NA_LAS float* wsf) {
    int tid_ = threadIdx.x; asm volatile("" : "+v"(tid_)); const int lane = tid_ & 63, r32 = lane & 31, hi = lane >> 5;
    const int r0 = min(max(r - 4, 0), rows - 8);
    const long qrow0 = rowbase + (long)r * 64;
    const unsigned short* qbase = PROJ + (qrow0 + r32) * PQ + COL_QB + h * 64 + hi * 8;
    bf16x8 qr[2][4];
#pragma unroll
    for (int qb2 = 0; qb2 < 2; ++qb2)
#pragma unroll
        for (int d0 = 0; d0 < 4; ++d0) qr[qb2][d0] = *(const bf16x8*)(qbase + (long)qb2 * 32 * PQ + d0 * 16);
    float mrun[2] = {-1e30f, -1e30f}, lrun[2] = {0.f, 0.f};
    f32x16 o[2][2];
#pragma unroll
    for (int a = 0; a < 2; ++a)
#pragma unroll
        for (int b = 0; b < 2; ++b) o[a][b] = f32x16{};
    const int lrow = lane >> 3, lc = lane & 7;
    const int vb = (int)wl_addr + 8192 + ((lane >> 4) & 1) * 32 + (lane & 3) * 8 + (4 * hi + ((lane & 15) >> 2)) * 64;
    for (int i = 0; i < 8; ++i) {
        const unsigned short* kb = PROJ + (rowbase + (long)(r0 + i) * 64 + lrow) * PQ + COL_KB + h * 64 + lc * 8;
        u32x4 kreg[8], vreg[8];
#pragma unroll
        for (int j = 0; j < 8; ++j) { kreg[j] = *(const u32x4*)(kb + (long)j * 8 * PQ); vreg[j] = *(const u32x4*)(kb + (COL_VB - COL_KB) + (long)j * 8 * PQ); }
#pragma unroll
        for (int j = 0; j < 8; ++j) { const int row = j * 8 + lrow;
            *(NA_LAS u32x4*)(wl + lc * 1024 + row * 16) = kreg[j];
            *(NA_LAS u32x4*)(wl + 8192 + (lc >> 2) * 4096 + (row >> 4) * 1024 + (row & 15) * 64 + (lc & 3) * 16) = vreg[j]; }
        bf16x8 kf[8];
#pragma unroll
        for (int d0 = 0; d0 < 4; ++d0) { kf[2 * d0] = *(const NA_LAS bf16x8*)(wl + (2 * d0 + hi) * 1024 + r32 * 16); kf[2 * d0 + 1] = *(const NA_LAS bf16x8*)(wl + (2 * d0 + hi) * 1024 + 512 + r32 * 16); }
        const int dr = r0 + i - r + 7;
#pragma unroll
        for (int qb2 = 0; qb2 < 2; ++qb2) {
            f32x16 p0 = f32x16{}, p1 = f32x16{};
#pragma unroll
            for (int d0 = 0; d0 < 4; ++d0) { p0 = __builtin_amdgcn_mfma_f32_32x32x16_bf16(kf[2 * d0], qr[qb2][d0], p0, 0, 0, 0); p1 = __builtin_amdgcn_mfma_f32_32x32x16_bf16(kf[2 * d0 + 1], qr[qb2][d0], p1, 0, 0, 0); }
            const int c = qb2 * 32 + r32, c0 = min(max(c - 8, 0), 48);
            const NA_LAS float* tb = T + dr * 32 + 15 - c + 4 * hi;
            const int kofs = 4 * hi - c0;
            float rm = -1e30f;
#pragma unroll
            for (int rr = 0; rr < 16; ++rr) { const int kc = (rr & 3) + 8 * (rr >> 2);
                const float s0 = ((unsigned)(kc + kofs) < 16u) ? p0[rr] + tb[kc] : -1e30f;
                const float s1 = ((unsigned)(kc + 32 + kofs) < 16u) ? p1[rr] + tb[kc + 32] : -1e30f;
                p0[rr] = s0; p1[rr] = s1; rm = fmaxf(rm, fmaxf(s0, s1)); }
            rm = fmaxf(rm, __shfl_xor(rm, 32));
            const float mn = fmaxf(mrun[qb2], rm), alpha = __builtin_amdgcn_exp2f(mrun[qb2] - mn);
            mrun[qb2] = mn;
            float sum = 0.f;
#pragma unroll
            for (int rr = 0; rr < 16; ++rr) { p0[rr] = __builtin_amdgcn_exp2f(p0[rr] - mn); p1[rr] = __builtin_amdgcn_exp2f(p1[rr] - mn); sum += p0[rr] + p1[rr]; }
            lrun[qb2] = lrun[qb2] * alpha + sum;
            if (__any(alpha != 1.0f)) {
                if (hi == 0) wsf[r32] = alpha;
#pragma unroll
                for (int rr = 0; rr < 16; ++rr) { const float a = wsf[crow(rr, hi)]; o[qb2][0][rr] *= a; o[qb2][1][rr] *= a; }
            }
            u32x4 pw0, pw1, pw2, pw3;
            pw0 = (u32x4){cvtpk(p0[0], p0[1]), cvtpk(p0[2], p0[3]), cvtpk(p0[4], p0[5]), cvtpk(p0[6], p0[7])};
            pw1 = (u32x4){cvtpk(p0[8], p0[9]), cvtpk(p0[10], p0[11]), cvtpk(p0[12], p0[13]), cvtpk(p0[14], p0[15])};
            pw2 = (u32x4){cvtpk(p1[0], p1[1]), cvtpk(p1[2], p1[3]), cvtpk(p1[4], p1[5]), cvtpk(p1[6], p1[7])};
            pw3 = (u32x4){cvtpk(p1[8], p1[9]), cvtpk(p1[10], p1[11]), cvtpk(p1[12], p1[13]), cvtpk(p1[14], p1[15])};
            attn_body::pv(o[qb2], vb, __builtin_bit_cast(bf16x8, pw0), __builtin_bit_cast(bf16x8, pw1), __builtin_bit_cast(bf16x8, pw2), __builtin_bit_cast(bf16x8, pw3));
        }
    }
#pragma unroll
    for (int qb2 = 0; qb2 < 2; ++qb2) {
        const float l = lrun[qb2] + __shfl_xor(lrun[qb2], 32);
        if (hi == 0) wsf[r32] = __builtin_amdgcn_rcpf(l);
        NA_LAS unsigned short* stg = (NA_LAS unsigned short*)(wl + qb2 * 4096);
#pragma unroll
        for (int rr = 0; rr < 16; ++rr) { const int orow = crow(rr, hi); const float rl = wsf[orow];
#pragma unroll
            for (int d0 = 0; d0 < 2; ++d0) stg[orow * 64 + d0 * 32 + r32] = (unsigned short)(cvtpk(o[qb2][d0][rr] * rl, 0.f) & 0xffffu); }
        unsigned short* Ow = O + (qrow0 + qb2 * 32) * PO + COL_OB + h * 64;
#pragma unroll
        for (int k = 0; k < 4; ++k) { const int row = k * 8 + (lane >> 3), ch = lane & 7; const u32x4 v = *(const NA_LAS u32x4*)(stg + row * 64 + ch * 8); *(u32x4*)(Ow + (long)row * PO + ch * 8) = v; }
    }
}
}
namespace cg = cooperative_groups;
constexpr int NWAVES = 8;
constexpr int DM = 1024, M_PROMPT = 32 * 2048, S_PROMPT = 2048, M_SAMPLE = 4 * 4096, S_SAMPLE = 4096, M_ALL = M_PROMPT + M_SAMPLE;
constexpr int NPROJ = 2304, DFF = 2816, NUP = 2 * DFF, PLE = 256;
constexpr int FFN_CHUNKS = 4, M_CHUNK = M_ALL / FFN_CHUNKS;
constexpr float C2 = 0.125f * 1.4426950408889634f;
constexpr float LOG2E = 1.4426950408889634f;
constexpr size_t MiB = 1u << 20;
constexpr size_t WS_SSQ2 = 0, WS_SSQ3 = 512 * 1024, WS_SSQ4 = 1 * MiB, WS_ROPE = 1 * MiB + 512 * 1024;
constexpr size_t WS_WIN = 2 * MiB, WS_WOUT = 7 * MiB, WS_WUP = 9 * MiB, WS_WDOWN = 20 * MiB, WS_WGATE = 26 * MiB, WS_WPLE = 28 * MiB;
constexpr size_t WS_PROJ = 32 * MiB;
constexpr size_t WS_XNO = 392 * MiB;
constexpr size_t WS_U = 32 * MiB;
constexpr size_t WS_ACT = 252 * MiB;
constexpr size_t WS_H2B = 32 * MiB;
constexpr size_t WS_E = 192 * MiB;
constexpr size_t WS_H1B = 824 * MiB;
constexpr size_t WS_PB = 984 * MiB;
constexpr size_t WS_END = 1024 * MiB;
static_assert(WS_PROJ + (size_t)M_ALL * NPROJ * 2 <= WS_XNO && WS_XNO + (size_t)M_ALL * DM * 2 <= WS_H1B && WS_U + (size_t)M_CHUNK * NUP * 2 <= WS_ACT && WS_ACT + (size_t)M_ALL * DFF * 2 <= WS_H1B, "d_ws map");
static_assert(WS_H1B + (size_t)M_ALL * DM * 2 <= WS_PB && WS_PB + (size_t)M_ALL * PLE * 2 <= WS_END && WS_H2B + (size_t)M_ALL * DM * 2 <= WS_E && WS_E + (size_t)M_ALL * DM * 2 <= WS_H1B, "d_ws map 2");
static_assert(WS_WIN + (size_t)NPROJ * DM * 2 <= WS_WOUT && WS_WUP + (size_t)NUP * DM * 2 <= WS_WDOWN && WS_WDOWN + (size_t)DM * DFF * 2 <= WS_WGATE, "weight map");
constexpr int RING_BYTES = 131072;
constexpr int NA_T_OFF = RING_BYTES, NA_T_BYTES = na_body::T_FLOATS * 4, NA_WSF_OFF = NA_T_OFF + NWAVES * NA_T_BYTES, LDS_BYTES = NA_WSF_OFF + NWAVES * 256;
static_assert(LDS_BYTES <= 163840 && attn_body::ATTN_LDS_BYTES <= RING_BYTES, "LDS map");

#define LAS __attribute__((address_space(3)))
typedef unsigned short bf16;
typedef unsigned v4u __attribute__((ext_vector_type(4)));
typedef unsigned v2u __attribute__((ext_vector_type(2)));
typedef float f32x4 __attribute__((ext_vector_type(4)));
__device__ __forceinline__ unsigned pk2(float lo, float hi) { return pg8::cvt_pk_bf16(lo, hi); }
__device__ __forceinline__ float bflo(unsigned w) { return __uint_as_float(w << 16); }
__device__ __forceinline__ float bfhi(unsigned w) { return __uint_as_float(w & 0xffff0000u); }
__device__ __forceinline__ float wave_sum(float v) {
#pragma unroll
    for (int o = 1; o < 64; o <<= 1) v += __shfl_xor(v, o);
    return v;
}
__device__ __forceinline__ void p0_transpose_item(const float* W, int K, int N, bf16* WT, LAS float* scr, int item, int lane, const float* gain, int nlo, int nhi, float nscale) {
    const int nblk = N / 32, kb = item / nblk, nb = item % nblk, k0 = 64 * kb, n0 = 32 * nb;
#pragma unroll 8
    for (int i = 0; i < 32; ++i) { const int kk = 2 * i + (lane >> 5); float w = W[(size_t)(k0 + kk) * N + n0 + (lane & 31)]; if (gain) w *= gain[k0 + kk]; scr[kk * 33 + (lane & 31)] = w; }
    asm volatile("s_waitcnt lgkmcnt(0)" ::: "memory");
    const int c = lane & 7;
#pragma unroll
    for (int j = 0; j < 4; ++j) { const int n = (lane >> 3) + 8 * j; const LAS float* s = scr + (8 * c) * 33 + n; const float ns = (n0 + n >= nlo && n0 + n < nhi) ? nscale : 1.0f;
        v4u o; o.x = pk2(s[0 * 33] * ns, s[1 * 33] * ns); o.y = pk2(s[2 * 33] * ns, s[3 * 33] * ns); o.z = pk2(s[4 * 33] * ns, s[5 * 33] * ns); o.w = pk2(s[6 * 33] * ns, s[7 * 33] * ns);
        *(v4u*)(WT + (size_t)(n0 + n) * K + k0 + 8 * c) = o; }
    asm volatile("s_waitcnt lgkmcnt(0)" ::: "memory");
}
__device__ __forceinline__ void sincos_cw(float a, float& s, float& c) {
    const float k = rintf(a * 0.636619772367581343f);
    float r = fmaf(-k, 1.5703125f, a); r = fmaf(-k, 4.837512969970703125e-4f, r); r = fmaf(-k, 7.54978995489188216e-8f, r);
    const float r2 = r * r;
    const float sp = r + r * r2 * (-1.6666667163e-01f + r2 * (8.3333337680e-03f + r2 * (-1.9841270114e-04f + r2 * 2.7557314297e-06f)));
    const float cp = 1.0f + r2 * (-0.5f + r2 * (4.1666667908e-02f + r2 * (-1.3888889225e-03f + r2 * (2.4801587642e-05f + r2 * -2.7557314297e-07f))));
    const int q = (int)k & 3;
    s = (q == 0) ? sp : (q == 1) ? cp : (q == 2) ? -sp : -cp;
    c = (q == 0) ? cp : (q == 1) ? -sp : (q == 2) ? -cp : sp;
}

typedef const __attribute__((address_space(4))) unsigned char* kptr_t;
struct Args { const float* in[21]; float* out; unsigned char* ws; };

__global__ void __launch_bounds__(NWAVES * 64, 2) hymba_fwd(Args args) {
    extern __shared__ __attribute__((aligned(16))) unsigned char lds[];
    cg::grid_group grid = cg::this_grid();
    LAS unsigned char* const L = (LAS unsigned char*)lds;
    const int wave = __builtin_amdgcn_readfirstlane(threadIdx.x >> 6);
    const int G = gridDim.x, bx = blockIdx.x, vcu = (G % 8 == 0) ? (bx % 8) * (G / 8) + bx / 8 : bx;
    const int gw = vcu * NWAVES + wave, NGW = G * NWAVES;
#define PHASE_PTRS() int tid = threadIdx.x; asm volatile("" : "+v"(tid)); const int lane = tid & 63; (void)lane; kptr_t kp = (kptr_t)__builtin_amdgcn_kernarg_segment_ptr(); asm volatile("" : "+s"(kp)); unsigned char* const ws = (unsigned char*)KLD(22); float* const out = (float*)KLD(21); (void)out; \
    float* const ssq2 = (float*)(ws + WS_SSQ2); float* const ssq3 = (float*)(ws + WS_SSQ3); float* const ssq4 = (float*)(ws + WS_SSQ4); float* const rope = (float*)(ws + WS_ROPE); (void)ssq2; (void)ssq3; (void)ssq4; (void)rope; \
    bf16* const PROJ = (bf16*)(ws + WS_PROJ); bf16* const XNO = (bf16*)(ws + WS_XNO); (void)PROJ; (void)XNO;
#define KLD(i) (*(const __attribute__((address_space(4))) unsigned long long*)(kp + 8 * (i)))
#define KIN(i) ((const float*)KLD(i))

    {
        PHASE_PTRS();
        const float* const x_prompt = KIN(0); const float* const x_sample = KIN(1); const float* const p_prompt = KIN(2); const float* const p_sample = KIN(3);
        bf16* const Win_t = (bf16*)(ws + WS_WIN); bf16* const Wout_t = (bf16*)(ws + WS_WOUT); bf16* const Wup_t = (bf16*)(ws + WS_WUP); bf16* const Wdown_t = (bf16*)(ws + WS_WDOWN);
        bf16* const Wgate_t = (bf16*)(ws + WS_WGATE); bf16* const Wple_t = (bf16*)(ws + WS_WPLE); bf16* const PB = (bf16*)(ws + WS_PB);
        LAS float* scr = (LAS float*)(L + wave * 16384);
        constexpr int I_IN = (DM / 64) * (NPROJ / 32), I_OUT = (DM / 64) * (DM / 32), I_UP = (DM / 64) * (NUP / 32), I_DOWN = (DFF / 64) * (DM / 32), I_GATE = I_OUT, I_PLE = (PLE / 64) * (DM / 32);
        constexpr int NITEMS = I_IN + I_OUT + I_UP + I_DOWN + I_GATE + I_PLE;
        for (int it = gw; it < NITEMS; it += NGW) {
            int r = it;
            if (r < I_IN) { p0_transpose_item(KIN(5), DM, NPROJ, Win_t, scr, r, lane, nullptr, na_body::COL_QB, na_body::COL_KB, C2); continue; } r -= I_IN;
            if (r < I_OUT) { p0_transpose_item(KIN(11), DM, DM, Wout_t, scr, r, lane, nullptr, 0, 0, 1.f); continue; } r -= I_OUT;
            if (r < I_UP) { p0_transpose_item(KIN(13), DM, NUP, Wup_t, scr, r, lane, KIN(12), 0, 0, 1.f); continue; } r -= I_UP;
            if (r < I_DOWN) { p0_transpose_item(KIN(16), DFF, DM, Wdown_t, scr, r, lane, nullptr, 0, 0, 1.f); continue; } r -= I_DOWN;
            if (r < I_GATE) { p0_transpose_item(KIN(18), DM, DM, Wgate_t, scr, r, lane, KIN(17), 0, 0, 1.f); continue; } r -= I_GATE;
            p0_transpose_item(KIN(19), PLE, DM, Wple_t, scr, r, lane, nullptr, 0, 0, 1.f);
        }
        const float* gain = KIN(4);
        for (int m = gw; m < M_ALL; m += NGW) {
            const float* xrow = (m < M_PROMPT) ? x_prompt + (size_t)m * DM : x_sample + (size_t)(m - M_PROMPT) * DM;
            const f32x4* xr = (const f32x4*)xrow + lane;
            f32x4 v[4]; float s = 0.f;
#pragma unroll
            for (int j = 0; j < 4; ++j) { v[j] = xr[64 * j]; s += (v[j].x * v[j].x + v[j].y * v[j].y) + (v[j].z * v[j].z + v[j].w * v[j].w); }
            const float rs = __builtin_amdgcn_rsqf(wave_sum(s) * (1.f / DM) + 1e-6f);
            unsigned long long* o8 = (unsigned long long*)(XNO + (size_t)m * DM) + lane;
#pragma unroll
            for (int j = 0; j < 4; ++j) { const f32x4 g = ((const f32x4*)gain)[lane + 64 * j];
                o8[64 * j] = (unsigned long long)pk2(v[j].x * rs * g.x, v[j].y * rs * g.y) | ((unsigned long long)pk2(v[j].z * rs * g.z, v[j].w * rs * g.w) << 32); }
            const float* prow = (m < M_PROMPT) ? p_prompt + (size_t)m * PLE : p_sample + (size_t)(m - M_PROMPT) * PLE;
            const f32x4 pv = ((const f32x4*)prow)[lane];
            ((unsigned long long*)(PB + (size_t)m * PLE))[lane] = (unsigned long long)pk2(pv.x, pv.y) | ((unsigned long long)pk2(pv.z, pv.w) << 32);
        }
        for (int e = bx * (NWAVES * 64) + tid; e < M_ALL; e += G * NWAVES * 64) { ssq2[e] = 0.f; ssq3[e] = 0.f; ssq4[e] = 0.f; }
        for (int e = bx * (NWAVES * 64) + tid; e < 1024; e += G * NWAVES * 64) { const int pos = e >> 4, i = e & 15;
            const float freq = exp2f(-(float)i * (13.287712379549449f / 16.0f)); float s, c; sincos_cw((float)pos * freq, s, c); rope[e] = c; rope[1024 + e] = s; }
    }
    grid.sync();

    {
        PHASE_PTRS(); bf16* const Win_t = (bf16*)(ws + WS_WIN);
        pg8::Gemm g{XNO, Win_t, M_ALL, NPROJ, DM}; pg8::StaticOrder S; S.init(M_ALL, NPROJ, G, bx);
        pg8::EpiBf16Rs E{PROJ, NPROJ, nullptr};
        pg8::gemm_phase<pg8::EpiBf16Rs, pg8::StaticOrder, true, true>(L, g, S, E);
    }
    grid.sync();

    {
        PHASE_PTRS();
        const float* qn = KIN(6); const float* kn = KIN(7);
        const int a = lane & 7;
        const long NIT = (long)M_ALL * 10 / 8;
        for (long it = gw; it < NIT; it += NGW) {
            const long item = it * 8 + (lane >> 3); const int m = (int)(item / 10), j = (int)(item % 10);
            const int t = (m < M_PROMPT) ? (m & (S_PROMPT - 1)) : (m & (S_SAMPLE - 1));
            bf16* p = PROJ + (size_t)m * NPROJ + j * 64 + a * 8;
            const v4u raw = *(const v4u*)p;
            float v[8] = {bflo(raw.x), bfhi(raw.x), bflo(raw.y), bfhi(raw.y), bflo(raw.z), bfhi(raw.z), bflo(raw.w), bfhi(raw.w)};
            float ss = 0.f;
#pragma unroll
            for (int i = 0; i < 8; ++i) ss += v[i] * v[i];
            ss += __shfl_xor(ss, 1); ss += __shfl_xor(ss, 2); ss += __shfl_xor(ss, 4);
            const float rs = __builtin_amdgcn_rsqf(ss * (1.f / 64.f) + 1e-6f);
            const float* gn = (j < 8 ? qn : kn) + a * 8;
            const int pos = (a < 4) ? (t >> 6) : (t & 63);
            const float* ct = rope + pos * 16 + (a & 1) * 8;
            const float sc = (j < 8) ? C2 : 1.0f;
            float o[8];
#pragma unroll
            for (int i = 0; i < 8; ++i) { const float y = v[i] * rs * gn[i]; const float py = __shfl_xor(y, 2); const float cs = ct[i], sn = ct[1024 + i];
                o[i] = ((a & 2) == 0 ? y * cs - py * sn : y * cs + py * sn) * sc; }
            v4u w; w.x = pk2(o[0], o[1]); w.y = pk2(o[2], o[3]); w.z = pk2(o[4], o[5]); w.w = pk2(o[6], o[7]);
            *(v4u*)p = w;
        }
    }
    grid.sync();

    {
        PHASE_PTRS();
        const attn_body::bf16* Q = (const attn_body::bf16*)PROJ; const attn_body::bf16* K = Q + 512; const attn_body::bf16* V = Q + 640; attn_body::bf16* Ob = (attn_body::bf16*)XNO;
        for (int pair = vcu; pair < 256; pair += G) { const int b = pair >> 3, h = pair & 7;
            for (int qb = 0; qb < 8; ++qb) attn_body::attn_unit<8>((long)b * S_PROMPT, S_PROMPT / 64, h, h >> 2, qb, Q, K, V, Ob, (char*)lds); }
        for (int su = vcu; su < 256; su += G) { const int pair = su >> 3, b = pair >> 3, h = pair & 7;
            for (int k = 0; k < 2; ++k) attn_body::attn_unit<8>((long)M_PROMPT + (long)b * S_SAMPLE, S_SAMPLE / 64, h, h >> 2, (su & 7) * 2 + k, Q, K, V, Ob, (char*)lds); }
        __syncthreads();
        LAS float* Tb = (LAS float*)(L + NA_T_OFF + wave * NA_T_BYTES);
        LAS float* wsf = (LAS float*)(L + NA_WSF_OFF + wave * 256);
        for (int e = lane; e < na_body::T_FLOATS; e += 64) Tb[e] = 0.f;
        { const float* rpb = KIN(8) + wave * 15 * 31;
          for (int e = lane; e < 15 * 31; e += 64) { const int dr = e / 31, dc = e % 31; Tb[na_body::T_GUARD + dr * 32 + dc] = rpb[e] * LOG2E; } }
        LAS unsigned char* wl = L + wave * 16384;
        const unsigned wl_addr = (unsigned)(uintptr_t)(lds + wave * 16384);
        for (int bu = vcu; bu < 1280; bu += G) {
            long rowbase; int rows, r;
            if (bu < 1024) { rowbase = (long)(bu >> 5) * S_PROMPT; rows = 32; r = bu & 31; } else { const int s = bu - 1024; rowbase = (long)M_PROMPT + (long)(s >> 6) * S_SAMPLE; rows = 64; r = s & 63; }
            na_body::na_unit(PROJ, XNO, rowbase, rows, r, wave, wl, wl_addr, Tb + na_body::T_GUARD, wsf);
        }
    }
    grid.sync();

    {
        PHASE_PTRS();
        const f32x4* ga = (const f32x4*)KIN(9) + lane * 2; const f32x4* gb = (const f32x4*)KIN(10) + lane * 2;
        const f32x4 ga0 = ga[0], ga1 = ga[1], gb0 = gb[0], gb1 = gb[1];
        for (int m = gw; m < M_ALL; m += NGW) {
            v4u* pa = (v4u*)(XNO + (size_t)m * DM) + lane; v4u* pb = pa + 64;
            const v4u ra = *pa, rb = *pb;
            float va[8] = {bflo(ra.x), bfhi(ra.x), bflo(ra.y), bfhi(ra.y), bflo(ra.z), bfhi(ra.z), bflo(ra.w), bfhi(ra.w)};
            float vb[8] = {bflo(rb.x), bfhi(rb.x), bflo(rb.y), bfhi(rb.y), bflo(rb.z), bfhi(rb.z), bflo(rb.w), bfhi(rb.w)};
            float sa = 0.f, sb = 0.f;
#pragma unroll
            for (int i = 0; i < 8; ++i) { sa += va[i] * va[i]; sb += vb[i] * vb[i]; }
            const float rsa = __builtin_amdgcn_rsqf(wave_sum(sa) * (1.f / 512.f) + 1e-6f), rsb = __builtin_amdgcn_rsqf(wave_sum(sb) * (1.f / 512.f) + 1e-6f);
            v4u wa, wb;
            wa.x = pk2(va[0] * rsa * ga0.x, va[1] * rsa * ga0.y); wa.y = pk2(va[2] * rsa * ga0.z, va[3] * rsa * ga0.w); wa.z = pk2(va[4] * rsa * ga1.x, va[5] * rsa * ga1.y); wa.w = pk2(va[6] * rsa * ga1.z, va[7] * rsa * ga1.w);
            wb.x = pk2(vb[0] * rsb * gb0.x, vb[1] * rsb * gb0.y); wb.y = pk2(vb[2] * rsb * gb0.z, vb[3] * rsb * gb0.w); wb.z = pk2(vb[4] * rsb * gb1.x, vb[5] * rsb * gb1.y); wb.w = pk2(vb[6] * rsb * gb1.z, vb[7] * rsb * gb1.w);
            *pa = wa; *pb = wb;
        }
    }
    grid.sync();

    {
        PHASE_PTRS(); bf16* const Wout_t = (bf16*)(ws + WS_WOUT); bf16* const H1B = (bf16*)(ws + WS_H1B); const float* const x_prompt = KIN(0); const float* const x_sample = KIN(1);
        pg8::Gemm g{XNO, Wout_t, M_ALL, DM, DM}; pg8::StaticOrder S; S.init(M_ALL, DM, G, bx);
        pg8::EpiRes E{x_prompt, x_sample, M_PROMPT, out, H1B, ssq2};
        pg8::gemm_phase<pg8::EpiRes, pg8::StaticOrder, true, true>(L, g, S, E);
    }
    grid.sync();

    for (int ch = 0; ch < FFN_CHUNKS; ++ch) {
        const int crow0 = ch * M_CHUNK;
        {
            PHASE_PTRS(); bf16* const Wup_t = (bf16*)(ws + WS_WUP); bf16* const H1B = (bf16*)(ws + WS_H1B); bf16* const U = (bf16*)(ws + WS_U);
            pg8::Gemm g{H1B + (size_t)crow0 * DM, Wup_t, M_CHUNK, NUP, DM}; pg8::StaticOrder S; S.init(M_CHUNK, NUP, G, bx);
            pg8::EpiBf16Rs E{U, NUP, ssq2 + crow0};
            pg8::gemm_phase<pg8::EpiBf16Rs, pg8::StaticOrder, true, true>(L, g, S, E);
        }
        grid.sync();
        {
            PHASE_PTRS(); const bf16* const U = (const bf16*)(ws + WS_U); bf16* const ACT = (bf16*)(ws + WS_ACT);
            const float* cw = KIN(14); const float* cb = KIN(15);
            constexpr int RG = 16, NCH = DFF / 8, NITEM = (M_CHUNK / RG) * NCH;
            for (int item = bx * (NWAVES * 64) + tid; item < NITEM; item += G * NWAVES * 64) {
                const int rg = item / NCH, c8 = (item % NCH) * 8; const int lm0 = rg * RG, m0 = crow0 + lm0;
                const int S_len = (m0 < M_PROMPT) ? S_PROMPT : S_SAMPLE; const int t0 = m0 & (S_len - 1);
                float wa[3][8], wg[3][8], ba[8], bg[8];
#pragma unroll
                for (int k = 0; k < 3; ++k)
#pragma unroll
                    for (int q = 0; q < 2; ++q) { const f32x4 a4 = *(const f32x4*)(cw + (size_t)k * NUP + c8 + 4 * q), g4 = *(const f32x4*)(cw + (size_t)k * NUP + DFF + c8 + 4 * q);
                        wa[k][4 * q] = a4.x; wa[k][4 * q + 1] = a4.y; wa[k][4 * q + 2] = a4.z; wa[k][4 * q + 3] = a4.w; wg[k][4 * q] = g4.x; wg[k][4 * q + 1] = g4.y; wg[k][4 * q + 2] = g4.z; wg[k][4 * q + 3] = g4.w; }
#pragma unroll
                for (int q = 0; q < 2; ++q) { const f32x4 a4 = *(const f32x4*)(cb + c8 + 4 * q), g4 = *(const f32x4*)(cb + DFF + c8 + 4 * q);
                    ba[4 * q] = a4.x; ba[4 * q + 1] = a4.y; ba[4 * q + 2] = a4.z; ba[4 * q + 3] = a4.w; bg[4 * q] = g4.x; bg[4 * q + 1] = g4.y; bg[4 * q + 2] = g4.z; bg[4 * q + 3] = g4.w; }
                const bf16* up = U + (size_t)lm0 * NUP + c8;
                v4u pa = (v4u){0u, 0u, 0u, 0u}, pg = pa, ca, cgv, na, ng;
                if (t0 != 0) { pa = *(const v4u*)(up - NUP); pg = *(const v4u*)(up - NUP + DFF); }
                ca = *(const v4u*)up; cgv = *(const v4u*)(up + DFF);
#pragma unroll 4
                for (int rr = 0; rr < RG; ++rr) {
                    const bool has_next = (rr < RG - 1) || (t0 + RG < S_len);
                    if (has_next) { na = *(const v4u*)(up + (size_t)(rr + 1) * NUP); ng = *(const v4u*)(up + (size_t)(rr + 1) * NUP + DFF); } else { na = (v4u){0u, 0u, 0u, 0u}; ng = na; }
                    v4u w;
#pragma unroll
                    for (int q = 0; q < 4; ++q) {
                        const float a_lo = wa[0][2 * q] * bflo(pa[q]) + wa[1][2 * q] * bflo(ca[q]) + wa[2][2 * q] * bflo(na[q]) + ba[2 * q];
                        const float a_hi = wa[0][2 * q + 1] * bfhi(pa[q]) + wa[1][2 * q + 1] * bfhi(ca[q]) + wa[2][2 * q + 1] * bfhi(na[q]) + ba[2 * q + 1];
                        const float g_lo = wg[0][2 * q] * bflo(pg[q]) + wg[1][2 * q] * bflo(cgv[q]) + wg[2][2 * q] * bflo(ng[q]) + bg[2 * q];
                        const float g_hi = wg[0][2 * q + 1] * bfhi(pg[q]) + wg[1][2 * q + 1] * bfhi(cgv[q]) + wg[2][2 * q + 1] * bfhi(ng[q]) + bg[2 * q + 1];
                        const float z_lo = -2.302208198f * (g_lo + 0.044715f * g_lo * g_lo * g_lo), z_hi = -2.302208198f * (g_hi + 0.044715f * g_hi * g_hi * g_hi);
                        const float ge_lo = g_lo * __builtin_amdgcn_rcpf(1.0f + __builtin_amdgcn_exp2f(z_lo)), ge_hi = g_hi * __builtin_amdgcn_rcpf(1.0f + __builtin_amdgcn_exp2f(z_hi));
                        w[q] = pk2(a_lo * ge_lo, a_hi * ge_hi);
                    }
                    *(v4u*)(ACT + (size_t)(m0 + rr) * DFF + c8) = w;
                    pa = ca; pg = cgv; ca = na; cgv = ng;
                }
            }
        }
        grid.sync();
    }

    {
        PHASE_PTRS(); bf16* const ACT = (bf16*)(ws + WS_ACT); bf16* const Wdown_t = (bf16*)(ws + WS_WDOWN); bf16* const H2B = (bf16*)(ws + WS_H2B);
        pg8::Gemm g{ACT, Wdown_t, M_ALL, DM, DFF}; pg8::StaticOrder S; S.init(M_ALL, DM, G, bx);
        pg8::EpiRes E{out, out, M_ALL, out, H2B, ssq3};
        pg8::gemm_phase<pg8::EpiRes, pg8::StaticOrder, true, true>(L, g, S, E);
    }
    grid.sync();

    {
        PHASE_PTRS(); bf16* const PB = (bf16*)(ws + WS_PB); bf16* const Wple_t = (bf16*)(ws + WS_WPLE); bf16* const EB = (bf16*)(ws + WS_E);
        pg8::Gemm g{PB, Wple_t, M_ALL, DM, PLE}; pg8::StaticOrder S; S.init(M_ALL, DM, G, bx);
        pg8::EpiBf16Rs E{EB, DM, nullptr};
        pg8::gemm_phase<pg8::EpiBf16Rs, pg8::StaticOrder, true, true>(L, g, S, E);
    }
    grid.sync();

    {
        PHASE_PTRS(); bf16* const H2B = (bf16*)(ws + WS_H2B); bf16* const Wgate_t = (bf16*)(ws + WS_WGATE); bf16* const EB = (bf16*)(ws + WS_E);
        pg8::Gemm g{H2B, Wgate_t, M_ALL, DM, DM}; pg8::StaticOrder S; S.init(M_ALL, DM, G, bx);
        pg8::EpiGate E{out, EB, ssq3, ssq4};
        pg8::gemm_phase<pg8::EpiGate, pg8::StaticOrder, true, true>(L, g, S, E);
    }
    grid.sync();

    {
        PHASE_PTRS();
        const f32x4* fg = (const f32x4*)KIN(20) + lane;
        const f32x4 g0 = fg[0], g1 = fg[64], g2 = fg[128], g3 = fg[192];
        for (int m = gw; m < M_ALL; m += NGW) {
            f32x4* xr = (f32x4*)(out + (size_t)m * DM) + lane;
            const float rs = __builtin_amdgcn_rsqf(ssq4[m] * (1.f / DM) + 1e-6f);
            const f32x4 v0 = xr[0], v1 = xr[64], v2 = xr[128], v3 = xr[192];
            xr[0] = v0 * rs * g0; xr[64] = v1 * rs * g1; xr[128] = v2 * rs * g2; xr[192] = v3 * rs * g3;
        }
    }
}

extern "C" void kernel_launch(void* const* d_in, const int* in_sizes, int n_in, void* d_out, int out_size, void* d_ws, size_t ws_size, hipStream_t stream) {
    static int grid = 0;
    if (grid == 0) {
        if (n_in != 21 || in_sizes[0] != M_PROMPT * DM || out_size != M_ALL * DM || ws_size < WS_END) { fprintf(stderr, "kernel_launch: unexpected shapes (n_in %d, in0 %d, out %d, ws %zu); nothing launched\n", n_in, n_in > 0 ? in_sizes[0] : -1, out_size, ws_size); grid = -1; return; }
        int dev = 0, cus = 0, per_cu = 0;
        if (hipGetDevice(&dev) != hipSuccess || hipDeviceGetAttribute(&cus, hipDeviceAttributeMultiprocessorCount, dev) != hipSuccess) { grid = -1; return; }
        if (hipFuncSetAttribute((const void*)hymba_fwd, hipFuncAttributeMaxDynamicSharedMemorySize, LDS_BYTES) != hipSuccess) { fprintf(stderr, "kernel_launch: hipFuncSetAttribute failed\n"); grid = -1; return; }
        if (hipOccupancyMaxActiveBlocksPerMultiprocessor(&per_cu, (const void*)hymba_fwd, NWAVES * 64, LDS_BYTES) != hipSuccess || per_cu < 1) { fprintf(stderr, "kernel_launch: occupancy query says %d blocks per CU\n", per_cu); (void)hipGetLastError(); }
        grid = cus;
    }
    if (grid < 0) return;
    Args a{};
    for (int i = 0; i < 21; ++i) a.in[i] = (const float*)d_in[i];
    a.out = (float*)d_out; a.ws = (unsigned char*)d_ws;
    void* kargs[] = {&a};
    const hipError_t e = hipLaunchCooperativeKernel((const void*)hymba_fwd, dim3(grid), dim3(NWAVES * 64), kargs, LDS_BYTES, stream);
    if (e != hipSuccess) fprintf(stderr, "kernel_launch: cooperative launch failed: %s (grid %d)\n", hipGetErrorString(e), grid);
}
```

```cpp
#include <hip/hip_cooperative_groups.h>
#include <hip/hip_runtime.h>
#include <cstdio>
#include <cstdint>
namespace pg8 {
#define PG8_LAS __attribute__((address_space(3)))
typedef unsigned short bf16_t;
typedef short bf16x8 __attribute__((ext_vector_type(8)));
typedef float f32x4 __attribute__((ext_vector_type(4)));
typedef unsigned u32x4 __attribute__((ext_vector_type(4)));
constexpr int BM = 256, BK = 64, HALF = 128, HTB = HALF * BK * 2  , STAGE_BYTES = 8 * HTB, NXCD = 8, WGM = 8;

__host__ __device__ __forceinline__ int lds_byte(int r, int c) { const int st = (r >> 4) * 2 + (c >> 5), rr = r & 15, cc = c & 31, ob = rr * 64 + cc * 2; return st * 1024 + (ob ^ (((ob >> 9) & 1) << 5)); }
__host__ __device__ __forceinline__ void stage_rc(int b, int& R, int& C) { const int st = b / 1024, sb = b % 1024, swz = sb ^ (((sb >> 9) & 1) << 5); R = (st >> 1) * 16 + swz / 64; C = (st & 1) * 32 + (swz % 64) / 2; }
__host__ __device__ __forceinline__ int perm32(int rho) { const int n = rho >> 4, i = rho & 15; return 8 * (i >> 2) + 4 * n + (i & 3); }

struct Unit { int pm, pn; };
struct Gemm { const bf16_t* A; const bf16_t* Bt; int M, N, K; };

struct StaticOrder {
    int nM, nN, nwg, G, c;
    __host__ __device__ void init(int M, int N, int G_, int c_) { nM = M / BM; nN = N / BM; nwg = nM * nN; G = G_; c = c_; }
    __host__ __device__ bool next(int i, Unit& u) const {
        const long L = (long)i * G + c; if (L >= nwg) return false;
        int wgid = (int)L; { const int q = nwg / NXCD, r = nwg % NXCD, xcd = wgid % NXCD, off = wgid / NXCD; wgid = (xcd < r ? xcd * (q + 1) : r * (q + 1) + (xcd - r) * q) + off; }
        const int nig = WGM * nN, gid = wgid / nig, fm = gid * WGM, gsz = (nM - fm) < WGM ? (nM - fm) : WGM;
        u.pm = fm + ((wgid % nig) % gsz); u.pn = (wgid % nig) / gsz; return true;
    }
    __device__ __forceinline__ void a_ready(const Unit&) const {}
    __device__ __forceinline__ void done(const Unit&) const {}
};

__device__ __forceinline__ unsigned cvt_pk_bf16(float lo, float hi) { unsigned r; asm volatile("v_cvt_pk_bf16_f32 %0, %1, %2" : "=v"(r) : "v"(lo), "v"(hi)); return r; }
typedef float f32x2 __attribute__((ext_vector_type(2)));
__device__ __forceinline__ f32x2 gelu_pk(f32x2 v) {
    const f32x2 av = __builtin_elementwise_abs(v), d = av * 0.2316418882f + 1.0f;
    f32x2 t; t.x = __builtin_amdgcn_rcpf(d.x); t.y = __builtin_amdgcn_rcpf(d.y);
    f32x2 q = t * 0.5307027145f + (-0.7265760135f); q = q * t + 0.7107068705f; q = q * t + (-0.142248368f); q = q * t + 0.127414796f; q = q * t;
    const f32x2 s = (v * v) * (-0.72134752044f);
    f32x2 e; e.x = __builtin_amdgcn_exp2f(s.x); e.y = __builtin_amdgcn_exp2f(s.y);
    const f32x2 m = v * (q * e), r = v - m;
    f32x2 o; o.x = v.x < 0.f ? m.x : r.x; o.y = v.y < 0.f ? m.y : r.y; return o;
}

template <int ACT  > struct EpiBf16 {
    static constexpr bool PERM = true, AFTER_DRAIN = false, MIDSCALE = false; static_assert(ACT == 0 || ACT == 1, "EpiBf16: ACT is 0 (none) or 1 (gelu_pk)");
    bf16_t* O; int ldc; const float* bias; int split_cols; size_t split_stride; float scale0;
    __device__ __forceinline__ void operator()(const f32x4 (&acc)[2][2][4][2], const Unit& u, int wr, int wc, int fr, int fq) const {
        const int row0 = u.pm * BM + wr * 64 + fr; int colt = u.pn * BM; bf16_t* base = O;
        float sc = 1.f; if (split_cols) { const int t = colt / split_cols; base += (size_t)t * split_stride; colt -= t * split_cols; if (t == 0) sc = scale0; }
        const int col0 = colt + wc * 32 + 8 * fq, bcol0 = u.pn * BM + wc * 32 + 8 * fq;
        f32x4 bv[2][2];
#pragma unroll
        for (int bj = 0; bj < 2; ++bj)
#pragma unroll
            for (int n = 0; n < 2; ++n) bv[bj][n] = bias ? *(const f32x4*)(bias + bcol0 + bj * HALF + 4 * n) : (f32x4){0.f, 0.f, 0.f, 0.f};
#pragma unroll
        for (int ai = 0; ai < 2; ++ai)
#pragma unroll
            for (int m = 0; m < 4; ++m) { bf16_t* rowp = base + (size_t)(row0 + ai * HALF + m * 16) * ldc + col0;
#pragma unroll
                for (int bj = 0; bj < 2; ++bj) { f32x4 v0 = acc[ai][bj][m][0] + bv[bj][0], v1 = acc[ai][bj][m][1] + bv[bj][1];
                    if (ACT == 1) { f32x2 a = gelu_pk((f32x2){v0[0], v0[1]}), b = gelu_pk((f32x2){v0[2], v0[3]}), c = gelu_pk((f32x2){v1[0], v1[1]}), d = gelu_pk((f32x2){v1[2], v1[3]});
                        v0 = (f32x4){a.x, a.y, b.x, b.y}; v1 = (f32x4){c.x, c.y, d.x, d.y}; }
                    v0 = v0 * sc; v1 = v1 * sc; u32x4 w; w.x = cvt_pk_bf16(v0[0], v0[1]); w.y = cvt_pk_bf16(v0[2], v0[3]); w.z = cvt_pk_bf16(v1[0], v1[1]); w.w = cvt_pk_bf16(v1[2], v1[3]);
                    *(u32x4*)(rowp + bj * HALF) = w; } }
    }
};
constexpr float RMS_EPS = 1e-6f;
__device__ __forceinline__ float f32_atomic_add(float* p, float v) { return __hip_atomic_fetch_add(p, v, __ATOMIC_RELAXED, __HIP_MEMORY_SCOPE_AGENT); }
__device__ __forceinline__ float bf_lo(unsigned w) { return __uint_as_float(w << 16); }
__device__ __forceinline__ float bf_hi(unsigned w) { return __uint_as_float(w & 0xffff0000u); }
__device__ __forceinline__ float sumsq8(const f32x4& v0, const f32x4& v1) { return (v0[0] * v0[0] + v0[1] * v0[1]) + (v0[2] * v0[2] + v0[3] * v0[3]) + (v1[0] * v1[0] + v1[1] * v1[1]) + (v1[2] * v1[2] + v1[3] * v1[3]); }
__device__ __forceinline__ u32x4 pack8(const f32x4& v0, const f32x4& v1) { u32x4 w; w.x = cvt_pk_bf16(v0[0], v0[1]); w.y = cvt_pk_bf16(v0[2], v0[3]); w.z = cvt_pk_bf16(v1[0], v1[1]); w.w = cvt_pk_bf16(v1[2], v1[3]); return w; }
struct EpiBf16Rs {
    static constexpr bool PERM = true, AFTER_DRAIN = false, MIDSCALE = false;
    bf16_t* O; int ldc; const float* ssq;
    __device__ __forceinline__ void operator()(const f32x4 (&acc)[2][2][4][2], const Unit& u, int wr, int wc, int fr, int fq) const {
        const int row0 = u.pm * BM + wr * 64 + fr, col0 = u.pn * BM + wc * 32 + 8 * fq;
#pragma unroll
        for (int ai = 0; ai < 2; ++ai)
#pragma unroll
            for (int m = 0; m < 4; ++m) { const int row = row0 + ai * HALF + m * 16; bf16_t* rowp = O + (size_t)row * ldc + col0;
                const float rs = ssq ? __builtin_amdgcn_rsqf(ssq[row] * (1.0f / 1024.0f) + RMS_EPS) : 1.0f;
#pragma unroll
                for (int bj = 0; bj < 2; ++bj) *(u32x4*)(rowp + bj * HALF) = pack8(acc[ai][bj][m][0] * rs, acc[ai][bj][m][1] * rs); }
    }
};
struct EpiOutProj {
    static constexpr bool PERM = true, AFTER_DRAIN = false, MIDSCALE = true;
    const float* base0; const float* base1; int split;
    bf16_t* hb; float* ssq; const float* ssqA; const float* ssqB;
    __device__ __forceinline__ void prep(PG8_LAS unsigned char* lds, int tid, const Unit& u, int wr, int fr) const {
        const int row0 = u.pm * BM + wr * 64 + fr; PG8_LAS f32x4* slot = (PG8_LAS f32x4*)(lds + STAGE_BYTES) + tid * 2;
#pragma unroll
        for (int ai = 0; ai < 2; ++ai) { f32x4 q;
#pragma unroll
            for (int m = 0; m < 4; ++m) { const int row = row0 + ai * HALF + m * 16;
                q[m] = __builtin_amdgcn_rsqf(ssqA[row] * (1.0f / 512.0f) + RMS_EPS) * __builtin_amdgcn_sqrtf(ssqB[row] * (1.0f / 512.0f) + RMS_EPS); }
            slot[ai] = q; }
    }
    __device__ __forceinline__ void midscale(f32x4 (&acc)[2][2][4][2], PG8_LAS unsigned char* lds, int tid) const {
        const PG8_LAS f32x4* slot = (const PG8_LAS f32x4*)(lds + STAGE_BYTES) + tid * 2;
#pragma unroll
        for (int ai = 0; ai < 2; ++ai) { const f32x4 q = slot[ai];
#pragma unroll
            for (int bj = 0; bj < 2; ++bj)
#pragma unroll
                for (int m = 0; m < 4; ++m)
#pragma unroll
                    for (int n = 0; n < 2; ++n) acc[ai][bj][m][n] *= q[m]; }
    }
    __device__ __forceinline__ void operator()(const f32x4 (&acc)[2][2][4][2], const Unit& u, int wr, int wc, int fr, int fq) const {
        const int row0 = u.pm * BM + wr * 64 + fr, col0 = u.pn * BM + wc * 32 + 8 * fq;
#pragma unroll
        for (int ai = 0; ai < 2; ++ai)
#pragma unroll
            for (int m = 0; m < 4; ++m) { const int row = row0 + ai * HALF + m * 16;
                const float* bp = (row < split ? base0 + (size_t)row * 1024 : base1 + (size_t)(row - split) * 1024) + col0;
                bf16_t* hp = hb + (size_t)row * 1024 + col0; float s = 0.f;
                const float rb = __builtin_amdgcn_rsqf(ssqB[row] * (1.0f / 512.0f) + RMS_EPS);
#pragma unroll
                for (int bj = 0; bj < 2; ++bj) { const f32x4 b0 = *(const f32x4*)(bp + bj * HALF), b1 = *(const f32x4*)(bp + bj * HALF + 4);
                    const f32x4 v0 = acc[ai][bj][m][0] * rb + b0, v1 = acc[ai][bj][m][1] * rb + b1;
                    *(u32x4*)(hp + bj * HALF) = pack8(v0, v1); s += sumsq8(v0, v1); }
                s += __shfl_xor(s, 16); s += __shfl_xor(s, 32);
                if (fq == 0) f32_atomic_add(ssq + row, s); }
    }
};
struct EpiResB {
    static constexpr bool PERM = true, AFTER_DRAIN = false, MIDSCALE = false;
    const bf16_t* hin; bf16_t* hout; float* ssq;
    __device__ __forceinline__ void operator()(const f32x4 (&acc)[2][2][4][2], const Unit& u, int wr, int wc, int fr, int fq) const {
        const int row0 = u.pm * BM + wr * 64 + fr, col0 = u.pn * BM + wc * 32 + 8 * fq;
#pragma unroll
        for (int ai = 0; ai < 2; ++ai)
#pragma unroll
            for (int m = 0; m < 4; ++m) { const int row = row0 + ai * HALF + m * 16;
                const bf16_t* bp = hin + (size_t)row * 1024 + col0; bf16_t* hp = hout + (size_t)row * 1024 + col0; float s = 0.f;
#pragma unroll
                for (int bj = 0; bj < 2; ++bj) { const u32x4 bw = *(const u32x4*)(bp + bj * HALF);
                    const f32x4 v0 = acc[ai][bj][m][0] + (f32x4){bf_lo(bw.x), bf_hi(bw.x), bf_lo(bw.y), bf_hi(bw.y)}, v1 = acc[ai][bj][m][1] + (f32x4){bf_lo(bw.z), bf_hi(bw.z), bf_lo(bw.w), bf_hi(bw.w)};
                    *(u32x4*)(hp + bj * HALF) = pack8(v0, v1); s += sumsq8(v0, v1); }
                s += __shfl_xor(s, 16); s += __shfl_xor(s, 32);
                if (fq == 0) f32_atomic_add(ssq + row, s); }
    }
};
struct EpiGate {
    static constexpr bool PERM = true, AFTER_DRAIN = false, MIDSCALE = false;
    const bf16_t* hin; const bf16_t* E; bf16_t* hout; const float* ssq_in; float* ssq_out;
    __device__ __forceinline__ void operator()(const f32x4 (&acc)[2][2][4][2], const Unit& u, int wr, int wc, int fr, int fq) const {
        const int row0 = u.pm * BM + wr * 64 + fr, col0 = u.pn * BM + wc * 32 + 8 * fq;
#pragma unroll
        for (int ai = 0; ai < 2; ++ai)
#pragma unroll
            for (int m = 0; m < 4; ++m) { const int row = row0 + ai * HALF + m * 16;
                const bf16_t* bp = hin + (size_t)row * 1024 + col0; const bf16_t* ep = E + (size_t)row * 1024 + col0; bf16_t* hp = hout + (size_t)row * 1024 + col0; float s = 0.f;
                const float rs = __builtin_amdgcn_rsqf(ssq_in[row] * (1.0f / 1024.0f) + RMS_EPS) * -1.4426950408889634f;
#pragma unroll
                for (int bj = 0; bj < 2; ++bj) { const u32x4 bw = *(const u32x4*)(bp + bj * HALF), ew = *(const u32x4*)(ep + bj * HALF);
                    const f32x4 b0 = (f32x4){bf_lo(bw.x), bf_hi(bw.x), bf_lo(bw.y), bf_hi(bw.y)}, b1 = (f32x4){bf_lo(bw.z), bf_hi(bw.z), bf_lo(bw.w), bf_hi(bw.w)};
                    const f32x4 e0 = (f32x4){bf_lo(ew.x), bf_hi(ew.x), bf_lo(ew.y), bf_hi(ew.y)}, e1 = (f32x4){bf_lo(ew.z), bf_hi(ew.z), bf_lo(ew.w), bf_hi(ew.w)};
                    f32x4 v0, v1;
#pragma unroll
                    for (int k = 0; k < 4; ++k) { const float g0 = __builtin_amdgcn_rcpf(1.0f + __builtin_amdgcn_exp2f(acc[ai][bj][m][0][k] * rs)), g1 = __builtin_amdgcn_rcpf(1.0f + __builtin_amdgcn_exp2f(acc[ai][bj][m][1][k] * rs));
                        v0[k] = b0[k] + g0 * e0[k]; v1[k] = b1[k] + g1 * e1[k]; }
                    *(u32x4*)(hp + bj * HALF) = pack8(v0, v1); s += sumsq8(v0, v1); }
                s += __shfl_xor(s, 16); s += __shfl_xor(s, 32);
                if (fq == 0) f32_atomic_add(ssq_out + row, s); }
    }
};

template <class Epi, class Sched, bool ALIGN_EPI = false, bool SP2 = false>
__device__ __forceinline__ void gemm_phase(PG8_LAS unsigned char* lds, const Gemm g, const Sched& S, const Epi& E) {
    int tid = threadIdx.x; asm volatile("" : "+v"(tid));
    const int wid = __builtin_amdgcn_readfirstlane(tid >> 6), lane = tid & 63, wr = wid >> 2, wc = wid & 3, fr = lane & 15, fq = lane >> 4;
    const int K = g.K, nt = K / BK;
    unsigned voffA[2], voffB[2];
#pragma unroll
    for (int i = 0; i < 2; ++i) { int R, C; stage_rc(tid * 16 + i * 8192, R, C); const int Rb = Epi::PERM ? ((R & ~31) + perm32(R & 31)) : R;
        voffA[i] = (unsigned)(R * K + C) * 2u; voffB[i] = (unsigned)(Rb * K + C) * 2u; }
    const size_t kstep = (size_t)(BK * 2);
    const size_t hstep = (size_t)HALF * K * 2;
    const size_t tstep = 2 * hstep;
    const unsigned ldsw = (unsigned)wid * 1024u;
    const int aoff = lds_byte(wr * 64 + fr, fq * 8), boff = lds_byte(wc * 32 + fr, fq * 8);
#define PG8_SA(b, h) (((b) * 2 + (h)) * HTB)
#define PG8_SB(b, h) ((4 + (b) * 2 + (h)) * HTB)
#define PG8_STAGE(bufoff, gbase, voff) do { _Pragma("unroll") for (int _i = 0; _i < 2; ++_i) \
        __builtin_amdgcn_global_load_lds((const unsigned*)((const char*)(gbase) + (voff)[_i]), (PG8_LAS unsigned*)(lds + (bufoff) + ldsw + _i * 8192), 16, 0, 0); } while (0)
#define PG8_LDA(dst, b, h) do { _Pragma("unroll") for (int m = 0; m < 4; ++m) _Pragma("unroll") for (int k = 0; k < 2; ++k) dst[m][k] = *(const PG8_LAS bf16x8*)(lds + PG8_SA(b, h) + aoff + m * 2048 + k * 1024); } while (0)
#define PG8_LDB(dst, b, h) do { _Pragma("unroll") for (int n = 0; n < 2; ++n) _Pragma("unroll") for (int k = 0; k < 2; ++k) dst[n][k] = *(const PG8_LAS bf16x8*)(lds + PG8_SB(b, h) + boff + n * 2048 + k * 1024); } while (0)
#define PG8_MMA(ai, bj, At, Bt) do { __builtin_amdgcn_s_setprio(1); _Pragma("unroll") for (int m = 0; m < 4; ++m) _Pragma("unroll") for (int n = 0; n < 2; ++n) _Pragma("unroll") for (int k = 0; k < 2; ++k) \
        acc[ai][bj][m][n] = __builtin_amdgcn_mfma_f32_16x16x32_bf16(Bt[n][k], At[m][k], acc[ai][bj][m][n], 0, 0, 0); __builtin_amdgcn_s_setprio(0); } while (0)
#define PG8_WAIT_V(n) asm volatile("s_waitcnt vmcnt(" #n ")" ::: "memory")
#define PG8_WAIT_L(n) asm volatile("s_waitcnt lgkmcnt(" #n ")" ::: "memory")
#define PG8_BAR __builtin_amdgcn_s_barrier()
#define PG8_SCHED __builtin_amdgcn_sched_barrier(0)
    Unit cur, nxt; int ui = 0;
    if (!S.next(0, cur)) return;
    f32x4 acc[2][2][4][2];
#pragma unroll
    for (int a = 0; a < 2; ++a)
#pragma unroll
        for (int b = 0; b < 2; ++b)
#pragma unroll
            for (int m = 0; m < 4; ++m)
#pragma unroll
                for (int n = 0; n < 2; ++n) acc[a][b][m][n] = (f32x4){0.f, 0.f, 0.f, 0.f};
    bf16x8 At[4][2], B0[2][2], B1[2][2];
    const char* cA = (const char*)g.A + (size_t)cur.pm * tstep; const char* cB = (const char*)g.Bt + (size_t)cur.pn * tstep;
    S.a_ready(cur);
    if constexpr (Epi::MIDSCALE) E.prep(lds, tid, cur, wr, fr);
    if constexpr (SP2) {
        PG8_STAGE(PG8_SB(0, 0), cB, voffB); PG8_STAGE(PG8_SB(0, 1), cB + hstep, voffB); PG8_STAGE(PG8_SA(0, 0), cA, voffA); PG8_STAGE(PG8_SA(0, 1), cA + hstep, voffA);
        if (wr == 1) PG8_BAR;
        PG8_WAIT_V(2); PG8_BAR;
        PG8_STAGE(PG8_SB(1, 0), cB + kstep, voffB); PG8_STAGE(PG8_SA(1, 0), cA + kstep, voffA); PG8_STAGE(PG8_SB(1, 1), cB + hstep + kstep, voffB);
        PG8_WAIT_V(6); PG8_BAR;
    } else {
        PG8_STAGE(PG8_SB(0, 0), cB, voffB); PG8_STAGE(PG8_SA(0, 0), cA, voffA); PG8_STAGE(PG8_SB(0, 1), cB + hstep, voffB); PG8_STAGE(PG8_SA(0, 1), cA + hstep, voffA);
        if (wr == 1) PG8_BAR;
        PG8_WAIT_V(4); PG8_BAR;
        PG8_STAGE(PG8_SB(1, 0), cB + kstep, voffB); PG8_STAGE(PG8_SA(1, 0), cA + kstep, voffA); PG8_STAGE(PG8_SB(1, 1), cB + hstep + kstep, voffB);
        PG8_WAIT_V(6); PG8_BAR;
    }
    for (;;) {
        const bool has_next = S.next(ui + 1, nxt);
        const char* nA = has_next ? (const char*)g.A + (size_t)nxt.pm * tstep : cA; const char* nB = has_next ? (const char*)g.Bt + (size_t)nxt.pn * tstep : cB;
        for (int t = 0; t < nt; t += 2) {
            if constexpr (Epi::MIDSCALE) { if (t == (nt >> 1)) E.midscale(acc, lds, tid); }
            const bool last = (t == nt - 2);
            const char* a1 = cA + (size_t)(t + 1) * kstep;
            const char* a2 = last ? nA : cA + (size_t)(t + 2) * kstep; const char* b2 = last ? nB : cB + (size_t)(t + 2) * kstep;
            const char* a3 = a2 + kstep; const char* b3 = b2 + kstep;
            if (last && has_next) S.a_ready(nxt);
            if constexpr (SP2) {
            PG8_LDB(B0, 0, 0); PG8_LDB(B1, 0, 1); PG8_SCHED; PG8_LDA(At, 0, 0); PG8_STAGE(PG8_SA(1, 1), a1 + hstep, voffA);
            PG8_WAIT_V(8); PG8_WAIT_L(0); PG8_BAR; PG8_MMA(0, 0, At, B0); PG8_MMA(0, 1, At, B1); PG8_BAR; PG8_SCHED;
            PG8_LDA(At, 0, 1); PG8_STAGE(PG8_SB(0, 0), b2, voffB); PG8_STAGE(PG8_SB(0, 1), b2 + hstep, voffB); PG8_STAGE(PG8_SA(0, 0), a2, voffA);
            PG8_WAIT_V(8); PG8_WAIT_L(0); PG8_BAR; PG8_MMA(1, 0, At, B0); PG8_MMA(1, 1, At, B1); PG8_BAR; PG8_SCHED;
            PG8_LDB(B0, 1, 0); PG8_LDB(B1, 1, 1); PG8_SCHED; PG8_LDA(At, 1, 0); PG8_STAGE(PG8_SA(0, 1), a2 + hstep, voffA);
            PG8_WAIT_V(8); PG8_WAIT_L(0); PG8_BAR; PG8_MMA(0, 0, At, B0); PG8_MMA(0, 1, At, B1); PG8_BAR; PG8_SCHED;
            PG8_LDA(At, 1, 1); PG8_STAGE(PG8_SB(1, 0), b3, voffB); PG8_STAGE(PG8_SB(1, 1), b3 + hstep, voffB); PG8_STAGE(PG8_SA(1, 0), a3, voffA);
            PG8_WAIT_V(8); PG8_WAIT_L(0); PG8_BAR; PG8_MMA(1, 0, At, B0); PG8_MMA(1, 1, At, B1); PG8_BAR; PG8_SCHED;
            } else {
            PG8_LDB(B0, 0, 0); PG8_SCHED; PG8_LDA(At, 0, 0); PG8_STAGE(PG8_SA(1, 1), a1 + hstep, voffA);
            PG8_WAIT_L(8); PG8_BAR; PG8_WAIT_L(0); PG8_MMA(0, 0, At, B0); PG8_BAR; PG8_SCHED;
            PG8_LDB(B1, 0, 1); PG8_STAGE(PG8_SB(0, 0), b2, voffB);
            PG8_BAR; PG8_WAIT_L(0); PG8_MMA(0, 1, At, B1); PG8_BAR;
            PG8_LDA(At, 0, 1); PG8_STAGE(PG8_SA(0, 0), a2, voffA);
            PG8_BAR; PG8_WAIT_L(0); PG8_MMA(1, 0, At, B0); PG8_BAR; PG8_SCHED;
            PG8_STAGE(PG8_SB(0, 1), b2 + hstep, voffB);
            PG8_WAIT_V(6); PG8_BAR; PG8_MMA(1, 1, At, B1); PG8_BAR;
            PG8_LDB(B0, 1, 0); PG8_SCHED; PG8_LDA(At, 1, 0); PG8_STAGE(PG8_SA(0, 1), a2 + hstep, voffA);
            PG8_WAIT_L(8); PG8_BAR; PG8_WAIT_L(0); PG8_MMA(0, 0, At, B0); PG8_BAR; PG8_SCHED;
            PG8_LDB(B1, 1, 1); PG8_STAGE(PG8_SB(1, 0), b3, voffB);
            PG8_BAR; PG8_WAIT_L(0); PG8_MMA(0, 1, At, B1); PG8_BAR;
            PG8_LDA(At, 1, 1); PG8_STAGE(PG8_SA(1, 0), a3, voffA);
            PG8_BAR; PG8_WAIT_L(0); PG8_MMA(1, 0, At, B0); PG8_BAR; PG8_SCHED;
            PG8_STAGE(PG8_SB(1, 1), b3 + hstep, voffB);
            PG8_WAIT_V(6); PG8_BAR; PG8_MMA(1, 1, At, B1); PG8_BAR;
            }
        }
        if constexpr (ALIGN_EPI) { if (wr == 0) PG8_BAR; }
        if constexpr (!Epi::AFTER_DRAIN) { E(acc, cur, wr, wc, fr, fq); S.done(cur); }
        if (!has_next) break;
#pragma unroll
        for (int a = 0; a < 2; ++a)
#pragma unroll
            for (int b = 0; b < 2; ++b)
#pragma unroll
                for (int m = 0; m < 4; ++m)
#pragma unroll
                    for (int n = 0; n < 2; ++n) acc[a][b][m][n] = (f32x4){0.f, 0.f, 0.f, 0.f};
        cur = nxt; cA = nA; cB = nB; ++ui;
        if constexpr (Epi::MIDSCALE) E.prep(lds, tid, cur, wr, fr);
        if constexpr (ALIGN_EPI) { if (wr == 1) PG8_BAR; }
    }
    PG8_WAIT_V(0);
    if constexpr (!ALIGN_EPI) { if (wr == 0) PG8_BAR; }
    PG8_BAR;
    if constexpr (Epi::AFTER_DRAIN) { E.fused(acc, cur, wr, wc, fr, fq, lds, wid, lane); S.done(cur); }
#undef PG8_SA
#undef PG8_SB
#undef PG8_STAGE
#undef PG8_LDA
#undef PG8_LDB
#undef PG8_MMA
#undef PG8_WAIT_V
#undef PG8_WAIT_L
#undef PG8_BAR
#undef PG8_SCHED
}
}
#include <hip/hip_bf16.h>
#include <cmath>
namespace attn_body {
using bf16=__hip_bfloat16;
using bf16x8=__attribute__((ext_vector_type(8)))short;
using s16x4=__attribute__((ext_vector_type(4)))short;
using f32x16=__attribute__((ext_vector_type(16)))float;
using u32x4=__attribute__((ext_vector_type(4)))unsigned;
constexpr int D=64,PQ=2304,PO=1024;
constexpr int NW=8,QBLK=32,QB=QBLK*NW,KVBLK=64;
__device__ __forceinline__ int crow(int r,int hi){return (r&3)+8*(r>>2)+4*hi;}
#define SBAR() __builtin_amdgcn_sched_barrier(0)
__device__ __forceinline__ void cmask(f32x16&p0,f32x16&p1,int jb,int qrel,int hi){
  const float NEG=-INFINITY; int kb=64*jb+4*hi;
  #pragma unroll
  for(int r=0;r<16;++r){int kv=kb+(r&3)+8*(r>>2); if(kv>qrel)p0[r]=NEG; if(kv+32>qrel)p1[r]=NEG;}
}

constexpr int NSLOT=3, SLOTB=8192;
constexpr int LDS_K=0, LDS_V=NSLOT*SLOTB, LDS_WS=2*NSLOT*SLOTB, LDS_OST=LDS_WS+NW*64*4, LDS_BYTES=LDS_OST+NW*4096;
constexpr float C2=0.125f*1.4426950408889634f;
__device__ __forceinline__ void glds16(const void*gsrc,unsigned lds_dst){unsigned keep;
  asm volatile("s_mov_b32 %0, m0\n\ts_mov_b32 m0, %2\n\ts_nop 0\n\tglobal_load_lds_dwordx4 %1, off\n\ts_mov_b32 m0, %0":"=&s"(keep):"v"(gsrc),"s"(lds_dst):"memory");}
__device__ __forceinline__ float max3f(float a,float b,float c){float r;asm("v_max3_f32 %0, %1, %2, %3":"=v"(r):"v"(a),"v"(b),"v"(c));return r;}
__device__ __forceinline__ float max2f(float a,float b){float r;asm("v_max_f32_e32 %0, %1, %2":"=v"(r):"v"(a),"v"(b));return r;}
__device__ __forceinline__ float fadd_s(float a,float b){float r;asm("v_add_f32_e32 %0, %1, %2":"=v"(r):"v"(a),"v"(b));return r;}
__device__ __forceinline__ float fsub_s(float a,float b){float r;asm("v_sub_f32_e32 %0, %1, %2":"=v"(r):"v"(a),"v"(b));return r;}
typedef float f32x2_t __attribute__((ext_vector_type(2))); typedef __bf16 bf16x2_t __attribute__((ext_vector_type(2)));
__device__ __forceinline__ unsigned cvtpk_s(float lo,float hi){f32x2_t v={lo,hi};bf16x2_t b=__builtin_convertvector(v,bf16x2_t);return __builtin_bit_cast(unsigned,b);}
#define WAIT_BAR(N) asm volatile("s_waitcnt vmcnt(" #N ") lgkmcnt(0)\n\ts_barrier":::"memory")

__device__ __forceinline__ void qkt(f32x16&p0,f32x16&p1,const char*Kslot,const bf16x8*qr,const f32x16&negm,int r32,int hi){
  const char*kb=Kslot+hi*1024+r32*16;
  #pragma unroll
  for(int d0=0;d0<4;++d0){
    const bf16x8 b0=*reinterpret_cast<const bf16x8*>(kb+d0*2048);
    const bf16x8 b1=*reinterpret_cast<const bf16x8*>(kb+d0*2048+512);
    if(d0==0){p0=__builtin_amdgcn_mfma_f32_32x32x16_bf16(b0,qr[0],negm,0,0,0);p1=__builtin_amdgcn_mfma_f32_32x32x16_bf16(b1,qr[0],negm,0,0,0);}
    else{p0=__builtin_amdgcn_mfma_f32_32x32x16_bf16(b0,qr[d0],p0,0,0,0);p1=__builtin_amdgcn_mfma_f32_32x32x16_bf16(b1,qr[d0],p1,0,0,0);}}
}
typedef __attribute__((address_space(3))) const char* lds_cptr;
typedef short v4i16_t __attribute__((ext_vector_type(4)));
__device__ __forceinline__ void kload8(bf16x8*kf,lds_cptr kp){
  kf[0]=*(const __attribute__((address_space(3))) bf16x8*)(kp);      kf[1]=*(const __attribute__((address_space(3))) bf16x8*)(kp+512);
  kf[2]=*(const __attribute__((address_space(3))) bf16x8*)(kp+2048); kf[3]=*(const __attribute__((address_space(3))) bf16x8*)(kp+2560);
  kf[4]=*(const __attribute__((address_space(3))) bf16x8*)(kp+4096); kf[5]=*(const __attribute__((address_space(3))) bf16x8*)(kp+4608);
  kf[6]=*(const __attribute__((address_space(3))) bf16x8*)(kp+6144); kf[7]=*(const __attribute__((address_space(3))) bf16x8*)(kp+6656);
}
__device__ __forceinline__ void kload2(bf16x8*kf,lds_cptr kp,int j){ kf[2*j]=*(const __attribute__((address_space(3))) bf16x8*)(kp+j*2048); kf[2*j+1]=*(const __attribute__((address_space(3))) bf16x8*)(kp+j*2048+512); }
__device__ __forceinline__ s16x4 vtr(lds_cptr p){ return __builtin_bit_cast(s16x4,__builtin_amdgcn_ds_read_tr16_b64_v4i16((__attribute__((address_space(3))) v4i16_t*)p)); }
__device__ __forceinline__ float rowmax(const f32x16&p0,const f32x16&p1){
  float a=max3f(p0[0],p0[1],p1[0]),b=max3f(p0[2],p0[3],p1[1]);a=max3f(a,p1[2],p1[3]);
  #pragma unroll
  for(int r=4;r<16;r+=4){a=max3f(a,p0[r],p0[r+1]);b=max3f(b,p0[r+2],p0[r+3]);a=max3f(a,p1[r],p1[r+1]);b=max3f(b,p1[r+2],p1[r+3]);}
  const float m=max2f(a,b);
  auto rr=__builtin_amdgcn_permlane32_swap(__float_as_uint(m),__float_as_uint(m),false,false);
  return max2f(__uint_as_float(rr[0]),__uint_as_float(rr[1]));
}
__device__ __forceinline__ void pv(f32x16*o,int vb,bf16x8 pa0,bf16x8 pa1,bf16x8 pa2,bf16x8 pa3){
  #pragma unroll
  for(int d0=0;d0<2;++d0){s16x4 lo[4],hi[4];
    #pragma unroll
    for(int ks=0;ks<4;++ks){
      asm volatile("ds_read_b64_tr_b16 %0,%1 offset:%c2":"=&v"(lo[ks]):"v"(vb),"i"(d0*4096+ks*1024):"memory");
      asm volatile("ds_read_b64_tr_b16 %0,%1 offset:%c2":"=&v"(hi[ks]):"v"(vb),"i"(d0*4096+ks*1024+512):"memory");}
    asm volatile("s_waitcnt lgkmcnt(0)":::"memory");SBAR();
    #define PK(k) (bf16x8){lo[k][0],lo[k][1],lo[k][2],lo[k][3],hi[k][0],hi[k][1],hi[k][2],hi[k][3]}
    o[d0]=__builtin_amdgcn_mfma_f32_32x32x16_bf16(pa0,PK(0),o[d0],0,0,0);
    o[d0]=__builtin_amdgcn_mfma_f32_32x32x16_bf16(pa1,PK(1),o[d0],0,0,0);
    o[d0]=__builtin_amdgcn_mfma_f32_32x32x16_bf16(pa2,PK(2),o[d0],0,0,0);
    o[d0]=__builtin_amdgcn_mfma_f32_32x32x16_bf16(pa3,PK(3),o[d0],0,0,0);
    #undef PK
  }
}

#ifndef ATTN_STORE16
#define ATTN_STORE16(p,v) (*(u32x4*)(p)=(v))
#endif
template<int THRL> __device__ __forceinline__ void attn_unit(long rowbase,int NT,int h,int kvh,int qb,const bf16*Q,const bf16*__restrict__ K,const bf16*__restrict__ V,bf16*O,float*ssq,char*shm){
  int tid=threadIdx.x; asm volatile("":"+v"(tid)); const int lane=tid&63,r32=lane&31,hi=lane>>5; const int wid=__builtin_amdgcn_readfirstlane(tid>>6);
  const int q0=qb*QB;
  const bf16*Qw=Q+(rowbase+q0+wid*QBLK)*PQ+h*D;
  const bf16*Kh=K+rowbase*PQ+kvh*D,*Vh=V+rowbase*PQ+kvh*D;
  const unsigned lds0=(unsigned)(uintptr_t)shm;
  float*wsf=(float*)(shm+LDS_WS)+wid*64;
  const bf16*ksrc=Kh+(long)lane*PQ+wid*8;
  const bf16*vsrc=Vh+(long)(16*(wid&3)+(lane>>2))*PQ+(wid>>2)*32+(lane&3)*8;
  const unsigned kdst=lds0+LDS_K+wid*1024, vdst=lds0+LDS_V+wid*1024;
  #define DMA_K(t,slot) glds16(ksrc+(long)(t)*KVBLK*PQ,(unsigned)__builtin_amdgcn_readfirstlane(kdst+(slot)))
  #define DMA_V(t,slot) glds16(vsrc+(long)(t)*KVBLK*PQ,(unsigned)__builtin_amdgcn_readfirstlane(vdst+(slot)))
  const int vb0=(int)(lds0+LDS_V)+((lane>>4)&1)*32+(lane&3)*8+(4*hi+((lane&15)>>2))*64;
  const char*Kbase=shm+LDS_K; bf16x8 kf[8];
  const lds_cptr shm3=(lds_cptr)shm; const lds_cptr kp0=shm3+LDS_K+hi*1024+r32*16; const lds_cptr vp0=shm3+LDS_V+((lane>>4)&1)*32+(lane&3)*8+(4*hi+((lane&15)>>2))*64;
  DMA_K(0,0);DMA_V(0,0);DMA_K(1,SLOTB);
  bf16x8 qr[4];
  #pragma unroll
  for(int d0=0;d0<4;++d0)qr[d0]=*reinterpret_cast<const bf16x8*>(&Qw[(long)r32*PQ+d0*16+hi*8]);
  float mhat=0.f,l_reg=0.f;f32x16 o[2];o[0]=f32x16{};o[1]=f32x16{};f32x16 negm=f32x16{};asm volatile("":"+v"(negm));
  const int qrel=wid*QBLK+r32;
  #define CMASK(P0,P1,t) do{int jb_=(t)-(NT-4); (void)jb_;(void)qrel;}while(0)
  bool resc=false;
  #define START(P0,P1) do{ const float rm=rowmax(P0,P1); resc=false; \
    { const float dl=rm; mhat=fadd_s(mhat,dl); \
      _Pragma("unroll") for(int r=0;r<16;++r){P0[r]=fsub_s(P0[r],dl);P1[r]=fsub_s(P1[r],dl);} \
      _Pragma("unroll") for(int r=0;r<16;++r)negm[r]=-mhat; asm volatile("":"+v"(negm)); } \
    _Pragma("unroll") for(int r=0;r<16;++r)P0[r]=__builtin_amdgcn_exp2f(P0[r]); }while(0)
  #define RESC() do{ if(resc){ asm volatile("s_waitcnt lgkmcnt(0)":::"memory"); \
      _Pragma("unroll") for(int d_=0;d_<2;++d_) _Pragma("unroll") for(int r=0;r<16;++r)o[d_][r]*=wsf[crow(r,hi)]; } }while(0)
  f32x16 pA0,pA1,pB0,pB1;
  int sl_prev=0,sl_cur=0,sl_next=SLOTB;
  #define ROT() do{sl_prev=sl_cur;sl_cur=sl_next;sl_next=(sl_next==(NSLOT-1)*SLOTB)?0:sl_next+SLOTB;}while(0)
  DMA_K(2,2*SLOTB);
  WAIT_BAR(3);
  qkt(pA0,pA1,Kbase,qr,negm,r32,hi);asm volatile("s_nop 15\n\ts_nop 7":"+v"(pA0),"+v"(pA1));CMASK(pA0,pA1,0);
  START(pA0,pA1);
  _Pragma("unroll") for(int r=0;r<16;++r)pA1[r]=__builtin_amdgcn_exp2f(pA1[r]);
  WAIT_BAR(0);
  DMA_K(3,0);DMA_V(1,SLOTB);
  ROT();
  kload8(kf,kp0+sl_cur);
  WAIT_BAR(2);
  s16x4 vlo[8],vhi[8]; u32x4 pw0,pw1,pw2,pw3;
  #define PKW(P,B) cvtpk_s(P[B],P[B+1])
  #define PAF(k) __builtin_bit_cast(bf16x8,pw##k)
  #define VFR(i) (bf16x8){vlo[i][0],vlo[i][1],vlo[i][2],vlo[i][3],vhi[i][0],vhi[i][1],vhi[i][2],vhi[i][3]}
  #define PIN(x) asm volatile("":"+v"(x))
  #define MX3(a,b,c) __builtin_fmaxf(__builtin_fmaxf((a),(b)),(c))
  #define GAPA(MF,A0,A1,A2,A3,W0,W1,PW) do{ MF; sacc+=A0; sacc+=A1; sacc+=A2; sacc+=A3; PIN(sacc); W0; W1; PIN(PW); SBAR(); }while(0)
  #define EX(v) __builtin_amdgcn_exp2f(v)
  #define GAPB(MF,X,B) do{ MF; X[B]=EX(X[B]); X[B+1]=EX(X[B+1]); X[B+2]=EX(X[B+2]); X[B+3]=EX(X[B+3]); PIN(X); SBAR(); }while(0)
  #define VRD(i) do{ vlo[i]=vtr(vp_+(((i)>>2)*4096+((i)&3)*1024)); vhi[i]=vtr(vp_+(((i)>>2)*4096+((i)&3)*1024+512)); }while(0)
  #define KRD(G,j) do{ if(G){ kload2(kf,kp0+sl_next,j); SBAR(); } }while(0)
  #define STEP(C0,C1,P0,P1,t,GK,GV,GL) do{ SBAR(); \
    const lds_cptr vp_=vp0+sl_prev; \
    VRD(0); SBAR(); float sacc=(P0[0]+P0[1]); \
    GAPA(C0=__builtin_amdgcn_mfma_f32_32x32x16_bf16(kf[0],qr[0],negm,0,0,0), P0[2],P0[3],P0[4],P0[5],     pw0[0]=PKW(P0,0), pw0[1]=PKW(P0,2), pw0); \
    VRD(4); SBAR(); GAPA(C1=__builtin_amdgcn_mfma_f32_32x32x16_bf16(kf[1],qr[0],negm,0,0,0), P0[6],P0[7],P0[8],P0[9],     pw0[2]=PKW(P0,4), pw0[3]=PKW(P0,6), pw0); \
    VRD(1); SBAR(); GAPA(C0=__builtin_amdgcn_mfma_f32_32x32x16_bf16(kf[2],qr[1],C0,0,0,0),   P0[10],P0[11],P0[12],P0[13], pw1[0]=PKW(P0,8), pw1[1]=PKW(P0,10), pw1); \
    VRD(5); SBAR(); GAPA(C1=__builtin_amdgcn_mfma_f32_32x32x16_bf16(kf[3],qr[1],C1,0,0,0),   P0[14],P0[15],P1[0],P1[1],   pw1[2]=PKW(P0,12),pw1[3]=PKW(P0,14), pw1); \
    VRD(2); SBAR(); GAPA(C0=__builtin_amdgcn_mfma_f32_32x32x16_bf16(kf[4],qr[2],C0,0,0,0),   P1[2],P1[3],P1[4],P1[5],     pw2[0]=PKW(P1,0), pw2[1]=PKW(P1,2), pw2); \
    VRD(6); SBAR(); GAPA(C1=__builtin_amdgcn_mfma_f32_32x32x16_bf16(kf[5],qr[2],C1,0,0,0),   P1[6],P1[7],P1[8],P1[9],     pw2[2]=PKW(P1,4), pw2[3]=PKW(P1,6), pw2); \
    VRD(3); SBAR(); GAPA(C0=__builtin_amdgcn_mfma_f32_32x32x16_bf16(kf[6],qr[3],C0,0,0,0),   P1[10],P1[11],P1[12],P1[13], pw3[0]=PKW(P1,8), pw3[1]=PKW(P1,10), pw3); \
    VRD(7); SBAR(); GAPA(C1=__builtin_amdgcn_mfma_f32_32x32x16_bf16(kf[7],qr[3],C1,0,0,0),   P1[14],P1[15],0.f,0.f,       pw3[2]=PKW(P1,12),pw3[3]=PKW(P1,14), pw3); \
    l_reg+=sacc; \
    if(GK){DMA_K((t)+3,sl_cur);} if(GV){DMA_V((t)+1,sl_next);} \
    CMASK(C0,C1,t); \
    { float a=MX3(C0[0],C0[1],C1[0]),b=MX3(C0[2],C0[3],C1[1]); a=MX3(a,C1[2],C1[3]); \
      _Pragma("unroll") for(int r=4;r<16;r+=4){a=MX3(a,C0[r],C0[r+1]);b=MX3(b,C0[r+2],C0[r+3]);a=MX3(a,C1[r],C1[r+1]);b=MX3(b,C1[r+2],C1[r+3]);} \
      float rm=__builtin_fmaxf(a,b); { auto rr=__builtin_amdgcn_permlane32_swap(__float_as_uint(rm),__float_as_uint(rm),false,false); rm=__builtin_fmaxf(__uint_as_float(rr[0]),__uint_as_float(rr[1])); } \
      resc=false; \
      if(__builtin_expect(__any(rm>(float)THRL),0)){ const float dl=__builtin_fmaxf(rm,0.f); mhat+=dl; \
        _Pragma("unroll") for(int r=0;r<16;++r){C0[r]-=dl;C1[r]-=dl;} \
        _Pragma("unroll") for(int r=0;r<16;++r)negm[r]=-mhat; asm volatile("":"+v"(negm)); \
        const float f=__builtin_amdgcn_exp2f(-dl); l_reg*=f; if(hi==0)wsf[r32]=f; resc=true; } } \
    SBAR(); \
    GAPB(o[0]=__builtin_amdgcn_mfma_f32_32x32x16_bf16(PAF(0),VFR(0),o[0],0,0,0), C0,0); \
    GAPB(o[1]=__builtin_amdgcn_mfma_f32_32x32x16_bf16(PAF(0),VFR(4),o[1],0,0,0), C0,4); \
    KRD(GL,0); GAPB(o[0]=__builtin_amdgcn_mfma_f32_32x32x16_bf16(PAF(1),VFR(1),o[0],0,0,0), C0,8); \
    KRD(GL,1); GAPB(o[1]=__builtin_amdgcn_mfma_f32_32x32x16_bf16(PAF(1),VFR(5),o[1],0,0,0), C0,12); \
    KRD(GL,2); GAPB(o[0]=__builtin_amdgcn_mfma_f32_32x32x16_bf16(PAF(2),VFR(2),o[0],0,0,0), C1,0); \
    KRD(GL,3); GAPB(o[1]=__builtin_amdgcn_mfma_f32_32x32x16_bf16(PAF(2),VFR(6),o[1],0,0,0), C1,4); \
    GAPB(o[0]=__builtin_amdgcn_mfma_f32_32x32x16_bf16(PAF(3),VFR(3),o[0],0,0,0), C1,8); \
    GAPB(o[1]=__builtin_amdgcn_mfma_f32_32x32x16_bf16(PAF(3),VFR(7),o[1],0,0,0), C1,12); \
    }while(0)
  int t=1;
  #undef CMASK
  #define CMASK(P0,P1,t) do{}while(0)
  for(;t+5<NT;t+=2){
    STEP(pB0,pB1,pA0,pA1,t,true,true,true);     WAIT_BAR(2); RESC(); ROT();
    STEP(pA0,pA1,pB0,pB1,t+1,true,true,true);   WAIT_BAR(2); RESC(); ROT();
  }
  #undef CMASK
  #define CMASK(P0,P1,t) do{int jb_=(t)-(NT-4); (void)jb_;(void)qrel;}while(0)
  #define ENDW(tt) do{ if((tt)+3<NT){WAIT_BAR(2);} else if((tt)+2<NT){WAIT_BAR(1);} else {WAIT_BAR(0);} }while(0)
  for(;t+1<NT;t+=2){
    STEP(pB0,pB1,pA0,pA1,t,(t+3<NT),(t+1<NT),(t+1<NT));       ENDW(t);   RESC(); ROT();
    STEP(pA0,pA1,pB0,pB1,t+1,(t+4<NT),(t+2<NT),(t+2<NT));     ENDW(t+1); RESC(); ROT();
  }
  STEP(pB0,pB1,pA0,pA1,NT-1,false,false,false); RESC();
  { float sacc=pB0[0]+pB0[1]; _Pragma("unroll") for(int r=2;r<16;++r)sacc+=pB0[r]; _Pragma("unroll") for(int r=0;r<16;++r)sacc+=pB1[r]; l_reg+=sacc;
    pw0=(u32x4){PKW(pB0,0),PKW(pB0,2),PKW(pB0,4),PKW(pB0,6)};pw1=(u32x4){PKW(pB0,8),PKW(pB0,10),PKW(pB0,12),PKW(pB0,14)};pw2=(u32x4){PKW(pB1,0),PKW(pB1,2),PKW(pB1,4),PKW(pB1,6)};pw3=(u32x4){PKW(pB1,8),PKW(pB1,10),PKW(pB1,12),PKW(pB1,14)};
    SBAR(); pv(o,vb0+sl_cur,PAF(0),PAF(1),PAF(2),PAF(3)); }
  #undef PKW
  #undef PAF
  #undef VFR
  #undef PIN
  #undef MX3
  #undef GAPA
  #undef GAPB
  #undef EX
  #undef VRD
  #undef KRD
  #undef STEP
  #undef ENDW
  {auto rr=__builtin_amdgcn_permlane32_swap(__float_as_uint(l_reg),__float_as_uint(l_reg),false,false);l_reg=__uint_as_float(rr[0])+__uint_as_float(rr[1]);}
  if(hi==0)wsf[32+r32]=l_reg;asm volatile("s_waitcnt lgkmcnt(0)":::"memory");
  float rli[16];
  #pragma unroll
  for(int r=0;r<16;++r)rli[r]=__builtin_amdgcn_rcpf(wsf[32+crow(r,hi)]);
  bf16*Ow=O+(rowbase+q0+wid*QBLK)*PO+h*D;
  { bf16*stg=(bf16*)(shm+LDS_OST)+wid*2048;
    #pragma unroll
    for(int r=0;r<16;++r){const int orow=crow(r,hi);
      #pragma unroll
      for(int d0=0;d0<2;++d0)stg[orow*64+d0*32+r32]=__float2bfloat16(o[d0][r]*rli[r]);}
    asm volatile("s_waitcnt lgkmcnt(0)":::"memory");
    #pragma unroll
    for(int i=0;i<4;++i){const int row=i*8+(lane>>3),ch=lane&7; const u32x4 v=*(const u32x4*)(stg+row*64+ch*8); ATTN_STORE16(Ow+(long)row*PO+ch*8,v);
      float ss=0.f; _Pragma("unroll") for(int e=0;e<4;++e){const float lo=__uint_as_float(v[e]<<16),hh=__uint_as_float(v[e]&0xffff0000u); ss+=lo*lo+hh*hh;}
      ss+=__shfl_xor(ss,1);ss+=__shfl_xor(ss,2);ss+=__shfl_xor(ss,4); if(ch==0)__hip_atomic_fetch_add(ssq+(rowbase+q0+wid*QBLK+row),ss,__ATOMIC_RELAXED,__HIP_MEMORY_SCOPE_AGENT);} }
  asm volatile("s_waitcnt lgkmcnt(0)\n\ts_barrier":::"memory");
  #undef DMA_K
  #undef DMA_V
  #undef CMASK
  #undef START
  #undef RESC
  #undef ROT
}
constexpr int ATTN_LDS_BYTES=LDS_BYTES;
#undef SBAR
#undef WAIT_BAR
}
namespace na_body {
using attn_body::bf16x8; using attn_body::s16x4; using attn_body::f32x16; using attn_body::u32x4;
#define NA_LAS __attribute__((address_space(3)))
constexpr int PQ = 2304, PO = 1024;
constexpr int COL_QB = 768, COL_KB = 1280, COL_VB = 1792, COL_OB = 512;
constexpr int T_GUARD = 48, T_FLOATS = T_GUARD + 15 * 32 + 48;
__device__ __forceinline__ int crow(int r, int hi) { return (r & 3) + 8 * (r >> 2) + 4 * hi; }
__device__ __forceinline__ unsigned cvtpk(float lo, float hi) { return attn_body::cvtpk_s(lo, hi); }

__device__ __forceinline__ void na_unit(const unsigned short* __restrict__ PROJ, unsigned short* __restrict__ O, long rowbase, int rows, int r, int h,
                                        NA_LAS unsigned char* wl, unsigned wl_addr, const NA_LAS float* T, NA_LAS float* wsf, float* ssq) {
    int tid_ = threadIdx.x; asm volatile("" : "+v"(tid_)); const int lane = tid_ & 63, r32 = lane & 31, hi = lane >> 5;
    const int r0 = min(max(r - 4, 0), rows - 8);
    const long qrow0 = rowbase + (long)r * 64;
    const unsigned short* qbase = PROJ + (qrow0 + r32) * PQ + COL_QB + h * 64 + hi * 8;
    bf16x8 qr[2][4];
#pragma unroll
    for (int qb2 = 0; qb2 < 2; ++qb2)
#pragma unroll
        for (int d0 = 0; d0 < 4; ++d0) qr[qb2][d0] = *(const bf16x8*)(qbase + (long)qb2 * 32 * PQ + d0 * 16);
    float mrun[2] = {-1e30f, -1e30f}, lrun[2] = {0.f, 0.f};
    f32x16 o[2][2];
#pragma unroll
    for (int a = 0; a < 2; ++a)
#pragma unroll
        for (int b = 0; b < 2; ++b) o[a][b] = f32x16{};
    const int lrow = lane >> 3, lc = lane & 7;
    const int vb = (int)wl_addr + 8192 + ((lane >> 4) & 1) * 32 + (lane & 3) * 8 + (4 * hi + ((lane & 15) >> 2)) * 64;
    for (int i = 0; i < 8; ++i) {
        const unsigned short* kb = PROJ + (rowbase + (long)(r0 + i) * 64 + lrow) * PQ + COL_KB + h * 64 + lc * 8;
        u32x4 kreg[8], vreg[8];
#pragma unroll
        for (int j = 0; j < 8; ++j) { kreg[j] = *(const u32x4*)(kb + (long)j * 8 * PQ); vreg[j] = *(const u32x4*)(kb + (COL_VB - COL_KB) + (long)j * 8 * PQ); }
#pragma unroll
        for (int j = 0; j < 8; ++j) { const int row = j * 8 + lrow;
            *(NA_LAS u32x4*)(wl + lc * 1024 + row * 16) = kreg[j];
            *(NA_LAS u32x4*)(wl + 8192 + (lc >> 2) * 4096 + (row >> 4) * 1024 + (row & 15) * 64 + (lc & 3) * 16) = vreg[j]; }
        bf16x8 kf[8];
#pragma unroll
        for (int d0 = 0; d0 < 4; ++d0) { kf[2 * d0] = *(const NA_LAS bf16x8*)(wl + (2 * d0 + hi) * 1024 + r32 * 16); kf[2 * d0 + 1] = *(const NA_LAS bf16x8*)(wl + (2 * d0 + hi) * 1024 + 512 + r32 * 16); }
        const int dr = r0 + i - r + 7;
#pragma unroll
        for (int qb2 = 0; qb2 < 2; ++qb2) {
            f32x16 p0 = f32x16{}, p1 = f32x16{};
#pragma unroll
            for (int d0 = 0; d0 < 4; ++d0) { p0 = __builtin_amdgcn_mfma_f32_32x32x16_bf16(kf[2 * d0], qr[qb2][d0], p0, 0, 0, 0); p1 = __builtin_amdgcn_mfma_f32_32x32x16_bf16(kf[2 * d0 + 1], qr[qb2][d0], p1, 0, 0, 0); }
            const int c = qb2 * 32 + r32, c0 = min(max(c - 8, 0), 48);
            const NA_LAS float* tb = T + dr * 32 + 15 - c + 4 * hi;
            const int kofs = 4 * hi - c0;
            float rm = -1e30f;
#pragma unroll
            for (int rr = 0; rr < 16; ++rr) { const int kc = (rr & 3) + 8 * (rr >> 2);
                const float s0 = ((unsigned)(kc + kofs) < 16u) ? p0[rr] + tb[kc] : -1e30f;
                const float s1 = ((unsigned)(kc + 32 + kofs) < 16u) ? p1[rr] + tb[kc + 32] : -1e30f;
                p0[rr] = s0; p1[rr] = s1; rm = fmaxf(rm, fmaxf(s0, s1)); }
            rm = fmaxf(rm, __shfl_xor(rm, 32));
            const float mn = fmaxf(mrun[qb2], rm), alpha = __builtin_amdgcn_exp2f(mrun[qb2] - mn);
            mrun[qb2] = mn;
            float sum = 0.f;
#pragma unroll
            for (int rr = 0; rr < 16; ++rr) { p0[rr] = __builtin_amdgcn_exp2f(p0[rr] - mn); p1[rr] = __builtin_amdgcn_exp2f(p1[rr] - mn); sum += p0[rr] + p1[rr]; }
            lrun[qb2] = lrun[qb2] * alpha + sum;
            if (__any(alpha != 1.0f)) {
                if (hi == 0) wsf[r32] = alpha;
#pragma unroll
                for (int rr = 0; rr < 16; ++rr) { const float a = wsf[crow(rr, hi)]; o[qb2][0][rr] *= a; o[qb2][1][rr] *= a; }
            }
            u32x4 pw0, pw1, pw2, pw3;
            pw0 = (u32x4){cvtpk(p0[0], p0[1]), cvtpk(p0[2], p0[3]), cvtpk(p0[4], p0[5]), cvtpk(p0[6], p0[7])};
            pw1 = (u32x4){cvtpk(p0[8], p0[9]), cvtpk(p0[10], p0[11]), cvtpk(p0[12], p0[13]), cvtpk(p0[14], p0[15])};
            pw2 = (u32x4){cvtpk(p1[0], p1[1]), cvtpk(p1[2], p1[3]), cvtpk(p1[4], p1[5]), cvtpk(p1[6], p1[7])};
            pw3 = (u32x4){cvtpk(p1[8], p1[9]), cvtpk(p1[10], p1[11]), cvtpk(p1[12], p1[13]), cvtpk(p1[14], p1[15])};
            attn_body::pv(o[qb2], vb, __builtin_bit_cast(bf16x8, pw0), __builtin_bit_cast(bf16x8, pw1), __builtin_bit_cast(bf16x8, pw2), __builtin_bit_cast(bf16x8, pw3));
        }
    }
#pragma unroll
    for (int qb2 = 0; qb2 < 2; ++qb2) {
        const float l = lrun[qb2] + __shfl_xor(lrun[qb2], 32);
        if (hi == 0) wsf[r32] = __builtin_amdgcn_rcpf(l);
        NA_LAS unsigned short* stg = (NA_LAS unsigned short*)(wl + qb2 * 4096);
#pragma unroll
        for (int rr = 0; rr < 16; ++rr) { const int orow = crow(rr, hi); const float rl = wsf[orow];
#pragma unroll
            for (int d0 = 0; d0 < 2; ++d0) stg[orow * 64 + d0 * 32 + r32] = (unsigned short)(cvtpk(o[qb2][d0][rr] * rl, 0.f) & 0xffffu); }
        unsigned short* Ow = O + (qrow0 + qb2 * 32) * PO + COL_OB + h * 64;
#pragma unroll
        for (int k = 0; k < 4; ++k) { const int row = k * 8 + (lane >> 3), ch = lane & 7; const u32x4 v = *(const NA_LAS u32x4*)(stg + row * 64 + ch * 8); *(u32x4*)(Ow + (long)row * PO + ch * 8) = v;
            float ss = 0.f;
#pragma unroll
            for (int e = 0; e < 4; ++e) { const float lo = __uint_as_float(v[e] << 16), hh = __uint_as_float(v[e] & 0xffff0000u); ss += lo * lo + hh * hh; }
            ss += __shfl_xor(ss, 1); ss += __shfl_xor(ss, 2); ss += __shfl_xor(ss, 4); if (ch == 0) __hip_atomic_fetch_add(ssq + (qrow0 + qb2 * 32 + row), ss, __ATOMIC_RELAXED, __HIP_MEMORY_SCOPE_AGENT); }
    }
}
}
namespace cg = cooperative_groups;
constexpr int NWAVES = 8;
constexpr int DM = 1024, M_PROMPT = 32 * 2048, S_PROMPT = 2048, M_SAMPLE = 4 * 4096, S_SAMPLE = 4096, M_ALL = M_PROMPT + M_SAMPLE;
constexpr int NPROJ = 2304, DFF = 2816, NUP = 2 * DFF, PLE = 256;
constexpr int FFN_CHUNKS = 4, M_CHUNK = M_ALL / FFN_CHUNKS;
constexpr float C2 = 0.125f * 1.4426950408889634f;
constexpr float LOG2E = 1.4426950408889634f;
constexpr size_t MiB = 1u << 20;
constexpr size_t WS_SSQ2 = 0, WS_SSQ3 = 384 * 1024, WS_SSQ4 = 768 * 1024, WS_SSQA = 1152 * 1024, WS_SSQB = 1536 * 1024, WS_ROPE = 1984 * 1024;
constexpr size_t WS_WIN = 2 * MiB, WS_WOUT = 7 * MiB, WS_WUP = 9 * MiB, WS_WDOWN = 20 * MiB, WS_WGATE = 26 * MiB, WS_WPLE = 28 * MiB;
constexpr size_t WS_PROJ = 32 * MiB;
constexpr size_t WS_XNO = 392 * MiB;
constexpr size_t WS_U = 32 * MiB;
constexpr size_t WS_ACT = 252 * MiB;
constexpr size_t WS_H2B = 32 * MiB;
constexpr size_t WS_H3B = 392 * MiB;
constexpr size_t WS_E = 192 * MiB;
constexpr size_t WS_H1B = 824 * MiB;
constexpr size_t WS_PB = 984 * MiB;
constexpr size_t WS_END = 1024 * MiB;
static_assert(WS_PROJ + (size_t)M_ALL * NPROJ * 2 <= WS_XNO && WS_XNO + (size_t)M_ALL * DM * 2 <= WS_H1B && WS_U + (size_t)M_CHUNK * NUP * 2 <= WS_ACT && WS_ACT + (size_t)M_ALL * DFF * 2 <= WS_H1B, "d_ws map");
static_assert(WS_H1B + (size_t)M_ALL * DM * 2 <= WS_PB && WS_PB + (size_t)M_ALL * PLE * 2 <= WS_END && WS_H2B + (size_t)M_ALL * DM * 2 <= WS_E && WS_E + (size_t)M_ALL * DM * 2 <= WS_H1B, "d_ws map 2");
static_assert(WS_WIN + (size_t)NPROJ * DM * 2 <= WS_WOUT && WS_WUP + (size_t)NUP * DM * 2 <= WS_WDOWN && WS_WDOWN + (size_t)DM * DFF * 2 <= WS_WGATE, "weight map");
constexpr int RING_BYTES = 131072;
constexpr int NA_T_OFF = RING_BYTES, NA_T_BYTES = na_body::T_FLOATS * 4, NA_WSF_OFF = NA_T_OFF + NWAVES * NA_T_BYTES, LDS_BYTES = NA_WSF_OFF + NWAVES * 256;
static_assert(LDS_BYTES <= 163840 && attn_body::ATTN_LDS_BYTES <= RING_BYTES, "LDS map");

#define LAS __attribute__((address_space(3)))
typedef unsigned short bf16;
typedef unsigned v4u __attribute__((ext_vector_type(4)));
typedef unsigned v2u __attribute__((ext_vector_type(2)));
typedef float f32x4 __attribute__((ext_vector_type(4)));
__device__ __forceinline__ unsigned pk2(float lo, float hi) { return pg8::cvt_pk_bf16(lo, hi); }
__device__ __forceinline__ float bflo(unsigned w) { return __uint_as_float(w << 16); }
__device__ __forceinline__ float bfhi(unsigned w) { return __uint_as_float(w & 0xffff0000u); }
__device__ __forceinline__ float wave_sum(float v) {
#pragma unroll
    for (int o = 1; o < 64; o <<= 1) v += __shfl_xor(v, o);
    return v;
}
__device__ __forceinline__ void p0_transpose_item(const float* W, int K, int N, bf16* WT, LAS float* scr, int item, int lane, const float* gain, const float* gain_hi, int ksplit, int nlo, int nhi, float nscale) {
    const int nblk = N / 32, kb = item / nblk, nb = item % nblk, k0 = 64 * kb, n0 = 32 * nb;
#pragma unroll 8
    for (int i = 0; i < 32; ++i) { const int kk = 2 * i + (lane >> 5); float w = W[(size_t)(k0 + kk) * N + n0 + (lane & 31)]; if (gain) w *= (k0 < ksplit ? gain[k0 + kk] : gain_hi[k0 + kk - ksplit]); scr[kk * 33 + (lane & 31)] = w; }
    asm volatile("s_waitcnt lgkmcnt(0)" ::: "memory");
    const int c = lane & 7;
#pragma unroll
    for (int j = 0; j < 4; ++j) { const int n = (lane >> 3) + 8 * j; const LAS float* s = scr + (8 * c) * 33 + n; const float ns = (n0 + n >= nlo && n0 + n < nhi) ? nscale : 1.0f;
        v4u o; o.x = pk2(s[0 * 33] * ns, s[1 * 33] * ns); o.y = pk2(s[2 * 33] * ns, s[3 * 33] * ns); o.z = pk2(s[4 * 33] * ns, s[5 * 33] * ns); o.w = pk2(s[6 * 33] * ns, s[7 * 33] * ns);
        *(v4u*)(WT + (size_t)(n0 + n) * K + k0 + 8 * c) = o; }
    asm volatile("s_waitcnt lgkmcnt(0)" ::: "memory");
}
__device__ __forceinline__ void sincos_cw(float a, float& s, float& c) {
    const float k = rintf(a * 0.636619772367581343f);
    float r = fmaf(-k, 1.5703125f, a); r = fmaf(-k, 4.837512969970703125e-4f, r); r = fmaf(-k, 7.54978995489188216e-8f, r);
    const float r2 = r * r;
    const float sp = r + r * r2 * (-1.6666667163e-01f + r2 * (8.3333337680e-03f + r2 * (-1.9841270114e-04f + r2 * 2.7557314297e-06f)));
    const float cp = 1.0f + r2 * (-0.5f + r2 * (4.1666667908e-02f + r2 * (-1.3888889225e-03f + r2 * (2.4801587642e-05f + r2 * -2.7557314297e-07f))));
    const int q = (int)k & 3;
    s = (q == 0) ? sp : (q == 1) ? cp : (q == 2) ? -sp : -cp;
    c = (q == 0) ? cp : (q == 1) ? -sp : (q == 2) ? -cp : sp;
}

typedef const __attribute__((address_space(4))) unsigned char* kptr_t;
struct Args { const float* in[21]; float* out; unsigned char* ws; };

__global__ void __launch_bounds__(NWAVES * 64, 2) hymba_fwd(Args args) {
    extern __shared__ __attribute__((aligned(16))) unsigned char lds[];
    cg::grid_group grid = cg::this_grid();
    LAS unsigned char* const L = (LAS unsigned char*)lds;
    const int wave = __builtin_amdgcn_readfirstlane(threadIdx.x >> 6);
    const int G = gridDim.x, bx = blockIdx.x, vcu = (G % 8 == 0) ? (bx % 8) * (G / 8) + bx / 8 : bx;
    const int gw = vcu * NWAVES + wave, NGW = G * NWAVES;
#define PHASE_PTRS() int tid = threadIdx.x; asm volatile("" : "+v"(tid)); const int lane = tid & 63; (void)lane; kptr_t kp = (kptr_t)__builtin_amdgcn_kernarg_segment_ptr(); asm volatile("" : "+s"(kp)); unsigned char* const ws = (unsigned char*)KLD(22); float* const out = (float*)KLD(21); (void)out; \
    float* const ssq2 = (float*)(ws + WS_SSQ2); float* const ssq3 = (float*)(ws + WS_SSQ3); float* const ssq4 = (float*)(ws + WS_SSQ4); float* const ssqA = (float*)(ws + WS_SSQA); float* const ssqB = (float*)(ws + WS_SSQB); (void)ssqA; (void)ssqB; float* const rope = (float*)(ws + WS_ROPE); (void)ssq2; (void)ssq3; (void)ssq4; (void)rope; \
    bf16* const PROJ = (bf16*)(ws + WS_PROJ); bf16* const XNO = (bf16*)(ws + WS_XNO); (void)PROJ; (void)XNO;
#define KLD(i) (*(const __attribute__((address_space(4))) unsigned long long*)(kp + 8 * (i)))
#define KIN(i) ((const float*)KLD(i))

    {
        PHASE_PTRS();
        const float* const x_prompt = KIN(0); const float* const x_sample = KIN(1); const float* const p_prompt = KIN(2); const float* const p_sample = KIN(3);
        bf16* const Win_t = (bf16*)(ws + WS_WIN); bf16* const Wout_t = (bf16*)(ws + WS_WOUT); bf16* const Wup_t = (bf16*)(ws + WS_WUP); bf16* const Wdown_t = (bf16*)(ws + WS_WDOWN);
        bf16* const Wgate_t = (bf16*)(ws + WS_WGATE); bf16* const Wple_t = (bf16*)(ws + WS_WPLE); bf16* const PB = (bf16*)(ws + WS_PB);
        LAS float* scr = (LAS float*)(L + wave * 16384);
        constexpr int I_IN = (DM / 64) * (NPROJ / 32), I_OUT = (DM / 64) * (DM / 32), I_UP = (DM / 64) * (NUP / 32), I_DOWN = (DFF / 64) * (DM / 32), I_GATE = I_OUT, I_PLE = (PLE / 64) * (DM / 32);
        constexpr int NITEMS = I_IN + I_OUT + I_UP + I_DOWN + I_GATE + I_PLE;
        for (int it = gw; it < NITEMS; it += NGW) {
            int r = it;
            if (r < I_IN) { p0_transpose_item(KIN(5), DM, NPROJ, Win_t, scr, r, lane, nullptr, nullptr, 0, na_body::COL_QB, na_body::COL_KB, C2); continue; } r -= I_IN;
            if (r < I_OUT) { p0_transpose_item(KIN(11), DM, DM, Wout_t, scr, r, lane, KIN(9), KIN(10), 512, 0, 0, 1.f); continue; } r -= I_OUT;
            if (r < I_UP) { p0_transpose_item(KIN(13), DM, NUP, Wup_t, scr, r, lane, KIN(12), nullptr, 1 << 30, 0, 0, 1.f); continue; } r -= I_UP;
            if (r < I_DOWN) { p0_transpose_item(KIN(16), DFF, DM, Wdown_t, scr, r, lane, nullptr, nullptr, 0, 0, 0, 1.f); continue; } r -= I_DOWN;
            if (r < I_GATE) { p0_transpose_item(KIN(18), DM, DM, Wgate_t, scr, r, lane, KIN(17), nullptr, 1 << 30, 0, 0, 1.f); continue; } r -= I_GATE;
            p0_transpose_item(KIN(19), PLE, DM, Wple_t, scr, r, lane, nullptr, nullptr, 0, 0, 0, 1.f);
        }
        const float* gain = KIN(4);
        for (int m = gw; m < M_ALL; m += NGW) {
            const float* xrow = (m < M_PROMPT) ? x_prompt + (size_t)m * DM : x_sample + (size_t)(m - M_PROMPT) * DM;
            const f32x4* xr = (const f32x4*)xrow + lane;
            f32x4 v[4]; float s = 0.f;
#pragma unroll
            for (int j = 0; j < 4; ++j) { v[j] = xr[64 * j]; s += (v[j].x * v[j].x + v[j].y * v[j].y) + (v[j].z * v[j].z + v[j].w * v[j].w); }
            const float rs = __builtin_amdgcn_rsqf(wave_sum(s) * (1.f / DM) + 1e-6f);
            unsigned long long* o8 = (unsigned long long*)(XNO + (size_t)m * DM) + lane;
#pragma unroll
            for (int j = 0; j < 4; ++j) { const f32x4 g = ((const f32x4*)gain)[lane + 64 * j];
                o8[64 * j] = (unsigned long long)pk2(v[j].x * rs * g.x, v[j].y * rs * g.y) | ((unsigned long long)pk2(v[j].z * rs * g.z, v[j].w * rs * g.w) << 32); }
            const float* prow = (m < M_PROMPT) ? p_prompt + (size_t)m * PLE : p_sample + (size_t)(m - M_PROMPT) * PLE;
            const f32x4 pv = ((const f32x4*)prow)[lane];
            ((unsigned long long*)(PB + (size_t)m * PLE))[lane] = (unsigned long long)pk2(pv.x, pv.y) | ((unsigned long long)pk2(pv.z, pv.w) << 32);
        }
        for (int e = bx * (NWAVES * 64) + tid; e < M_ALL; e += G * NWAVES * 64) { ssq2[e] = 0.f; ssq3[e] = 0.f; ssq4[e] = 0.f; ssqA[e] = 0.f; ssqB[e] = 0.f; }
        for (int e = bx * (NWAVES * 64) + tid; e < 1024; e += G * NWAVES * 64) { const int pos = e >> 4, i = e & 15;
            const float freq = exp2f(-(float)i * (13.287712379549449f / 16.0f)); float s, c; sincos_cw((float)pos * freq, s, c); rope[e] = c; rope[1024 + e] = s; }
    }
    grid.sync();

    {
        PHASE_PTRS(); bf16* const Win_t = (bf16*)(ws + WS_WIN);
        pg8::Gemm g{XNO, Win_t, M_ALL, NPROJ, DM}; pg8::StaticOrder S; S.init(M_ALL, NPROJ, G, bx);
        pg8::EpiBf16Rs E{PROJ, NPROJ, nullptr};
        pg8::gemm_phase<pg8::EpiBf16Rs, pg8::StaticOrder, true, true>(L, g, S, E);
    }
    grid.sync();

    {
        PHASE_PTRS();
        const float* qn = KIN(6); const float* kn = KIN(7);
        const int a = lane & 7;
        const long NIT = (long)M_ALL * 10 / 8;
        for (long it = gw; it < NIT; it += NGW) {
            const long item = it * 8 + (lane >> 3); const int m = (int)(item / 10), j = (int)(item % 10);
            const int t = (m < M_PROMPT) ? (m & (S_PROMPT - 1)) : (m & (S_SAMPLE - 1));
            bf16* p = PROJ + (size_t)m * NPROJ + j * 64 + a * 8;
            const v4u raw = *(const v4u*)p;
            float v[8] = {bflo(raw.x), bfhi(raw.x), bflo(raw.y), bfhi(raw.y), bflo(raw.z), bfhi(raw.z), bflo(raw.w), bfhi(raw.w)};
            float ss = 0.f;
#pragma unroll
            for (int i = 0; i < 8; ++i) ss += v[i] * v[i];
            ss += __shfl_xor(ss, 1); ss += __shfl_xor(ss, 2); ss += __shfl_xor(ss, 4);
            const float rs = __builtin_amdgcn_rsqf(ss * (1.f / 64.f) + 1e-6f);
            const float* gn = (j < 8 ? qn : kn) + a * 8;
            const int pos = (a < 4) ? (t >> 6) : (t & 63);
            const float* ct = rope + pos * 16 + (a & 1) * 8;
            const float sc = (j < 8) ? C2 : 1.0f;
            float o[8];
#pragma unroll
            for (int i = 0; i < 8; ++i) { const float y = v[i] * rs * gn[i]; const float py = __shfl_xor(y, 2); const float cs = ct[i], sn = ct[1024 + i];
                o[i] = ((a & 2) == 0 ? y * cs - py * sn : y * cs + py * sn) * sc; }
            v4u w; w.x = pk2(o[0], o[1]); w.y = pk2(o[2], o[3]); w.z = pk2(o[4], o[5]); w.w = pk2(o[6], o[7]);
            *(v4u*)p = w;
        }
    }
    grid.sync();

    {
        PHASE_PTRS();
        const attn_body::bf16* Q = (const attn_body::bf16*)PROJ; const attn_body::bf16* K = Q + 512; const attn_body::bf16* V = Q + 640; attn_body::bf16* Ob = (attn_body::bf16*)XNO;
        for (int pair = vcu; pair < 256; pair += G) { const int b = pair >> 3, h = pair & 7;
            for (int qb = 0; qb < 8; ++qb) attn_body::attn_unit<8>((long)b * S_PROMPT, S_PROMPT / 64, h, h >> 2, qb, Q, K, V, Ob, ssqA, (char*)lds); }
        for (int su = vcu; su < 256; su += G) { const int pair = su >> 3, b = pair >> 3, h = pair & 7;
            for (int k = 0; k < 2; ++k) attn_body::attn_unit<8>((long)M_PROMPT + (long)b * S_SAMPLE, S_SAMPLE / 64, h, h >> 2, (su & 7) * 2 + k, Q, K, V, Ob, ssqA, (char*)lds); }
        __syncthreads();
        LAS float* Tb = (LAS float*)(L + NA_T_OFF + wave * NA_T_BYTES);
        LAS float* wsf = (LAS float*)(L + NA_WSF_OFF + wave * 256);
        for (int e = lane; e < na_body::T_FLOATS; e += 64) Tb[e] = 0.f;
        { const float* rpb = KIN(8) + wave * 15 * 31;
          for (int e = lane; e < 15 * 31; e += 64) { const int dr = e / 31, dc = e % 31; Tb[na_body::T_GUARD + dr * 32 + dc] = rpb[e] * LOG2E; } }
        LAS unsigned char* wl = L + wave * 16384;
        const unsigned wl_addr = (unsigned)(uintptr_t)(lds + wave * 16384);
        for (int bu = vcu; bu < 1280; bu += G) {
            long rowbase; int rows, r;
            if (bu < 1024) { rowbase = (long)(bu >> 5) * S_PROMPT; rows = 32; r = bu & 31; } else { const int s = bu - 1024; rowbase = (long)M_PROMPT + (long)(s >> 6) * S_SAMPLE; rows = 64; r = s & 63; }
            na_body::na_unit(PROJ, XNO, rowbase, rows, r, wave, wl, wl_addr, Tb + na_body::T_GUARD, wsf, ssqB);
        }
    }
    grid.sync();

    {
        PHASE_PTRS(); bf16* const Wout_t = (bf16*)(ws + WS_WOUT); bf16* const H1B = (bf16*)(ws + WS_H1B); const float* const x_prompt = KIN(0); const float* const x_sample = KIN(1);
        pg8::Gemm g{XNO, Wout_t, M_ALL, DM, DM}; pg8::StaticOrder S; S.init(M_ALL, DM, G, bx);
        pg8::EpiOutProj E{x_prompt, x_sample, M_PROMPT, H1B, ssq2, ssqA, ssqB};
        pg8::gemm_phase<pg8::EpiOutProj, pg8::StaticOrder, true, true>(L, g, S, E);
    }
    grid.sync();

    for (int ch = 0; ch < FFN_CHUNKS; ++ch) {
        const int crow0 = ch * M_CHUNK;
        {
            PHASE_PTRS(); bf16* const Wup_t = (bf16*)(ws + WS_WUP); bf16* const H1B = (bf16*)(ws + WS_H1B); bf16* const U = (bf16*)(ws + WS_U);
            pg8::Gemm g{H1B + (size_t)crow0 * DM, Wup_t, M_CHUNK, NUP, DM}; pg8::StaticOrder S; S.init(M_CHUNK, NUP, G, bx);
            pg8::EpiBf16Rs E{U, NUP, ssq2 + crow0};
            pg8::gemm_phase<pg8::EpiBf16Rs, pg8::StaticOrder, true, true>(L, g, S, E);
        }
        grid.sync();
        {
            PHASE_PTRS(); const bf16* const U = (const bf16*)(ws + WS_U); bf16* const ACT = (bf16*)(ws + WS_ACT);
            const float* cw = KIN(14); const float* cb = KIN(15);
            constexpr int RG = 16, NCH = DFF / 8, NITEM = (M_CHUNK / RG) * NCH;
            for (int item = bx * (NWAVES * 64) + tid; item < NITEM; item += G * NWAVES * 64) {
                const int rg = item / NCH, c8 = (item % NCH) * 8; const int lm0 = rg * RG, m0 = crow0 + lm0;
                const int S_len = (m0 < M_PROMPT) ? S_PROMPT : S_SAMPLE; const int t0 = m0 & (S_len - 1);
                float wa[3][8], wg[3][8], ba[8], bg[8];
#pragma unroll
                for (int k = 0; k < 3; ++k)
#pragma unroll
                    for (int q = 0; q < 2; ++q) { const f32x4 a4 = *(const f32x4*)(cw + (size_t)k * NUP + c8 + 4 * q), g4 = *(const f32x4*)(cw + (size_t)k * NUP + DFF + c8 + 4 * q);
                        wa[k][4 * q] = a4.x; wa[k][4 * q + 1] = a4.y; wa[k][4 * q + 2] = a4.z; wa[k][4 * q + 3] = a4.w; wg[k][4 * q] = g4.x; wg[k][4 * q + 1] = g4.y; wg[k][4 * q + 2] = g4.z; wg[k][4 * q + 3] = g4.w; }
#pragma unroll
                for (int q = 0; q < 2; ++q) { const f32x4 a4 = *(const f32x4*)(cb + c8 + 4 * q), g4 = *(const f32x4*)(cb + DFF + c8 + 4 * q);
                    ba[4 * q] = a4.x; ba[4 * q + 1] = a4.y; ba[4 * q + 2] = a4.z; ba[4 * q + 3] = a4.w; bg[4 * q] = g4.x; bg[4 * q + 1] = g4.y; bg[4 * q + 2] = g4.z; bg[4 * q + 3] = g4.w; }
                const bf16* up = U + (size_t)lm0 * NUP + c8;
                v4u pa = (v4u){0u, 0u, 0u, 0u}, pg = pa, ca, cgv, na, ng;
                if (t0 != 0) { pa = *(const v4u*)(up - NUP); pg = *(const v4u*)(up - NUP + DFF); }
                ca = *(const v4u*)up; cgv = *(const v4u*)(up + DFF);
#pragma unroll 4
                for (int rr = 0; rr < RG; ++rr) {
                    const bool has_next = (rr < RG - 1) || (t0 + RG < S_len);
                    if (has_next) { na = *(const v4u*)(up + (size_t)(rr + 1) * NUP); ng = *(const v4u*)(up + (size_t)(rr + 1) * NUP + DFF); } else { na = (v4u){0u, 0u, 0u, 0u}; ng = na; }
                    v4u w;
#pragma unroll
                    for (int q = 0; q < 4; ++q) {
                        const float a_lo = wa[0][2 * q] * bflo(pa[q]) + wa[1][2 * q] * bflo(ca[q]) + wa[2][2 * q] * bflo(na[q]) + ba[2 * q];
                        const float a_hi = wa[0][2 * q + 1] * bfhi(pa[q]) + wa[1][2 * q + 1] * bfhi(ca[q]) + wa[2][2 * q + 1] * bfhi(na[q]) + ba[2 * q + 1];
                        const float g_lo = wg[0][2 * q] * bflo(pg[q]) + wg[1][2 * q] * bflo(cgv[q]) + wg[2][2 * q] * bflo(ng[q]) + bg[2 * q];
                        const float g_hi = wg[0][2 * q + 1] * bfhi(pg[q]) + wg[1][2 * q + 1] * bfhi(cgv[q]) + wg[2][2 * q + 1] * bfhi(ng[q]) + bg[2 * q + 1];
                        const float z_lo = -2.302208198f * (g_lo + 0.044715f * g_lo * g_lo * g_lo), z_hi = -2.302208198f * (g_hi + 0.044715f * g_hi * g_hi * g_hi);
                        const float ge_lo = g_lo * __builtin_amdgcn_rcpf(1.0f + __builtin_amdgcn_exp2f(z_lo)), ge_hi = g_hi * __builtin_amdgcn_rcpf(1.0f + __builtin_amdgcn_exp2f(z_hi));
                        w[q] = pk2(a_lo * ge_lo, a_hi * ge_hi);
                    }
                    *(v4u*)(ACT + (size_t)(m0 + rr) * DFF + c8) = w;
                    pa = ca; pg = cgv; ca = na; cgv = ng;
                }
            }
        }
        grid.sync();
    }

    {
        PHASE_PTRS(); bf16* const ACT = (bf16*)(ws + WS_ACT); bf16* const Wdown_t = (bf16*)(ws + WS_WDOWN); bf16* const H2B = (bf16*)(ws + WS_H2B); bf16* const H1B = (bf16*)(ws + WS_H1B);
        pg8::Gemm g{ACT, Wdown_t, M_ALL, DM, DFF}; pg8::StaticOrder S; S.init(M_ALL, DM, G, bx);
        pg8::EpiResB E{H1B, H2B, ssq3};
        pg8::gemm_phase<pg8::EpiResB, pg8::StaticOrder, true, true>(L, g, S, E);
    }
    grid.sync();

    {
        PHASE_PTRS(); bf16* const PB = (bf16*)(ws + WS_PB); bf16* const Wple_t = (bf16*)(ws + WS_WPLE); bf16* const EB = (bf16*)(ws + WS_E);
        pg8::Gemm g{PB, Wple_t, M_ALL, DM, PLE}; pg8::StaticOrder S; S.init(M_ALL, DM, G, bx);
        pg8::EpiBf16Rs E{EB, DM, nullptr};
        pg8::gemm_phase<pg8::EpiBf16Rs, pg8::StaticOrder, true, true>(L, g, S, E);
    }
    grid.sync();

    {
        PHASE_PTRS(); bf16* const H2B = (bf16*)(ws + WS_H2B); bf16* const Wgate_t = (bf16*)(ws + WS_WGATE); bf16* const EB = (bf16*)(ws + WS_E); bf16* const H3B = (bf16*)(ws + WS_H3B);
        pg8::Gemm g{H2B, Wgate_t, M_ALL, DM, DM}; pg8::StaticOrder S; S.init(M_ALL, DM, G, bx);
        pg8::EpiGate E{H2B, EB, H3B, ssq3, ssq4};
        pg8::gemm_phase<pg8::EpiGate, pg8::StaticOrder, true, true>(L, g, S, E);
    }
    grid.sync();

    {
        PHASE_PTRS();
        const f32x4* fg = (const f32x4*)KIN(20) + lane;
        const f32x4 g0 = fg[0], g1 = fg[64], g2 = fg[128], g3 = fg[192];
        const bf16* const H3B = (const bf16*)(ws + WS_H3B);
        for (int m = gw; m < M_ALL; m += NGW) {
            f32x4* xr = (f32x4*)(out + (size_t)m * DM) + lane;
            const v2u* hr = (const v2u*)(H3B + (size_t)m * DM) + lane;
            const v2u h0 = hr[0], h1 = hr[64], h2 = hr[128], h3 = hr[192];
            const float rs = __builtin_amdgcn_rsqf(ssq4[m] * (1.f / DM) + 1e-6f);
            xr[0] = (f32x4){bflo(h0.x), bfhi(h0.x), bflo(h0.y), bfhi(h0.y)} * rs * g0; xr[64] = (f32x4){bflo(h1.x), bfhi(h1.x), bflo(h1.y), bfhi(h1.y)} * rs * g1;
            xr[128] = (f32x4){bflo(h2.x), bfhi(h2.x), bflo(h2.y), bfhi(h2.y)} * rs * g2; xr[192] = (f32x4){bflo(h3.x), bfhi(h3.x), bflo(h3.y), bfhi(h3.y)} * rs * g3;
        }
    }
}

extern "C" void kernel_launch(void* const* d_in, const int* in_sizes, int n_in, void* d_out, int out_size, void* d_ws, size_t ws_size, hipStream_t stream) {
    static int grid = 0;
    if (grid == 0) {
        if (n_in != 21 || in_sizes[0] != M_PROMPT * DM || out_size != M_ALL * DM || ws_size < WS_END) { fprintf(stderr, "kernel_launch: unexpected shapes (n_in %d, in0 %d, out %d, ws %zu); nothing launched\n", n_in, n_in > 0 ? in_sizes[0] : -1, out_size, ws_size); grid = -1; return; }
        int dev = 0, cus = 0, per_cu = 0;
        if (hipGetDevice(&dev) != hipSuccess || hipDeviceGetAttribute(&cus, hipDeviceAttributeMultiprocessorCount, dev) != hipSuccess) { grid = -1; return; }
        if (hipFuncSetAttribute((const void*)hymba_fwd, hipFuncAttributeMaxDynamicSharedMemorySize, LDS_BYTES) != hipSuccess) { fprintf(stderr, "kernel_launch: hipFuncSetAttribute failed\n"); grid = -1; return; }
        if (hipOccupancyMaxActiveBlocksPerMultiprocessor(&per_cu, (const void*)hymba_fwd, NWAVES * 64, LDS_BYTES) != hipSuccess || per_cu < 1) { fprintf(stderr, "kernel_launch: occupancy query says %d blocks per CU\n", per_cu); (void)hipGetLastError(); }
        grid = cus;
    }
    if (grid < 0) return;
    Args a{};
    for (int i = 0; i < 21; ++i) a.in[i] = (const float*)d_in[i];
    a.out = (float*)d_out; a.ws = (unsigned char*)d_ws;
    void* kargs[] = {&a};
    const hipError_t e = hipLaunchCooperativeKernel((const void*)hymba_fwd, dim3(grid), dim3(NWAVES * 64), kargs, LDS_BYTES, stream);
    if (e != hipSuccess) fprintf(stderr, "kernel_launch: cooperative launch failed: %s (grid %d)\n", hipGetErrorString(e), grid);
}
```

```cpp
#include <hip/hip_cooperative_groups.h>
#include <hip/hip_runtime.h>
#include <cstdio>
#include <cstdint>
namespace pg8 {
#define PG8_LAS __attribute__((address_space(3)))
typedef unsigned short bf16_t;
typedef short bf16x8 __attribute__((ext_vector_type(8)));
typedef float f32x4 __attribute__((ext_vector_type(4)));
typedef unsigned u32x4 __attribute__((ext_vector_type(4)));
constexpr int BM = 256, BK = 64, HALF = 128, HTB = HALF * BK * 2  , STAGE_BYTES = 8 * HTB, NXCD = 8, WGM = 8;

__host__ __device__ __forceinline__ int lds_byte(int r, int c) { const int st = (r >> 4) * 2 + (c >> 5), rr = r & 15, cc = c & 31, ob = rr * 64 + cc * 2; return st * 1024 + (ob ^ (((ob >> 9) & 1) << 5)); }
__host__ __device__ __forceinline__ void stage_rc(int b, int& R, int& C) { const int st = b / 1024, sb = b % 1024, swz = sb ^ (((sb >> 9) & 1) << 5); R = (st >> 1) * 16 + swz / 64; C = (st & 1) * 32 + (swz % 64) / 2; }
__host__ __device__ __forceinline__ int perm32(int rho) { const int n = rho >> 4, i = rho & 15; return 8 * (i >> 2) + 4 * n + (i & 3); }

struct Unit { int pm, pn; };
struct Gemm { const bf16_t* A; const bf16_t* Bt; int M, N, K; size_t a_tstep; };

struct StaticOrder {
    int nM, nN, nwg, G, c;
    __host__ __device__ void init(int M, int N, int G_, int c_) { nM = M / BM; nN = N / BM; nwg = nM * nN; G = G_; c = c_; }
    __host__ __device__ bool next(int i, Unit& u) const {
        const long L = (long)i * G + c; if (L >= nwg) return false;
        int wgid = (int)L; { const int q = nwg / NXCD, r = nwg % NXCD, xcd = wgid % NXCD, off = wgid / NXCD; wgid = (xcd < r ? xcd * (q + 1) : r * (q + 1) + (xcd - r) * q) + off; }
        const int nig = WGM * nN, gid = wgid / nig, fm = gid * WGM, gsz = (nM - fm) < WGM ? (nM - fm) : WGM;
        u.pm = fm + ((wgid % nig) % gsz); u.pn = (wgid % nig) / gsz; return true;
    }
    __device__ __forceinline__ void a_ready(const Unit&) const {}
    __device__ __forceinline__ void done(const Unit&) const {}
};

__device__ __forceinline__ unsigned cvt_pk_bf16(float lo, float hi) { unsigned r; asm volatile("v_cvt_pk_bf16_f32 %0, %1, %2" : "=v"(r) : "v"(lo), "v"(hi)); return r; }
typedef float f32x2 __attribute__((ext_vector_type(2)));
__device__ __forceinline__ f32x2 gelu_pk(f32x2 v) {
    const f32x2 av = __builtin_elementwise_abs(v), d = av * 0.2316418882f + 1.0f;
    f32x2 t; t.x = __builtin_amdgcn_rcpf(d.x); t.y = __builtin_amdgcn_rcpf(d.y);
    f32x2 q = t * 0.5307027145f + (-0.7265760135f); q = q * t + 0.7107068705f; q = q * t + (-0.142248368f); q = q * t + 0.127414796f; q = q * t;
    const f32x2 s = (v * v) * (-0.72134752044f);
    f32x2 e; e.x = __builtin_amdgcn_exp2f(s.x); e.y = __builtin_amdgcn_exp2f(s.y);
    const f32x2 m = v * (q * e), r = v - m;
    f32x2 o; o.x = v.x < 0.f ? m.x : r.x; o.y = v.y < 0.f ? m.y : r.y; return o;
}

template <int ACT  > struct EpiBf16 {
    static constexpr bool PERM = true, AFTER_DRAIN = false, MIDSCALE = false, FULL = false; static_assert(ACT == 0 || ACT == 1, "EpiBf16: ACT is 0 (none) or 1 (gelu_pk)");
    bf16_t* O; int ldc; const float* bias; int split_cols; size_t split_stride; float scale0;
    __device__ __forceinline__ void operator()(const f32x4 (&acc)[2][2][4][2], const Unit& u, int wr, int wc, int fr, int fq) const {
        const int row0 = u.pm * BM + wr * 64 + fr; int colt = u.pn * BM; bf16_t* base = O;
        float sc = 1.f; if (split_cols) { const int t = colt / split_cols; base += (size_t)t * split_stride; colt -= t * split_cols; if (t == 0) sc = scale0; }
        const int col0 = colt + wc * 32 + 8 * fq, bcol0 = u.pn * BM + wc * 32 + 8 * fq;
        f32x4 bv[2][2];
#pragma unroll
        for (int bj = 0; bj < 2; ++bj)
#pragma unroll
            for (int n = 0; n < 2; ++n) bv[bj][n] = bias ? *(const f32x4*)(bias + bcol0 + bj * HALF + 4 * n) : (f32x4){0.f, 0.f, 0.f, 0.f};
#pragma unroll
        for (int ai = 0; ai < 2; ++ai)
#pragma unroll
            for (int m = 0; m < 4; ++m) { bf16_t* rowp = base + (size_t)(row0 + ai * HALF + m * 16) * ldc + col0;
#pragma unroll
                for (int bj = 0; bj < 2; ++bj) { f32x4 v0 = acc[ai][bj][m][0] + bv[bj][0], v1 = acc[ai][bj][m][1] + bv[bj][1];
                    if (ACT == 1) { f32x2 a = gelu_pk((f32x2){v0[0], v0[1]}), b = gelu_pk((f32x2){v0[2], v0[3]}), c = gelu_pk((f32x2){v1[0], v1[1]}), d = gelu_pk((f32x2){v1[2], v1[3]});
                        v0 = (f32x4){a.x, a.y, b.x, b.y}; v1 = (f32x4){c.x, c.y, d.x, d.y}; }
                    v0 = v0 * sc; v1 = v1 * sc; u32x4 w; w.x = cvt_pk_bf16(v0[0], v0[1]); w.y = cvt_pk_bf16(v0[2], v0[3]); w.z = cvt_pk_bf16(v1[0], v1[1]); w.w = cvt_pk_bf16(v1[2], v1[3]);
                    *(u32x4*)(rowp + bj * HALF) = w; } }
    }
};
constexpr float RMS_EPS = 1e-6f;
typedef unsigned u32x2 __attribute__((ext_vector_type(2)));
__device__ __forceinline__ float f32_atomic_add(float* p, float v) { return __hip_atomic_fetch_add(p, v, __ATOMIC_RELAXED, __HIP_MEMORY_SCOPE_AGENT); }
__device__ __forceinline__ float bf_lo(unsigned w) { return __uint_as_float(w << 16); }
__device__ __forceinline__ float bf_hi(unsigned w) { return __uint_as_float(w & 0xffff0000u); }
__device__ __forceinline__ float sumsq8(const f32x4& v0, const f32x4& v1) { return (v0[0] * v0[0] + v0[1] * v0[1]) + (v0[2] * v0[2] + v0[3] * v0[3]) + (v1[0] * v1[0] + v1[1] * v1[1]) + (v1[2] * v1[2] + v1[3] * v1[3]); }
__device__ __forceinline__ u32x4 pack8(const f32x4& v0, const f32x4& v1) { u32x4 w; w.x = cvt_pk_bf16(v0[0], v0[1]); w.y = cvt_pk_bf16(v0[2], v0[3]); w.z = cvt_pk_bf16(v1[0], v1[1]); w.w = cvt_pk_bf16(v1[2], v1[3]); return w; }
struct EpiBf16Rs {
    static constexpr bool PERM = true, AFTER_DRAIN = false, MIDSCALE = false, FULL = false;
    bf16_t* O; int ldc; const float* ssq;
    __device__ __forceinline__ void operator()(const f32x4 (&acc)[2][2][4][2], const Unit& u, int wr, int wc, int fr, int fq) const {
        const int row0 = u.pm * BM + wr * 64 + fr, col0 = u.pn * BM + wc * 32 + 8 * fq;
#pragma unroll
        for (int ai = 0; ai < 2; ++ai)
#pragma unroll
            for (int m = 0; m < 4; ++m) { const int row = row0 + ai * HALF + m * 16; bf16_t* rowp = O + (size_t)row * ldc + col0;
                const float rs = ssq ? __builtin_amdgcn_rsqf(ssq[row] * (1.0f / 1024.0f) + RMS_EPS) : 1.0f;
#pragma unroll
                for (int bj = 0; bj < 2; ++bj) *(u32x4*)(rowp + bj * HALF) = pack8(acc[ai][bj][m][0] * rs, acc[ai][bj][m][1] * rs); }
    }
};
struct EpiOutProj {
    static constexpr bool PERM = true, AFTER_DRAIN = false, MIDSCALE = true, FULL = false;
    const float* base0; const float* base1; int split;
    bf16_t* hb; float* ssq; const float* ssqA; const float* ssqB;
    __device__ __forceinline__ void prep(PG8_LAS unsigned char* lds, int tid, const Unit& u, int wr, int fr) const {
        const int row0 = u.pm * BM + wr * 64 + fr; PG8_LAS f32x4* slot = (PG8_LAS f32x4*)(lds + STAGE_BYTES) + tid * 2;
#pragma unroll
        for (int ai = 0; ai < 2; ++ai) { f32x4 q;
#pragma unroll
            for (int m = 0; m < 4; ++m) { const int row = row0 + ai * HALF + m * 16;
                q[m] = __builtin_amdgcn_rsqf(ssqA[row] * (1.0f / 512.0f) + RMS_EPS) * __builtin_amdgcn_sqrtf(ssqB[row] * (1.0f / 512.0f) + RMS_EPS); }
            slot[ai] = q; }
    }
    __device__ __forceinline__ void midscale(f32x4 (&acc)[2][2][4][2], PG8_LAS unsigned char* lds, int tid) const {
        const PG8_LAS f32x4* slot = (const PG8_LAS f32x4*)(lds + STAGE_BYTES) + tid * 2;
#pragma unroll
        for (int ai = 0; ai < 2; ++ai) { const f32x4 q = slot[ai];
#pragma unroll
            for (int bj = 0; bj < 2; ++bj)
#pragma unroll
                for (int m = 0; m < 4; ++m)
#pragma unroll
                    for (int n = 0; n < 2; ++n) acc[ai][bj][m][n] *= q[m]; }
    }
    __device__ __forceinline__ void operator()(const f32x4 (&acc)[2][2][4][2], const Unit& u, int wr, int wc, int fr, int fq) const {
        const int row0 = u.pm * BM + wr * 64 + fr, col0 = u.pn * BM + wc * 32 + 8 * fq;
#pragma unroll
        for (int ai = 0; ai < 2; ++ai)
#pragma unroll
            for (int m = 0; m < 4; ++m) { const int row = row0 + ai * HALF + m * 16;
                const float* bp = (row < split ? base0 + (size_t)row * 1024 : base1 + (size_t)(row - split) * 1024) + col0;
                bf16_t* hp = hb + (size_t)row * 1024 + col0; float s = 0.f;
                const float rb = __builtin_amdgcn_rsqf(ssqB[row] * (1.0f / 512.0f) + RMS_EPS);
#pragma unroll
                for (int bj = 0; bj < 2; ++bj) { const f32x4 b0 = *(const f32x4*)(bp + bj * HALF), b1 = *(const f32x4*)(bp + bj * HALF + 4);
                    const f32x4 v0 = acc[ai][bj][m][0] * rb + b0, v1 = acc[ai][bj][m][1] * rb + b1;
                    *(u32x4*)(hp + bj * HALF) = pack8(v0, v1); s += sumsq8(v0, v1); }
                s += __shfl_xor(s, 16); s += __shfl_xor(s, 32);
                if (fq == 0) f32_atomic_add(ssq + row, s); }
    }
};
struct EpiResB {
    static constexpr bool PERM = true, AFTER_DRAIN = false, MIDSCALE = false, FULL = false;
    const bf16_t* hin; bf16_t* hout; float* ssq;
    __device__ __forceinline__ void operator()(const f32x4 (&acc)[2][2][4][2], const Unit& u, int wr, int wc, int fr, int fq) const {
        const int row0 = u.pm * BM + wr * 64 + fr, col0 = u.pn * BM + wc * 32 + 8 * fq;
#pragma unroll
        for (int ai = 0; ai < 2; ++ai)
#pragma unroll
            for (int m = 0; m < 4; ++m) { const int row = row0 + ai * HALF + m * 16;
                const bf16_t* bp = hin + (size_t)row * 1024 + col0; bf16_t* hp = hout + (size_t)row * 1024 + col0; float s = 0.f;
#pragma unroll
                for (int bj = 0; bj < 2; ++bj) { const u32x4 bw = *(const u32x4*)(bp + bj * HALF);
                    const f32x4 v0 = acc[ai][bj][m][0] + (f32x4){bf_lo(bw.x), bf_hi(bw.x), bf_lo(bw.y), bf_hi(bw.y)}, v1 = acc[ai][bj][m][1] + (f32x4){bf_lo(bw.z), bf_hi(bw.z), bf_lo(bw.w), bf_hi(bw.w)};
                    *(u32x4*)(hp + bj * HALF) = pack8(v0, v1); s += sumsq8(v0, v1); }
                s += __shfl_xor(s, 16); s += __shfl_xor(s, 32);
                if (fq == 0) f32_atomic_add(ssq + row, s); }
    }
};
struct EpiGate {
    static constexpr bool PERM = true, AFTER_DRAIN = false, MIDSCALE = false, FULL = false;
    const bf16_t* hin; const bf16_t* E; bf16_t* hout; const float* ssq_in; float* ssq_out;
    __device__ __forceinline__ void operator()(const f32x4 (&acc)[2][2][4][2], const Unit& u, int wr, int wc, int fr, int fq) const {
        const int row0 = u.pm * BM + wr * 64 + fr, col0 = u.pn * BM + wc * 32 + 8 * fq;
#pragma unroll
        for (int ai = 0; ai < 2; ++ai)
#pragma unroll
            for (int m = 0; m < 4; ++m) { const int row = row0 + ai * HALF + m * 16;
                const bf16_t* bp = hin + (size_t)row * 1024 + col0; const bf16_t* ep = E + (size_t)row * 1024 + col0; bf16_t* hp = hout + (size_t)row * 1024 + col0; float s = 0.f;
                const float rs = __builtin_amdgcn_rsqf(ssq_in[row] * (1.0f / 1024.0f) + RMS_EPS) * -1.4426950408889634f;
#pragma unroll
                for (int bj = 0; bj < 2; ++bj) { const u32x4 bw = *(const u32x4*)(bp + bj * HALF), ew = *(const u32x4*)(ep + bj * HALF);
                    const f32x4 b0 = (f32x4){bf_lo(bw.x), bf_hi(bw.x), bf_lo(bw.y), bf_hi(bw.y)}, b1 = (f32x4){bf_lo(bw.z), bf_hi(bw.z), bf_lo(bw.w), bf_hi(bw.w)};
                    const f32x4 e0 = (f32x4){bf_lo(ew.x), bf_hi(ew.x), bf_lo(ew.y), bf_hi(ew.y)}, e1 = (f32x4){bf_lo(ew.z), bf_hi(ew.z), bf_lo(ew.w), bf_hi(ew.w)};
                    f32x4 v0, v1;
#pragma unroll
                    for (int k = 0; k < 4; ++k) { const float g0 = __builtin_amdgcn_rcpf(1.0f + __builtin_amdgcn_exp2f(acc[ai][bj][m][0][k] * rs)), g1 = __builtin_amdgcn_rcpf(1.0f + __builtin_amdgcn_exp2f(acc[ai][bj][m][1][k] * rs));
                        v0[k] = b0[k] + g0 * e0[k]; v1[k] = b1[k] + g1 * e1[k]; }
                    *(u32x4*)(hp + bj * HALF) = pack8(v0, v1); s += sumsq8(v0, v1); }
                s += __shfl_xor(s, 16); s += __shfl_xor(s, 32);
                if (fq == 0) f32_atomic_add(ssq_out + row, s); }
    }
};

#define PG8_DPPF(oldv, srcv, ctrl, bc) __builtin_bit_cast(float, __builtin_amdgcn_update_dpp(__builtin_bit_cast(int, (float)(oldv)), __builtin_bit_cast(int, (float)(srcv)), (ctrl), 0xf, 0xf, (bc)))
struct EpiConvGate {
    static constexpr bool PERM = true, AFTER_DRAIN = false, MIDSCALE = false, FULL = true;
    bf16_t* ACT; const float* ssq; const float* cw; const float* cb; int Mrows; int dff;
    __device__ __forceinline__ void full(f32x4 (&acc)[2][2][4][2], const Unit& u, int wr_, int wc_, int fr_, int fq_, PG8_LAS unsigned char* lds, int tid_) const {
        int tid = tid_; asm volatile("" : "+v"(tid));
        const int wid = __builtin_amdgcn_readfirstlane(tid >> 6), lane = tid & 63, wr = wid >> 2, wc = wid & 3, fr = lane & 15, fq = lane >> 4; (void)wr_; (void)wc_; (void)fr_; (void)fq_;
        const int gbase = u.pm * 254 - 1, rbase = wr * 64 + fr, col = wc * 32 + 8 * fq, cbase = u.pn * HALF + col;
        const unsigned voff = (unsigned)cbase * 4u;
        PG8_LAS float* X = (PG8_LAS float*)(lds + STAGE_BYTES);
#pragma unroll
        for (int ai = 0; ai < 2; ++ai)
#pragma unroll
            for (int m = 0; m < 4; ++m) { const int g = gbase + rbase + ai * HALF + m * 16; const int gc = g < 0 ? 0 : (g >= Mrows ? Mrows - 1 : g);
                const float rs = __builtin_amdgcn_rsqf(ssq[gc] * (1.0f / 1024.0f) + RMS_EPS);
#pragma unroll
                for (int bj = 0; bj < 2; ++bj)
#pragma unroll
                    for (int n = 0; n < 2; ++n) { acc[ai][bj][m][n] *= rs; asm volatile("" : "+v"(acc[ai][bj][m][n])); }
                __builtin_amdgcn_sched_barrier(0); }
        if (tid < 64) *(PG8_LAS f32x4*)(X + 8 * 256 + tid * 4) = (f32x4){0.f, 0.f, 0.f, 0.f};
        if (fr == 0) {
#pragma unroll
            for (int ai = 0; ai < 2; ++ai)
#pragma unroll
                for (int bj = 0; bj < 2; ++bj)
#pragma unroll
                    for (int n = 0; n < 2; ++n) *(PG8_LAS f32x4*)(X + ((2 * ai + wr) * 2 + 0) * 256 + bj * HALF + col + 4 * n) = acc[ai][bj][0][n]; }
        if (fr == 15) {
#pragma unroll
            for (int ai = 0; ai < 2; ++ai)
#pragma unroll
                for (int bj = 0; bj < 2; ++bj)
#pragma unroll
                    for (int n = 0; n < 2; ++n) *(PG8_LAS f32x4*)(X + ((2 * ai + wr) * 2 + 1) * 256 + bj * HALF + col + 4 * n) = acc[ai][bj][3][n]; }
        asm volatile("s_waitcnt lgkmcnt(0)" ::: "memory"); __builtin_amdgcn_s_barrier(); asm volatile("" ::: "memory");
        const float e0 = (fr == 0) ? 1.f : 0.f, e15 = (fr == 15) ? 1.f : 0.f;
#pragma unroll
        for (int n = 0; n < 2; ++n) {
            f32x4 w[2][4];
#pragma unroll
            for (int bj = 0; bj < 2; ++bj) {
#pragma unroll
                for (int k = 0; k < 3; ++k) w[bj][k] = *(const f32x4*)((const char*)(cw + (size_t)k * 2 * dff + bj * dff + 4 * n) + voff);
                w[bj][3] = *(const f32x4*)((const char*)(cb + bj * dff + 4 * n) + voff); }
#pragma unroll
            for (int ai = 0; ai < 2; ++ai) { const int sg = 2 * ai + wr; const int slotP = (sg > 0) ? (sg - 1) * 2 + 1 : 8, slotN = (sg < 3) ? (sg + 1) * 2 : 8;
                f32x4 saved[2], haloN[2];
#pragma unroll
                for (int bj = 0; bj < 2; ++bj) { saved[bj] = *(const PG8_LAS f32x4*)(X + slotP * 256 + bj * HALF + col + 4 * n); haloN[bj] = *(const PG8_LAS f32x4*)(X + slotN * 256 + bj * HALF + col + 4 * n); }
#pragma unroll
                for (int m = 0; m < 4; ++m) { const int r = rbase + ai * HALF + m * 16, g = gbase + r; const int S = (g < 65536) ? 2048 : 4096; const int t = g & (S - 1);
                    const float hp = (t != 0) ? 1.f : 0.f, hn = (t != S - 1) ? 1.f : 0.f;
                    f32x4 y[2];
#pragma unroll
                    for (int bj = 0; bj < 2; ++bj) { const f32x4 cur = acc[ai][bj][m][n]; const f32x4 nx = (m < 3) ? acc[ai][bj][m < 3 ? m + 1 : 3][n] : haloN[bj];
#pragma unroll
                        for (int i = 0; i < 4; ++i) {
                            const float pin = PG8_DPPF(0.f, cur[i], 0x111, true) + e0 * PG8_DPPF(0.f, saved[bj][i], 0x121, true);
                            const float nin = PG8_DPPF(0.f, cur[i], 0x101, true) + e15 * PG8_DPPF(0.f, nx[i], 0x12f, true);
                            y[bj][i] = (w[bj][1][i] * cur[i] + w[bj][3][i]) + (w[bj][0][i] * (hp * pin) + w[bj][2][i] * (hn * nin)); }
                        saved[bj] = cur; }
                    float o[4];
#pragma unroll
                    for (int i = 0; i < 4; ++i) { const float a = y[0][i], gg = y[1][i];
                        const float z = -2.302208198f * (gg + 0.044715f * gg * gg * gg);
                        o[i] = a * gg * __builtin_amdgcn_rcpf(1.0f + __builtin_amdgcn_exp2f(z)); }
                    u32x2 pk; pk.x = cvt_pk_bf16(o[0], o[1]); pk.y = cvt_pk_bf16(o[2], o[3]);
                    if (r >= 1 && r <= 254 && g < Mrows) *(u32x2*)(ACT + (size_t)g * dff + cbase + 4 * n) = pk;
                    __builtin_amdgcn_sched_barrier(0); } } }
    }
};

template <class Epi, class Sched, bool ALIGN_EPI = false, bool SP2 = false>
__device__ __forceinline__ void gemm_phase(PG8_LAS unsigned char* lds, const Gemm g, const Sched& S, const Epi& E) {
    int tid = threadIdx.x; asm volatile("" : "+v"(tid));
    const int wid = __builtin_amdgcn_readfirstlane(tid >> 6), lane = tid & 63, wr = wid >> 2, wc = wid & 3, fr = lane & 15, fq = lane >> 4;
    const int K = g.K, nt = K / BK;
    unsigned voffA[2], voffB[2];
#pragma unroll
    for (int i = 0; i < 2; ++i) { int R, C; stage_rc(tid * 16 + i * 8192, R, C); const int Rb = Epi::PERM ? ((R & ~31) + perm32(R & 31)) : R;
        voffA[i] = (unsigned)(R * K + C) * 2u; voffB[i] = (unsigned)(Rb * K + C) * 2u; }
    const size_t kstep = (size_t)(BK * 2);
    const size_t hstep = (size_t)HALF * K * 2;
    const size_t tstep = 2 * hstep;
    const size_t tstepA = g.a_tstep ? g.a_tstep : tstep;
    const unsigned ldsw = (unsigned)wid * 1024u;
    const int aoff = lds_byte(wr * 64 + fr, fq * 8), boff = lds_byte(wc * 32 + fr, fq * 8);
#define PG8_SA(b, h) (((b) * 2 + (h)) * HTB)
#define PG8_SB(b, h) ((4 + (b) * 2 + (h)) * HTB)
#define PG8_STAGE(bufoff, gbase, voff) do { _Pragma("unroll") for (int _i = 0; _i < 2; ++_i) \
        __builtin_amdgcn_global_load_lds((const unsigned*)((const char*)(gbase) + (voff)[_i]), (PG8_LAS unsigned*)(lds + (bufoff) + ldsw + _i * 8192), 16, 0, 0); } while (0)
#define PG8_LDA(dst, b, h) do { _Pragma("unroll") for (int m = 0; m < 4; ++m) _Pragma("unroll") for (int k = 0; k < 2; ++k) dst[m][k] = *(const PG8_LAS bf16x8*)(lds + PG8_SA(b, h) + aoff + m * 2048 + k * 1024); } while (0)
#define PG8_LDB(dst, b, h) do { _Pragma("unroll") for (int n = 0; n < 2; ++n) _Pragma("unroll") for (int k = 0; k < 2; ++k) dst[n][k] = *(const PG8_LAS bf16x8*)(lds + PG8_SB(b, h) + boff + n * 2048 + k * 1024); } while (0)
#define PG8_MMA(ai, bj, At, Bt) do { __builtin_amdgcn_s_setprio(1); _Pragma("unroll") for (int m = 0; m < 4; ++m) _Pragma("unroll") for (int n = 0; n < 2; ++n) _Pragma("unroll") for (int k = 0; k < 2; ++k) \
        acc[ai][bj][m][n] = __builtin_amdgcn_mfma_f32_16x16x32_bf16(Bt[n][k], At[m][k], acc[ai][bj][m][n], 0, 0, 0); __builtin_amdgcn_s_setprio(0); } while (0)
#define PG8_WAIT_V(n) asm volatile("s_waitcnt vmcnt(" #n ")" ::: "memory")
#define PG8_WAIT_L(n) asm volatile("s_waitcnt lgkmcnt(" #n ")" ::: "memory")
#define PG8_BAR __builtin_amdgcn_s_barrier()
#define PG8_SCHED __builtin_amdgcn_sched_barrier(0)
    Unit cur, nxt; int ui = 0;
    if (!S.next(0, cur)) return;
    f32x4 acc[2][2][4][2];
#pragma unroll
    for (int a = 0; a < 2; ++a)
#pragma unroll
        for (int b = 0; b < 2; ++b)
#pragma unroll
            for (int m = 0; m < 4; ++m)
#pragma unroll
                for (int n = 0; n < 2; ++n) acc[a][b][m][n] = (f32x4){0.f, 0.f, 0.f, 0.f};
    bf16x8 At[4][2], B0[2][2], B1[2][2];
    const char* cA = (const char*)g.A + (size_t)cur.pm * tstepA; const char* cB = (const char*)g.Bt + (size_t)cur.pn * tstep;
    S.a_ready(cur);
    if constexpr (Epi::MIDSCALE) E.prep(lds, tid, cur, wr, fr);
    if constexpr (SP2) {
        PG8_STAGE(PG8_SB(0, 0), cB, voffB); PG8_STAGE(PG8_SB(0, 1), cB + hstep, voffB); PG8_STAGE(PG8_SA(0, 0), cA, voffA); PG8_STAGE(PG8_SA(0, 1), cA + hstep, voffA);
        if (wr == 1) PG8_BAR;
        PG8_WAIT_V(2); PG8_BAR;
        PG8_STAGE(PG8_SB(1, 0), cB + kstep, voffB); PG8_STAGE(PG8_SA(1, 0), cA + kstep, voffA); PG8_STAGE(PG8_SB(1, 1), cB + hstep + kstep, voffB);
        PG8_WAIT_V(6); PG8_BAR;
    } else {
        PG8_STAGE(PG8_SB(0, 0), cB, voffB); PG8_STAGE(PG8_SA(0, 0), cA, voffA); PG8_STAGE(PG8_SB(0, 1), cB + hstep, voffB); PG8_STAGE(PG8_SA(0, 1), cA + hstep, voffA);
        if (wr == 1) PG8_BAR;
        PG8_WAIT_V(4); PG8_BAR;
        PG8_STAGE(PG8_SB(1, 0), cB + kstep, voffB); PG8_STAGE(PG8_SA(1, 0), cA + kstep, voffA); PG8_STAGE(PG8_SB(1, 1), cB + hstep + kstep, voffB);
        PG8_WAIT_V(6); PG8_BAR;
    }
    for (;;) {
        const bool has_next = S.next(ui + 1, nxt);
        const char* nA = has_next ? (const char*)g.A + (size_t)nxt.pm * tstepA : cA; const char* nB = has_next ? (const char*)g.Bt + (size_t)nxt.pn * tstep : cB;
        for (int t = 0; t < nt; t += 2) {
            if constexpr (Epi::MIDSCALE) { if (t == (nt >> 1)) E.midscale(acc, lds, tid); }
            const bool last = (t == nt - 2);
            const char* a1 = cA + (size_t)(t + 1) * kstep;
            const char* a2 = last ? nA : cA + (size_t)(t + 2) * kstep; const char* b2 = last ? nB : cB + (size_t)(t + 2) * kstep;
            const char* a3 = a2 + kstep; const char* b3 = b2 + kstep;
            if (last && has_next) S.a_ready(nxt);
            if constexpr (SP2) {
            PG8_LDB(B0, 0, 0); PG8_LDB(B1, 0, 1); PG8_SCHED; PG8_LDA(At, 0, 0); PG8_STAGE(PG8_SA(1, 1), a1 + hstep, voffA);
            PG8_WAIT_V(8); PG8_WAIT_L(0); PG8_BAR; PG8_MMA(0, 0, At, B0); PG8_MMA(0, 1, At, B1); PG8_BAR; PG8_SCHED;
            PG8_LDA(At, 0, 1); PG8_STAGE(PG8_SB(0, 0), b2, voffB); PG8_STAGE(PG8_SB(0, 1), b2 + hstep, voffB); PG8_STAGE(PG8_SA(0, 0), a2, voffA);
            PG8_WAIT_V(8); PG8_WAIT_L(0); PG8_BAR; PG8_MMA(1, 0, At, B0); PG8_MMA(1, 1, At, B1); PG8_BAR; PG8_SCHED;
            PG8_LDB(B0, 1, 0); PG8_LDB(B1, 1, 1); PG8_SCHED; PG8_LDA(At, 1, 0); PG8_STAGE(PG8_SA(0, 1), a2 + hstep, voffA);
            PG8_WAIT_V(8); PG8_WAIT_L(0); PG8_BAR; PG8_MMA(0, 0, At, B0); PG8_MMA(0, 1, At, B1); PG8_BAR; PG8_SCHED;
            PG8_LDA(At, 1, 1); PG8_STAGE(PG8_SB(1, 0), b3, voffB); PG8_STAGE(PG8_SB(1, 1), b3 + hstep, voffB); PG8_STAGE(PG8_SA(1, 0), a3, voffA);
            PG8_WAIT_V(8); PG8_WAIT_L(0); PG8_BAR; PG8_MMA(1, 0, At, B0); PG8_MMA(1, 1, At, B1); PG8_BAR; PG8_SCHED;
            } else {
            PG8_LDB(B0, 0, 0); PG8_SCHED; PG8_LDA(At, 0, 0); PG8_STAGE(PG8_SA(1, 1), a1 + hstep, voffA);
            PG8_WAIT_L(8); PG8_BAR; PG8_WAIT_L(0); PG8_MMA(0, 0, At, B0); PG8_BAR; PG8_SCHED;
            PG8_LDB(B1, 0, 1); PG8_STAGE(PG8_SB(0, 0), b2, voffB);
            PG8_BAR; PG8_WAIT_L(0); PG8_MMA(0, 1, At, B1); PG8_BAR;
            PG8_LDA(At, 0, 1); PG8_STAGE(PG8_SA(0, 0), a2, voffA);
            PG8_BAR; PG8_WAIT_L(0); PG8_MMA(1, 0, At, B0); PG8_BAR; PG8_SCHED;
            PG8_STAGE(PG8_SB(0, 1), b2 + hstep, voffB);
            PG8_WAIT_V(6); PG8_BAR; PG8_MMA(1, 1, At, B1); PG8_BAR;
            PG8_LDB(B0, 1, 0); PG8_SCHED; PG8_LDA(At, 1, 0); PG8_STAGE(PG8_SA(0, 1), a2 + hstep, voffA);
            PG8_WAIT_L(8); PG8_BAR; PG8_WAIT_L(0); PG8_MMA(0, 0, At, B0); PG8_BAR; PG8_SCHED;
            PG8_LDB(B1, 1, 1); PG8_STAGE(PG8_SB(1, 0), b3, voffB);
            PG8_BAR; PG8_WAIT_L(0); PG8_MMA(0, 1, At, B1); PG8_BAR;
            PG8_LDA(At, 1, 1); PG8_STAGE(PG8_SA(1, 0), a3, voffA);
            PG8_BAR; PG8_WAIT_L(0); PG8_MMA(1, 0, At, B0); PG8_BAR; PG8_SCHED;
            PG8_STAGE(PG8_SB(1, 1), b3 + hstep, voffB);
            PG8_WAIT_V(6); PG8_BAR; PG8_MMA(1, 1, At, B1); PG8_BAR;
            }
        }
        if constexpr (ALIGN_EPI) { if (wr == 0) PG8_BAR; }
        if constexpr (Epi::FULL) { E.full(acc, cur, wr, wc, fr, fq, lds, tid); S.done(cur); } else if constexpr (!Epi::AFTER_DRAIN) { E(acc, cur, wr, wc, fr, fq); S.done(cur); }
        if (!has_next) break;
#pragma unroll
        for (int a = 0; a < 2; ++a)
#pragma unroll
            for (int b = 0; b < 2; ++b)
#pragma unroll
                for (int m = 0; m < 4; ++m)
#pragma unroll
                    for (int n = 0; n < 2; ++n) acc[a][b][m][n] = (f32x4){0.f, 0.f, 0.f, 0.f};
        cur = nxt; cA = nA; cB = nB; ++ui;
        if constexpr (Epi::MIDSCALE) E.prep(lds, tid, cur, wr, fr);
        if constexpr (ALIGN_EPI) { if (wr == 1) PG8_BAR; }
    }
    PG8_WAIT_V(0);
    if constexpr (!ALIGN_EPI) { if (wr == 0) PG8_BAR; }
    PG8_BAR;
    if constexpr (Epi::AFTER_DRAIN) { E.fused(acc, cur, wr, wc, fr, fq, lds, wid, lane); S.done(cur); }
#undef PG8_SA
#undef PG8_SB
#undef PG8_STAGE
#undef PG8_LDA
#undef PG8_LDB
#undef PG8_MMA
#undef PG8_WAIT_V
#undef PG8_WAIT_L
#undef PG8_BAR
#undef PG8_SCHED
}
}
#include <hip/hip_bf16.h>
#include <cmath>
namespace attn_body {
using bf16=__hip_bfloat16;
using bf16x8=__attribute__((ext_vector_type(8)))short;
using s16x4=__attribute__((ext_vector_type(4)))short;
using f32x16=__attribute__((ext_vector_type(16)))float;
using u32x4=__attribute__((ext_vector_type(4)))unsigned;
constexpr int D=64,PQ=2304,PO=1024;
constexpr int NW=8,QBLK=32,QB=QBLK*NW,KVBLK=64;
__device__ __forceinline__ int crow(int r,int hi){return (r&3)+8*(r>>2)+4*hi;}
#define SBAR() __builtin_amdgcn_sched_barrier(0)
__device__ __forceinline__ void cmask(f32x16&p0,f32x16&p1,int jb,int qrel,int hi){
  const float NEG=-INFINITY; int kb=64*jb+4*hi;
  #pragma unroll
  for(int r=0;r<16;++r){int kv=kb+(r&3)+8*(r>>2); if(kv>qrel)p0[r]=NEG; if(kv+32>qrel)p1[r]=NEG;}
}

constexpr int NSLOT=3, SLOTB=8192;
constexpr int LDS_K=0, LDS_V=NSLOT*SLOTB, LDS_WS=2*NSLOT*SLOTB, LDS_OST=LDS_WS+NW*64*4, LDS_BYTES=LDS_OST+NW*4096;
constexpr float C2=0.125f*1.4426950408889634f;
__device__ __forceinline__ void glds16(const void*gsrc,unsigned lds_dst){unsigned keep;
  asm volatile("s_mov_b32 %0, m0\n\ts_mov_b32 m0, %2\n\ts_nop 0\n\tglobal_load_lds_dwordx4 %1, off\n\ts_mov_b32 m0, %0":"=&s"(keep):"v"(gsrc),"s"(lds_dst):"memory");}
__device__ __forceinline__ float max3f(float a,float b,float c){float r;asm("v_max3_f32 %0, %1, %2, %3":"=v"(r):"v"(a),"v"(b),"v"(c));return r;}
__device__ __forceinline__ float max2f(float a,float b){float r;asm("v_max_f32_e32 %0, %1, %2":"=v"(r):"v"(a),"v"(b));return r;}
__device__ __forceinline__ float fadd_s(float a,float b){float r;asm("v_add_f32_e32 %0, %1, %2":"=v"(r):"v"(a),"v"(b));return r;}
__device__ __forceinline__ float fsub_s(float a,float b){float r;asm("v_sub_f32_e32 %0, %1, %2":"=v"(r):"v"(a),"v"(b));return r;}
typedef float f32x2_t __attribute__((ext_vector_type(2))); typedef __bf16 bf16x2_t __attribute__((ext_vector_type(2)));
__device__ __forceinline__ unsigned cvtpk_s(float lo,float hi){f32x2_t v={lo,hi};bf16x2_t b=__builtin_convertvector(v,bf16x2_t);return __builtin_bit_cast(unsigned,b);}
#define WAIT_BAR(N) asm volatile("s_waitcnt vmcnt(" #N ") lgkmcnt(0)\n\ts_barrier":::"memory")

__device__ __forceinline__ void qkt(f32x16&p0,f32x16&p1,const char*Kslot,const bf16x8*qr,const f32x16&negm,int r32,int hi){
  const char*kb=Kslot+hi*1024+r32*16;
  #pragma unroll
  for(int d0=0;d0<4;++d0){
    const bf16x8 b0=*reinterpret_cast<const bf16x8*>(kb+d0*2048);
    const bf16x8 b1=*reinterpret_cast<const bf16x8*>(kb+d0*2048+512);
    if(d0==0){p0=__builtin_amdgcn_mfma_f32_32x32x16_bf16(b0,qr[0],negm,0,0,0);p1=__builtin_amdgcn_mfma_f32_32x32x16_bf16(b1,qr[0],negm,0,0,0);}
    else{p0=__builtin_amdgcn_mfma_f32_32x32x16_bf16(b0,qr[d0],p0,0,0,0);p1=__builtin_amdgcn_mfma_f32_32x32x16_bf16(b1,qr[d0],p1,0,0,0);}}
}
typedef __attribute__((address_space(3))) const char* lds_cptr;
typedef short v4i16_t __attribute__((ext_vector_type(4)));
__device__ __forceinline__ void kload8(bf16x8*kf,lds_cptr kp){
  kf[0]=*(const __attribute__((address_space(3))) bf16x8*)(kp);      kf[1]=*(const __attribute__((address_space(3))) bf16x8*)(kp+512);
  kf[2]=*(const __attribute__((address_space(3))) bf16x8*)(kp+2048); kf[3]=*(const __attribute__((address_space(3))) bf16x8*)(kp+2560);
  kf[4]=*(const __attribute__((address_space(3))) bf16x8*)(kp+4096); kf[5]=*(const __attribute__((address_space(3))) bf16x8*)(kp+4608);
  kf[6]=*(const __attribute__((address_space(3))) bf16x8*)(kp+6144); kf[7]=*(const __attribute__((address_space(3))) bf16x8*)(kp+6656);
}
__device__ __forceinline__ void kload2(bf16x8*kf,lds_cptr kp,int j){ kf[2*j]=*(const __attribute__((address_space(3))) bf16x8*)(kp+j*2048); kf[2*j+1]=*(const __attribute__((address_space(3))) bf16x8*)(kp+j*2048+512); }
__device__ __forceinline__ s16x4 vtr(lds_cptr p){ return __builtin_bit_cast(s16x4,__builtin_amdgcn_ds_read_tr16_b64_v4i16((__attribute__((address_space(3))) v4i16_t*)p)); }
__device__ __forceinline__ float rowmax(const f32x16&p0,const f32x16&p1){
  float a=max3f(p0[0],p0[1],p1[0]),b=max3f(p0[2],p0[3],p1[1]);a=max3f(a,p1[2],p1[3]);
  #pragma unroll
  for(int r=4;r<16;r+=4){a=max3f(a,p0[r],p0[r+1]);b=max3f(b,p0[r+2],p0[r+3]);a=max3f(a,p1[r],p1[r+1]);b=max3f(b,p1[r+2],p1[r+3]);}
  const float m=max2f(a,b);
  auto rr=__builtin_amdgcn_permlane32_swap(__float_as_uint(m),__float_as_uint(m),false,false);
  return max2f(__uint_as_float(rr[0]),__uint_as_float(rr[1]));
}
__device__ __forceinline__ void pv(f32x16*o,int vb,bf16x8 pa0,bf16x8 pa1,bf16x8 pa2,bf16x8 pa3){
  #pragma unroll
  for(int d0=0;d0<2;++d0){s16x4 lo[4],hi[4];
    #pragma unroll
    for(int ks=0;ks<4;++ks){
      asm volatile("ds_read_b64_tr_b16 %0,%1 offset:%c2":"=&v"(lo[ks]):"v"(vb),"i"(d0*4096+ks*1024):"memory");
      asm volatile("ds_read_b64_tr_b16 %0,%1 offset:%c2":"=&v"(hi[ks]):"v"(vb),"i"(d0*4096+ks*1024+512):"memory");}
    asm volatile("s_waitcnt lgkmcnt(0)":::"memory");SBAR();
    #define PK(k) (bf16x8){lo[k][0],lo[k][1],lo[k][2],lo[k][3],hi[k][0],hi[k][1],hi[k][2],hi[k][3]}
    o[d0]=__builtin_amdgcn_mfma_f32_32x32x16_bf16(pa0,PK(0),o[d0],0,0,0);
    o[d0]=__builtin_amdgcn_mfma_f32_32x32x16_bf16(pa1,PK(1),o[d0],0,0,0);
    o[d0]=__builtin_amdgcn_mfma_f32_32x32x16_bf16(pa2,PK(2),o[d0],0,0,0);
    o[d0]=__builtin_amdgcn_mfma_f32_32x32x16_bf16(pa3,PK(3),o[d0],0,0,0);
    #undef PK
  }
}

#ifndef ATTN_STORE16
#define ATTN_STORE16(p,v) (*(u32x4*)(p)=(v))
#endif
template<int THRL> __device__ __forceinline__ void attn_unit(long rowbase,int NT,int h,int kvh,int qb,const bf16*Q,const bf16*__restrict__ K,const bf16*__restrict__ V,bf16*O,float*ssq,char*shm){
  int tid=threadIdx.x; asm volatile("":"+v"(tid)); const int lane=tid&63,r32=lane&31,hi=lane>>5; const int wid=__builtin_amdgcn_readfirstlane(tid>>6);
  const int q0=qb*QB;
  const bf16*Qw=Q+(rowbase+q0+wid*QBLK)*PQ+h*D;
  const bf16*Kh=K+rowbase*PQ+kvh*D,*Vh=V+rowbase*PQ+kvh*D;
  const unsigned lds0=(unsigned)(uintptr_t)shm;
  float*wsf=(float*)(shm+LDS_WS)+wid*64;
  const bf16*ksrc=Kh+(long)lane*PQ+wid*8;
  const bf16*vsrc=Vh+(long)(16*(wid&3)+(lane>>2))*PQ+(wid>>2)*32+(lane&3)*8;
  const unsigned kdst=lds0+LDS_K+wid*1024, vdst=lds0+LDS_V+wid*1024;
  #define DMA_K(t,slot) glds16(ksrc+(long)(t)*KVBLK*PQ,(unsigned)__builtin_amdgcn_readfirstlane(kdst+(slot)))
  #define DMA_V(t,slot) glds16(vsrc+(long)(t)*KVBLK*PQ,(unsigned)__builtin_amdgcn_readfirstlane(vdst+(slot)))
  const int vb0=(int)(lds0+LDS_V)+((lane>>4)&1)*32+(lane&3)*8+(4*hi+((lane&15)>>2))*64;
  const char*Kbase=shm+LDS_K; bf16x8 kf[8];
  const lds_cptr shm3=(lds_cptr)shm; const lds_cptr kp0=shm3+LDS_K+hi*1024+r32*16; const lds_cptr vp0=shm3+LDS_V+((lane>>4)&1)*32+(lane&3)*8+(4*hi+((lane&15)>>2))*64;
  DMA_K(0,0);DMA_V(0,0);DMA_K(1,SLOTB);
  bf16x8 qr[4];
  #pragma unroll
  for(int d0=0;d0<4;++d0)qr[d0]=*reinterpret_cast<const bf16x8*>(&Qw[(long)r32*PQ+d0*16+hi*8]);
  float mhat=0.f,l_reg=0.f;f32x16 o[2];o[0]=f32x16{};o[1]=f32x16{};f32x16 negm=f32x16{};asm volatile("":"+v"(negm));
  const int qrel=wid*QBLK+r32;
  #define CMASK(P0,P1,t) do{int jb_=(t)-(NT-4); (void)jb_;(void)qrel;}while(0)
  bool resc=false;
  #define START(P0,P1) do{ const float rm=rowmax(P0,P1); resc=false; \
    { const float dl=rm; mhat=fadd_s(mhat,dl); \
      _Pragma("unroll") for(int r=0;r<16;++r){P0[r]=fsub_s(P0[r],dl);P1[r]=fsub_s(P1[r],dl);} \
      _Pragma("unroll") for(int r=0;r<16;++r)negm[r]=-mhat; asm volatile("":"+v"(negm)); } \
    _Pragma("unroll") for(int r=0;r<16;++r)P0[r]=__builtin_amdgcn_exp2f(P0[r]); }while(0)
  #define RESC() do{ if(resc){ asm volatile("s_waitcnt lgkmcnt(0)":::"memory"); \
      _Pragma("unroll") for(int d_=0;d_<2;++d_) _Pragma("unroll") for(int r=0;r<16;++r)o[d_][r]*=wsf[crow(r,hi)]; } }while(0)
  f32x16 pA0,pA1,pB0,pB1;
  int sl_prev=0,sl_cur=0,sl_next=SLOTB;
  #define ROT() do{sl_prev=sl_cur;sl_cur=sl_next;sl_next=(sl_next==(NSLOT-1)*SLOTB)?0:sl_next+SLOTB;}while(0)
  DMA_K(2,2*SLOTB);
  WAIT_BAR(3);
  qkt(pA0,pA1,Kbase,qr,negm,r32,hi);asm volatile("s_nop 15\n\ts_nop 7":"+v"(pA0),"+v"(pA1));CMASK(pA0,pA1,0);
  START(pA0,pA1);
  _Pragma("unroll") for(int r=0;r<16;++r)pA1[r]=__builtin_amdgcn_exp2f(pA1[r]);
  WAIT_BAR(0);
  DMA_K(3,0);DMA_V(1,SLOTB);
  ROT();
  kload8(kf,kp0+sl_cur);
  WAIT_BAR(2);
  s16x4 vlo[8],vhi[8]; u32x4 pw0,pw1,pw2,pw3;
  #define PKW(P,B) cvtpk_s(P[B],P[B+1])
  #define PAF(k) __builtin_bit_cast(bf16x8,pw##k)
  #define VFR(i) (bf16x8){vlo[i][0],vlo[i][1],vlo[i][2],vlo[i][3],vhi[i][0],vhi[i][1],vhi[i][2],vhi[i][3]}
  #define PIN(x) asm volatile("":"+v"(x))
  #define MX3(a,b,c) __builtin_fmaxf(__builtin_fmaxf((a),(b)),(c))
  #define GAPA(MF,A0,A1,A2,A3,W0,W1,PW) do{ MF; sacc+=A0; sacc+=A1; sacc+=A2; sacc+=A3; PIN(sacc); W0; W1; PIN(PW); SBAR(); }while(0)
  #define EX(v) __builtin_amdgcn_exp2f(v)
  #define GAPB(MF,X,B) do{ MF; X[B]=EX(X[B]); X[B+1]=EX(X[B+1]); X[B+2]=EX(X[B+2]); X[B+3]=EX(X[B+3]); PIN(X); SBAR(); }while(0)
  #define VRD(i) do{ vlo[i]=vtr(vp_+(((i)>>2)*4096+((i)&3)*1024)); vhi[i]=vtr(vp_+(((i)>>2)*4096+((i)&3)*1024+512)); }while(0)
  #define KRD(G,j) do{ if(G){ kload2(kf,kp0+sl_next,j); SBAR(); } }while(0)
  #define STEP(C0,C1,P0,P1,t,GK,GV,GL) do{ SBAR(); \
    const lds_cptr vp_=vp0+sl_prev; \
    VRD(0); SBAR(); float sacc=(P0[0]+P0[1]); \
    GAPA(C0=__builtin_amdgcn_mfma_f32_32x32x16_bf16(kf[0],qr[0],negm,0,0,0), P0[2],P0[3],P0[4],P0[5],     pw0[0]=PKW(P0,0), pw0[1]=PKW(P0,2), pw0); \
    VRD(4); SBAR(); GAPA(C1=__builtin_amdgcn_mfma_f32_32x32x16_bf16(kf[1],qr[0],negm,0,0,0), P0[6],P0[7],P0[8],P0[9],     pw0[2]=PKW(P0,4), pw0[3]=PKW(P0,6), pw0); \
    VRD(1); SBAR(); GAPA(C0=__builtin_amdgcn_mfma_f32_32x32x16_bf16(kf[2],qr[1],C0,0,0,0),   P0[10],P0[11],P0[12],P0[13], pw1[0]=PKW(P0,8), pw1[1]=PKW(P0,10), pw1); \
    VRD(5); SBAR(); GAPA(C1=__builtin_amdgcn_mfma_f32_32x32x16_bf16(kf[3],qr[1],C1,0,0,0),   P0[14],P0[15],P1[0],P1[1],   pw1[2]=PKW(P0,12),pw1[3]=PKW(P0,14), pw1); \
    VRD(2); SBAR(); GAPA(C0=__builtin_amdgcn_mfma_f32_32x32x16_bf16(kf[4],qr[2],C0,0,0,0),   P1[2],P1[3],P1[4],P1[5],     pw2[0]=PKW(P1,0), pw2[1]=PKW(P1,2), pw2); \
    VRD(6); SBAR(); GAPA(C1=__builtin_amdgcn_mfma_f32_32x32x16_bf16(kf[5],qr[2],C1,0,0,0),   P1[6],P1[7],P1[8],P1[9],     pw2[2]=PKW(P1,4), pw2[3]=PKW(P1,6), pw2); \
    VRD(3); SBAR(); GAPA(C0=__builtin_amdgcn_mfma_f32_32x32x16_bf16(kf[6],qr[3],C0,0,0,0),   P1[10],P1[11],P1[12],P1[13], pw3[0]=PKW(P1,8), pw3[1]=PKW(P1,10), pw3); \
    VRD(7); SBAR(); GAPA(C1=__builtin_amdgcn_mfma_f32_32x32x16_bf16(kf[7],qr[3],C1,0,0,0),   P1[14],P1[15],0.f,0.f,       pw3[2]=PKW(P1,12),pw3[3]=PKW(P1,14), pw3); \
    l_reg+=sacc; \
    if(GK){DMA_K((t)+3,sl_cur);} if(GV){DMA_V((t)+1,sl_next);} \
    CMASK(C0,C1,t); \
    { float a=MX3(C0[0],C0[1],C1[0]),b=MX3(C0[2],C0[3],C1[1]); a=MX3(a,C1[2],C1[3]); \
      _Pragma("unroll") for(int r=4;r<16;r+=4){a=MX3(a,C0[r],C0[r+1]);b=MX3(b,C0[r+2],C0[r+3]);a=MX3(a,C1[r],C1[r+1]);b=MX3(b,C1[r+2],C1[r+3]);} \
      float rm=__builtin_fmaxf(a,b); { auto rr=__builtin_amdgcn_permlane32_swap(__float_as_uint(rm),__float_as_uint(rm),false,false); rm=__builtin_fmaxf(__uint_as_float(rr[0]),__uint_as_float(rr[1])); } \
      resc=false; \
      if(__builtin_expect(__any(rm>(float)THRL),0)){ const float dl=__builtin_fmaxf(rm,0.f); mhat+=dl; \
        _Pragma("unroll") for(int r=0;r<16;++r){C0[r]-=dl;C1[r]-=dl;} \
        _Pragma("unroll") for(int r=0;r<16;++r)negm[r]=-mhat; asm volatile("":"+v"(negm)); \
        const float f=__builtin_amdgcn_exp2f(-dl); l_reg*=f; if(hi==0)wsf[r32]=f; resc=true; } } \
    SBAR(); \
    GAPB(o[0]=__builtin_amdgcn_mfma_f32_32x32x16_bf16(PAF(0),VFR(0),o[0],0,0,0), C0,0); \
    GAPB(o[1]=__builtin_amdgcn_mfma_f32_32x32x16_bf16(PAF(0),VFR(4),o[1],0,0,0), C0,4); \
    KRD(GL,0); GAPB(o[0]=__builtin_amdgcn_mfma_f32_32x32x16_bf16(PAF(1),VFR(1),o[0],0,0,0), C0,8); \
    KRD(GL,1); GAPB(o[1]=__builtin_amdgcn_mfma_f32_32x32x16_bf16(PAF(1),VFR(5),o[1],0,0,0), C0,12); \
    KRD(GL,2); GAPB(o[0]=__builtin_amdgcn_mfma_f32_32x32x16_bf16(PAF(2),VFR(2),o[0],0,0,0), C1,0); \
    KRD(GL,3); GAPB(o[1]=__builtin_amdgcn_mfma_f32_32x32x16_bf16(PAF(2),VFR(6),o[1],0,0,0), C1,4); \
    GAPB(o[0]=__builtin_amdgcn_mfma_f32_32x32x16_bf16(PAF(3),VFR(3),o[0],0,0,0), C1,8); \
    GAPB(o[1]=__builtin_amdgcn_mfma_f32_32x32x16_bf16(PAF(3),VFR(7),o[1],0,0,0), C1,12); \
    }while(0)
  int t=1;
  #undef CMASK
  #define CMASK(P0,P1,t) do{}while(0)
  for(;t+5<NT;t+=2){
    STEP(pB0,pB1,pA0,pA1,t,true,true,true);     WAIT_BAR(2); RESC(); ROT();
    STEP(pA0,pA1,pB0,pB1,t+1,true,true,true);   WAIT_BAR(2); RESC(); ROT();
  }
  #undef CMASK
  #define CMASK(P0,P1,t) do{int jb_=(t)-(NT-4); (void)jb_;(void)qrel;}while(0)
  #define ENDW(tt) do{ if((tt)+3<NT){WAIT_BAR(2);} else if((tt)+2<NT){WAIT_BAR(1);} else {WAIT_BAR(0);} }while(0)
  for(;t+1<NT;t+=2){
    STEP(pB0,pB1,pA0,pA1,t,(t+3<NT),(t+1<NT),(t+1<NT));       ENDW(t);   RESC(); ROT();
    STEP(pA0,pA1,pB0,pB1,t+1,(t+4<NT),(t+2<NT),(t+2<NT));     ENDW(t+1); RESC(); ROT();
  }
  STEP(pB0,pB1,pA0,pA1,NT-1,false,false,false); RESC();
  { float sacc=pB0[0]+pB0[1]; _Pragma("unroll") for(int r=2;r<16;++r)sacc+=pB0[r]; _Pragma("unroll") for(int r=0;r<16;++r)sacc+=pB1[r]; l_reg+=sacc;
    pw0=(u32x4){PKW(pB0,0),PKW(pB0,2),PKW(pB0,4),PKW(pB0,6)};pw1=(u32x4){PKW(pB0,8),PKW(pB0,10),PKW(pB0,12),PKW(pB0,14)};pw2=(u32x4){PKW(pB1,0),PKW(pB1,2),PKW(pB1,4),PKW(pB1,6)};pw3=(u32x4){PKW(pB1,8),PKW(pB1,10),PKW(pB1,12),PKW(pB1,14)};
    SBAR(); pv(o,vb0+sl_cur,PAF(0),PAF(1),PAF(2),PAF(3)); }
  #undef PKW
  #undef PAF
  #undef VFR
  #undef PIN
  #undef MX3
  #undef GAPA
  #undef GAPB
  #undef EX
  #undef VRD
  #undef KRD
  #undef STEP
  #undef ENDW
  {auto rr=__builtin_amdgcn_permlane32_swap(__float_as_uint(l_reg),__float_as_uint(l_reg),false,false);l_reg=__uint_as_float(rr[0])+__uint_as_float(rr[1]);}
  if(hi==0)wsf[32+r32]=l_reg;asm volatile("s_waitcnt lgkmcnt(0)":::"memory");
  float rli[16];
  #pragma unroll
  for(int r=0;r<16;++r)rli[r]=__builtin_amdgcn_rcpf(wsf[32+crow(r,hi)]);
  bf16*Ow=O+(rowbase+q0+wid*QBLK)*PO+h*D;
  { bf16*stg=(bf16*)(shm+LDS_OST)+wid*2048;
    #pragma unroll
    for(int r=0;r<16;++r){const int orow=crow(r,hi);
      #pragma unroll
      for(int d0=0;d0<2;++d0)stg[orow*64+d0*32+r32]=__float2bfloat16(o[d0][r]*rli[r]);}
    asm volatile("s_waitcnt lgkmcnt(0)":::"memory");
    #pragma unroll
    for(int i=0;i<4;++i){const int row=i*8+(lane>>3),ch=lane&7; const u32x4 v=*(const u32x4*)(stg+row*64+ch*8); ATTN_STORE16(Ow+(long)row*PO+ch*8,v);
      float ss=0.f; _Pragma("unroll") for(int e=0;e<4;++e){const float lo=__uint_as_float(v[e]<<16),hh=__uint_as_float(v[e]&0xffff0000u); ss+=lo*lo+hh*hh;}
      ss+=__shfl_xor(ss,1);ss+=__shfl_xor(ss,2);ss+=__shfl_xor(ss,4); if(ch==0)__hip_atomic_fetch_add(ssq+(rowbase+q0+wid*QBLK+row),ss,__ATOMIC_RELAXED,__HIP_MEMORY_SCOPE_AGENT);} }
  asm volatile("s_waitcnt lgkmcnt(0)\n\ts_barrier":::"memory");
  #undef DMA_K
  #undef DMA_V
  #undef CMASK
  #undef START
  #undef RESC
  #undef ROT
}
constexpr int ATTN_LDS_BYTES=LDS_BYTES;
#undef SBAR
#undef WAIT_BAR
}
namespace na_body {
using attn_body::bf16x8; using attn_body::s16x4; using attn_body::f32x16; using attn_body::u32x4;
#define NA_LAS __attribute__((address_space(3)))
constexpr int PQ = 2304, PO = 1024;
constexpr int COL_QB = 768, COL_KB = 1280, COL_VB = 1792, COL_OB = 512;
constexpr int T_GUARD = 48, T_FLOATS = T_GUARD + 15 * 32 + 48;
__device__ __forceinline__ int crow(int r, int hi) { return (r & 3) + 8 * (r >> 2) + 4 * hi; }
__device__ __forceinline__ unsigned cvtpk(float lo, float hi) { return attn_body::cvtpk_s(lo, hi); }

__device__ __forceinline__ void na_unit(const unsigned short* __restrict__ PROJ, unsigned short* __restrict__ O, long rowbase, int rows, int r, int h,
                                        NA_LAS unsigned char* wl, unsigned wl_addr, const NA_LAS float* T, NA_LAS float* wsf, float* ssq) {
    int tid_ = threadIdx.x; asm volatile("" : "+v"(tid_)); const int lane = tid_ & 63, r32 = lane & 31, hi = lane >> 5;
    const int r0 = min(max(r - 4, 0), rows - 8);
    const long qrow0 = rowbase + (long)r * 64;
    const unsigned short* qbase = PROJ + (qrow0 + r32) * PQ + COL_QB + h * 64 + hi * 8;
    bf16x8 qr[2][4];
#pragma unroll
    for (int qb2 = 0; qb2 < 2; ++qb2)
#pragma unroll
        for (int d0 = 0; d0 < 4; ++d0) qr[qb2][d0] = *(const bf16x8*)(qbase + (long)qb2 * 32 * PQ + d0 * 16);
    float mrun[2] = {-1e30f, -1e30f}, lrun[2] = {0.f, 0.f};
    f32x16 o[2][2];
#pragma unroll
    for (int a = 0; a < 2; ++a)
#pragma unroll
        for (int b = 0; b < 2; ++b) o[a][b] = f32x16{};
    const int lrow = lane >> 3, lc = lane & 7;
    const int vb = (int)wl_addr + 8192 + ((lane >> 4) & 1) * 32 + (lane & 3) * 8 + (4 * hi + ((lane & 15) >> 2)) * 64;
    for (int i = 0; i < 8; ++i) {
        const unsigned short* kb = PROJ + (rowbase + (long)(r0 + i) * 64 + lrow) * PQ + COL_KB + h * 64 + lc * 8;
        u32x4 kreg[8], vreg[8];
#pragma unroll
        for (int j = 0; j < 8; ++j) { kreg[j] = *(const u32x4*)(kb + (long)j * 8 * PQ); vreg[j] = *(const u32x4*)(kb + (COL_VB - COL_KB) + (long)j * 8 * PQ); }
#pragma unroll
        for (int j = 0; j < 8; ++j) { const int row = j * 8 + lrow;
            *(NA_LAS u32x4*)(wl + lc * 1024 + row * 16) = kreg[j];
            *(NA_LAS u32x4*)(wl + 8192 + (lc >> 2) * 4096 + (row >> 4) * 1024 + (row & 15) * 64 + (lc & 3) * 16) = vreg[j]; }
        bf16x8 kf[8];
#pragma unroll
        for (int d0 = 0; d0 < 4; ++d0) { kf[2 * d0] = *(const NA_LAS bf16x8*)(wl + (2 * d0 + hi) * 1024 + r32 * 16); kf[2 * d0 + 1] = *(const NA_LAS bf16x8*)(wl + (2 * d0 + hi) * 1024 + 512 + r32 * 16); }
        const int dr = r0 + i - r + 7;
#pragma unroll
        for (int qb2 = 0; qb2 < 2; ++qb2) {
            f32x16 p0 = f32x16{}, p1 = f32x16{};
#pragma unroll
            for (int d0 = 0; d0 < 4; ++d0) { p0 = __builtin_amdgcn_mfma_f32_32x32x16_bf16(kf[2 * d0], qr[qb2][d0], p0, 0, 0, 0); p1 = __builtin_amdgcn_mfma_f32_32x32x16_bf16(kf[2 * d0 + 1], qr[qb2][d0], p1, 0, 0, 0); }
            const int c = qb2 * 32 + r32, c0 = min(max(c - 8, 0), 48);
            const NA_LAS float* tb = T + dr * 32 + 15 - c + 4 * hi;
            const int kofs = 4 * hi - c0;
            float rm = -1e30f;
#pragma unroll
            for (int rr = 0; rr < 16; ++rr) { const int kc = (rr & 3) + 8 * (rr >> 2);
                const float s0 = ((unsigned)(kc + kofs) < 16u) ? p0[rr] + tb[kc] : -1e30f;
                const float s1 = ((unsigned)(kc + 32 + kofs) < 16u) ? p1[rr] + tb[kc + 32] : -1e30f;
                p0[rr] = s0; p1[rr] = s1; rm = fmaxf(rm, fmaxf(s0, s1)); }
            rm = fmaxf(rm, __shfl_xor(rm, 32));
            const float mn = fmaxf(mrun[qb2], rm), alpha = __builtin_amdgcn_exp2f(mrun[qb2] - mn);
            mrun[qb2] = mn;
            float sum = 0.f;
#pragma unroll
            for (int rr = 0; rr < 16; ++rr) { p0[rr] = __builtin_amdgcn_exp2f(p0[rr] - mn); p1[rr] = __builtin_amdgcn_exp2f(p1[rr] - mn); sum += p0[rr] + p1[rr]; }
            lrun[qb2] = lrun[qb2] * alpha + sum;
            if (__any(alpha != 1.0f)) {
                if (hi == 0) wsf[r32] = alpha;
#pragma unroll
                for (int rr = 0; rr < 16; ++rr) { const float a = wsf[crow(rr, hi)]; o[qb2][0][rr] *= a; o[qb2][1][rr] *= a; }
            }
            u32x4 pw0, pw1, pw2, pw3;
            pw0 = (u32x4){cvtpk(p0[0], p0[1]), cvtpk(p0[2], p0[3]), cvtpk(p0[4], p0[5]), cvtpk(p0[6], p0[7])};
            pw1 = (u32x4){cvtpk(p0[8], p0[9]), cvtpk(p0[10], p0[11]), cvtpk(p0[12], p0[13]), cvtpk(p0[14], p0[15])};
            pw2 = (u32x4){cvtpk(p1[0], p1[1]), cvtpk(p1[2], p1[3]), cvtpk(p1[4], p1[5]), cvtpk(p1[6], p1[7])};
            pw3 = (u32x4){cvtpk(p1[8], p1[9]), cvtpk(p1[10], p1[11]), cvtpk(p1[12], p1[13]), cvtpk(p1[14], p1[15])};
            attn_body::pv(o[qb2], vb, __builtin_bit_cast(bf16x8, pw0), __builtin_bit_cast(bf16x8, pw1), __builtin_bit_cast(bf16x8, pw2), __builtin_bit_cast(bf16x8, pw3));
        }
    }
#pragma unroll
    for (int qb2 = 0; qb2 < 2; ++qb2) {
        const float l = lrun[qb2] + __shfl_xor(lrun[qb2], 32);
        if (hi == 0) wsf[r32] = __builtin_amdgcn_rcpf(l);
        NA_LAS unsigned short* stg = (NA_LAS unsigned short*)(wl + qb2 * 4096);
#pragma unroll
        for (int rr = 0; rr < 16; ++rr) { const int orow = crow(rr, hi); const float rl = wsf[orow];
#pragma unroll
            for (int d0 = 0; d0 < 2; ++d0) stg[orow * 64 + d0 * 32 + r32] = (unsigned short)(cvtpk(o[qb2][d0][rr] * rl, 0.f) & 0xffffu); }
        unsigned short* Ow = O + (qrow0 + qb2 * 32) * PO + COL_OB + h * 64;
#pragma unroll
        for (int k = 0; k < 4; ++k) { const int row = k * 8 + (lane >> 3), ch = lane & 7; const u32x4 v = *(const NA_LAS u32x4*)(stg + row * 64 + ch * 8); *(u32x4*)(Ow + (long)row * PO + ch * 8) = v;
            float ss = 0.f;
#pragma unroll
            for (int e = 0; e < 4; ++e) { const float lo = __uint_as_float(v[e] << 16), hh = __uint_as_float(v[e] & 0xffff0000u); ss += lo * lo + hh * hh; }
            ss += __shfl_xor(ss, 1); ss += __shfl_xor(ss, 2); ss += __shfl_xor(ss, 4); if (ch == 0) __hip_atomic_fetch_add(ssq + (qrow0 + qb2 * 32 + row), ss, __ATOMIC_RELAXED, __HIP_MEMORY_SCOPE_AGENT); }
    }
}
}
namespace cg = cooperative_groups;
constexpr int NWAVES = 8;
constexpr int DM = 1024, M_PROMPT = 32 * 2048, S_PROMPT = 2048, M_SAMPLE = 4 * 4096, S_SAMPLE = 4096, M_ALL = M_PROMPT + M_SAMPLE;
constexpr int NPROJ = 2304, DFF = 2816, NUP = 2 * DFF, PLE = 256;
constexpr int FFN_CHUNKS = 4, M_CHUNK = M_ALL / FFN_CHUNKS;
constexpr float C2 = 0.125f * 1.4426950408889634f;
constexpr float LOG2E = 1.4426950408889634f;
constexpr size_t MiB = 1u << 20;
constexpr size_t WS_SSQ2 = 0, WS_SSQ3 = 384 * 1024, WS_SSQ4 = 768 * 1024, WS_SSQA = 1152 * 1024, WS_SSQB = 1536 * 1024, WS_ROPE = 1984 * 1024;
constexpr size_t WS_WIN = 2 * MiB, WS_WOUT = 7 * MiB, WS_WUP = 9 * MiB, WS_WDOWN = 20 * MiB, WS_WGATE = 26 * MiB, WS_WPLE = 28 * MiB;
constexpr size_t WS_PROJ = 32 * MiB;
constexpr size_t WS_XNO = 392 * MiB;
constexpr size_t WS_U = 32 * MiB;
constexpr size_t WS_ACT = 252 * MiB;
constexpr size_t WS_H2B = 32 * MiB;
constexpr size_t WS_H3B = 392 * MiB;
constexpr size_t WS_E = 192 * MiB;
constexpr size_t WS_H1B = 824 * MiB;
constexpr size_t WS_PB = 984 * MiB;
constexpr size_t WS_END = 1024 * MiB;
static_assert(WS_PROJ + (size_t)M_ALL * NPROJ * 2 <= WS_XNO && WS_XNO + (size_t)M_ALL * DM * 2 <= WS_H1B && WS_U + (size_t)M_CHUNK * NUP * 2 <= WS_ACT && WS_ACT + (size_t)M_ALL * DFF * 2 <= WS_H1B, "d_ws map");
static_assert(WS_H1B + (size_t)M_ALL * DM * 2 <= WS_PB && WS_PB + (size_t)M_ALL * PLE * 2 <= WS_END && WS_H2B + (size_t)M_ALL * DM * 2 <= WS_E && WS_E + (size_t)M_ALL * DM * 2 <= WS_H1B, "d_ws map 2");
static_assert(WS_WIN + (size_t)NPROJ * DM * 2 <= WS_WOUT && WS_WUP + (size_t)NUP * DM * 2 <= WS_WDOWN && WS_WDOWN + (size_t)DM * DFF * 2 <= WS_WGATE, "weight map");
constexpr int RING_BYTES = 131072;
constexpr int NA_T_OFF = RING_BYTES, NA_T_BYTES = na_body::T_FLOATS * 4, NA_WSF_OFF = NA_T_OFF + NWAVES * NA_T_BYTES, LDS_BYTES = NA_WSF_OFF + NWAVES * 256;
static_assert(LDS_BYTES <= 163840 && attn_body::ATTN_LDS_BYTES <= RING_BYTES, "LDS map");

#define LAS __attribute__((address_space(3)))
typedef unsigned short bf16;
typedef unsigned v4u __attribute__((ext_vector_type(4)));
typedef unsigned v2u __attribute__((ext_vector_type(2)));
typedef float f32x4 __attribute__((ext_vector_type(4)));
__device__ __forceinline__ unsigned pk2(float lo, float hi) { return pg8::cvt_pk_bf16(lo, hi); }
__device__ __forceinline__ float bflo(unsigned w) { return __uint_as_float(w << 16); }
__device__ __forceinline__ float bfhi(unsigned w) { return __uint_as_float(w & 0xffff0000u); }
__device__ __forceinline__ float wave_sum(float v) {
#pragma unroll
    for (int o = 1; o < 64; o <<= 1) v += __shfl_xor(v, o);
    return v;
}
__device__ __forceinline__ void p0_transpose_item(const float* W, int K, int N, bf16* WT, LAS float* scr, int item, int lane, const float* gain, const float* gain_hi, int ksplit, int nlo, int nhi, float nscale, bool upmap = false) {
    const int nblk = N / 32, kb = item / nblk, nb = item % nblk, k0 = 64 * kb, n0 = 32 * nb;
#pragma unroll 8
    for (int i = 0; i < 32; ++i) { const int kk = 2 * i + (lane >> 5); float w = W[(size_t)(k0 + kk) * N + n0 + (lane & 31)]; if (gain) w *= (k0 < ksplit ? gain[k0 + kk] : gain_hi[k0 + kk - ksplit]); scr[kk * 33 + (lane & 31)] = w; }
    asm volatile("s_waitcnt lgkmcnt(0)" ::: "memory");
    const int c = lane & 7;
#pragma unroll
    for (int j = 0; j < 4; ++j) { const int n = (lane >> 3) + 8 * j; const LAS float* s = scr + (8 * c) * 33 + n; const float ns = (n0 + n >= nlo && n0 + n < nhi) ? nscale : 1.0f;
        v4u o; o.x = pk2(s[0 * 33] * ns, s[1 * 33] * ns); o.y = pk2(s[2 * 33] * ns, s[3 * 33] * ns); o.z = pk2(s[4 * 33] * ns, s[5 * 33] * ns); o.w = pk2(s[6 * 33] * ns, s[7 * 33] * ns);
        int nn = n0 + n; if (upmap) nn = (nn < DFF) ? 256 * (nn / 128) + (nn % 128) : 256 * ((nn - DFF) / 128) + 128 + ((nn - DFF) % 128);
        *(v4u*)(WT + (size_t)nn * K + k0 + 8 * c) = o; }
    asm volatile("s_waitcnt lgkmcnt(0)" ::: "memory");
}
__device__ __forceinline__ void sincos_cw(float a, float& s, float& c) {
    const float k = rintf(a * 0.636619772367581343f);
    float r = fmaf(-k, 1.5703125f, a); r = fmaf(-k, 4.837512969970703125e-4f, r); r = fmaf(-k, 7.54978995489188216e-8f, r);
    const float r2 = r * r;
    const float sp = r + r * r2 * (-1.6666667163e-01f + r2 * (8.3333337680e-03f + r2 * (-1.9841270114e-04f + r2 * 2.7557314297e-06f)));
    const float cp = 1.0f + r2 * (-0.5f + r2 * (4.1666667908e-02f + r2 * (-1.3888889225e-03f + r2 * (2.4801587642e-05f + r2 * -2.7557314297e-07f))));
    const int q = (int)k & 3;
    s = (q == 0) ? sp : (q == 1) ? cp : (q == 2) ? -sp : -cp;
    c = (q == 0) ? cp : (q == 1) ? -sp : (q == 2) ? -cp : sp;
}

typedef const __attribute__((address_space(4))) unsigned char* kptr_t;
struct Args { const float* in[21]; float* out; unsigned char* ws; };

__global__ void __launch_bounds__(NWAVES * 64, 2) hymba_fwd(Args args) {
    extern __shared__ __attribute__((aligned(16))) unsigned char lds[];
    cg::grid_group grid = cg::this_grid();
    LAS unsigned char* const L = (LAS unsigned char*)lds;
    const int wave = __builtin_amdgcn_readfirstlane(threadIdx.x >> 6);
    const int G = gridDim.x, bx = blockIdx.x, vcu = (G % 8 == 0) ? (bx % 8) * (G / 8) + bx / 8 : bx;
    const int gw = vcu * NWAVES + wave, NGW = G * NWAVES;
#define PHASE_PTRS() int tid = threadIdx.x; asm volatile("" : "+v"(tid)); const int lane = tid & 63; (void)lane; kptr_t kp = (kptr_t)__builtin_amdgcn_kernarg_segment_ptr(); asm volatile("" : "+s"(kp)); unsigned char* const ws = (unsigned char*)KLD(22); float* const out = (float*)KLD(21); (void)out; \
    float* const ssq2 = (float*)(ws + WS_SSQ2); float* const ssq3 = (float*)(ws + WS_SSQ3); float* const ssq4 = (float*)(ws + WS_SSQ4); float* const ssqA = (float*)(ws + WS_SSQA); float* const ssqB = (float*)(ws + WS_SSQB); (void)ssqA; (void)ssqB; float* const rope = (float*)(ws + WS_ROPE); (void)ssq2; (void)ssq3; (void)ssq4; (void)rope; \
    bf16* const PROJ = (bf16*)(ws + WS_PROJ); bf16* const XNO = (bf16*)(ws + WS_XNO); (void)PROJ; (void)XNO;
#define KLD(i) (*(const __attribute__((address_space(4))) unsigned long long*)(kp + 8 * (i)))
#define KIN(i) ((const float*)KLD(i))

    {
        PHASE_PTRS();
        const float* const x_prompt = KIN(0); const float* const x_sample = KIN(1); const float* const p_prompt = KIN(2); const float* const p_sample = KIN(3);
        bf16* const Win_t = (bf16*)(ws + WS_WIN); bf16* const Wout_t = (bf16*)(ws + WS_WOUT); bf16* const Wup_t = (bf16*)(ws + WS_WUP); bf16* const Wdown_t = (bf16*)(ws + WS_WDOWN);
        bf16* const Wgate_t = (bf16*)(ws + WS_WGATE); bf16* const Wple_t = (bf16*)(ws + WS_WPLE); bf16* const PB = (bf16*)(ws + WS_PB);
        LAS float* scr = (LAS float*)(L + wave * 16384);
        constexpr int I_IN = (DM / 64) * (NPROJ / 32), I_OUT = (DM / 64) * (DM / 32), I_UP = (DM / 64) * (NUP / 32), I_DOWN = (DFF / 64) * (DM / 32), I_GATE = I_OUT, I_PLE = (PLE / 64) * (DM / 32);
        constexpr int NITEMS = I_IN + I_OUT + I_UP + I_DOWN + I_GATE + I_PLE;
        for (int it = gw; it < NITEMS; it += NGW) {
            int r = it;
            if (r < I_IN) { p0_transpose_item(KIN(5), DM, NPROJ, Win_t, scr, r, lane, nullptr, nullptr, 0, na_body::COL_QB, na_body::COL_KB, C2); continue; } r -= I_IN;
            if (r < I_OUT) { p0_transpose_item(KIN(11), DM, DM, Wout_t, scr, r, lane, KIN(9), KIN(10), 512, 0, 0, 1.f); continue; } r -= I_OUT;
            if (r < I_UP) { p0_transpose_item(KIN(13), DM, NUP, Wup_t, scr, r, lane, KIN(12), nullptr, 1 << 30, 0, 0, 1.f, true); continue; } r -= I_UP;
            if (r < I_DOWN) { p0_transpose_item(KIN(16), DFF, DM, Wdown_t, scr, r, lane, nullptr, nullptr, 0, 0, 0, 1.f); continue; } r -= I_DOWN;
            if (r < I_GATE) { p0_transpose_item(KIN(18), DM, DM, Wgate_t, scr, r, lane, KIN(17), nullptr, 1 << 30, 0, 0, 1.f); continue; } r -= I_GATE;
            p0_transpose_item(KIN(19), PLE, DM, Wple_t, scr, r, lane, nullptr, nullptr, 0, 0, 0, 1.f);
        }
        const float* gain = KIN(4);
        for (int m = gw; m < M_ALL; m += NGW) {
            const float* xrow = (m < M_PROMPT) ? x_prompt + (size_t)m * DM : x_sample + (size_t)(m - M_PROMPT) * DM;
            const f32x4* xr = (const f32x4*)xrow + lane;
            f32x4 v[4]; float s = 0.f;
#pragma unroll
            for (int j = 0; j < 4; ++j) { v[j] = xr[64 * j]; s += (v[j].x * v[j].x + v[j].y * v[j].y) + (v[j].z * v[j].z + v[j].w * v[j].w); }
            const float rs = __builtin_amdgcn_rsqf(wave_sum(s) * (1.f / DM) + 1e-6f);
            unsigned long long* o8 = (unsigned long long*)(XNO + (size_t)m * DM) + lane;
#pragma unroll
            for (int j = 0; j < 4; ++j) { const f32x4 g = ((const f32x4*)gain)[lane + 64 * j];
                o8[64 * j] = (unsigned long long)pk2(v[j].x * rs * g.x, v[j].y * rs * g.y) | ((unsigned long long)pk2(v[j].z * rs * g.z, v[j].w * rs * g.w) << 32); }
            const float* prow = (m < M_PROMPT) ? p_prompt + (size_t)m * PLE : p_sample + (size_t)(m - M_PROMPT) * PLE;
            const f32x4 pv = ((const f32x4*)prow)[lane];
            ((unsigned long long*)(PB + (size_t)m * PLE))[lane] = (unsigned long long)pk2(pv.x, pv.y) | ((unsigned long long)pk2(pv.z, pv.w) << 32);
        }
        for (int e = bx * (NWAVES * 64) + tid; e < M_ALL; e += G * NWAVES * 64) { ssq2[e] = 0.f; ssq3[e] = 0.f; ssq4[e] = 0.f; ssqA[e] = 0.f; ssqB[e] = 0.f; }
        for (int e = bx * (NWAVES * 64) + tid; e < 1024; e += G * NWAVES * 64) { const int pos = e >> 4, i = e & 15;
            const float freq = exp2f(-(float)i * (13.287712379549449f / 16.0f)); float s, c; sincos_cw((float)pos * freq, s, c); rope[e] = c; rope[1024 + e] = s; }
    }
    grid.sync();

    {
        PHASE_PTRS(); bf16* const Win_t = (bf16*)(ws + WS_WIN);
        pg8::Gemm g{XNO, Win_t, M_ALL, NPROJ, DM}; pg8::StaticOrder S; S.init(M_ALL, NPROJ, G, bx);
        pg8::EpiBf16Rs E{PROJ, NPROJ, nullptr};
        pg8::gemm_phase<pg8::EpiBf16Rs, pg8::StaticOrder, true, true>(L, g, S, E);
    }
    grid.sync();

    {
        PHASE_PTRS();
        const float* qn = KIN(6); const float* kn = KIN(7);
        const int a = lane & 7;
        const long NIT = (long)M_ALL * 10 / 8;
        for (long it = gw; it < NIT; it += NGW) {
            const long item = it * 8 + (lane >> 3); const int m = (int)(item / 10), j = (int)(item % 10);
            const int t = (m < M_PROMPT) ? (m & (S_PROMPT - 1)) : (m & (S_SAMPLE - 1));
            bf16* p = PROJ + (size_t)m * NPROJ + j * 64 + a * 8;
            const v4u raw = *(const v4u*)p;
            float v[8] = {bflo(raw.x), bfhi(raw.x), bflo(raw.y), bfhi(raw.y), bflo(raw.z), bfhi(raw.z), bflo(raw.w), bfhi(raw.w)};
            float ss = 0.f;
#pragma unroll
            for (int i = 0; i < 8; ++i) ss += v[i] * v[i];
            ss += __shfl_xor(ss, 1); ss += __shfl_xor(ss, 2); ss += __shfl_xor(ss, 4);
            const float rs = __builtin_amdgcn_rsqf(ss * (1.f / 64.f) + 1e-6f);
            const float* gn = (j < 8 ? qn : kn) + a * 8;
            const int pos = (a < 4) ? (t >> 6) : (t & 63);
            const float* ct = rope + pos * 16 + (a & 1) * 8;
            const float sc = (j < 8) ? C2 : 1.0f;
            float o[8];
#pragma unroll
            for (int i = 0; i < 8; ++i) { const float y = v[i] * rs * gn[i]; const float py = __shfl_xor(y, 2); const float cs = ct[i], sn = ct[1024 + i];
                o[i] = ((a & 2) == 0 ? y * cs - py * sn : y * cs + py * sn) * sc; }
            v4u w; w.x = pk2(o[0], o[1]); w.y = pk2(o[2], o[3]); w.z = pk2(o[4], o[5]); w.w = pk2(o[6], o[7]);
            *(v4u*)p = w;
        }
    }
    grid.sync();

    {
        PHASE_PTRS();
        const attn_body::bf16* Q = (const attn_body::bf16*)PROJ; const attn_body::bf16* K = Q + 512; const attn_body::bf16* V = Q + 640; attn_body::bf16* Ob = (attn_body::bf16*)XNO;
        for (int pair = vcu; pair < 256; pair += G) { const int b = pair >> 3, h = pair & 7;
            for (int qb = 0; qb < 8; ++qb) attn_body::attn_unit<8>((long)b * S_PROMPT, S_PROMPT / 64, h, h >> 2, qb, Q, K, V, Ob, ssqA, (char*)lds); }
        for (int su = vcu; su < 256; su += G) { const int pair = su >> 3, b = pair >> 3, h = pair & 7;
            for (int k = 0; k < 2; ++k) attn_body::attn_unit<8>((long)M_PROMPT + (long)b * S_SAMPLE, S_SAMPLE / 64, h, h >> 2, (su & 7) * 2 + k, Q, K, V, Ob, ssqA, (char*)lds); }
        __syncthreads();
        LAS float* Tb = (LAS float*)(L + NA_T_OFF + wave * NA_T_BYTES);
        LAS float* wsf = (LAS float*)(L + NA_WSF_OFF + wave * 256);
        for (int e = lane; e < na_body::T_FLOATS; e += 64) Tb[e] = 0.f;
        { const float* rpb = KIN(8) + wave * 15 * 31;
          for (int e = lane; e < 15 * 31; e += 64) { const int dr = e / 31, dc = e % 31; Tb[na_body::T_GUARD + dr * 32 + dc] = rpb[e] * LOG2E; } }
        LAS unsigned char* wl = L + wave * 16384;
        const unsigned wl_addr = (unsigned)(uintptr_t)(lds + wave * 16384);
        for (int bu = vcu; bu < 1280; bu += G) {
            long rowbase; int rows, r;
            if (bu < 1024) { rowbase = (long)(bu >> 5) * S_PROMPT; rows = 32; r = bu & 31; } else { const int s = bu - 1024; rowbase = (long)M_PROMPT + (long)(s >> 6) * S_SAMPLE; rows = 64; r = s & 63; }
            na_body::na_unit(PROJ, XNO, rowbase, rows, r, wave, wl, wl_addr, Tb + na_body::T_GUARD, wsf, ssqB);
        }
    }
    grid.sync();

    {
        PHASE_PTRS(); bf16* const Wout_t = (bf16*)(ws + WS_WOUT); bf16* const H1B = (bf16*)(ws + WS_H1B); const float* const x_prompt = KIN(0); const float* const x_sample = KIN(1);
        pg8::Gemm g{XNO, Wout_t, M_ALL, DM, DM}; pg8::StaticOrder S; S.init(M_ALL, DM, G, bx);
        pg8::EpiOutProj E{x_prompt, x_sample, M_PROMPT, H1B, ssq2, ssqA, ssqB};
        pg8::gemm_phase<pg8::EpiOutProj, pg8::StaticOrder, true, true>(L, g, S, E);
    }
    grid.sync();

    {
        PHASE_PTRS(); bf16* const Wup_t = (bf16*)(ws + WS_WUP); bf16* const H1B = (bf16*)(ws + WS_H1B); bf16* const ACT = (bf16*)(ws + WS_ACT);
        constexpr int NM_UP = (M_ALL + 253) / 254;
        pg8::Gemm g{H1B - DM, Wup_t, NM_UP * 256, NUP, DM, (size_t)254 * DM * 2}; pg8::StaticOrder S; S.init(NM_UP * 256, NUP, G, bx);
        pg8::EpiConvGate E{ACT, ssq2, KIN(14), KIN(15), M_ALL, DFF};
        pg8::gemm_phase<pg8::EpiConvGate, pg8::StaticOrder, true, true>(L, g, S, E);
    }
    grid.sync();

    {
        PHASE_PTRS(); bf16* const ACT = (bf16*)(ws + WS_ACT); bf16* const Wdown_t = (bf16*)(ws + WS_WDOWN); bf16* const H2B = (bf16*)(ws + WS_H2B); bf16* const H1B = (bf16*)(ws + WS_H1B);
        pg8::Gemm g{ACT, Wdown_t, M_ALL, DM, DFF}; pg8::StaticOrder S; S.init(M_ALL, DM, G, bx);
        pg8::EpiResB E{H1B, H2B, ssq3};
        pg8::gemm_phase<pg8::EpiResB, pg8::StaticOrder, true, true>(L, g, S, E);
    }
    grid.sync();

    {
        PHASE_PTRS(); bf16* const PB = (bf16*)(ws + WS_PB); bf16* const Wple_t = (bf16*)(ws + WS_WPLE); bf16* const EB = (bf16*)(ws + WS_E);
        pg8::Gemm g{PB, Wple_t, M_ALL, DM, PLE}; pg8::StaticOrder S; S.init(M_ALL, DM, G, bx);
        pg8::EpiBf16Rs E{EB, DM, nullptr};
        pg8::gemm_phase<pg8::EpiBf16Rs, pg8::StaticOrder, true, true>(L, g, S, E);
    }
    grid.sync();

    {
        PHASE_PTRS(); bf16* const H2B = (bf16*)(ws + WS_H2B); bf16* const Wgate_t = (bf16*)(ws + WS_WGATE); bf16* const EB = (bf16*)(ws + WS_E); bf16* const H3B = (bf16*)(ws + WS_H3B);
        pg8::Gemm g{H2B, Wgate_t, M_ALL, DM, DM}; pg8::StaticOrder S; S.init(M_ALL, DM, G, bx);
        pg8::EpiGate E{H2B, EB, H3B, ssq3, ssq4};
        pg8::gemm_phase<pg8::EpiGate, pg8::StaticOrder, true, true>(L, g, S, E);
    }
    grid.sync();

    {
        PHASE_PTRS();
        const f32x4* fg = (const f32x4*)KIN(20) + lane;
        const f32x4 g0 = fg[0], g1 = fg[64], g2 = fg[128], g3 = fg[192];
        const bf16* const H3B = (const bf16*)(ws + WS_H3B);
        for (int m = gw; m < M_ALL; m += NGW) {
            f32x4* xr = (f32x4*)(out + (size_t)m * DM) + lane;
            const v2u* hr = (const v2u*)(H3B + (size_t)m * DM) + lane;
            const v2u h0 = hr[0], h1 = hr[64], h2 = hr[128], h3 = hr[192];
            const float rs = __builtin_amdgcn_rsqf(ssq4[m] * (1.f / DM) + 1e-6f);
            xr[0] = (f32x4){bflo(h0.x), bfhi(h0.x), bflo(h0.y), bfhi(h0.y)} * rs * g0; xr[64] = (f32x4){bflo(h1.x), bfhi(h1.x), bflo(h1.y), bfhi(h1.y)} * rs * g1;
            xr[128] = (f32x4){bflo(h2.x), bfhi(h2.x), bflo(h2.y), bfhi(h2.y)} * rs * g2; xr[192] = (f32x4){bflo(h3.x), bfhi(h3.x), bflo(h3.y), bfhi(h3.y)} * rs * g3;
        }
    }
}

extern "C" void kernel_launch(void* const* d_in, const int* in_sizes, int n_in, void* d_out, int out_size, void* d_ws, size_t ws_size, hipStream_t stream) {
    static int grid = 0;
    if (grid == 0) {
        if (n_in != 21 || in_sizes[0] != M_PROMPT * DM || out_size != M_ALL * DM || ws_size < WS_END) { fprintf(stderr, "kernel_launch: unexpected shapes (n_in %d, in0 %d, out %d, ws %zu); nothing launched\n", n_in, n_in > 0 ? in_sizes[0] : -1, out_size, ws_size); grid = -1; return; }
        int dev = 0, cus = 0, per_cu = 0;
        if (hipGetDevice(&dev) != hipSuccess || hipDeviceGetAttribute(&cus, hipDeviceAttributeMultiprocessorCount, dev) != hipSuccess) { grid = -1; return; }
        if (hipFuncSetAttribute((const void*)hymba_fwd, hipFuncAttributeMaxDynamicSharedMemorySize, LDS_BYTES) != hipSuccess) { fprintf(stderr, "kernel_launch: hipFuncSetAttribute failed\n"); grid = -1; return; }
        if (hipOccupancyMaxActiveBlocksPerMultiprocessor(&per_cu, (const void*)hymba_fwd, NWAVES * 64, LDS_BYTES) != hipSuccess || per_cu < 1) { fprintf(stderr, "kernel_launch: occupancy query says %d blocks per CU\n", per_cu); (void)hipGetLastError(); }
        grid = cus;
    }
    if (grid < 0) return;
    Args a{};
    for (int i = 0; i < 21; ++i) a.in[i] = (const float*)d_in[i];
    a.out = (float*)d_out; a.ws = (unsigned char*)d_ws;
    void* kargs[] = {&a};
    const hipError_t e = hipLaunchCooperativeKernel((const void*)hymba_fwd, dim3(grid), dim3(NWAVES * 64), kargs, LDS_BYTES, stream);
    if (e != hipSuccess) fprintf(stderr, "kernel_launch: cooperative launch failed: %s (grid %d)\n", hipGetErrorString(e), grid);
}
```

```cpp
#include <hip/hip_cooperative_groups.h>
#include <hip/hip_runtime.h>
#include <cstdio>
#include <cstdint>
namespace pg8 {
#define PG8_LAS __attribute__((address_space(3)))
typedef unsigned short bf16_t;
typedef short bf16x8 __attribute__((ext_vector_type(8)));
typedef float f32x4 __attribute__((ext_vector_type(4)));
typedef unsigned u32x4 __attribute__((ext_vector_type(4)));
constexpr int BM = 256, BK = 64, HALF = 128, HTB = HALF * BK * 2  , STAGE_BYTES = 8 * HTB, NXCD = 8, WGM = 8;

__host__ __device__ __forceinline__ int lds_byte(int r, int c) { const int st = (r >> 4) * 2 + (c >> 5), rr = r & 15, cc = c & 31, ob = rr * 64 + cc * 2; return st * 1024 + (ob ^ (((ob >> 9) & 1) << 5)); }
__host__ __device__ __forceinline__ void stage_rc(int b, int& R, int& C) { const int st = b / 1024, sb = b % 1024, swz = sb ^ (((sb >> 9) & 1) << 5); R = (st >> 1) * 16 + swz / 64; C = (st & 1) * 32 + (swz % 64) / 2; }
__host__ __device__ __forceinline__ int perm32(int rho) { const int n = rho >> 4, i = rho & 15; return 8 * (i >> 2) + 4 * n + (i & 3); }

struct Unit { int pm, pn; };
struct Gemm { const bf16_t* A; const bf16_t* Bt; int M, N, K; size_t a_tstep; };

struct StaticOrder {
    int nM, nN, nwg, G, c;
    __host__ __device__ void init(int M, int N, int G_, int c_) { nM = M / BM; nN = N / BM; nwg = nM * nN; G = G_; c = c_; }
    __host__ __device__ bool next(int i, Unit& u) const {
        const long L = (long)i * G + c; if (L >= nwg) return false;
        int wgid = (int)L; { const int q = nwg / NXCD, r = nwg % NXCD, xcd = wgid % NXCD, off = wgid / NXCD; wgid = (xcd < r ? xcd * (q + 1) : r * (q + 1) + (xcd - r) * q) + off; }
        const int nig = WGM * nN, gid = wgid / nig, fm = gid * WGM, gsz = (nM - fm) < WGM ? (nM - fm) : WGM;
        u.pm = fm + ((wgid % nig) % gsz); u.pn = (wgid % nig) / gsz; return true;
    }
    __device__ __forceinline__ void a_ready(const Unit&) const {}
    __device__ __forceinline__ void done(const Unit&) const {}
};

__device__ __forceinline__ unsigned cvt_pk_bf16(float lo, float hi) { unsigned r; asm volatile("v_cvt_pk_bf16_f32 %0, %1, %2" : "=v"(r) : "v"(lo), "v"(hi)); return r; }
typedef float f32x2 __attribute__((ext_vector_type(2)));
__device__ __forceinline__ f32x2 gelu_pk(f32x2 v) {
    const f32x2 av = __builtin_elementwise_abs(v), d = av * 0.2316418882f + 1.0f;
    f32x2 t; t.x = __builtin_amdgcn_rcpf(d.x); t.y = __builtin_amdgcn_rcpf(d.y);
    f32x2 q = t * 0.5307027145f + (-0.7265760135f); q = q * t + 0.7107068705f; q = q * t + (-0.142248368f); q = q * t + 0.127414796f; q = q * t;
    const f32x2 s = (v * v) * (-0.72134752044f);
    f32x2 e; e.x = __builtin_amdgcn_exp2f(s.x); e.y = __builtin_amdgcn_exp2f(s.y);
    const f32x2 m = v * (q * e), r = v - m;
    f32x2 o; o.x = v.x < 0.f ? m.x : r.x; o.y = v.y < 0.f ? m.y : r.y; return o;
}

template <int ACT  > struct EpiBf16 {
    static constexpr bool PERM = true, AFTER_DRAIN = false, MIDSCALE = false, FULL = false; static_assert(ACT == 0 || ACT == 1, "EpiBf16: ACT is 0 (none) or 1 (gelu_pk)");
    bf16_t* O; int ldc; const float* bias; int split_cols; size_t split_stride; float scale0;
    __device__ __forceinline__ void operator()(const f32x4 (&acc)[2][2][4][2], const Unit& u, int wr, int wc, int fr, int fq) const {
        const int row0 = u.pm * BM + wr * 64 + fr; int colt = u.pn * BM; bf16_t* base = O;
        float sc = 1.f; if (split_cols) { const int t = colt / split_cols; base += (size_t)t * split_stride; colt -= t * split_cols; if (t == 0) sc = scale0; }
        const int col0 = colt + wc * 32 + 8 * fq, bcol0 = u.pn * BM + wc * 32 + 8 * fq;
        f32x4 bv[2][2];
#pragma unroll
        for (int bj = 0; bj < 2; ++bj)
#pragma unroll
            for (int n = 0; n < 2; ++n) bv[bj][n] = bias ? *(const f32x4*)(bias + bcol0 + bj * HALF + 4 * n) : (f32x4){0.f, 0.f, 0.f, 0.f};
#pragma unroll
        for (int ai = 0; ai < 2; ++ai)
#pragma unroll
            for (int m = 0; m < 4; ++m) { bf16_t* rowp = base + (size_t)(row0 + ai * HALF + m * 16) * ldc + col0;
#pragma unroll
                for (int bj = 0; bj < 2; ++bj) { f32x4 v0 = acc[ai][bj][m][0] + bv[bj][0], v1 = acc[ai][bj][m][1] + bv[bj][1];
                    if (ACT == 1) { f32x2 a = gelu_pk((f32x2){v0[0], v0[1]}), b = gelu_pk((f32x2){v0[2], v0[3]}), c = gelu_pk((f32x2){v1[0], v1[1]}), d = gelu_pk((f32x2){v1[2], v1[3]});
                        v0 = (f32x4){a.x, a.y, b.x, b.y}; v1 = (f32x4){c.x, c.y, d.x, d.y}; }
                    v0 = v0 * sc; v1 = v1 * sc; u32x4 w; w.x = cvt_pk_bf16(v0[0], v0[1]); w.y = cvt_pk_bf16(v0[2], v0[3]); w.z = cvt_pk_bf16(v1[0], v1[1]); w.w = cvt_pk_bf16(v1[2], v1[3]);
                    *(u32x4*)(rowp + bj * HALF) = w; } }
    }
};
constexpr float RMS_EPS = 1e-6f;
typedef unsigned u32x2 __attribute__((ext_vector_type(2)));
__device__ __forceinline__ float f32_atomic_add(float* p, float v) { return __hip_atomic_fetch_add(p, v, __ATOMIC_RELAXED, __HIP_MEMORY_SCOPE_AGENT); }
__device__ __forceinline__ float bf_lo(unsigned w) { return __uint_as_float(w << 16); }
__device__ __forceinline__ float bf_hi(unsigned w) { return __uint_as_float(w & 0xffff0000u); }
__device__ __forceinline__ float sumsq8(const f32x4& v0, const f32x4& v1) { return (v0[0] * v0[0] + v0[1] * v0[1]) + (v0[2] * v0[2] + v0[3] * v0[3]) + (v1[0] * v1[0] + v1[1] * v1[1]) + (v1[2] * v1[2] + v1[3] * v1[3]); }
__device__ __forceinline__ u32x4 pack8(const f32x4& v0, const f32x4& v1) { u32x4 w; w.x = cvt_pk_bf16(v0[0], v0[1]); w.y = cvt_pk_bf16(v0[2], v0[3]); w.z = cvt_pk_bf16(v1[0], v1[1]); w.w = cvt_pk_bf16(v1[2], v1[3]); return w; }
struct EpiBf16Rs {
    static constexpr bool PERM = true, AFTER_DRAIN = false, MIDSCALE = false, FULL = false;
    bf16_t* O; int ldc; const float* ssq;
    __device__ __forceinline__ void operator()(const f32x4 (&acc)[2][2][4][2], const Unit& u, int wr, int wc, int fr, int fq) const {
        const int row0 = u.pm * BM + wr * 64 + fr, col0 = u.pn * BM + wc * 32 + 8 * fq;
#pragma unroll
        for (int ai = 0; ai < 2; ++ai)
#pragma unroll
            for (int m = 0; m < 4; ++m) { const int row = row0 + ai * HALF + m * 16; bf16_t* rowp = O + (size_t)row * ldc + col0;
                const float rs = ssq ? __builtin_amdgcn_rsqf(ssq[row] * (1.0f / 1024.0f) + RMS_EPS) : 1.0f;
#pragma unroll
                for (int bj = 0; bj < 2; ++bj) *(u32x4*)(rowp + bj * HALF) = pack8(acc[ai][bj][m][0] * rs, acc[ai][bj][m][1] * rs); }
    }
};
struct EpiOutProj {
    static constexpr bool PERM = true, AFTER_DRAIN = false, MIDSCALE = true, FULL = false;
    const float* base0; const float* base1; int split;
    bf16_t* hb; float* ssq; const float* ssqA; const float* ssqB;
    __device__ __forceinline__ void prep(PG8_LAS unsigned char* lds, int tid, const Unit& u, int wr, int fr) const {
        const int row0 = u.pm * BM + wr * 64 + fr; PG8_LAS f32x4* slot = (PG8_LAS f32x4*)(lds + STAGE_BYTES) + tid * 2;
#pragma unroll
        for (int ai = 0; ai < 2; ++ai) { f32x4 q;
#pragma unroll
            for (int m = 0; m < 4; ++m) { const int row = row0 + ai * HALF + m * 16;
                q[m] = __builtin_amdgcn_rsqf(ssqA[row] * (1.0f / 512.0f) + RMS_EPS) * __builtin_amdgcn_sqrtf(ssqB[row] * (1.0f / 512.0f) + RMS_EPS); }
            slot[ai] = q; }
    }
    __device__ __forceinline__ void midscale(f32x4 (&acc)[2][2][4][2], PG8_LAS unsigned char* lds, int tid) const {
        const PG8_LAS f32x4* slot = (const PG8_LAS f32x4*)(lds + STAGE_BYTES) + tid * 2;
#pragma unroll
        for (int ai = 0; ai < 2; ++ai) { const f32x4 q = slot[ai];
#pragma unroll
            for (int bj = 0; bj < 2; ++bj)
#pragma unroll
                for (int m = 0; m < 4; ++m)
#pragma unroll
                    for (int n = 0; n < 2; ++n) acc[ai][bj][m][n] *= q[m]; }
    }
    __device__ __forceinline__ void operator()(const f32x4 (&acc)[2][2][4][2], const Unit& u, int wr, int wc, int fr, int fq) const {
        const int row0 = u.pm * BM + wr * 64 + fr, col0 = u.pn * BM + wc * 32 + 8 * fq;
#pragma unroll
        for (int ai = 0; ai < 2; ++ai)
#pragma unroll
            for (int m = 0; m < 4; ++m) { const int row = row0 + ai * HALF + m * 16;
                const float* bp = (row < split ? base0 + (size_t)row * 1024 : base1 + (size_t)(row - split) * 1024) + col0;
                bf16_t* hp = hb + (size_t)row * 1024 + col0; float s = 0.f;
                const float rb = __builtin_amdgcn_rsqf(ssqB[row] * (1.0f / 512.0f) + RMS_EPS);
#pragma unroll
                for (int bj = 0; bj < 2; ++bj) { const f32x4 b0 = *(const f32x4*)(bp + bj * HALF), b1 = *(const f32x4*)(bp + bj * HALF + 4);
                    const f32x4 v0 = acc[ai][bj][m][0] * rb + b0, v1 = acc[ai][bj][m][1] * rb + b1;
                    *(u32x4*)(hp + bj * HALF) = pack8(v0, v1); s += sumsq8(v0, v1); }
                s += __shfl_xor(s, 16); s += __shfl_xor(s, 32);
                if (fq == 0) f32_atomic_add(ssq + row, s); }
    }
};
struct EpiResB {
    static constexpr bool PERM = true, AFTER_DRAIN = false, MIDSCALE = false, FULL = false;
    const bf16_t* hin; bf16_t* hout; float* ssq;
    __device__ __forceinline__ void operator()(const f32x4 (&acc)[2][2][4][2], const Unit& u, int wr, int wc, int fr, int fq) const {
        const int row0 = u.pm * BM + wr * 64 + fr, col0 = u.pn * BM + wc * 32 + 8 * fq;
#pragma unroll
        for (int ai = 0; ai < 2; ++ai)
#pragma unroll
            for (int m = 0; m < 4; ++m) { const int row = row0 + ai * HALF + m * 16;
                const bf16_t* bp = hin + (size_t)row * 1024 + col0; bf16_t* hp = hout + (size_t)row * 1024 + col0; float s = 0.f;
#pragma unroll
                for (int bj = 0; bj < 2; ++bj) { const u32x4 bw = *(const u32x4*)(bp + bj * HALF);
                    const f32x4 v0 = acc[ai][bj][m][0] + (f32x4){bf_lo(bw.x), bf_hi(bw.x), bf_lo(bw.y), bf_hi(bw.y)}, v1 = acc[ai][bj][m][1] + (f32x4){bf_lo(bw.z), bf_hi(bw.z), bf_lo(bw.w), bf_hi(bw.w)};
                    *(u32x4*)(hp + bj * HALF) = pack8(v0, v1); s += sumsq8(v0, v1); }
                s += __shfl_xor(s, 16); s += __shfl_xor(s, 32);
                if (fq == 0) f32_atomic_add(ssq + row, s); }
    }
};
struct EpiGate {
    static constexpr bool PERM = true, AFTER_DRAIN = false, MIDSCALE = false, FULL = false;
    const bf16_t* hin; const bf16_t* E; bf16_t* hout; const float* ssq_in; float* ssq_out;
    __device__ __forceinline__ void operator()(const f32x4 (&acc)[2][2][4][2], const Unit& u, int wr, int wc, int fr, int fq) const {
        const int row0 = u.pm * BM + wr * 64 + fr, col0 = u.pn * BM + wc * 32 + 8 * fq;
#pragma unroll
        for (int ai = 0; ai < 2; ++ai)
#pragma unroll
            for (int m = 0; m < 4; ++m) { const int row = row0 + ai * HALF + m * 16;
                const bf16_t* bp = hin + (size_t)row * 1024 + col0; const bf16_t* ep = E + (size_t)row * 1024 + col0; bf16_t* hp = hout + (size_t)row * 1024 + col0; float s = 0.f;
                const float rs = __builtin_amdgcn_rsqf(ssq_in[row] * (1.0f / 1024.0f) + RMS_EPS) * -1.4426950408889634f;
#pragma unroll
                for (int bj = 0; bj < 2; ++bj) { const u32x4 bw = *(const u32x4*)(bp + bj * HALF), ew = *(const u32x4*)(ep + bj * HALF);
                    const f32x4 b0 = (f32x4){bf_lo(bw.x), bf_hi(bw.x), bf_lo(bw.y), bf_hi(bw.y)}, b1 = (f32x4){bf_lo(bw.z), bf_hi(bw.z), bf_lo(bw.w), bf_hi(bw.w)};
                    const f32x4 e0 = (f32x4){bf_lo(ew.x), bf_hi(ew.x), bf_lo(ew.y), bf_hi(ew.y)}, e1 = (f32x4){bf_lo(ew.z), bf_hi(ew.z), bf_lo(ew.w), bf_hi(ew.w)};
                    f32x4 v0, v1;
#pragma unroll
                    for (int k = 0; k < 4; ++k) { const float g0 = __builtin_amdgcn_rcpf(1.0f + __builtin_amdgcn_exp2f(acc[ai][bj][m][0][k] * rs)), g1 = __builtin_amdgcn_rcpf(1.0f + __builtin_amdgcn_exp2f(acc[ai][bj][m][1][k] * rs));
                        v0[k] = b0[k] + g0 * e0[k]; v1[k] = b1[k] + g1 * e1[k]; }
                    *(u32x4*)(hp + bj * HALF) = pack8(v0, v1); s += sumsq8(v0, v1); }
                s += __shfl_xor(s, 16); s += __shfl_xor(s, 32);
                if (fq == 0) f32_atomic_add(ssq_out + row, s); }
    }
};

#define PG8_DPPF(oldv, srcv, ctrl, bc) __builtin_bit_cast(float, __builtin_amdgcn_update_dpp(__builtin_bit_cast(int, (float)(oldv)), __builtin_bit_cast(int, (float)(srcv)), (ctrl), 0xf, 0xf, (bc)))
struct EpiConvGate {
    static constexpr bool PERM = true, AFTER_DRAIN = false, MIDSCALE = false, FULL = true;
    bf16_t* ACT; const float* ssq; const float* cw; const float* cb; int Mrows; int dff;
    template <bool MASKED> __device__ __forceinline__ void conv(const f32x4 (&acc)[2][2][4][2], const PG8_LAS float* X, int wr, int rbase, int gbase, int col, int cbase, unsigned voff) const {
#pragma unroll
        for (int n = 0; n < 2; ++n) {
            f32x4 w[2][4];
#pragma unroll
            for (int bj = 0; bj < 2; ++bj) {
#pragma unroll
                for (int k = 0; k < 3; ++k) w[bj][k] = *(const f32x4*)((const char*)(cw + (size_t)k * 2 * dff + bj * dff + 4 * n) + voff);
                w[bj][3] = *(const f32x4*)((const char*)(cb + bj * dff + 4 * n) + voff); }
#pragma unroll
            for (int ai = 0; ai < 2; ++ai) { const int sg = 2 * ai + wr; const int slotP = (sg > 0) ? (sg - 1) * 2 + 1 : 8, slotN = (sg < 3) ? (sg + 1) * 2 : 8;
                f32x4 saved[2], haloN[2];
#pragma unroll
                for (int bj = 0; bj < 2; ++bj) { saved[bj] = *(const PG8_LAS f32x4*)(X + slotP * 256 + bj * HALF + col + 4 * n); haloN[bj] = *(const PG8_LAS f32x4*)(X + slotN * 256 + bj * HALF + col + 4 * n); }
#pragma unroll
                for (int m = 0; m < 4; ++m) { const int r = rbase + ai * HALF + m * 16, g = gbase + r;
                    float hp = 1.f, hn = 1.f;
                    if constexpr (MASKED) { const int S = (g < 65536) ? 2048 : 4096; const int t = g & (S - 1); hp = (t != 0) ? 1.f : 0.f; hn = (t != S - 1) ? 1.f : 0.f; }
                    f32x4 y[2];
#pragma unroll
                    for (int bj = 0; bj < 2; ++bj) { const f32x4 cur = acc[ai][bj][m][n]; const f32x4 nx = (m < 3) ? acc[ai][bj][m < 3 ? m + 1 : 3][n] : haloN[bj];
#pragma unroll
                        for (int i = 0; i < 4; ++i) {
                            float pin = PG8_DPPF(PG8_DPPF(0.f, saved[bj][i], 0x121, true), cur[i], 0x111, false);
                            float nin = PG8_DPPF(PG8_DPPF(0.f, nx[i], 0x12f, true), cur[i], 0x101, false);
                            if constexpr (MASKED) { pin *= hp; nin *= hn; }
                            y[bj][i] = (w[bj][1][i] * cur[i] + w[bj][3][i]) + (w[bj][0][i] * pin + w[bj][2][i] * nin); }
                        saved[bj] = cur; }
                    float o[4];
#pragma unroll
                    for (int i = 0; i < 4; ++i) { const float a = y[0][i], gg = y[1][i];
                        const float z = -2.302208198f * (gg + 0.044715f * gg * gg * gg);
                        o[i] = a * gg * __builtin_amdgcn_rcpf(1.0f + __builtin_amdgcn_exp2f(z)); }
                    u32x2 pk; pk.x = cvt_pk_bf16(o[0], o[1]); pk.y = cvt_pk_bf16(o[2], o[3]);
                    if (r >= 1 && r <= 254 && g < Mrows) *(u32x2*)(ACT + (size_t)g * dff + cbase + 4 * n) = pk;
                    __builtin_amdgcn_sched_barrier(0); } } }
    }
    __device__ __forceinline__ void full(f32x4 (&acc)[2][2][4][2], const Unit& u, int wr_, int wc_, int fr_, int fq_, PG8_LAS unsigned char* lds, int tid_) const {
        int tid = tid_; asm volatile("" : "+v"(tid));
        const int wid = __builtin_amdgcn_readfirstlane(tid >> 6), lane = tid & 63, wr = wid >> 2, wc = wid & 3, fr = lane & 15, fq = lane >> 4; (void)wr_; (void)wc_; (void)fr_; (void)fq_;
        const int gbase = u.pm * 254 - 1, rbase = wr * 64 + fr, col = wc * 32 + 8 * fq, cbase = u.pn * HALF + col;
        const unsigned voff = (unsigned)cbase * 4u;
        PG8_LAS float* X = (PG8_LAS float*)(lds + STAGE_BYTES);
#pragma unroll
        for (int ai = 0; ai < 2; ++ai)
#pragma unroll
            for (int m = 0; m < 4; ++m) { const int g = gbase + rbase + ai * HALF + m * 16; const int gc = g < 0 ? 0 : (g >= Mrows ? Mrows - 1 : g);
                const float rs = __builtin_amdgcn_rsqf(ssq[gc] * (1.0f / 1024.0f) + RMS_EPS);
#pragma unroll
                for (int bj = 0; bj < 2; ++bj)
#pragma unroll
                    for (int n = 0; n < 2; ++n) { acc[ai][bj][m][n] *= rs; asm volatile("" : "+v"(acc[ai][bj][m][n])); }
                __builtin_amdgcn_sched_barrier(0); }
        if (tid < 64) *(PG8_LAS f32x4*)(X + 8 * 256 + tid * 4) = (f32x4){0.f, 0.f, 0.f, 0.f};
        if (fr == 0) {
#pragma unroll
            for (int ai = 0; ai < 2; ++ai)
#pragma unroll
                for (int bj = 0; bj < 2; ++bj)
#pragma unroll
                    for (int n = 0; n < 2; ++n) *(PG8_LAS f32x4*)(X + ((2 * ai + wr) * 2 + 0) * 256 + bj * HALF + col + 4 * n) = acc[ai][bj][0][n]; }
        if (fr == 15) {
#pragma unroll
            for (int ai = 0; ai < 2; ++ai)
#pragma unroll
                for (int bj = 0; bj < 2; ++bj)
#pragma unroll
                    for (int n = 0; n < 2; ++n) *(PG8_LAS f32x4*)(X + ((2 * ai + wr) * 2 + 1) * 256 + bj * HALF + col + 4 * n) = acc[ai][bj][3][n]; }
        asm volatile("s_waitcnt lgkmcnt(0)" ::: "memory"); __builtin_amdgcn_s_barrier(); asm volatile("" ::: "memory");
        const bool boundary = ((gbase + 256) >> 11) != (gbase >> 11);
        (void)boundary; conv<true>(acc, X, wr, rbase, gbase, col, cbase, voff);
    }
};

template <class Epi, class Sched, bool ALIGN_EPI = false, bool SP2 = false>
__device__ __forceinline__ void gemm_phase(PG8_LAS unsigned char* lds, const Gemm g, const Sched& S, const Epi& E) {
    int tid = threadIdx.x; asm volatile("" : "+v"(tid));
    const int wid = __builtin_amdgcn_readfirstlane(tid >> 6), lane = tid & 63, wr = wid >> 2, wc = wid & 3, fr = lane & 15, fq = lane >> 4;
    const int K = g.K, nt = K / BK;
    unsigned voffA[2], voffB[2];
#pragma unroll
    for (int i = 0; i < 2; ++i) { int R, C; stage_rc(tid * 16 + i * 8192, R, C); const int Rb = Epi::PERM ? ((R & ~31) + perm32(R & 31)) : R;
        voffA[i] = (unsigned)(R * K + C) * 2u; voffB[i] = (unsigned)(Rb * K + C) * 2u; }
    const size_t kstep = (size_t)(BK * 2);
    const size_t hstep = (size_t)HALF * K * 2;
    const size_t tstep = 2 * hstep;
    const size_t tstepA = g.a_tstep ? g.a_tstep : tstep;
    const unsigned ldsw = (unsigned)wid * 1024u;
    const int aoff = lds_byte(wr * 64 + fr, fq * 8), boff = lds_byte(wc * 32 + fr, fq * 8);
#define PG8_SA(b, h) (((b) * 2 + (h)) * HTB)
#define PG8_SB(b, h) ((4 + (b) * 2 + (h)) * HTB)
#define PG8_STAGE(bufoff, gbase, voff) do { _Pragma("unroll") for (int _i = 0; _i < 2; ++_i) \
        __builtin_amdgcn_global_load_lds((const unsigned*)((const char*)(gbase) + (voff)[_i]), (PG8_LAS unsigned*)(lds + (bufoff) + ldsw + _i * 8192), 16, 0, 0); } while (0)
#define PG8_LDA(dst, b, h) do { _Pragma("unroll") for (int m = 0; m < 4; ++m) _Pragma("unroll") for (int k = 0; k < 2; ++k) dst[m][k] = *(const PG8_LAS bf16x8*)(lds + PG8_SA(b, h) + aoff + m * 2048 + k * 1024); } while (0)
#define PG8_LDB(dst, b, h) do { _Pragma("unroll") for (int n = 0; n < 2; ++n) _Pragma("unroll") for (int k = 0; k < 2; ++k) dst[n][k] = *(const PG8_LAS bf16x8*)(lds + PG8_SB(b, h) + boff + n * 2048 + k * 1024); } while (0)
#define PG8_MMA(ai, bj, At, Bt) do { __builtin_amdgcn_s_setprio(1); _Pragma("unroll") for (int m = 0; m < 4; ++m) _Pragma("unroll") for (int n = 0; n < 2; ++n) _Pragma("unroll") for (int k = 0; k < 2; ++k) \
        acc[ai][bj][m][n] = __builtin_amdgcn_mfma_f32_16x16x32_bf16(Bt[n][k], At[m][k], acc[ai][bj][m][n], 0, 0, 0); __builtin_amdgcn_s_setprio(0); } while (0)
#define PG8_WAIT_V(n) asm volatile("s_waitcnt vmcnt(" #n ")" ::: "memory")
#define PG8_WAIT_L(n) asm volatile("s_waitcnt lgkmcnt(" #n ")" ::: "memory")
#define PG8_BAR __builtin_amdgcn_s_barrier()
#define PG8_SCHED __builtin_amdgcn_sched_barrier(0)
    Unit cur, nxt; int ui = 0;
    if (!S.next(0, cur)) return;
    f32x4 acc[2][2][4][2];
#pragma unroll
    for (int a = 0; a < 2; ++a)
#pragma unroll
        for (int b = 0; b < 2; ++b)
#pragma unroll
            for (int m = 0; m < 4; ++m)
#pragma unroll
                for (int n = 0; n < 2; ++n) acc[a][b][m][n] = (f32x4){0.f, 0.f, 0.f, 0.f};
    bf16x8 At[4][2], B0[2][2], B1[2][2];
    const char* cA = (const char*)g.A + (size_t)cur.pm * tstepA; const char* cB = (const char*)g.Bt + (size_t)cur.pn * tstep;
    S.a_ready(cur);
    if constexpr (Epi::MIDSCALE) E.prep(lds, tid, cur, wr, fr);
    if constexpr (SP2) {
        PG8_STAGE(PG8_SB(0, 0), cB, voffB); PG8_STAGE(PG8_SB(0, 1), cB + hstep, voffB); PG8_STAGE(PG8_SA(0, 0), cA, voffA); PG8_STAGE(PG8_SA(0, 1), cA + hstep, voffA);
        if (wr == 1) PG8_BAR;
        PG8_WAIT_V(2); PG8_BAR;
        PG8_STAGE(PG8_SB(1, 0), cB + kstep, voffB); PG8_STAGE(PG8_SA(1, 0), cA + kstep, voffA); PG8_STAGE(PG8_SB(1, 1), cB + hstep + kstep, voffB);
        PG8_WAIT_V(6); PG8_BAR;
    } else {
        PG8_STAGE(PG8_SB(0, 0), cB, voffB); PG8_STAGE(PG8_SA(0, 0), cA, voffA); PG8_STAGE(PG8_SB(0, 1), cB + hstep, voffB); PG8_STAGE(PG8_SA(0, 1), cA + hstep, voffA);
        if (wr == 1) PG8_BAR;
        PG8_WAIT_V(4); PG8_BAR;
        PG8_STAGE(PG8_SB(1, 0), cB + kstep, voffB); PG8_STAGE(PG8_SA(1, 0), cA + kstep, voffA); PG8_STAGE(PG8_SB(1, 1), cB + hstep + kstep, voffB);
        PG8_WAIT_V(6); PG8_BAR;
    }
    for (;;) {
        const bool has_next = S.next(ui + 1, nxt);
        const char* nA = has_next ? (const char*)g.A + (size_t)nxt.pm * tstepA : cA; const char* nB = has_next ? (const char*)g.Bt + (size_t)nxt.pn * tstep : cB;
        for (int t = 0; t < nt; t += 2) {
            if constexpr (Epi::MIDSCALE) { if (t == (nt >> 1)) E.midscale(acc, lds, tid); }
            const bool last = (t == nt - 2);
            const char* a1 = cA + (size_t)(t + 1) * kstep;
            const char* a2 = last ? nA : cA + (size_t)(t + 2) * kstep; const char* b2 = last ? nB : cB + (size_t)(t + 2) * kstep;
            const char* a3 = a2 + kstep; const char* b3 = b2 + kstep;
            if (last && has_next) S.a_ready(nxt);
            if constexpr (SP2) {
            PG8_LDB(B0, 0, 0); PG8_LDB(B1, 0, 1); PG8_SCHED; PG8_LDA(At, 0, 0); PG8_STAGE(PG8_SA(1, 1), a1 + hstep, voffA);
            PG8_WAIT_V(8); PG8_WAIT_L(0); PG8_BAR; PG8_MMA(0, 0, At, B0); PG8_MMA(0, 1, At, B1); PG8_BAR; PG8_SCHED;
            PG8_LDA(At, 0, 1); PG8_STAGE(PG8_SB(0, 0), b2, voffB); PG8_STAGE(PG8_SB(0, 1), b2 + hstep, voffB); PG8_STAGE(PG8_SA(0, 0), a2, voffA);
            PG8_WAIT_V(8); PG8_WAIT_L(0); PG8_BAR; PG8_MMA(1, 0, At, B0); PG8_MMA(1, 1, At, B1); PG8_BAR; PG8_SCHED;
            PG8_LDB(B0, 1, 0); PG8_LDB(B1, 1, 1); PG8_SCHED; PG8_LDA(At, 1, 0); PG8_STAGE(PG8_SA(0, 1), a2 + hstep, voffA);
            PG8_WAIT_V(8); PG8_WAIT_L(0); PG8_BAR; PG8_MMA(0, 0, At, B0); PG8_MMA(0, 1, At, B1); PG8_BAR; PG8_SCHED;
            PG8_LDA(At, 1, 1); PG8_STAGE(PG8_SB(1, 0), b3, voffB); PG8_STAGE(PG8_SB(1, 1), b3 + hstep, voffB); PG8_STAGE(PG8_SA(1, 0), a3, voffA);
            PG8_WAIT_V(8); PG8_WAIT_L(0); PG8_BAR; PG8_MMA(1, 0, At, B0); PG8_MMA(1, 1, At, B1); PG8_BAR; PG8_SCHED;
            } else {
            PG8_LDB(B0, 0, 0); PG8_SCHED; PG8_LDA(At, 0, 0); PG8_STAGE(PG8_SA(1, 1), a1 + hstep, voffA);
            PG8_WAIT_L(8); PG8_BAR; PG8_WAIT_L(0); PG8_MMA(0, 0, At, B0); PG8_BAR; PG8_SCHED;
            PG8_LDB(B1, 0, 1); PG8_STAGE(PG8_SB(0, 0), b2, voffB);
            PG8_BAR; PG8_WAIT_L(0); PG8_MMA(0, 1, At, B1); PG8_BAR;
            PG8_LDA(At, 0, 1); PG8_STAGE(PG8_SA(0, 0), a2, voffA);
            PG8_BAR; PG8_WAIT_L(0); PG8_MMA(1, 0, At, B0); PG8_BAR; PG8_SCHED;
            PG8_STAGE(PG8_SB(0, 1), b2 + hstep, voffB);
            PG8_WAIT_V(6); PG8_BAR; PG8_MMA(1, 1, At, B1); PG8_BAR;
            PG8_LDB(B0, 1, 0); PG8_SCHED; PG8_LDA(At, 1, 0); PG8_STAGE(PG8_SA(0, 1), a2 + hstep, voffA);
            PG8_WAIT_L(8); PG8_BAR; PG8_WAIT_L(0); PG8_MMA(0, 0, At, B0); PG8_BAR; PG8_SCHED;
            PG8_LDB(B1, 1, 1); PG8_STAGE(PG8_SB(1, 0), b3, voffB);
            PG8_BAR; PG8_WAIT_L(0); PG8_MMA(0, 1, At, B1); PG8_BAR;
            PG8_LDA(At, 1, 1); PG8_STAGE(PG8_SA(1, 0), a3, voffA);
            PG8_BAR; PG8_WAIT_L(0); PG8_MMA(1, 0, At, B0); PG8_BAR; PG8_SCHED;
            PG8_STAGE(PG8_SB(1, 1), b3 + hstep, voffB);
            PG8_WAIT_V(6); PG8_BAR; PG8_MMA(1, 1, At, B1); PG8_BAR;
            }
        }
        if constexpr (ALIGN_EPI) { if (wr == 0) PG8_BAR; }
        if constexpr (Epi::FULL) { E.full(acc, cur, wr, wc, fr, fq, lds, tid); S.done(cur); } else if constexpr (!Epi::AFTER_DRAIN) { E(acc, cur, wr, wc, fr, fq); S.done(cur); }
        if (!has_next) break;
#pragma unroll
        for (int a = 0; a < 2; ++a)
#pragma unroll
            for (int b = 0; b < 2; ++b)
#pragma unroll
                for (int m = 0; m < 4; ++m)
#pragma unroll
                    for (int n = 0; n < 2; ++n) acc[a][b][m][n] = (f32x4){0.f, 0.f, 0.f, 0.f};
        cur = nxt; cA = nA; cB = nB; ++ui;
        if constexpr (Epi::MIDSCALE) E.prep(lds, tid, cur, wr, fr);
        if constexpr (ALIGN_EPI) { if (wr == 1) PG8_BAR; }
    }
    PG8_WAIT_V(0);
    if constexpr (!ALIGN_EPI) { if (wr == 0) PG8_BAR; }
    PG8_BAR;
    if constexpr (Epi::AFTER_DRAIN) { E.fused(acc, cur, wr, wc, fr, fq, lds, wid, lane); S.done(cur); }
#undef PG8_SA
#undef PG8_SB
#undef PG8_STAGE
#undef PG8_LDA
#undef PG8_LDB
#undef PG8_MMA
#undef PG8_WAIT_V
#undef PG8_WAIT_L
#undef PG8_BAR
#undef PG8_SCHED
}
}
#include <hip/hip_bf16.h>
#include <cmath>
namespace attn_body {
using bf16=__hip_bfloat16;
using bf16x8=__attribute__((ext_vector_type(8)))short;
using s16x4=__attribute__((ext_vector_type(4)))short;
using f32x16=__attribute__((ext_vector_type(16)))float;
using u32x4=__attribute__((ext_vector_type(4)))unsigned;
constexpr int D=64,PQ=2304,PO=1024;
constexpr int NW=8,QBLK=32,QB=QBLK*NW,KVBLK=64;
__device__ __forceinline__ int crow(int r,int hi){return (r&3)+8*(r>>2)+4*hi;}
#define SBAR() __builtin_amdgcn_sched_barrier(0)
__device__ __forceinline__ void cmask(f32x16&p0,f32x16&p1,int jb,int qrel,int hi){
  const float NEG=-INFINITY; int kb=64*jb+4*hi;
  #pragma unroll
  for(int r=0;r<16;++r){int kv=kb+(r&3)+8*(r>>2); if(kv>qrel)p0[r]=NEG; if(kv+32>qrel)p1[r]=NEG;}
}

constexpr int NSLOT=3, SLOTB=8192;
constexpr int LDS_K=0, LDS_V=NSLOT*SLOTB, LDS_WS=2*NSLOT*SLOTB, LDS_OST=LDS_WS+NW*64*4, LDS_BYTES=LDS_OST+NW*4096;
constexpr float C2=0.125f*1.4426950408889634f;
__device__ __forceinline__ void glds16(const void*gsrc,unsigned lds_dst){unsigned keep;
  asm volatile("s_mov_b32 %0, m0\n\ts_mov_b32 m0, %2\n\ts_nop 0\n\tglobal_load_lds_dwordx4 %1, off\n\ts_mov_b32 m0, %0":"=&s"(keep):"v"(gsrc),"s"(lds_dst):"memory");}
__device__ __forceinline__ float max3f(float a,float b,float c){float r;asm("v_max3_f32 %0, %1, %2, %3":"=v"(r):"v"(a),"v"(b),"v"(c));return r;}
__device__ __forceinline__ float max2f(float a,float b){float r;asm("v_max_f32_e32 %0, %1, %2":"=v"(r):"v"(a),"v"(b));return r;}
__device__ __forceinline__ float fadd_s(float a,float b){float r;asm("v_add_f32_e32 %0, %1, %2":"=v"(r):"v"(a),"v"(b));return r;}
__device__ __forceinline__ float fsub_s(float a,float b){float r;asm("v_sub_f32_e32 %0, %1, %2":"=v"(r):"v"(a),"v"(b));return r;}
typedef float f32x2_t __attribute__((ext_vector_type(2))); typedef __bf16 bf16x2_t __attribute__((ext_vector_type(2)));
__device__ __forceinline__ unsigned cvtpk_s(float lo,float hi){f32x2_t v={lo,hi};bf16x2_t b=__builtin_convertvector(v,bf16x2_t);return __builtin_bit_cast(unsigned,b);}
#define WAIT_BAR(N) asm volatile("s_waitcnt vmcnt(" #N ") lgkmcnt(0)\n\ts_barrier":::"memory")

__device__ __forceinline__ void qkt(f32x16&p0,f32x16&p1,const char*Kslot,const bf16x8*qr,const f32x16&negm,int r32,int hi){
  const char*kb=Kslot+hi*1024+r32*16;
  #pragma unroll
  for(int d0=0;d0<4;++d0){
    const bf16x8 b0=*reinterpret_cast<const bf16x8*>(kb+d0*2048);
    const bf16x8 b1=*reinterpret_cast<const bf16x8*>(kb+d0*2048+512);
    if(d0==0){p0=__builtin_amdgcn_mfma_f32_32x32x16_bf16(b0,qr[0],negm,0,0,0);p1=__builtin_amdgcn_mfma_f32_32x32x16_bf16(b1,qr[0],negm,0,0,0);}
    else{p0=__builtin_amdgcn_mfma_f32_32x32x16_bf16(b0,qr[d0],p0,0,0,0);p1=__builtin_amdgcn_mfma_f32_32x32x16_bf16(b1,qr[d0],p1,0,0,0);}}
}
typedef __attribute__((address_space(3))) const char* lds_cptr;
typedef short v4i16_t __attribute__((ext_vector_type(4)));
__device__ __forceinline__ void kload8(bf16x8*kf,lds_cptr kp){
  kf[0]=*(const __attribute__((address_space(3))) bf16x8*)(kp);      kf[1]=*(const __attribute__((address_space(3))) bf16x8*)(kp+512);
  kf[2]=*(const __attribute__((address_space(3))) bf16x8*)(kp+2048); kf[3]=*(const __attribute__((address_space(3))) bf16x8*)(kp+2560);
  kf[4]=*(const __attribute__((address_space(3))) bf16x8*)(kp+4096); kf[5]=*(const __attribute__((address_space(3))) bf16x8*)(kp+4608);
  kf[6]=*(const __attribute__((address_space(3))) bf16x8*)(kp+6144); kf[7]=*(const __attribute__((address_space(3))) bf16x8*)(kp+6656);
}
__device__ __forceinline__ void kload2(bf16x8*kf,lds_cptr kp,int j){ kf[2*j]=*(const __attribute__((address_space(3))) bf16x8*)(kp+j*2048); kf[2*j+1]=*(const __attribute__((address_space(3))) bf16x8*)(kp+j*2048+512); }
__device__ __forceinline__ s16x4 vtr(lds_cptr p){ return __builtin_bit_cast(s16x4,__builtin_amdgcn_ds_read_tr16_b64_v4i16((__attribute__((address_space(3))) v4i16_t*)p)); }
__device__ __forceinline__ float rowmax(const f32x16&p0,const f32x16&p1){
  float a=max3f(p0[0],p0[1],p1[0]),b=max3f(p0[2],p0[3],p1[1]);a=max3f(a,p1[2],p1[3]);
  #pragma unroll
  for(int r=4;r<16;r+=4){a=max3f(a,p0[r],p0[r+1]);b=max3f(b,p0[r+2],p0[r+3]);a=max3f(a,p1[r],p1[r+1]);b=max3f(b,p1[r+2],p1[r+3]);}
  const float m=max2f(a,b);
  auto rr=__builtin_amdgcn_permlane32_swap(__float_as_uint(m),__float_as_uint(m),false,false);
  return max2f(__uint_as_float(rr[0]),__uint_as_float(rr[1]));
}
__device__ __forceinline__ void pv(f32x16*o,int vb,bf16x8 pa0,bf16x8 pa1,bf16x8 pa2,bf16x8 pa3){
  #pragma unroll
  for(int d0=0;d0<2;++d0){s16x4 lo[4],hi[4];
    #pragma unroll
    for(int ks=0;ks<4;++ks){
      asm volatile("ds_read_b64_tr_b16 %0,%1 offset:%c2":"=&v"(lo[ks]):"v"(vb),"i"(d0*4096+ks*1024):"memory");
      asm volatile("ds_read_b64_tr_b16 %0,%1 offset:%c2":"=&v"(hi[ks]):"v"(vb),"i"(d0*4096+ks*1024+512):"memory");}
    asm volatile("s_waitcnt lgkmcnt(0)":::"memory");SBAR();
    #define PK(k) (bf16x8){lo[k][0],lo[k][1],lo[k][2],lo[k][3],hi[k][0],hi[k][1],hi[k][2],hi[k][3]}
    o[d0]=__builtin_amdgcn_mfma_f32_32x32x16_bf16(pa0,PK(0),o[d0],0,0,0);
    o[d0]=__builtin_amdgcn_mfma_f32_32x32x16_bf16(pa1,PK(1),o[d0],0,0,0);
    o[d0]=__builtin_amdgcn_mfma_f32_32x32x16_bf16(pa2,PK(2),o[d0],0,0,0);
    o[d0]=__builtin_amdgcn_mfma_f32_32x32x16_bf16(pa3,PK(3),o[d0],0,0,0);
    #undef PK
  }
}

#ifndef ATTN_STORE16
#define ATTN_STORE16(p,v) (*(u32x4*)(p)=(v))
#endif
template<int THRL> __device__ __forceinline__ void attn_unit(long rowbase,int NT,int h,int kvh,int qb,const bf16*Q,const bf16*__restrict__ K,const bf16*__restrict__ V,bf16*O,float*ssq,char*shm){
  int tid=threadIdx.x; asm volatile("":"+v"(tid)); const int lane=tid&63,r32=lane&31,hi=lane>>5; const int wid=__builtin_amdgcn_readfirstlane(tid>>6);
  const int q0=qb*QB;
  const bf16*Qw=Q+(rowbase+q0+wid*QBLK)*PQ+h*D;
  const bf16*Kh=K+rowbase*PQ+kvh*D,*Vh=V+rowbase*PQ+kvh*D;
  const unsigned lds0=(unsigned)(uintptr_t)shm;
  float*wsf=(float*)(shm+LDS_WS)+wid*64;
  const bf16*ksrc=Kh+(long)lane*PQ+wid*8;
  const bf16*vsrc=Vh+(long)(16*(wid&3)+(lane>>2))*PQ+(wid>>2)*32+(lane&3)*8;
  const unsigned kdst=lds0+LDS_K+wid*1024, vdst=lds0+LDS_V+wid*1024;
  #define DMA_K(t,slot) glds16(ksrc+(long)(t)*KVBLK*PQ,(unsigned)__builtin_amdgcn_readfirstlane(kdst+(slot)))
  #define DMA_V(t,slot) glds16(vsrc+(long)(t)*KVBLK*PQ,(unsigned)__builtin_amdgcn_readfirstlane(vdst+(slot)))
  const int vb0=(int)(lds0+LDS_V)+((lane>>4)&1)*32+(lane&3)*8+(4*hi+((lane&15)>>2))*64;
  const char*Kbase=shm+LDS_K; bf16x8 kf[8];
  const lds_cptr shm3=(lds_cptr)shm; const lds_cptr kp0=shm3+LDS_K+hi*1024+r32*16; const lds_cptr vp0=shm3+LDS_V+((lane>>4)&1)*32+(lane&3)*8+(4*hi+((lane&15)>>2))*64;
  DMA_K(0,0);DMA_V(0,0);DMA_K(1,SLOTB);
  bf16x8 qr[4];
  #pragma unroll
  for(int d0=0;d0<4;++d0)qr[d0]=*reinterpret_cast<const bf16x8*>(&Qw[(long)r32*PQ+d0*16+hi*8]);
  float mhat=0.f,l_reg=0.f;f32x16 o[2];o[0]=f32x16{};o[1]=f32x16{};f32x16 negm=f32x16{};asm volatile("":"+v"(negm));
  const int qrel=wid*QBLK+r32;
  #define CMASK(P0,P1,t) do{int jb_=(t)-(NT-4); (void)jb_;(void)qrel;}while(0)
  bool resc=false;
  #define START(P0,P1) do{ const float rm=rowmax(P0,P1); resc=false; \
    { const float dl=rm; mhat=fadd_s(mhat,dl); \
      _Pragma("unroll") for(int r=0;r<16;++r){P0[r]=fsub_s(P0[r],dl);P1[r]=fsub_s(P1[r],dl);} \
      _Pragma("unroll") for(int r=0;r<16;++r)negm[r]=-mhat; asm volatile("":"+v"(negm)); } \
    _Pragma("unroll") for(int r=0;r<16;++r)P0[r]=__builtin_amdgcn_exp2f(P0[r]); }while(0)
  #define RESC() do{ if(resc){ asm volatile("s_waitcnt lgkmcnt(0)":::"memory"); \
      _Pragma("unroll") for(int d_=0;d_<2;++d_) _Pragma("unroll") for(int r=0;r<16;++r)o[d_][r]*=wsf[crow(r,hi)]; } }while(0)
  f32x16 pA0,pA1,pB0,pB1;
  int sl_prev=0,sl_cur=0,sl_next=SLOTB;
  #define ROT() do{sl_prev=sl_cur;sl_cur=sl_next;sl_next=(sl_next==(NSLOT-1)*SLOTB)?0:sl_next+SLOTB;}while(0)
  DMA_K(2,2*SLOTB);
  WAIT_BAR(3);
  qkt(pA0,pA1,Kbase,qr,negm,r32,hi);asm volatile("s_nop 15\n\ts_nop 7":"+v"(pA0),"+v"(pA1));CMASK(pA0,pA1,0);
  START(pA0,pA1);
  _Pragma("unroll") for(int r=0;r<16;++r)pA1[r]=__builtin_amdgcn_exp2f(pA1[r]);
  WAIT_BAR(0);
  DMA_K(3,0);DMA_V(1,SLOTB);
  ROT();
  kload8(kf,kp0+sl_cur);
  WAIT_BAR(2);
  s16x4 vlo[8],vhi[8]; u32x4 pw0,pw1,pw2,pw3;
  #define PKW(P,B) cvtpk_s(P[B],P[B+1])
  #define PAF(k) __builtin_bit_cast(bf16x8,pw##k)
  #define VFR(i) (bf16x8){vlo[i][0],vlo[i][1],vlo[i][2],vlo[i][3],vhi[i][0],vhi[i][1],vhi[i][2],vhi[i][3]}
  #define PIN(x) asm volatile("":"+v"(x))
  #define MX3(a,b,c) __builtin_fmaxf(__builtin_fmaxf((a),(b)),(c))
  #define GAPA(MF,A0,A1,A2,A3,W0,W1,PW) do{ MF; sacc+=A0; sacc+=A1; sacc+=A2; sacc+=A3; PIN(sacc); W0; W1; PIN(PW); SBAR(); }while(0)
  #define EX(v) __builtin_amdgcn_exp2f(v)
  #define GAPB(MF,X,B) do{ MF; X[B]=EX(X[B]); X[B+1]=EX(X[B+1]); X[B+2]=EX(X[B+2]); X[B+3]=EX(X[B+3]); PIN(X); SBAR(); }while(0)
  #define VRD(i) do{ vlo[i]=vtr(vp_+(((i)>>2)*4096+((i)&3)*1024)); vhi[i]=vtr(vp_+(((i)>>2)*4096+((i)&3)*1024+512)); }while(0)
  #define KRD(G,j) do{ if(G){ kload2(kf,kp0+sl_next,j); SBAR(); } }while(0)
  #define STEP(C0,C1,P0,P1,t,GK,GV,GL) do{ SBAR(); \
    const lds_cptr vp_=vp0+sl_prev; \
    VRD(0); SBAR(); float sacc=(P0[0]+P0[1]); \
    GAPA(C0=__builtin_amdgcn_mfma_f32_32x32x16_bf16(kf[0],qr[0],negm,0,0,0), P0[2],P0[3],P0[4],P0[5],     pw0[0]=PKW(P0,0), pw0[1]=PKW(P0,2), pw0); \
    VRD(4); SBAR(); GAPA(C1=__builtin_amdgcn_mfma_f32_32x32x16_bf16(kf[1],qr[0],negm,0,0,0), P0[6],P0[7],P0[8],P0[9],     pw0[2]=PKW(P0,4), pw0[3]=PKW(P0,6), pw0); \
    VRD(1); SBAR(); GAPA(C0=__builtin_amdgcn_mfma_f32_32x32x16_bf16(kf[2],qr[1],C0,0,0,0),   P0[10],P0[11],P0[12],P0[13], pw1[0]=PKW(P0,8), pw1[1]=PKW(P0,10), pw1); \
    VRD(5); SBAR(); GAPA(C1=__builtin_amdgcn_mfma_f32_32x32x16_bf16(kf[3],qr[1],C1,0,0,0),   P0[14],P0[15],P1[0],P1[1],   pw1[2]=PKW(P0,12),pw1[3]=PKW(P0,14), pw1); \
    VRD(2); SBAR(); GAPA(C0=__builtin_amdgcn_mfma_f32_32x32x16_bf16(kf[4],qr[2],C0,0,0,0),   P1[2],P1[3],P1[4],P1[5],     pw2[0]=PKW(P1,0), pw2[1]=PKW(P1,2), pw2); \
    VRD(6); SBAR(); GAPA(C1=__builtin_amdgcn_mfma_f32_32x32x16_bf16(kf[5],qr[2],C1,0,0,0),   P1[6],P1[7],P1[8],P1[9],     pw2[2]=PKW(P1,4), pw2[3]=PKW(P1,6), pw2); \
    VRD(3); SBAR(); GAPA(C0=__builtin_amdgcn_mfma_f32_32x32x16_bf16(kf[6],qr[3],C0,0,0,0),   P1[10],P1[11],P1[12],P1[13], pw3[0]=PKW(P1,8), pw3[1]=PKW(P1,10), pw3); \
    VRD(7); SBAR(); GAPA(C1=__builtin_amdgcn_mfma_f32_32x32x16_bf16(kf[7],qr[3],C1,0,0,0),   P1[14],P1[15],0.f,0.f,       pw3[2]=PKW(P1,12),pw3[3]=PKW(P1,14), pw3); \
    l_reg+=sacc; \
    if(GK){DMA_K((t)+3,sl_cur);} if(GV){DMA_V((t)+1,sl_next);} \
    CMASK(C0,C1,t); \
    { float a=MX3(C0[0],C0[1],C1[0]),b=MX3(C0[2],C0[3],C1[1]); a=MX3(a,C1[2],C1[3]); \
      _Pragma("unroll") for(int r=4;r<16;r+=4){a=MX3(a,C0[r],C0[r+1]);b=MX3(b,C0[r+2],C0[r+3]);a=MX3(a,C1[r],C1[r+1]);b=MX3(b,C1[r+2],C1[r+3]);} \
      float rm=__builtin_fmaxf(a,b); { auto rr=__builtin_amdgcn_permlane32_swap(__float_as_uint(rm),__float_as_uint(rm),false,false); rm=__builtin_fmaxf(__uint_as_float(rr[0]),__uint_as_float(rr[1])); } \
      resc=false; \
      if(__builtin_expect(__any(rm>(float)THRL),0)){ const float dl=__builtin_fmaxf(rm,0.f); mhat+=dl; \
        _Pragma("unroll") for(int r=0;r<16;++r){C0[r]-=dl;C1[r]-=dl;} \
        _Pragma("unroll") for(int r=0;r<16;++r)negm[r]=-mhat; asm volatile("":"+v"(negm)); \
        const float f=__builtin_amdgcn_exp2f(-dl); l_reg*=f; if(hi==0)wsf[r32]=f; resc=true; } } \
    SBAR(); \
    GAPB(o[0]=__builtin_amdgcn_mfma_f32_32x32x16_bf16(PAF(0),VFR(0),o[0],0,0,0), C0,0); \
    GAPB(o[1]=__builtin_amdgcn_mfma_f32_32x32x16_bf16(PAF(0),VFR(4),o[1],0,0,0), C0,4); \
    KRD(GL,0); GAPB(o[0]=__builtin_amdgcn_mfma_f32_32x32x16_bf16(PAF(1),VFR(1),o[0],0,0,0), C0,8); \
    KRD(GL,1); GAPB(o[1]=__builtin_amdgcn_mfma_f32_32x32x16_bf16(PAF(1),VFR(5),o[1],0,0,0), C0,12); \
    KRD(GL,2); GAPB(o[0]=__builtin_amdgcn_mfma_f32_32x32x16_bf16(PAF(2),VFR(2),o[0],0,0,0), C1,0); \
    KRD(GL,3); GAPB(o[1]=__builtin_amdgcn_mfma_f32_32x32x16_bf16(PAF(2),VFR(6),o[1],0,0,0), C1,4); \
    GAPB(o[0]=__builtin_amdgcn_mfma_f32_32x32x16_bf16(PAF(3),VFR(3),o[0],0,0,0), C1,8); \
    GAPB(o[1]=__builtin_amdgcn_mfma_f32_32x32x16_bf16(PAF(3),VFR(7),o[1],0,0,0), C1,12); \
    }while(0)
  int t=1;
  #undef CMASK
  #define CMASK(P0,P1,t) do{}while(0)
  for(;t+5<NT;t+=2){
    STEP(pB0,pB1,pA0,pA1,t,true,true,true);     WAIT_BAR(2); RESC(); ROT();
    STEP(pA0,pA1,pB0,pB1,t+1,true,true,true);   WAIT_BAR(2); RESC(); ROT();
  }
  #undef CMASK
  #define CMASK(P0,P1,t) do{int jb_=(t)-(NT-4); (void)jb_;(void)qrel;}while(0)
  #define ENDW(tt) do{ if((tt)+3<NT){WAIT_BAR(2);} else if((tt)+2<NT){WAIT_BAR(1);} else {WAIT_BAR(0);} }while(0)
  for(;t+1<NT;t+=2){
    STEP(pB0,pB1,pA0,pA1,t,(t+3<NT),(t+1<NT),(t+1<NT));       ENDW(t);   RESC(); ROT();
    STEP(pA0,pA1,pB0,pB1,t+1,(t+4<NT),(t+2<NT),(t+2<NT));     ENDW(t+1); RESC(); ROT();
  }
  STEP(pB0,pB1,pA0,pA1,NT-1,false,false,false); RESC();
  { float sacc=pB0[0]+pB0[1]; _Pragma("unroll") for(int r=2;r<16;++r)sacc+=pB0[r]; _Pragma("unroll") for(int r=0;r<16;++r)sacc+=pB1[r]; l_reg+=sacc;
    pw0=(u32x4){PKW(pB0,0),PKW(pB0,2),PKW(pB0,4),PKW(pB0,6)};pw1=(u32x4){PKW(pB0,8),PKW(pB0,10),PKW(pB0,12),PKW(pB0,14)};pw2=(u32x4){PKW(pB1,0),PKW(pB1,2),PKW(pB1,4),PKW(pB1,6)};pw3=(u32x4){PKW(pB1,8),PKW(pB1,10),PKW(pB1,12),PKW(pB1,14)};
    SBAR(); pv(o,vb0+sl_cur,PAF(0),PAF(1),PAF(2),PAF(3)); }
  #undef PKW
  #undef PAF
  #undef VFR
  #undef PIN
  #undef MX3
  #undef GAPA
  #undef GAPB
  #undef EX
  #undef VRD
  #undef KRD
  #undef STEP
  #undef ENDW
  {auto rr=__builtin_amdgcn_permlane32_swap(__float_as_uint(l_reg),__float_as_uint(l_reg),false,false);l_reg=__uint_as_float(rr[0])+__uint_as_float(rr[1]);}
  if(hi==0)wsf[32+r32]=l_reg;asm volatile("s_waitcnt lgkmcnt(0)":::"memory");
  float rli[16];
  #pragma unroll
  for(int r=0;r<16;++r)rli[r]=__builtin_amdgcn_rcpf(wsf[32+crow(r,hi)]);
  bf16*Ow=O+(rowbase+q0+wid*QBLK)*PO+h*D;
  { bf16*stg=(bf16*)(shm+LDS_OST)+wid*2048;
    #pragma unroll
    for(int r=0;r<16;++r){const int orow=crow(r,hi);
      #pragma unroll
      for(int d0=0;d0<2;++d0)stg[orow*64+d0*32+r32]=__float2bfloat16(o[d0][r]*rli[r]);}
    asm volatile("s_waitcnt lgkmcnt(0)":::"memory");
    #pragma unroll
    for(int i=0;i<4;++i){const int row=i*8+(lane>>3),ch=lane&7; const u32x4 v=*(const u32x4*)(stg+row*64+ch*8); ATTN_STORE16(Ow+(long)row*PO+ch*8,v);
      float ss=0.f; _Pragma("unroll") for(int e=0;e<4;++e){const float lo=__uint_as_float(v[e]<<16),hh=__uint_as_float(v[e]&0xffff0000u); ss+=lo*lo+hh*hh;}
      ss+=__shfl_xor(ss,1);ss+=__shfl_xor(ss,2);ss+=__shfl_xor(ss,4); if(ch==0)__hip_atomic_fetch_add(ssq+(rowbase+q0+wid*QBLK+row),ss,__ATOMIC_RELAXED,__HIP_MEMORY_SCOPE_AGENT);} }
  asm volatile("s_waitcnt lgkmcnt(0)\n\ts_barrier":::"memory");
  #undef DMA_K
  #undef DMA_V
  #undef CMASK
  #undef START
  #undef RESC
  #undef ROT
}
constexpr int ATTN_LDS_BYTES=LDS_BYTES;
#undef SBAR
#undef WAIT_BAR
}
namespace na_body {
using attn_body::bf16x8; using attn_body::s16x4; using attn_body::f32x16; using attn_body::u32x4;
#define NA_LAS __attribute__((address_space(3)))
constexpr int PQ = 2304, PO = 1024;
constexpr int COL_QB = 768, COL_KB = 1280, COL_VB = 1792, COL_OB = 512;
constexpr int T_GUARD = 48, T_FLOATS = T_GUARD + 15 * 32 + 48;
__device__ __forceinline__ int crow(int r, int hi) { return (r & 3) + 8 * (r >> 2) + 4 * hi; }
__device__ __forceinline__ unsigned cvtpk(float lo, float hi) { return attn_body::cvtpk_s(lo, hi); }

__device__ __forceinline__ void na_unit(const unsigned short* __restrict__ PROJ, unsigned short* __restrict__ O, long rowbase, int rows, int r, int h,
                                        NA_LAS unsigned char* wl, unsigned wl_addr, const NA_LAS float* T, NA_LAS float* wsf, float* ssq) {
    int tid_ = threadIdx.x; asm volatile("" : "+v"(tid_)); const int lane = tid_ & 63, r32 = lane & 31, hi = lane >> 5;
    const int r0 = min(max(r - 4, 0), rows - 8);
    const long qrow0 = rowbase + (long)r * 64;
    const unsigned short* qbase = PROJ + (qrow0 + r32) * PQ + COL_QB + h * 64 + hi * 8;
    bf16x8 qr[2][4];
#pragma unroll
    for (int qb2 = 0; qb2 < 2; ++qb2)
#pragma unroll
        for (int d0 = 0; d0 < 4; ++d0) qr[qb2][d0] = *(const bf16x8*)(qbase + (long)qb2 * 32 * PQ + d0 * 16);
    float mrun[2] = {-1e30f, -1e30f}, lrun[2] = {0.f, 0.f};
    f32x16 o[2][2];
#pragma unroll
    for (int a = 0; a < 2; ++a)
#pragma unroll
        for (int b = 0; b < 2; ++b) o[a][b] = f32x16{};
    const int lrow = lane >> 3, lc = lane & 7;
    const int vb = (int)wl_addr + 8192 + ((lane >> 4) & 1) * 32 + (lane & 3) * 8 + (4 * hi + ((lane & 15) >> 2)) * 64;
    for (int i = 0; i < 8; ++i) {
        const unsigned short* kb = PROJ + (rowbase + (long)(r0 + i) * 64 + lrow) * PQ + COL_KB + h * 64 + lc * 8;
        u32x4 kreg[8], vreg[8];
#pragma unroll
        for (int j = 0; j < 8; ++j) { kreg[j] = *(const u32x4*)(kb + (long)j * 8 * PQ); vreg[j] = *(const u32x4*)(kb + (COL_VB - COL_KB) + (long)j * 8 * PQ); }
#pragma unroll
        for (int j = 0; j < 8; ++j) { const int row = j * 8 + lrow;
            *(NA_LAS u32x4*)(wl + lc * 1024 + row * 16) = kreg[j];
            *(NA_LAS u32x4*)(wl + 8192 + (lc >> 2) * 4096 + (row >> 4) * 1024 + (row & 15) * 64 + (lc & 3) * 16) = vreg[j]; }
        bf16x8 kf[8];
#pragma unroll
        for (int d0 = 0; d0 < 4; ++d0) { kf[2 * d0] = *(const NA_LAS bf16x8*)(wl + (2 * d0 + hi) * 1024 + r32 * 16); kf[2 * d0 + 1] = *(const NA_LAS bf16x8*)(wl + (2 * d0 + hi) * 1024 + 512 + r32 * 16); }
        const int dr = r0 + i - r + 7;
#pragma unroll
        for (int qb2 = 0; qb2 < 2; ++qb2) {
            f32x16 p0 = f32x16{}, p1 = f32x16{};
#pragma unroll
            for (int d0 = 0; d0 < 4; ++d0) { p0 = __builtin_amdgcn_mfma_f32_32x32x16_bf16(kf[2 * d0], qr[qb2][d0], p0, 0, 0, 0); p1 = __builtin_amdgcn_mfma_f32_32x32x16_bf16(kf[2 * d0 + 1], qr[qb2][d0], p1, 0, 0, 0); }
            const int c = qb2 * 32 + r32, c0 = min(max(c - 8, 0), 48);
            const NA_LAS float* tb = T + dr * 32 + 15 - c + 4 * hi;
            const int kofs = 4 * hi - c0;
            float rm = -1e30f;
#pragma unroll
            for (int rr = 0; rr < 16; ++rr) { const int kc = (rr & 3) + 8 * (rr >> 2);
                const float s0 = ((unsigned)(kc + kofs) < 16u) ? p0[rr] + tb[kc] : -1e30f;
                const float s1 = ((unsigned)(kc + 32 + kofs) < 16u) ? p1[rr] + tb[kc + 32] : -1e30f;
                p0[rr] = s0; p1[rr] = s1; rm = fmaxf(rm, fmaxf(s0, s1)); }
            rm = fmaxf(rm, __shfl_xor(rm, 32));
            const float mn = fmaxf(mrun[qb2], rm), alpha = __builtin_amdgcn_exp2f(mrun[qb2] - mn);
            mrun[qb2] = mn;
            float sum = 0.f;
#pragma unroll
            for (int rr = 0; rr < 16; ++rr) { p0[rr] = __builtin_amdgcn_exp2f(p0[rr] - mn); p1[rr] = __builtin_amdgcn_exp2f(p1[rr] - mn); sum += p0[rr] + p1[rr]; }
            lrun[qb2] = lrun[qb2] * alpha + sum;
            if (__any(alpha != 1.0f)) {
                if (hi == 0) wsf[r32] = alpha;
#pragma unroll
                for (int rr = 0; rr < 16; ++rr) { const float a = wsf[crow(rr, hi)]; o[qb2][0][rr] *= a; o[qb2][1][rr] *= a; }
            }
            u32x4 pw0, pw1, pw2, pw3;
            pw0 = (u32x4){cvtpk(p0[0], p0[1]), cvtpk(p0[2], p0[3]), cvtpk(p0[4], p0[5]), cvtpk(p0[6], p0[7])};
            pw1 = (u32x4){cvtpk(p0[8], p0[9]), cvtpk(p0[10], p0[11]), cvtpk(p0[12], p0[13]), cvtpk(p0[14], p0[15])};
            pw2 = (u32x4){cvtpk(p1[0], p1[1]), cvtpk(p1[2], p1[3]), cvtpk(p1[4], p1[5]), cvtpk(p1[6], p1[7])};
            pw3 = (u32x4){cvtpk(p1[8], p1[9]), cvtpk(p1[10], p1[11]), cvtpk(p1[12], p1[13]), cvtpk(p1[14], p1[15])};
            attn_body::pv(o[qb2], vb, __builtin_bit_cast(bf16x8, pw0), __builtin_bit_cast(bf16x8, pw1), __builtin_bit_cast(bf16x8, pw2), __builtin_bit_cast(bf16x8, pw3));
        }
    }
#pragma unroll
    for (int qb2 = 0; qb2 < 2; ++qb2) {
        const float l = lrun[qb2] + __shfl_xor(lrun[qb2], 32);
        if (hi == 0) wsf[r32] = __builtin_amdgcn_rcpf(l);
        NA_LAS unsigned short* stg = (NA_LAS unsigned short*)(wl + qb2 * 4096);
#pragma unroll
        for (int rr = 0; rr < 16; ++rr) { const int orow = crow(rr, hi); const float rl = wsf[orow];
#pragma unroll
            for (int d0 = 0; d0 < 2; ++d0) stg[orow * 64 + d0 * 32 + r32] = (unsigned short)(cvtpk(o[qb2][d0][rr] * rl, 0.f) & 0xffffu); }
        unsigned short* Ow = O + (qrow0 + qb2 * 32) * PO + COL_OB + h * 64;
#pragma unroll
        for (int k = 0; k < 4; ++k) { const int row = k * 8 + (lane >> 3), ch = lane & 7; const u32x4 v = *(const NA_LAS u32x4*)(stg + row * 64 + ch * 8); *(u32x4*)(Ow + (long)row * PO + ch * 8) = v;
            float ss = 0.f;
#pragma unroll
            for (int e = 0; e < 4; ++e) { const float lo = __uint_as_float(v[e] << 16), hh = __uint_as_float(v[e] & 0xffff0000u); ss += lo * lo + hh * hh; }
            ss += __shfl_xor(ss, 1); ss += __shfl_xor(ss, 2); ss += __shfl_xor(ss, 4); if (ch == 0) __hip_atomic_fetch_add(ssq + (qrow0 + qb2 * 32 + row), ss, __ATOMIC_RELAXED, __HIP_MEMORY_SCOPE_AGENT); }
    }
}
}
namespace cg = cooperative_groups;
constexpr int NWAVES = 8;
constexpr int DM = 1024, M_PROMPT = 32 * 2048, S_PROMPT = 2048, M_SAMPLE = 4 * 4096, S_SAMPLE = 4096, M_ALL = M_PROMPT + M_SAMPLE;
constexpr int NPROJ = 2304, DFF = 2816, NUP = 2 * DFF, PLE = 256;
constexpr int FFN_CHUNKS = 4, M_CHUNK = M_ALL / FFN_CHUNKS;
constexpr float C2 = 0.125f * 1.4426950408889634f;
constexpr float LOG2E = 1.4426950408889634f;
constexpr size_t MiB = 1u << 20;
constexpr size_t WS_SSQ2 = 0, WS_SSQ3 = 384 * 1024, WS_SSQ4 = 768 * 1024, WS_SSQA = 1152 * 1024, WS_SSQB = 1536 * 1024, WS_ROPE = 1984 * 1024;
constexpr size_t WS_WIN = 2 * MiB, WS_WOUT = 7 * MiB, WS_WUP = 9 * MiB, WS_WDOWN = 20 * MiB, WS_WGATE = 26 * MiB, WS_WPLE = 28 * MiB;
constexpr size_t WS_PROJ = 32 * MiB;
constexpr size_t WS_XNO = 392 * MiB;
constexpr size_t WS_ACT = 32 * MiB;
constexpr size_t WS_H2B = 472 * MiB;
constexpr size_t WS_H3B = 32 * MiB;
constexpr size_t WS_E = 632 * MiB;
constexpr size_t WS_H1B = 824 * MiB;
constexpr size_t WS_PB = 984 * MiB;
constexpr size_t WS_END = 1024 * MiB;
static_assert(WS_PROJ + (size_t)M_ALL * NPROJ * 2 <= WS_XNO && WS_XNO + (size_t)M_ALL * DM * 2 <= WS_E && WS_ACT + (size_t)M_ALL * DFF * 2 <= WS_H2B && WS_H2B + (size_t)M_ALL * DM * 2 <= WS_E, "d_ws map");
static_assert(WS_E + (size_t)M_ALL * DM * 2 <= WS_H1B && WS_H1B + (size_t)M_ALL * DM * 2 <= WS_PB && WS_PB + (size_t)M_ALL * PLE * 2 <= WS_END && WS_H3B + (size_t)M_ALL * DM * 2 <= WS_H2B, "d_ws map 2");
static_assert(WS_WIN + (size_t)NPROJ * DM * 2 <= WS_WOUT && WS_WUP + (size_t)NUP * DM * 2 <= WS_WDOWN && WS_WDOWN + (size_t)DM * DFF * 2 <= WS_WGATE, "weight map");
constexpr int RING_BYTES = 131072;
constexpr int NA_T_OFF = RING_BYTES, NA_T_BYTES = na_body::T_FLOATS * 4, NA_WSF_OFF = NA_T_OFF + NWAVES * NA_T_BYTES, LDS_BYTES = NA_WSF_OFF + NWAVES * 256;
static_assert(LDS_BYTES <= 163840 && attn_body::ATTN_LDS_BYTES <= RING_BYTES, "LDS map");

#define LAS __attribute__((address_space(3)))
typedef unsigned short bf16;
typedef unsigned v4u __attribute__((ext_vector_type(4)));
typedef unsigned v2u __attribute__((ext_vector_type(2)));
typedef float f32x4 __attribute__((ext_vector_type(4)));
__device__ __forceinline__ unsigned pk2(float lo, float hi) { return pg8::cvt_pk_bf16(lo, hi); }
__device__ __forceinline__ float bflo(unsigned w) { return __uint_as_float(w << 16); }
__device__ __forceinline__ float bfhi(unsigned w) { return __uint_as_float(w & 0xffff0000u); }
__device__ __forceinline__ float wave_sum(float v) {
#pragma unroll
    for (int o = 1; o < 64; o <<= 1) v += __shfl_xor(v, o);
    return v;
}
__device__ __forceinline__ void p0_transpose_item(const float* W, int K, int N, bf16* WT, LAS float* scr, int item, int lane, const float* gain, const float* gain_hi, int ksplit, int nlo, int nhi, float nscale, bool upmap = false) {
    const int nblk = N / 32, kb = item / nblk, nb = item % nblk, k0 = 64 * kb, n0 = 32 * nb;
#pragma unroll 8
    for (int i = 0; i < 32; ++i) { const int kk = 2 * i + (lane >> 5); float w = W[(size_t)(k0 + kk) * N + n0 + (lane & 31)]; if (gain) w *= (k0 < ksplit ? gain[k0 + kk] : gain_hi[k0 + kk - ksplit]); scr[kk * 33 + (lane & 31)] = w; }
    asm volatile("s_waitcnt lgkmcnt(0)" ::: "memory");
    const int c = lane & 7;
#pragma unroll
    for (int j = 0; j < 4; ++j) { const int n = (lane >> 3) + 8 * j; const LAS float* s = scr + (8 * c) * 33 + n; const float ns = (n0 + n >= nlo && n0 + n < nhi) ? nscale : 1.0f;
        v4u o; o.x = pk2(s[0 * 33] * ns, s[1 * 33] * ns); o.y = pk2(s[2 * 33] * ns, s[3 * 33] * ns); o.z = pk2(s[4 * 33] * ns, s[5 * 33] * ns); o.w = pk2(s[6 * 33] * ns, s[7 * 33] * ns);
        int nn = n0 + n; if (upmap) nn = (nn < DFF) ? 256 * (nn / 128) + (nn % 128) : 256 * ((nn - DFF) / 128) + 128 + ((nn - DFF) % 128);
        *(v4u*)(WT + (size_t)nn * K + k0 + 8 * c) = o; }
    asm volatile("s_waitcnt lgkmcnt(0)" ::: "memory");
}
__device__ __forceinline__ void sincos_cw(float a, float& s, float& c) {
    const float k = rintf(a * 0.636619772367581343f);
    float r = fmaf(-k, 1.5703125f, a); r = fmaf(-k, 4.837512969970703125e-4f, r); r = fmaf(-k, 7.54978995489188216e-8f, r);
    const float r2 = r * r;
    const float sp = r + r * r2 * (-1.6666667163e-01f + r2 * (8.3333337680e-03f + r2 * (-1.9841270114e-04f + r2 * 2.7557314297e-06f)));
    const float cp = 1.0f + r2 * (-0.5f + r2 * (4.1666667908e-02f + r2 * (-1.3888889225e-03f + r2 * (2.4801587642e-05f + r2 * -2.7557314297e-07f))));
    const int q = (int)k & 3;
    s = (q == 0) ? sp : (q == 1) ? cp : (q == 2) ? -sp : -cp;
    c = (q == 0) ? cp : (q == 1) ? -sp : (q == 2) ? -cp : sp;
}

typedef const __attribute__((address_space(4))) unsigned char* kptr_t;
struct Args { const float* in[21]; float* out; unsigned char* ws; };

__global__ void __launch_bounds__(NWAVES * 64, 2) hymba_fwd(Args args) {
    extern __shared__ __attribute__((aligned(16))) unsigned char lds[];
    cg::grid_group grid = cg::this_grid();
    LAS unsigned char* const L = (LAS unsigned char*)lds;
    const int wave = __builtin_amdgcn_readfirstlane(threadIdx.x >> 6);
    const int G = gridDim.x, bx = blockIdx.x, vcu = (G % 8 == 0) ? (bx % 8) * (G / 8) + bx / 8 : bx;
    const int gw = vcu * NWAVES + wave, NGW = G * NWAVES;
#define PHASE_PTRS() int tid = threadIdx.x; asm volatile("" : "+v"(tid)); const int lane = tid & 63; (void)lane; kptr_t kp = (kptr_t)__builtin_amdgcn_kernarg_segment_ptr(); asm volatile("" : "+s"(kp)); unsigned char* const ws = (unsigned char*)KLD(22); float* const out = (float*)KLD(21); (void)out; \
    float* const ssq2 = (float*)(ws + WS_SSQ2); float* const ssq3 = (float*)(ws + WS_SSQ3); float* const ssq4 = (float*)(ws + WS_SSQ4); float* const ssqA = (float*)(ws + WS_SSQA); float* const ssqB = (float*)(ws + WS_SSQB); (void)ssqA; (void)ssqB; float* const rope = (float*)(ws + WS_ROPE); (void)ssq2; (void)ssq3; (void)ssq4; (void)rope; \
    bf16* const PROJ = (bf16*)(ws + WS_PROJ); bf16* const XNO = (bf16*)(ws + WS_XNO); (void)PROJ; (void)XNO;
#define KLD(i) (*(const __attribute__((address_space(4))) unsigned long long*)(kp + 8 * (i)))
#define KIN(i) ((const float*)KLD(i))

    {
        PHASE_PTRS();
        const float* const x_prompt = KIN(0); const float* const x_sample = KIN(1); const float* const p_prompt = KIN(2); const float* const p_sample = KIN(3);
        bf16* const Win_t = (bf16*)(ws + WS_WIN); bf16* const Wout_t = (bf16*)(ws + WS_WOUT); bf16* const Wup_t = (bf16*)(ws + WS_WUP); bf16* const Wdown_t = (bf16*)(ws + WS_WDOWN);
        bf16* const Wgate_t = (bf16*)(ws + WS_WGATE); bf16* const Wple_t = (bf16*)(ws + WS_WPLE); bf16* const PB = (bf16*)(ws + WS_PB);
        LAS float* scr = (LAS float*)(L + wave * 16384);
        constexpr int I_IN = (DM / 64) * (NPROJ / 32), I_OUT = (DM / 64) * (DM / 32), I_UP = (DM / 64) * (NUP / 32), I_DOWN = (DFF / 64) * (DM / 32), I_GATE = I_OUT, I_PLE = (PLE / 64) * (DM / 32);
        constexpr int NITEMS = I_IN + I_OUT + I_UP + I_DOWN + I_GATE + I_PLE;
        for (int it = gw; it < NITEMS; it += NGW) {
            int r = it;
            if (r < I_IN) { p0_transpose_item(KIN(5), DM, NPROJ, Win_t, scr, r, lane, nullptr, nullptr, 0, na_body::COL_QB, na_body::COL_KB, C2); continue; } r -= I_IN;
            if (r < I_OUT) { p0_transpose_item(KIN(11), DM, DM, Wout_t, scr, r, lane, KIN(9), KIN(10), 512, 0, 0, 1.f); continue; } r -= I_OUT;
            if (r < I_UP) { p0_transpose_item(KIN(13), DM, NUP, Wup_t, scr, r, lane, KIN(12), nullptr, 1 << 30, 0, 0, 1.f, true); continue; } r -= I_UP;
            if (r < I_DOWN) { p0_transpose_item(KIN(16), DFF, DM, Wdown_t, scr, r, lane, nullptr, nullptr, 0, 0, 0, 1.f); continue; } r -= I_DOWN;
            if (r < I_GATE) { p0_transpose_item(KIN(18), DM, DM, Wgate_t, scr, r, lane, KIN(17), nullptr, 1 << 30, 0, 0, 1.f); continue; } r -= I_GATE;
            p0_transpose_item(KIN(19), PLE, DM, Wple_t, scr, r, lane, nullptr, nullptr, 0, 0, 0, 1.f);
        }
        const float* gain = KIN(4);
        for (int m = gw; m < M_ALL; m += NGW) {
            const float* xrow = (m < M_PROMPT) ? x_prompt + (size_t)m * DM : x_sample + (size_t)(m - M_PROMPT) * DM;
            const f32x4* xr = (const f32x4*)xrow + lane;
            f32x4 v[4]; float s = 0.f;
#pragma unroll
            for (int j = 0; j < 4; ++j) { v[j] = xr[64 * j]; s += (v[j].x * v[j].x + v[j].y * v[j].y) + (v[j].z * v[j].z + v[j].w * v[j].w); }
            const float rs = __builtin_amdgcn_rsqf(wave_sum(s) * (1.f / DM) + 1e-6f);
            unsigned long long* o8 = (unsigned long long*)(XNO + (size_t)m * DM) + lane;
#pragma unroll
            for (int j = 0; j < 4; ++j) { const f32x4 g = ((const f32x4*)gain)[lane + 64 * j];
                o8[64 * j] = (unsigned long long)pk2(v[j].x * rs * g.x, v[j].y * rs * g.y) | ((unsigned long long)pk2(v[j].z * rs * g.z, v[j].w * rs * g.w) << 32); }
            const float* prow = (m < M_PROMPT) ? p_prompt + (size_t)m * PLE : p_sample + (size_t)(m - M_PROMPT) * PLE;
            const f32x4 pv = ((const f32x4*)prow)[lane];
            ((unsigned long long*)(PB + (size_t)m * PLE))[lane] = (unsigned long long)pk2(pv.x, pv.y) | ((unsigned long long)pk2(pv.z, pv.w) << 32);
        }
        for (int e = bx * (NWAVES * 64) + tid; e < M_ALL; e += G * NWAVES * 64) { ssq2[e] = 0.f; ssq3[e] = 0.f; ssq4[e] = 0.f; ssqA[e] = 0.f; ssqB[e] = 0.f; }
        for (int e = bx * (NWAVES * 64) + tid; e < 1024; e += G * NWAVES * 64) { const int pos = e >> 4, i = e & 15;
            const float freq = exp2f(-(float)i * (13.287712379549449f / 16.0f)); float s, c; sincos_cw((float)pos * freq, s, c); rope[e] = c; rope[1024 + e] = s; }
    }
    grid.sync();

    {
        PHASE_PTRS(); bf16* const Win_t = (bf16*)(ws + WS_WIN);
        pg8::Gemm g{XNO, Win_t, M_ALL, NPROJ, DM}; pg8::StaticOrder S; S.init(M_ALL, NPROJ, G, bx);
        pg8::EpiBf16Rs E{PROJ, NPROJ, nullptr};
        pg8::gemm_phase<pg8::EpiBf16Rs, pg8::StaticOrder, true, true>(L, g, S, E);
    }
    {
        PHASE_PTRS(); bf16* const PB = (bf16*)(ws + WS_PB); bf16* const Wple_t = (bf16*)(ws + WS_WPLE); bf16* const EB = (bf16*)(ws + WS_E);
        pg8::Gemm g{PB, Wple_t, M_ALL, DM, PLE}; pg8::StaticOrder S; S.init(M_ALL, DM, G, bx);
        pg8::EpiBf16Rs E{EB, DM, nullptr};
        pg8::gemm_phase<pg8::EpiBf16Rs, pg8::StaticOrder, true, true>(L, g, S, E);
    }
    grid.sync();

    {
        PHASE_PTRS();
        const float* qn = KIN(6); const float* kn = KIN(7);
        const int a = lane & 7;
        const long NIT = (long)M_ALL * 10 / 8;
        for (long it = gw; it < NIT; it += NGW) {
            const long item = it * 8 + (lane >> 3); const int m = (int)(item / 10), j = (int)(item % 10);
            const int t = (m < M_PROMPT) ? (m & (S_PROMPT - 1)) : (m & (S_SAMPLE - 1));
            bf16* p = PROJ + (size_t)m * NPROJ + j * 64 + a * 8;
            const v4u raw = *(const v4u*)p;
            float v[8] = {bflo(raw.x), bfhi(raw.x), bflo(raw.y), bfhi(raw.y), bflo(raw.z), bfhi(raw.z), bflo(raw.w), bfhi(raw.w)};
            float ss = 0.f;
#pragma unroll
            for (int i = 0; i < 8; ++i) ss += v[i] * v[i];
            ss += __shfl_xor(ss, 1); ss += __shfl_xor(ss, 2); ss += __shfl_xor(ss, 4);
            const float rs = __builtin_amdgcn_rsqf(ss * (1.f / 64.f) + 1e-6f);
            const float* gn = (j < 8 ? qn : kn) + a * 8;
            const int pos = (a < 4) ? (t >> 6) : (t & 63);
            const float* ct = rope + pos * 16 + (a & 1) * 8;
            const float sc = (j < 8) ? C2 : 1.0f;
            float o[8];
#pragma unroll
            for (int i = 0; i < 8; ++i) { const float y = v[i] * rs * gn[i]; const float py = __shfl_xor(y, 2); const float cs = ct[i], sn = ct[1024 + i];
                o[i] = ((a & 2) == 0 ? y * cs - py * sn : y * cs + py * sn) * sc; }
            v4u w; w.x = pk2(o[0], o[1]); w.y = pk2(o[2], o[3]); w.z = pk2(o[4], o[5]); w.w = pk2(o[6], o[7]);
            *(v4u*)p = w;
        }
    }
    grid.sync();

    {
        PHASE_PTRS();
        const attn_body::bf16* Q = (const attn_body::bf16*)PROJ; const attn_body::bf16* K = Q + 512; const attn_body::bf16* V = Q + 640; attn_body::bf16* Ob = (attn_body::bf16*)XNO;
        for (int pair = vcu; pair < 256; pair += G) { const int b = pair >> 3, h = pair & 7;
            for (int qb = 0; qb < 8; ++qb) attn_body::attn_unit<8>((long)b * S_PROMPT, S_PROMPT / 64, h, h >> 2, qb, Q, K, V, Ob, ssqA, (char*)lds); }
        for (int su = vcu; su < 256; su += G) { const int pair = su >> 3, b = pair >> 3, h = pair & 7;
            for (int k = 0; k < 2; ++k) attn_body::attn_unit<8>((long)M_PROMPT + (long)b * S_SAMPLE, S_SAMPLE / 64, h, h >> 2, (su & 7) * 2 + k, Q, K, V, Ob, ssqA, (char*)lds); }
        __syncthreads();
        LAS float* Tb = (LAS float*)(L + NA_T_OFF + wave * NA_T_BYTES);
        LAS float* wsf = (LAS float*)(L + NA_WSF_OFF + wave * 256);
        for (int e = lane; e < na_body::T_FLOATS; e += 64) Tb[e] = 0.f;
        { const float* rpb = KIN(8) + wave * 15 * 31;
          for (int e = lane; e < 15 * 31; e += 64) { const int dr = e / 31, dc = e % 31; Tb[na_body::T_GUARD + dr * 32 + dc] = rpb[e] * LOG2E; } }
        LAS unsigned char* wl = L + wave * 16384;
        const unsigned wl_addr = (unsigned)(uintptr_t)(lds + wave * 16384);
        for (int bu = vcu; bu < 1280; bu += G) {
            long rowbase; int rows, r;
            if (bu < 1024) { rowbase = (long)(bu >> 5) * S_PROMPT; rows = 32; r = bu & 31; } else { const int s = bu - 1024; rowbase = (long)M_PROMPT + (long)(s >> 6) * S_SAMPLE; rows = 64; r = s & 63; }
            na_body::na_unit(PROJ, XNO, rowbase, rows, r, wave, wl, wl_addr, Tb + na_body::T_GUARD, wsf, ssqB);
        }
    }
    grid.sync();

    {
        PHASE_PTRS(); bf16* const Wout_t = (bf16*)(ws + WS_WOUT); bf16* const H1B = (bf16*)(ws + WS_H1B); const float* const x_prompt = KIN(0); const float* const x_sample = KIN(1);
        pg8::Gemm g{XNO, Wout_t, M_ALL, DM, DM}; pg8::StaticOrder S; S.init(M_ALL, DM, G, bx);
        pg8::EpiOutProj E{x_prompt, x_sample, M_PROMPT, H1B, ssq2, ssqA, ssqB};
        pg8::gemm_phase<pg8::EpiOutProj, pg8::StaticOrder, true, true>(L, g, S, E);
    }
    grid.sync();

    {
        PHASE_PTRS(); bf16* const Wup_t = (bf16*)(ws + WS_WUP); bf16* const H1B = (bf16*)(ws + WS_H1B); bf16* const ACT = (bf16*)(ws + WS_ACT);
        constexpr int NM_UP = (M_ALL + 253) / 254;
        pg8::Gemm g{H1B - DM, Wup_t, NM_UP * 256, NUP, DM, (size_t)254 * DM * 2}; pg8::StaticOrder S; S.init(NM_UP * 256, NUP, G, bx);
        pg8::EpiConvGate E{ACT, ssq2, KIN(14), KIN(15), M_ALL, DFF};
        pg8::gemm_phase<pg8::EpiConvGate, pg8::StaticOrder, true, true>(L, g, S, E);
    }
    grid.sync();

    {
        PHASE_PTRS(); bf16* const ACT = (bf16*)(ws + WS_ACT); bf16* const Wdown_t = (bf16*)(ws + WS_WDOWN); bf16* const H2B = (bf16*)(ws + WS_H2B); bf16* const H1B = (bf16*)(ws + WS_H1B);
        pg8::Gemm g{ACT, Wdown_t, M_ALL, DM, DFF}; pg8::StaticOrder S; S.init(M_ALL, DM, G, bx);
        pg8::EpiResB E{H1B, H2B, ssq3};
        pg8::gemm_phase<pg8::EpiResB, pg8::StaticOrder, true, true>(L, g, S, E);
    }
    grid.sync();

    {
        PHASE_PTRS(); bf16* const H2B = (bf16*)(ws + WS_H2B); bf16* const Wgate_t = (bf16*)(ws + WS_WGATE); bf16* const EB = (bf16*)(ws + WS_E); bf16* const H3B = (bf16*)(ws + WS_H3B);
        pg8::Gemm g{H2B, Wgate_t, M_ALL, DM, DM}; pg8::StaticOrder S; S.init(M_ALL, DM, G, bx);
        pg8::EpiGate E{H2B, EB, H3B, ssq3, ssq4};
        pg8::gemm_phase<pg8::EpiGate, pg8::StaticOrder, true, true>(L, g, S, E);
    }
    grid.sync();

    {
        PHASE_PTRS();
        const f32x4* fg = (const f32x4*)KIN(20) + lane;
        const f32x4 g0 = fg[0], g1 = fg[64], g2 = fg[128], g3 = fg[192];
        const bf16* const H3B = (const bf16*)(ws + WS_H3B);
        for (int m = gw; m < M_ALL; m += NGW) {
            f32x4* xr = (f32x4*)(out + (size_t)m * DM) + lane;
            const v2u* hr = (const v2u*)(H3B + (size_t)m * DM) + lane;
            const v2u h0 = hr[0], h1 = hr[64], h2 = hr[128], h3 = hr[192];
            const float rs = __builtin_amdgcn_rsqf(ssq4[m] * (1.f / DM) + 1e-6f);
            xr[0] = (f32x4){bflo(h0.x), bfhi(h0.x), bflo(h0.y), bfhi(h0.y)} * rs * g0; xr[64] = (f32x4){bflo(h1.x), bfhi(h1.x), bflo(h1.y), bfhi(h1.y)} * rs * g1;
            xr[128] = (f32x4){bflo(h2.x), bfhi(h2.x), bflo(h2.y), bfhi(h2.y)} * rs * g2; xr[192] = (f32x4){bflo(h3.x), bfhi(h3.x), bflo(h3.y), bfhi(h3.y)} * rs * g3;
        }
    }
}

extern "C" void kernel_launch(void* const* d_in, const int* in_sizes, int n_in, void* d_out, int out_size, void* d_ws, size_t ws_size, hipStream_t stream) {
    static int grid = 0;
    if (grid == 0) {
        if (n_in != 21 || in_sizes[0] != M_PROMPT * DM || out_size != M_ALL * DM || ws_size < WS_END) { fprintf(stderr, "kernel_launch: unexpected shapes (n_in %d, in0 %d, out %d, ws %zu); nothing launched\n", n_in, n_in > 0 ? in_sizes[0] : -1, out_size, ws_size); grid = -1; return; }
        int dev = 0, cus = 0, per_cu = 0;
        if (hipGetDevice(&dev) != hipSuccess || hipDeviceGetAttribute(&cus, hipDeviceAttributeMultiprocessorCount, dev) != hipSuccess) { grid = -1; return; }
        if (hipFuncSetAttribute((const void*)hymba_fwd, hipFuncAttributeMaxDynamicSharedMemorySize, LDS_BYTES) != hipSuccess) { fprintf(stderr, "kernel_launch: hipFuncSetAttribute failed\n"); grid = -1; return; }
        if (hipOccupancyMaxActiveBlocksPerMultiprocessor(&per_cu, (const void*)hymba_fwd, NWAVES * 64, LDS_BYTES) != hipSuccess || per_cu < 1) { fprintf(stderr, "kernel_launch: occupancy query says %d blocks per CU\n", per_cu); (void)hipGetLastError(); }
        grid = cus;
    }
    if (grid < 0) return;
    Args a{};
    for (int i = 0; i < 21; ++i) a.in[i] = (const float*)d_in[i];
    a.out = (float*)d_out; a.ws = (unsigned char*)d_ws;
    void* kargs[] = {&a};
    const hipError_t e = hipLaunchCooperativeKernel((const void*)hymba_fwd, dim3(grid), dim3(NWAVES * 64), kargs, LDS_BYTES, stream);
    if (e != hipSuccess) fprintf(stderr, "kernel_launch: cooperative launch failed: %s (grid %d)\n", hipGetErrorString(e), grid);
}
```

```cpp
#include <hip/hip_cooperative_groups.h>
#include <hip/hip_runtime.h>
#include <cstdio>
#include <cstdint>
namespace pg8 {
#define PG8_LAS __attribute__((address_space(3)))
typedef unsigned short bf16_t;
typedef short bf16x8 __attribute__((ext_vector_type(8)));
typedef float f32x4 __attribute__((ext_vector_type(4)));
typedef unsigned u32x4 __attribute__((ext_vector_type(4)));
constexpr int BM = 256, BK = 64, HALF = 128, HTB = HALF * BK * 2  , STAGE_BYTES = 8 * HTB, NXCD = 8, WGM = 8;

__host__ __device__ __forceinline__ int lds_byte(int r, int c) { const int st = (r >> 4) * 2 + (c >> 5), rr = r & 15, cc = c & 31, ob = rr * 64 + cc * 2; return st * 1024 + (ob ^ (((ob >> 9) & 1) << 5)); }
__host__ __device__ __forceinline__ void stage_rc(int b, int& R, int& C) { const int st = b / 1024, sb = b % 1024, swz = sb ^ (((sb >> 9) & 1) << 5); R = (st >> 1) * 16 + swz / 64; C = (st & 1) * 32 + (swz % 64) / 2; }
__host__ __device__ __forceinline__ int perm32(int rho) { const int n = rho >> 4, i = rho & 15; return 8 * (i >> 2) + 4 * n + (i & 3); }

struct Unit { int pm, pn; };
struct Gemm { const bf16_t* A; const bf16_t* Bt; int M, N, K; size_t a_tstep; };

struct StaticOrder {
    int nM, nN, nwg, G, c;
    __host__ __device__ void init(int M, int N, int G_, int c_) { nM = M / BM; nN = N / BM; nwg = nM * nN; G = G_; c = c_; }
    __host__ __device__ bool next(int i, Unit& u) const {
        const long L = (long)i * G + c; if (L >= nwg) return false;
        int wgid = (int)L; { const int q = nwg / NXCD, r = nwg % NXCD, xcd = wgid % NXCD, off = wgid / NXCD; wgid = (xcd < r ? xcd * (q + 1) : r * (q + 1) + (xcd - r) * q) + off; }
        const int nig = WGM * nN, gid = wgid / nig, fm = gid * WGM, gsz = (nM - fm) < WGM ? (nM - fm) : WGM;
        u.pm = fm + ((wgid % nig) % gsz); u.pn = (wgid % nig) / gsz; return true;
    }
    __device__ __forceinline__ void a_ready(const Unit&) const {}
    __device__ __forceinline__ void done(const Unit&) const {}
};

__device__ __forceinline__ unsigned cvt_pk_bf16(float lo, float hi) { unsigned r; asm volatile("v_cvt_pk_bf16_f32 %0, %1, %2" : "=v"(r) : "v"(lo), "v"(hi)); return r; }
typedef float f32x2 __attribute__((ext_vector_type(2)));
__device__ __forceinline__ f32x2 gelu_pk(f32x2 v) {
    const f32x2 av = __builtin_elementwise_abs(v), d = av * 0.2316418882f + 1.0f;
    f32x2 t; t.x = __builtin_amdgcn_rcpf(d.x); t.y = __builtin_amdgcn_rcpf(d.y);
    f32x2 q = t * 0.5307027145f + (-0.7265760135f); q = q * t + 0.7107068705f; q = q * t + (-0.142248368f); q = q * t + 0.127414796f; q = q * t;
    const f32x2 s = (v * v) * (-0.72134752044f);
    f32x2 e; e.x = __builtin_amdgcn_exp2f(s.x); e.y = __builtin_amdgcn_exp2f(s.y);
    const f32x2 m = v * (q * e), r = v - m;
    f32x2 o; o.x = v.x < 0.f ? m.x : r.x; o.y = v.y < 0.f ? m.y : r.y; return o;
}

template <int ACT  > struct EpiBf16 {
    static constexpr bool PERM = true, AFTER_DRAIN = false, MIDSCALE = false, FULL = false; static_assert(ACT == 0 || ACT == 1, "EpiBf16: ACT is 0 (none) or 1 (gelu_pk)");
    bf16_t* O; int ldc; const float* bias; int split_cols; size_t split_stride; float scale0;
    __device__ __forceinline__ void operator()(const f32x4 (&acc)[2][2][4][2], const Unit& u, int wr, int wc, int fr, int fq) const {
        const int row0 = u.pm * BM + wr * 64 + fr; int colt = u.pn * BM; bf16_t* base = O;
        float sc = 1.f; if (split_cols) { const int t = colt / split_cols; base += (size_t)t * split_stride; colt -= t * split_cols; if (t == 0) sc = scale0; }
        const int col0 = colt + wc * 32 + 8 * fq, bcol0 = u.pn * BM + wc * 32 + 8 * fq;
        f32x4 bv[2][2];
#pragma unroll
        for (int bj = 0; bj < 2; ++bj)
#pragma unroll
            for (int n = 0; n < 2; ++n) bv[bj][n] = bias ? *(const f32x4*)(bias + bcol0 + bj * HALF + 4 * n) : (f32x4){0.f, 0.f, 0.f, 0.f};
#pragma unroll
        for (int ai = 0; ai < 2; ++ai)
#pragma unroll
            for (int m = 0; m < 4; ++m) { bf16_t* rowp = base + (size_t)(row0 + ai * HALF + m * 16) * ldc + col0;
#pragma unroll
                for (int bj = 0; bj < 2; ++bj) { f32x4 v0 = acc[ai][bj][m][0] + bv[bj][0], v1 = acc[ai][bj][m][1] + bv[bj][1];
                    if (ACT == 1) { f32x2 a = gelu_pk((f32x2){v0[0], v0[1]}), b = gelu_pk((f32x2){v0[2], v0[3]}), c = gelu_pk((f32x2){v1[0], v1[1]}), d = gelu_pk((f32x2){v1[2], v1[3]});
                        v0 = (f32x4){a.x, a.y, b.x, b.y}; v1 = (f32x4){c.x, c.y, d.x, d.y}; }
                    v0 = v0 * sc; v1 = v1 * sc; u32x4 w; w.x = cvt_pk_bf16(v0[0], v0[1]); w.y = cvt_pk_bf16(v0[2], v0[3]); w.z = cvt_pk_bf16(v1[0], v1[1]); w.w = cvt_pk_bf16(v1[2], v1[3]);
                    *(u32x4*)(rowp + bj * HALF) = w; } }
    }
};
constexpr float RMS_EPS = 1e-6f;
typedef unsigned u32x2 __attribute__((ext_vector_type(2)));
__device__ __forceinline__ float f32_atomic_add(float* p, float v) { return __hip_atomic_fetch_add(p, v, __ATOMIC_RELAXED, __HIP_MEMORY_SCOPE_AGENT); }
__device__ __forceinline__ float bf_lo(unsigned w) { return __uint_as_float(w << 16); }
__device__ __forceinline__ float bf_hi(unsigned w) { return __uint_as_float(w & 0xffff0000u); }
__device__ __forceinline__ float sumsq8(const f32x4& v0, const f32x4& v1) { return (v0[0] * v0[0] + v0[1] * v0[1]) + (v0[2] * v0[2] + v0[3] * v0[3]) + (v1[0] * v1[0] + v1[1] * v1[1]) + (v1[2] * v1[2] + v1[3] * v1[3]); }
__device__ __forceinline__ u32x4 pack8(const f32x4& v0, const f32x4& v1) { u32x4 w; w.x = cvt_pk_bf16(v0[0], v0[1]); w.y = cvt_pk_bf16(v0[2], v0[3]); w.z = cvt_pk_bf16(v1[0], v1[1]); w.w = cvt_pk_bf16(v1[2], v1[3]); return w; }
struct EpiBf16Rs {
    static constexpr bool PERM = true, AFTER_DRAIN = false, MIDSCALE = false, FULL = false;
    bf16_t* O; int ldc; const float* ssq;
    __device__ __forceinline__ void operator()(const f32x4 (&acc)[2][2][4][2], const Unit& u, int wr, int wc, int fr, int fq) const {
        const int row0 = u.pm * BM + wr * 64 + fr, col0 = u.pn * BM + wc * 32 + 8 * fq;
#pragma unroll
        for (int ai = 0; ai < 2; ++ai)
#pragma unroll
            for (int m = 0; m < 4; ++m) { const int row = row0 + ai * HALF + m * 16; bf16_t* rowp = O + (size_t)row * ldc + col0;
                const float rs = ssq ? __builtin_amdgcn_rsqf(ssq[row] * (1.0f / 1024.0f) + RMS_EPS) : 1.0f;
#pragma unroll
                for (int bj = 0; bj < 2; ++bj) *(u32x4*)(rowp + bj * HALF) = pack8(acc[ai][bj][m][0] * rs, acc[ai][bj][m][1] * rs); }
    }
};
struct EpiOutProj {
    static constexpr bool PERM = true, AFTER_DRAIN = false, MIDSCALE = true, FULL = false;
    const float* base0; const float* base1; int split;
    bf16_t* hb; float* ssq; const float* ssqA; const float* ssqB;
    __device__ __forceinline__ void prep(PG8_LAS unsigned char* lds, int tid, const Unit& u, int wr, int fr) const {
        const int row0 = u.pm * BM + wr * 64 + fr; PG8_LAS f32x4* slot = (PG8_LAS f32x4*)(lds + STAGE_BYTES) + tid * 2;
#pragma unroll
        for (int ai = 0; ai < 2; ++ai) { f32x4 q;
#pragma unroll
            for (int m = 0; m < 4; ++m) { const int row = row0 + ai * HALF + m * 16;
                q[m] = __builtin_amdgcn_rsqf(ssqA[row] * (1.0f / 512.0f) + RMS_EPS) * __builtin_amdgcn_sqrtf(ssqB[row] * (1.0f / 512.0f) + RMS_EPS); }
            slot[ai] = q; }
    }
    __device__ __forceinline__ void midscale(f32x4 (&acc)[2][2][4][2], PG8_LAS unsigned char* lds, int tid) const {
        const PG8_LAS f32x4* slot = (const PG8_LAS f32x4*)(lds + STAGE_BYTES) + tid * 2;
#pragma unroll
        for (int ai = 0; ai < 2; ++ai) { const f32x4 q = slot[ai];
#pragma unroll
            for (int bj = 0; bj < 2; ++bj)
#pragma unroll
                for (int m = 0; m < 4; ++m)
#pragma unroll
                    for (int n = 0; n < 2; ++n) acc[ai][bj][m][n] *= q[m]; }
    }
    __device__ __forceinline__ void operator()(const f32x4 (&acc)[2][2][4][2], const Unit& u, int wr, int wc, int fr, int fq) const {
        const int row0 = u.pm * BM + wr * 64 + fr, col0 = u.pn * BM + wc * 32 + 8 * fq;
#pragma unroll
        for (int ai = 0; ai < 2; ++ai)
#pragma unroll
            for (int m = 0; m < 4; ++m) { const int row = row0 + ai * HALF + m * 16;
                const float* bp = (row < split ? base0 + (size_t)row * 1024 : base1 + (size_t)(row - split) * 1024) + col0;
                bf16_t* hp = hb + (size_t)row * 1024 + col0; float s = 0.f;
                const float rb = __builtin_amdgcn_rsqf(ssqB[row] * (1.0f / 512.0f) + RMS_EPS);
#pragma unroll
                for (int bj = 0; bj < 2; ++bj) { const f32x4 b0 = *(const f32x4*)(bp + bj * HALF), b1 = *(const f32x4*)(bp + bj * HALF + 4);
                    const f32x4 v0 = acc[ai][bj][m][0] * rb + b0, v1 = acc[ai][bj][m][1] * rb + b1;
                    *(u32x4*)(hp + bj * HALF) = pack8(v0, v1); s += sumsq8(v0, v1); }
                s += __shfl_xor(s, 16); s += __shfl_xor(s, 32);
                if (fq == 0) f32_atomic_add(ssq + row, s); }
    }
};
struct EpiResB {
    static constexpr bool PERM = true, AFTER_DRAIN = false, MIDSCALE = false, FULL = false;
    const bf16_t* hin; bf16_t* hout; float* ssq;
    __device__ __forceinline__ void operator()(const f32x4 (&acc)[2][2][4][2], const Unit& u, int wr, int wc, int fr, int fq) const {
        const int row0 = u.pm * BM + wr * 64 + fr, col0 = u.pn * BM + wc * 32 + 8 * fq;
#pragma unroll
        for (int ai = 0; ai < 2; ++ai)
#pragma unroll
            for (int m = 0; m < 4; ++m) { const int row = row0 + ai * HALF + m * 16;
                const bf16_t* bp = hin + (size_t)row * 1024 + col0; bf16_t* hp = hout + (size_t)row * 1024 + col0; float s = 0.f;
#pragma unroll
                for (int bj = 0; bj < 2; ++bj) { const u32x4 bw = *(const u32x4*)(bp + bj * HALF);
                    const f32x4 v0 = acc[ai][bj][m][0] + (f32x4){bf_lo(bw.x), bf_hi(bw.x), bf_lo(bw.y), bf_hi(bw.y)}, v1 = acc[ai][bj][m][1] + (f32x4){bf_lo(bw.z), bf_hi(bw.z), bf_lo(bw.w), bf_hi(bw.w)};
                    *(u32x4*)(hp + bj * HALF) = pack8(v0, v1); s += sumsq8(v0, v1); }
                s += __shfl_xor(s, 16); s += __shfl_xor(s, 32);
                if (fq == 0) f32_atomic_add(ssq + row, s); }
    }
};
struct EpiGate {
    static constexpr bool PERM = true, AFTER_DRAIN = false, MIDSCALE = false, FULL = false;
    const bf16_t* hin; const bf16_t* E; bf16_t* hout; const float* ssq_in; float* ssq_out;
    __device__ __forceinline__ void operator()(const f32x4 (&acc)[2][2][4][2], const Unit& u, int wr, int wc, int fr, int fq) const {
        const int row0 = u.pm * BM + wr * 64 + fr, col0 = u.pn * BM + wc * 32 + 8 * fq;
#pragma unroll
        for (int ai = 0; ai < 2; ++ai)
#pragma unroll
            for (int m = 0; m < 4; ++m) { const int row = row0 + ai * HALF + m * 16;
                const bf16_t* bp = hin + (size_t)row * 1024 + col0; const bf16_t* ep = E + (size_t)row * 1024 + col0; bf16_t* hp = hout + (size_t)row * 1024 + col0; float s = 0.f;
                const float rs = __builtin_amdgcn_rsqf(ssq_in[row] * (1.0f / 1024.0f) + RMS_EPS) * -1.4426950408889634f;
#pragma unroll
                for (int bj = 0; bj < 2; ++bj) { const u32x4 bw = *(const u32x4*)(bp + bj * HALF), ew = *(const u32x4*)(ep + bj * HALF);
                    const f32x4 b0 = (f32x4){bf_lo(bw.x), bf_hi(bw.x), bf_lo(bw.y), bf_hi(bw.y)}, b1 = (f32x4){bf_lo(bw.z), bf_hi(bw.z), bf_lo(bw.w), bf_hi(bw.w)};
                    const f32x4 e0 = (f32x4){bf_lo(ew.x), bf_hi(ew.x), bf_lo(ew.y), bf_hi(ew.y)}, e1 = (f32x4){bf_lo(ew.z), bf_hi(ew.z), bf_lo(ew.w), bf_hi(ew.w)};
                    f32x4 v0, v1;
#pragma unroll
                    for (int k = 0; k < 4; ++k) { const float g0 = __builtin_amdgcn_rcpf(1.0f + __builtin_amdgcn_exp2f(acc[ai][bj][m][0][k] * rs)), g1 = __builtin_amdgcn_rcpf(1.0f + __builtin_amdgcn_exp2f(acc[ai][bj][m][1][k] * rs));
                        v0[k] = b0[k] + g0 * e0[k]; v1[k] = b1[k] + g1 * e1[k]; }
                    *(u32x4*)(hp + bj * HALF) = pack8(v0, v1); s += sumsq8(v0, v1); }
                s += __shfl_xor(s, 16); s += __shfl_xor(s, 32);
                if (fq == 0) f32_atomic_add(ssq_out + row, s); }
    }
};

#define PG8_DPPF(oldv, srcv, ctrl, bc) __builtin_bit_cast(float, __builtin_amdgcn_update_dpp(__builtin_bit_cast(int, (float)(oldv)), __builtin_bit_cast(int, (float)(srcv)), (ctrl), 0xf, 0xf, (bc)))
struct EpiConvGate {
    static constexpr bool PERM = true, AFTER_DRAIN = false, MIDSCALE = false, FULL = true;
    bf16_t* ACT; const float* ssq; const float* cw; const float* cb; int Mrows; int dff;
    template <bool MASKED> __device__ __forceinline__ void conv(const f32x4 (&acc)[2][2][4][2], const PG8_LAS float* X, int wr, int rbase, int gbase, int col, int cbase, unsigned voff) const {
#pragma unroll
        for (int n = 0; n < 2; ++n) {
            f32x4 w[2][4];
#pragma unroll
            for (int bj = 0; bj < 2; ++bj) {
#pragma unroll
                for (int k = 0; k < 3; ++k) w[bj][k] = *(const f32x4*)((const char*)(cw + (size_t)k * 2 * dff + bj * dff + 4 * n) + voff);
                w[bj][3] = *(const f32x4*)((const char*)(cb + bj * dff + 4 * n) + voff); }
#pragma unroll
            for (int ai = 0; ai < 2; ++ai) { const int sg = 2 * ai + wr; const int slotP = (sg > 0) ? (sg - 1) * 2 + 1 : 8, slotN = (sg < 3) ? (sg + 1) * 2 : 8;
                f32x4 saved[2], haloN[2];
#pragma unroll
                for (int bj = 0; bj < 2; ++bj) { saved[bj] = *(const PG8_LAS f32x4*)(X + slotP * 256 + bj * HALF + col + 4 * n); haloN[bj] = *(const PG8_LAS f32x4*)(X + slotN * 256 + bj * HALF + col + 4 * n); }
#pragma unroll
                for (int m = 0; m < 4; ++m) { const int r = rbase + ai * HALF + m * 16, g = gbase + r;
                    float hp = 1.f, hn = 1.f;
                    if constexpr (MASKED) { const int S = (g < 65536) ? 2048 : 4096; const int t = g & (S - 1); hp = (t != 0) ? 1.f : 0.f; hn = (t != S - 1) ? 1.f : 0.f; }
                    f32x4 y[2];
#pragma unroll
                    for (int bj = 0; bj < 2; ++bj) { const f32x4 cur = acc[ai][bj][m][n]; const f32x4 nx = (m < 3) ? acc[ai][bj][m < 3 ? m + 1 : 3][n] : haloN[bj];
#pragma unroll
                        for (int i = 0; i < 4; ++i) {
                            float pin = PG8_DPPF(PG8_DPPF(0.f, saved[bj][i], 0x121, true), cur[i], 0x111, false);
                            float nin = PG8_DPPF(PG8_DPPF(0.f, nx[i], 0x12f, true), cur[i], 0x101, false);
                            if constexpr (MASKED) { pin *= hp; nin *= hn; }
                            y[bj][i] = (w[bj][1][i] * cur[i] + w[bj][3][i]) + (w[bj][0][i] * pin + w[bj][2][i] * nin); }
                        saved[bj] = cur; }
                    float o[4];
#pragma unroll
                    for (int i = 0; i < 4; ++i) { const float a = y[0][i], gg = y[1][i];
                        const float z = -2.302208198f * (gg + 0.044715f * gg * gg * gg);
                        o[i] = a * gg * __builtin_amdgcn_rcpf(1.0f + __builtin_amdgcn_exp2f(z)); }
                    u32x2 pk; pk.x = cvt_pk_bf16(o[0], o[1]); pk.y = cvt_pk_bf16(o[2], o[3]);
                    if (r >= 1 && r <= 254 && g < Mrows) *(u32x2*)(ACT + (size_t)g * dff + cbase + 4 * n) = pk;
                    __builtin_amdgcn_sched_barrier(0); } } }
    }
    __device__ __forceinline__ void full(f32x4 (&acc)[2][2][4][2], const Unit& u, int wr_, int wc_, int fr_, int fq_, PG8_LAS unsigned char* lds, int tid_) const {
        int tid = tid_; asm volatile("" : "+v"(tid));
        const int wid = __builtin_amdgcn_readfirstlane(tid >> 6), lane = tid & 63, wr = wid >> 2, wc = wid & 3, fr = lane & 15, fq = lane >> 4; (void)wr_; (void)wc_; (void)fr_; (void)fq_;
        const int gbase = u.pm * 254 - 1, rbase = wr * 64 + fr, col = wc * 32 + 8 * fq, cbase = u.pn * HALF + col;
        const unsigned voff = (unsigned)cbase * 4u;
        PG8_LAS float* X = (PG8_LAS float*)(lds + STAGE_BYTES);
#pragma unroll
        for (int ai = 0; ai < 2; ++ai)
#pragma unroll
            for (int m = 0; m < 4; ++m) { const int g = gbase + rbase + ai * HALF + m * 16; const int gc = g < 0 ? 0 : (g >= Mrows ? Mrows - 1 : g);
                const float rs = __builtin_amdgcn_rsqf(ssq[gc] * (1.0f / 1024.0f) + RMS_EPS);
#pragma unroll
                for (int bj = 0; bj < 2; ++bj)
#pragma unroll
                    for (int n = 0; n < 2; ++n) { acc[ai][bj][m][n] *= rs; asm volatile("" : "+v"(acc[ai][bj][m][n])); }
                __builtin_amdgcn_sched_barrier(0); }
        if (tid < 64) *(PG8_LAS f32x4*)(X + 8 * 256 + tid * 4) = (f32x4){0.f, 0.f, 0.f, 0.f};
        if (fr == 0) {
#pragma unroll
            for (int ai = 0; ai < 2; ++ai)
#pragma unroll
                for (int bj = 0; bj < 2; ++bj)
#pragma unroll
                    for (int n = 0; n < 2; ++n) *(PG8_LAS f32x4*)(X + ((2 * ai + wr) * 2 + 0) * 256 + bj * HALF + col + 4 * n) = acc[ai][bj][0][n]; }
        if (fr == 15) {
#pragma unroll
            for (int ai = 0; ai < 2; ++ai)
#pragma unroll
                for (int bj = 0; bj < 2; ++bj)
#pragma unroll
                    for (int n = 0; n < 2; ++n) *(PG8_LAS f32x4*)(X + ((2 * ai + wr) * 2 + 1) * 256 + bj * HALF + col + 4 * n) = acc[ai][bj][3][n]; }
        asm volatile("s_waitcnt lgkmcnt(0)" ::: "memory"); __builtin_amdgcn_s_barrier(); asm volatile("" ::: "memory");
        const bool boundary = ((gbase + 256) >> 11) != (gbase >> 11);
        (void)boundary; conv<true>(acc, X, wr, rbase, gbase, col, cbase, voff);
    }
};

template <class Epi, class Sched, bool ALIGN_EPI = false, bool SP2 = false>
__device__ __forceinline__ void gemm_phase(PG8_LAS unsigned char* lds, const Gemm g, const Sched& S, const Epi& E) {
    int tid = threadIdx.x; asm volatile("" : "+v"(tid));
    const int wid = __builtin_amdgcn_readfirstlane(tid >> 6), lane = tid & 63, wr = wid >> 2, wc = wid & 3, fr = lane & 15, fq = lane >> 4;
    const int K = g.K, nt = K / BK;
    unsigned voffA[2], voffB[2];
#pragma unroll
    for (int i = 0; i < 2; ++i) { int R, C; stage_rc(tid * 16 + i * 8192, R, C); const int Rb = Epi::PERM ? ((R & ~31) + perm32(R & 31)) : R;
        voffA[i] = (unsigned)(R * K + C) * 2u; voffB[i] = (unsigned)(Rb * K + C) * 2u; }
    const size_t kstep = (size_t)(BK * 2);
    const size_t hstep = (size_t)HALF * K * 2;
    const size_t tstep = 2 * hstep;
    const size_t tstepA = g.a_tstep ? g.a_tstep : tstep;
    const unsigned ldsw = (unsigned)wid * 1024u;
    const int aoff = lds_byte(wr * 64 + fr, fq * 8), boff = lds_byte(wc * 32 + fr, fq * 8);
#define PG8_SA(b, h) (((b) * 2 + (h)) * HTB)
#define PG8_SB(b, h) ((4 + (b) * 2 + (h)) * HTB)
#define PG8_STAGE(bufoff, gbase, voff) do { _Pragma("unroll") for (int _i = 0; _i < 2; ++_i) \
        __builtin_amdgcn_global_load_lds((const unsigned*)((const char*)(gbase) + (voff)[_i]), (PG8_LAS unsigned*)(lds + (bufoff) + ldsw + _i * 8192), 16, 0, 0); } while (0)
#define PG8_LDA(dst, b, h) do { _Pragma("unroll") for (int m = 0; m < 4; ++m) _Pragma("unroll") for (int k = 0; k < 2; ++k) dst[m][k] = *(const PG8_LAS bf16x8*)(lds + PG8_SA(b, h) + aoff + m * 2048 + k * 1024); } while (0)
#define PG8_LDB(dst, b, h) do { _Pragma("unroll") for (int n = 0; n < 2; ++n) _Pragma("unroll") for (int k = 0; k < 2; ++k) dst[n][k] = *(const PG8_LAS bf16x8*)(lds + PG8_SB(b, h) + boff + n * 2048 + k * 1024); } while (0)
#define PG8_MMA(ai, bj, At, Bt) do { __builtin_amdgcn_s_setprio(1); _Pragma("unroll") for (int m = 0; m < 4; ++m) _Pragma("unroll") for (int n = 0; n < 2; ++n) _Pragma("unroll") for (int k = 0; k < 2; ++k) \
        acc[ai][bj][m][n] = __builtin_amdgcn_mfma_f32_16x16x32_bf16(Bt[n][k], At[m][k], acc[ai][bj][m][n], 0, 0, 0); __builtin_amdgcn_s_setprio(0); } while (0)
#define PG8_WAIT_V(n) asm volatile("s_waitcnt vmcnt(" #n ")" ::: "memory")
#define PG8_WAIT_L(n) asm volatile("s_waitcnt lgkmcnt(" #n ")" ::: "memory")
#define PG8_BAR __builtin_amdgcn_s_barrier()
#define PG8_SCHED __builtin_amdgcn_sched_barrier(0)
    Unit cur, nxt; int ui = 0;
    if (!S.next(0, cur)) return;
    f32x4 acc[2][2][4][2];
#pragma unroll
    for (int a = 0; a < 2; ++a)
#pragma unroll
        for (int b = 0; b < 2; ++b)
#pragma unroll
            for (int m = 0; m < 4; ++m)
#pragma unroll
                for (int n = 0; n < 2; ++n) acc[a][b][m][n] = (f32x4){0.f, 0.f, 0.f, 0.f};
    bf16x8 At[4][2], B0[2][2], B1[2][2];
    const char* cA = (const char*)g.A + (size_t)cur.pm * tstepA; const char* cB = (const char*)g.Bt + (size_t)cur.pn * tstep;
    S.a_ready(cur);
    if constexpr (Epi::MIDSCALE) E.prep(lds, tid, cur, wr, fr);
    if constexpr (SP2) {
        PG8_STAGE(PG8_SB(0, 0), cB, voffB); PG8_STAGE(PG8_SB(0, 1), cB + hstep, voffB); PG8_STAGE(PG8_SA(0, 0), cA, voffA); PG8_STAGE(PG8_SA(0, 1), cA + hstep, voffA);
        if (wr == 1) PG8_BAR;
        PG8_WAIT_V(2); PG8_BAR;
        PG8_STAGE(PG8_SB(1, 0), cB + kstep, voffB); PG8_STAGE(PG8_SA(1, 0), cA + kstep, voffA); PG8_STAGE(PG8_SB(1, 1), cB + hstep + kstep, voffB);
        PG8_WAIT_V(6); PG8_BAR;
    } else {
        PG8_STAGE(PG8_SB(0, 0), cB, voffB); PG8_STAGE(PG8_SA(0, 0), cA, voffA); PG8_STAGE(PG8_SB(0, 1), cB + hstep, voffB); PG8_STAGE(PG8_SA(0, 1), cA + hstep, voffA);
        if (wr == 1) PG8_BAR;
        PG8_WAIT_V(4); PG8_BAR;
        PG8_STAGE(PG8_SB(1, 0), cB + kstep, voffB); PG8_STAGE(PG8_SA(1, 0), cA + kstep, voffA); PG8_STAGE(PG8_SB(1, 1), cB + hstep + kstep, voffB);
        PG8_WAIT_V(6); PG8_BAR;
    }
    for (;;) {
        const bool has_next = S.next(ui + 1, nxt);
        const char* nA = has_next ? (const char*)g.A + (size_t)nxt.pm * tstepA : cA; const char* nB = has_next ? (const char*)g.Bt + (size_t)nxt.pn * tstep : cB;
        for (int t = 0; t < nt; t += 2) {
            if constexpr (Epi::MIDSCALE) { if (t == (nt >> 1)) E.midscale(acc, lds, tid); }
            const bool last = (t == nt - 2);
            const char* a1 = cA + (size_t)(t + 1) * kstep;
            const char* a2 = last ? nA : cA + (size_t)(t + 2) * kstep; const char* b2 = last ? nB : cB + (size_t)(t + 2) * kstep;
            const char* a3 = a2 + kstep; const char* b3 = b2 + kstep;
            if (last && has_next) S.a_ready(nxt);
            if constexpr (SP2) {
            PG8_LDB(B0, 0, 0); PG8_LDB(B1, 0, 1); PG8_SCHED; PG8_LDA(At, 0, 0); PG8_STAGE(PG8_SA(1, 1), a1 + hstep, voffA);
            PG8_WAIT_V(8); PG8_WAIT_L(0); PG8_BAR; PG8_MMA(0, 0, At, B0); PG8_MMA(0, 1, At, B1); PG8_BAR; PG8_SCHED;
            PG8_LDA(At, 0, 1); PG8_STAGE(PG8_SB(0, 0), b2, voffB); PG8_STAGE(PG8_SB(0, 1), b2 + hstep, voffB); PG8_STAGE(PG8_SA(0, 0), a2, voffA);
            PG8_WAIT_V(8); PG8_WAIT_L(0); PG8_BAR; PG8_MMA(1, 0, At, B0); PG8_MMA(1, 1, At, B1); PG8_BAR; PG8_SCHED;
            PG8_LDB(B0, 1, 0); PG8_LDB(B1, 1, 1); PG8_SCHED; PG8_LDA(At, 1, 0); PG8_STAGE(PG8_SA(0, 1), a2 + hstep, voffA);
            PG8_WAIT_V(8); PG8_WAIT_L(0); PG8_BAR; PG8_MMA(0, 0, At, B0); PG8_MMA(0, 1, At, B1); PG8_BAR; PG8_SCHED;
            PG8_LDA(At, 1, 1); PG8_STAGE(PG8_SB(1, 0), b3, voffB); PG8_STAGE(PG8_SB(1, 1), b3 + hstep, voffB); PG8_STAGE(PG8_SA(1, 0), a3, voffA);
            PG8_WAIT_V(8); PG8_WAIT_L(0); PG8_BAR; PG8_MMA(1, 0, At, B0); PG8_MMA(1, 1, At, B1); PG8_BAR; PG8_SCHED;
            } else {
            PG8_LDB(B0, 0, 0); PG8_SCHED; PG8_LDA(At, 0, 0); PG8_STAGE(PG8_SA(1, 1), a1 + hstep, voffA);
            PG8_WAIT_L(8); PG8_BAR; PG8_WAIT_L(0); PG8_MMA(0, 0, At, B0); PG8_BAR; PG8_SCHED;
            PG8_LDB(B1, 0, 1); PG8_STAGE(PG8_SB(0, 0), b2, voffB);
            PG8_BAR; PG8_WAIT_L(0); PG8_MMA(0, 1, At, B1); PG8_BAR;
            PG8_LDA(At, 0, 1); PG8_STAGE(PG8_SA(0, 0), a2, voffA);
            PG8_BAR; PG8_WAIT_L(0); PG8_MMA(1, 0, At, B0); PG8_BAR; PG8_SCHED;
            PG8_STAGE(PG8_SB(0, 1), b2 + hstep, voffB);
            PG8_WAIT_V(6); PG8_BAR; PG8_MMA(1, 1, At, B1); PG8_BAR;
            PG8_LDB(B0, 1, 0); PG8_SCHED; PG8_LDA(At, 1, 0); PG8_STAGE(PG8_SA(0, 1), a2 + hstep, voffA);
            PG8_WAIT_L(8); PG8_BAR; PG8_WAIT_L(0); PG8_MMA(0, 0, At, B0); PG8_BAR; PG8_SCHED;
            PG8_LDB(B1, 1, 1); PG8_STAGE(PG8_SB(1, 0), b3, voffB);
            PG8_BAR; PG8_WAIT_L(0); PG8_MMA(0, 1, At, B1); PG8_BAR;
            PG8_LDA(At, 1, 1); PG8_STAGE(PG8_SA(1, 0), a3, voffA);
            PG8_BAR; PG8_WAIT_L(0); PG8_MMA(1, 0, At, B0); PG8_BAR; PG8_SCHED;
            PG8_STAGE(PG8_SB(1, 1), b3 + hstep, voffB);
            PG8_WAIT_V(6); PG8_BAR; PG8_MMA(1, 1, At, B1); PG8_BAR;
            }
        }
        if constexpr (ALIGN_EPI) { if (wr == 0) PG8_BAR; }
        if constexpr (Epi::FULL) { E.full(acc, cur, wr, wc, fr, fq, lds, tid); S.done(cur); } else if constexpr (!Epi::AFTER_DRAIN) { E(acc, cur, wr, wc, fr, fq); S.done(cur); }
        if (!has_next) break;
#pragma unroll
        for (int a = 0; a < 2; ++a)
#pragma unroll
            for (int b = 0; b < 2; ++b)
#pragma unroll
                for (int m = 0; m < 4; ++m)
#pragma unroll
                    for (int n = 0; n < 2; ++n) acc[a][b][m][n] = (f32x4){0.f, 0.f, 0.f, 0.f};
        cur = nxt; cA = nA; cB = nB; ++ui;
        if constexpr (Epi::MIDSCALE) E.prep(lds, tid, cur, wr, fr);
        if constexpr (ALIGN_EPI) { if (wr == 1) PG8_BAR; }
    }
    PG8_WAIT_V(0);
    if constexpr (!ALIGN_EPI) { if (wr == 0) PG8_BAR; }
    PG8_BAR;
    if constexpr (Epi::AFTER_DRAIN) { E.fused(acc, cur, wr, wc, fr, fq, lds, wid, lane); S.done(cur); }
#undef PG8_SA
#undef PG8_SB
#undef PG8_STAGE
#undef PG8_LDA
#undef PG8_LDB
#undef PG8_MMA
#undef PG8_WAIT_V
#undef PG8_WAIT_L
#undef PG8_BAR
#undef PG8_SCHED
}
}
#include <hip/hip_bf16.h>
#include <cmath>
namespace attn_body {
using bf16=__hip_bfloat16;
using bf16x8=__attribute__((ext_vector_type(8)))short;
using s16x4=__attribute__((ext_vector_type(4)))short;
using f32x16=__attribute__((ext_vector_type(16)))float;
using u32x4=__attribute__((ext_vector_type(4)))unsigned;
constexpr int D=64,PQ=2304,PO=1024;
constexpr int NW=8,QBLK=32,QB=QBLK*NW,KVBLK=64;
__device__ __forceinline__ int crow(int r,int hi){return (r&3)+8*(r>>2)+4*hi;}
#define SBAR() __builtin_amdgcn_sched_barrier(0)
__device__ __forceinline__ void cmask(f32x16&p0,f32x16&p1,int jb,int qrel,int hi){
  const float NEG=-INFINITY; int kb=64*jb+4*hi;
  #pragma unroll
  for(int r=0;r<16;++r){int kv=kb+(r&3)+8*(r>>2); if(kv>qrel)p0[r]=NEG; if(kv+32>qrel)p1[r]=NEG;}
}

constexpr int NSLOT=3, SLOTB=8192;
constexpr int LDS_K=0, LDS_V=NSLOT*SLOTB, LDS_WS=2*NSLOT*SLOTB, LDS_OST=LDS_WS+NW*64*4, LDS_BYTES=LDS_OST+NW*4096;
constexpr float C2=0.125f*1.4426950408889634f;
__device__ __forceinline__ void glds16(const void*gsrc,unsigned lds_dst){unsigned keep;
  asm volatile("s_mov_b32 %0, m0\n\ts_mov_b32 m0, %2\n\ts_nop 0\n\tglobal_load_lds_dwordx4 %1, off\n\ts_mov_b32 m0, %0":"=&s"(keep):"v"(gsrc),"s"(lds_dst):"memory");}
#define ATT_DPPF(srcv, ctrl) __builtin_bit_cast(float, __builtin_amdgcn_update_dpp(0, __builtin_bit_cast(int, (float)(srcv)), (ctrl), 0xf, 0xf, true))
__device__ __forceinline__ float sum8(float x){ x+=ATT_DPPF(x,0xB1); x+=ATT_DPPF(x,0x4E); x+=ATT_DPPF(x,0x141); return x; }
__device__ __forceinline__ float xsum32(float x){ auto rr=__builtin_amdgcn_permlane32_swap(__float_as_uint(x),__float_as_uint(x),false,false); return __uint_as_float(rr[0])+__uint_as_float(rr[1]); }
__device__ __forceinline__ float xmax32(float x){ auto rr=__builtin_amdgcn_permlane32_swap(__float_as_uint(x),__float_as_uint(x),false,false); return __builtin_fmaxf(__uint_as_float(rr[0]),__uint_as_float(rr[1])); }
__device__ __forceinline__ float max3f(float a,float b,float c){float r;asm("v_max3_f32 %0, %1, %2, %3":"=v"(r):"v"(a),"v"(b),"v"(c));return r;}
__device__ __forceinline__ float max2f(float a,float b){float r;asm("v_max_f32_e32 %0, %1, %2":"=v"(r):"v"(a),"v"(b));return r;}
__device__ __forceinline__ float fadd_s(float a,float b){float r;asm("v_add_f32_e32 %0, %1, %2":"=v"(r):"v"(a),"v"(b));return r;}
__device__ __forceinline__ float fsub_s(float a,float b){float r;asm("v_sub_f32_e32 %0, %1, %2":"=v"(r):"v"(a),"v"(b));return r;}
typedef float f32x2_t __attribute__((ext_vector_type(2))); typedef __bf16 bf16x2_t __attribute__((ext_vector_type(2)));
__device__ __forceinline__ unsigned cvtpk_s(float lo,float hi){f32x2_t v={lo,hi};bf16x2_t b=__builtin_convertvector(v,bf16x2_t);return __builtin_bit_cast(unsigned,b);}
#define WAIT_BAR(N) asm volatile("s_waitcnt vmcnt(" #N ") lgkmcnt(0)\n\ts_barrier":::"memory")

__device__ __forceinline__ void qkt(f32x16&p0,f32x16&p1,const char*Kslot,const bf16x8*qr,const f32x16&negm,int r32,int hi){
  const char*kb=Kslot+hi*1024+r32*16;
  #pragma unroll
  for(int d0=0;d0<4;++d0){
    const bf16x8 b0=*reinterpret_cast<const bf16x8*>(kb+d0*2048);
    const bf16x8 b1=*reinterpret_cast<const bf16x8*>(kb+d0*2048+512);
    if(d0==0){p0=__builtin_amdgcn_mfma_f32_32x32x16_bf16(b0,qr[0],negm,0,0,0);p1=__builtin_amdgcn_mfma_f32_32x32x16_bf16(b1,qr[0],negm,0,0,0);}
    else{p0=__builtin_amdgcn_mfma_f32_32x32x16_bf16(b0,qr[d0],p0,0,0,0);p1=__builtin_amdgcn_mfma_f32_32x32x16_bf16(b1,qr[d0],p1,0,0,0);}}
}
typedef __attribute__((address_space(3))) const char* lds_cptr;
typedef short v4i16_t __attribute__((ext_vector_type(4)));
__device__ __forceinline__ void kload8(bf16x8*kf,lds_cptr kp){
  kf[0]=*(const __attribute__((address_space(3))) bf16x8*)(kp);      kf[1]=*(const __attribute__((address_space(3))) bf16x8*)(kp+512);
  kf[2]=*(const __attribute__((address_space(3))) bf16x8*)(kp+2048); kf[3]=*(const __attribute__((address_space(3))) bf16x8*)(kp+2560);
  kf[4]=*(const __attribute__((address_space(3))) bf16x8*)(kp+4096); kf[5]=*(const __attribute__((address_space(3))) bf16x8*)(kp+4608);
  kf[6]=*(const __attribute__((address_space(3))) bf16x8*)(kp+6144); kf[7]=*(const __attribute__((address_space(3))) bf16x8*)(kp+6656);
}
__device__ __forceinline__ void kload2(bf16x8*kf,lds_cptr kp,int j){ kf[2*j]=*(const __attribute__((address_space(3))) bf16x8*)(kp+j*2048); kf[2*j+1]=*(const __attribute__((address_space(3))) bf16x8*)(kp+j*2048+512); }
__device__ __forceinline__ s16x4 vtr(lds_cptr p){ return __builtin_bit_cast(s16x4,__builtin_amdgcn_ds_read_tr16_b64_v4i16((__attribute__((address_space(3))) v4i16_t*)p)); }
__device__ __forceinline__ float rowmax(const f32x16&p0,const f32x16&p1){
  float a=max3f(p0[0],p0[1],p1[0]),b=max3f(p0[2],p0[3],p1[1]);a=max3f(a,p1[2],p1[3]);
  #pragma unroll
  for(int r=4;r<16;r+=4){a=max3f(a,p0[r],p0[r+1]);b=max3f(b,p0[r+2],p0[r+3]);a=max3f(a,p1[r],p1[r+1]);b=max3f(b,p1[r+2],p1[r+3]);}
  const float m=max2f(a,b);
  auto rr=__builtin_amdgcn_permlane32_swap(__float_as_uint(m),__float_as_uint(m),false,false);
  return max2f(__uint_as_float(rr[0]),__uint_as_float(rr[1]));
}
__device__ __forceinline__ void pv(f32x16*o,int vb,bf16x8 pa0,bf16x8 pa1,bf16x8 pa2,bf16x8 pa3){
  #pragma unroll
  for(int d0=0;d0<2;++d0){s16x4 lo[4],hi[4];
    #pragma unroll
    for(int ks=0;ks<4;++ks){
      asm volatile("ds_read_b64_tr_b16 %0,%1 offset:%c2":"=&v"(lo[ks]):"v"(vb),"i"(d0*4096+ks*1024):"memory");
      asm volatile("ds_read_b64_tr_b16 %0,%1 offset:%c2":"=&v"(hi[ks]):"v"(vb),"i"(d0*4096+ks*1024+512):"memory");}
    asm volatile("s_waitcnt lgkmcnt(0)":::"memory");SBAR();
    #define PK(k) (bf16x8){lo[k][0],lo[k][1],lo[k][2],lo[k][3],hi[k][0],hi[k][1],hi[k][2],hi[k][3]}
    o[d0]=__builtin_amdgcn_mfma_f32_32x32x16_bf16(pa0,PK(0),o[d0],0,0,0);
    o[d0]=__builtin_amdgcn_mfma_f32_32x32x16_bf16(pa1,PK(1),o[d0],0,0,0);
    o[d0]=__builtin_amdgcn_mfma_f32_32x32x16_bf16(pa2,PK(2),o[d0],0,0,0);
    o[d0]=__builtin_amdgcn_mfma_f32_32x32x16_bf16(pa3,PK(3),o[d0],0,0,0);
    #undef PK
  }
}

#ifndef ATTN_STORE16
#define ATTN_STORE16(p,v) (*(u32x4*)(p)=(v))
#endif
template<int THRL> __device__ __forceinline__ void attn_unit(long rowbase,int NT,int h,int kvh,int qb,const bf16*Q,const bf16*__restrict__ K,const bf16*__restrict__ V,bf16*O,float*ssq,char*shm){
  int tid=threadIdx.x; asm volatile("":"+v"(tid)); const int lane=tid&63,r32=lane&31,hi=lane>>5; const int wid=__builtin_amdgcn_readfirstlane(tid>>6);
  const int q0=qb*QB;
  const bf16*Qw=Q+(rowbase+q0+wid*QBLK)*PQ+h*D;
  const bf16*Kh=K+rowbase*PQ+kvh*D,*Vh=V+rowbase*PQ+kvh*D;
  const unsigned lds0=(unsigned)(uintptr_t)shm;
  float*wsf=(float*)(shm+LDS_WS)+wid*64;
  const bf16*ksrc=Kh+(long)lane*PQ+wid*8;
  const bf16*vsrc=Vh+(long)(16*(wid&3)+(lane>>2))*PQ+(wid>>2)*32+(lane&3)*8;
  const unsigned kdst=lds0+LDS_K+wid*1024, vdst=lds0+LDS_V+wid*1024;
  #define DMA_K(t,slot) glds16(ksrc+(long)(t)*KVBLK*PQ,(unsigned)__builtin_amdgcn_readfirstlane(kdst+(slot)))
  #define DMA_V(t,slot) glds16(vsrc+(long)(t)*KVBLK*PQ,(unsigned)__builtin_amdgcn_readfirstlane(vdst+(slot)))
  const int vb0=(int)(lds0+LDS_V)+((lane>>4)&1)*32+(lane&3)*8+(4*hi+((lane&15)>>2))*64;
  const char*Kbase=shm+LDS_K; bf16x8 kf[8];
  const lds_cptr shm3=(lds_cptr)shm; const lds_cptr kp0=shm3+LDS_K+hi*1024+r32*16; const lds_cptr vp0=shm3+LDS_V+((lane>>4)&1)*32+(lane&3)*8+(4*hi+((lane&15)>>2))*64;
  DMA_K(0,0);DMA_V(0,0);DMA_K(1,SLOTB);
  bf16x8 qr[4];
  #pragma unroll
  for(int d0=0;d0<4;++d0)qr[d0]=*reinterpret_cast<const bf16x8*>(&Qw[(long)r32*PQ+d0*16+hi*8]);
  float mhat=0.f,l_reg=0.f;f32x16 o[2];o[0]=f32x16{};o[1]=f32x16{};f32x16 negm=f32x16{};asm volatile("":"+v"(negm));
  const int qrel=wid*QBLK+r32;
  #define CMASK(P0,P1,t) do{int jb_=(t)-(NT-4); (void)jb_;(void)qrel;}while(0)
  bool resc=false;
  #define START(P0,P1) do{ const float rm=rowmax(P0,P1); resc=false; \
    { const float dl=rm; mhat=fadd_s(mhat,dl); \
      _Pragma("unroll") for(int r=0;r<16;++r){P0[r]=fsub_s(P0[r],dl);P1[r]=fsub_s(P1[r],dl);} \
      _Pragma("unroll") for(int r=0;r<16;++r)negm[r]=-mhat; asm volatile("":"+v"(negm)); } \
    _Pragma("unroll") for(int r=0;r<16;++r)P0[r]=__builtin_amdgcn_exp2f(P0[r]); }while(0)
  #define RESC() do{ if(resc){ asm volatile("s_waitcnt lgkmcnt(0)":::"memory"); \
      _Pragma("unroll") for(int d_=0;d_<2;++d_) _Pragma("unroll") for(int r=0;r<16;++r)o[d_][r]*=wsf[crow(r,hi)]; } }while(0)
  f32x16 pA0,pA1,pB0,pB1;
  int sl_prev=0,sl_cur=0,sl_next=SLOTB;
  #define ROT() do{sl_prev=sl_cur;sl_cur=sl_next;sl_next=(sl_next==(NSLOT-1)*SLOTB)?0:sl_next+SLOTB;}while(0)
  DMA_K(2,2*SLOTB);
  WAIT_BAR(3);
  qkt(pA0,pA1,Kbase,qr,negm,r32,hi);asm volatile("s_nop 15\n\ts_nop 7":"+v"(pA0),"+v"(pA1));CMASK(pA0,pA1,0);
  START(pA0,pA1);
  _Pragma("unroll") for(int r=0;r<16;++r)pA1[r]=__builtin_amdgcn_exp2f(pA1[r]);
  WAIT_BAR(0);
  DMA_K(3,0);DMA_V(1,SLOTB);
  ROT();
  kload8(kf,kp0+sl_cur);
  WAIT_BAR(2);
  s16x4 vlo[8],vhi[8]; u32x4 pw0,pw1,pw2,pw3;
  #define PKW(P,B) cvtpk_s(P[B],P[B+1])
  #define PAF(k) __builtin_bit_cast(bf16x8,pw##k)
  #define VFR(i) (bf16x8){vlo[i][0],vlo[i][1],vlo[i][2],vlo[i][3],vhi[i][0],vhi[i][1],vhi[i][2],vhi[i][3]}
  #define PIN(x) asm volatile("":"+v"(x))
  #define MX3(a,b,c) __builtin_fmaxf(__builtin_fmaxf((a),(b)),(c))
  #define GAPA(MF,A0,A1,A2,A3,W0,W1,PW) do{ MF; sacc+=A0; sacc+=A1; sacc+=A2; sacc+=A3; PIN(sacc); W0; W1; PIN(PW); SBAR(); }while(0)
  #define EX(v) __builtin_amdgcn_exp2f(v)
  #define GAPB(MF,X,B) do{ MF; X[B]=EX(X[B]); X[B+1]=EX(X[B+1]); X[B+2]=EX(X[B+2]); X[B+3]=EX(X[B+3]); PIN(X); SBAR(); }while(0)
  #define VRD(i) do{ vlo[i]=vtr(vp_+(((i)>>2)*4096+((i)&3)*1024)); vhi[i]=vtr(vp_+(((i)>>2)*4096+((i)&3)*1024+512)); }while(0)
  #define KRD(G,j) do{ if(G){ kload2(kf,kp0+sl_next,j); SBAR(); } }while(0)
  #define STEP(C0,C1,P0,P1,t,GK,GV,GL) do{ SBAR(); \
    const lds_cptr vp_=vp0+sl_prev; \
    VRD(0); SBAR(); float sacc=(P0[0]+P0[1]); \
    GAPA(C0=__builtin_amdgcn_mfma_f32_32x32x16_bf16(kf[0],qr[0],negm,0,0,0), P0[2],P0[3],P0[4],P0[5],     pw0[0]=PKW(P0,0), pw0[1]=PKW(P0,2), pw0); \
    VRD(4); SBAR(); GAPA(C1=__builtin_amdgcn_mfma_f32_32x32x16_bf16(kf[1],qr[0],negm,0,0,0), P0[6],P0[7],P0[8],P0[9],     pw0[2]=PKW(P0,4), pw0[3]=PKW(P0,6), pw0); \
    VRD(1); SBAR(); GAPA(C0=__builtin_amdgcn_mfma_f32_32x32x16_bf16(kf[2],qr[1],C0,0,0,0),   P0[10],P0[11],P0[12],P0[13], pw1[0]=PKW(P0,8), pw1[1]=PKW(P0,10), pw1); \
    VRD(5); SBAR(); GAPA(C1=__builtin_amdgcn_mfma_f32_32x32x16_bf16(kf[3],qr[1],C1,0,0,0),   P0[14],P0[15],P1[0],P1[1],   pw1[2]=PKW(P0,12),pw1[3]=PKW(P0,14), pw1); \
    VRD(2); SBAR(); GAPA(C0=__builtin_amdgcn_mfma_f32_32x32x16_bf16(kf[4],qr[2],C0,0,0,0),   P1[2],P1[3],P1[4],P1[5],     pw2[0]=PKW(P1,0), pw2[1]=PKW(P1,2), pw2); \
    VRD(6); SBAR(); GAPA(C1=__builtin_amdgcn_mfma_f32_32x32x16_bf16(kf[5],qr[2],C1,0,0,0),   P1[6],P1[7],P1[8],P1[9],     pw2[2]=PKW(P1,4), pw2[3]=PKW(P1,6), pw2); \
    VRD(3); SBAR(); GAPA(C0=__builtin_amdgcn_mfma_f32_32x32x16_bf16(kf[6],qr[3],C0,0,0,0),   P1[10],P1[11],P1[12],P1[13], pw3[0]=PKW(P1,8), pw3[1]=PKW(P1,10), pw3); \
    VRD(7); SBAR(); GAPA(C1=__builtin_amdgcn_mfma_f32_32x32x16_bf16(kf[7],qr[3],C1,0,0,0),   P1[14],P1[15],0.f,0.f,       pw3[2]=PKW(P1,12),pw3[3]=PKW(P1,14), pw3); \
    l_reg+=sacc; \
    if(GK){DMA_K((t)+3,sl_cur);} if(GV){DMA_V((t)+1,sl_next);} \
    CMASK(C0,C1,t); \
    { float a=MX3(C0[0],C0[1],C1[0]),b=MX3(C0[2],C0[3],C1[1]); a=MX3(a,C1[2],C1[3]); \
      _Pragma("unroll") for(int r=4;r<16;r+=4){a=MX3(a,C0[r],C0[r+1]);b=MX3(b,C0[r+2],C0[r+3]);a=MX3(a,C1[r],C1[r+1]);b=MX3(b,C1[r+2],C1[r+3]);} \
      float rm=__builtin_fmaxf(a,b); { auto rr=__builtin_amdgcn_permlane32_swap(__float_as_uint(rm),__float_as_uint(rm),false,false); rm=__builtin_fmaxf(__uint_as_float(rr[0]),__uint_as_float(rr[1])); } \
      resc=false; \
      if(__builtin_expect(__any(rm>(float)THRL),0)){ const float dl=__builtin_fmaxf(rm,0.f); mhat+=dl; \
        _Pragma("unroll") for(int r=0;r<16;++r){C0[r]-=dl;C1[r]-=dl;} \
        _Pragma("unroll") for(int r=0;r<16;++r)negm[r]=-mhat; asm volatile("":"+v"(negm)); \
        const float f=__builtin_amdgcn_exp2f(-dl); l_reg*=f; if(hi==0)wsf[r32]=f; resc=true; } } \
    SBAR(); \
    GAPB(o[0]=__builtin_amdgcn_mfma_f32_32x32x16_bf16(PAF(0),VFR(0),o[0],0,0,0), C0,0); \
    GAPB(o[1]=__builtin_amdgcn_mfma_f32_32x32x16_bf16(PAF(0),VFR(4),o[1],0,0,0), C0,4); \
    KRD(GL,0); GAPB(o[0]=__builtin_amdgcn_mfma_f32_32x32x16_bf16(PAF(1),VFR(1),o[0],0,0,0), C0,8); \
    KRD(GL,1); GAPB(o[1]=__builtin_amdgcn_mfma_f32_32x32x16_bf16(PAF(1),VFR(5),o[1],0,0,0), C0,12); \
    KRD(GL,2); GAPB(o[0]=__builtin_amdgcn_mfma_f32_32x32x16_bf16(PAF(2),VFR(2),o[0],0,0,0), C1,0); \
    KRD(GL,3); GAPB(o[1]=__builtin_amdgcn_mfma_f32_32x32x16_bf16(PAF(2),VFR(6),o[1],0,0,0), C1,4); \
    GAPB(o[0]=__builtin_amdgcn_mfma_f32_32x32x16_bf16(PAF(3),VFR(3),o[0],0,0,0), C1,8); \
    GAPB(o[1]=__builtin_amdgcn_mfma_f32_32x32x16_bf16(PAF(3),VFR(7),o[1],0,0,0), C1,12); \
    }while(0)
  int t=1;
  #undef CMASK
  #define CMASK(P0,P1,t) do{}while(0)
  for(;t+5<NT;t+=2){
    STEP(pB0,pB1,pA0,pA1,t,true,true,true);     WAIT_BAR(2); RESC(); ROT();
    STEP(pA0,pA1,pB0,pB1,t+1,true,true,true);   WAIT_BAR(2); RESC(); ROT();
  }
  #undef CMASK
  #define CMASK(P0,P1,t) do{int jb_=(t)-(NT-4); (void)jb_;(void)qrel;}while(0)
  #define ENDW(tt) do{ if((tt)+3<NT){WAIT_BAR(2);} else if((tt)+2<NT){WAIT_BAR(1);} else {WAIT_BAR(0);} }while(0)
  for(;t+1<NT;t+=2){
    STEP(pB0,pB1,pA0,pA1,t,(t+3<NT),(t+1<NT),(t+1<NT));       ENDW(t);   RESC(); ROT();
    STEP(pA0,pA1,pB0,pB1,t+1,(t+4<NT),(t+2<NT),(t+2<NT));     ENDW(t+1); RESC(); ROT();
  }
  STEP(pB0,pB1,pA0,pA1,NT-1,false,false,false); RESC();
  { float sacc=pB0[0]+pB0[1]; _Pragma("unroll") for(int r=2;r<16;++r)sacc+=pB0[r]; _Pragma("unroll") for(int r=0;r<16;++r)sacc+=pB1[r]; l_reg+=sacc;
    pw0=(u32x4){PKW(pB0,0),PKW(pB0,2),PKW(pB0,4),PKW(pB0,6)};pw1=(u32x4){PKW(pB0,8),PKW(pB0,10),PKW(pB0,12),PKW(pB0,14)};pw2=(u32x4){PKW(pB1,0),PKW(pB1,2),PKW(pB1,4),PKW(pB1,6)};pw3=(u32x4){PKW(pB1,8),PKW(pB1,10),PKW(pB1,12),PKW(pB1,14)};
    SBAR(); pv(o,vb0+sl_cur,PAF(0),PAF(1),PAF(2),PAF(3)); }
  #undef PKW
  #undef PAF
  #undef VFR
  #undef PIN
  #undef MX3
  #undef GAPA
  #undef GAPB
  #undef EX
  #undef VRD
  #undef KRD
  #undef STEP
  #undef ENDW
  {auto rr=__builtin_amdgcn_permlane32_swap(__float_as_uint(l_reg),__float_as_uint(l_reg),false,false);l_reg=__uint_as_float(rr[0])+__uint_as_float(rr[1]);}
  if(hi==0)wsf[32+r32]=l_reg;asm volatile("s_waitcnt lgkmcnt(0)":::"memory");
  float rli[16];
  #pragma unroll
  for(int r=0;r<16;++r)rli[r]=__builtin_amdgcn_rcpf(wsf[32+crow(r,hi)]);
  bf16*Ow=O+(rowbase+q0+wid*QBLK)*PO+h*D;
  { bf16*stg=(bf16*)(shm+LDS_OST)+wid*2048;
    #pragma unroll
    for(int r=0;r<16;++r){const int orow=crow(r,hi);
      #pragma unroll
      for(int d0=0;d0<2;++d0)stg[orow*64+d0*32+r32]=__float2bfloat16(o[d0][r]*rli[r]);}
    asm volatile("s_waitcnt lgkmcnt(0)":::"memory");
    #pragma unroll
    for(int i=0;i<4;++i){const int row=i*8+(lane>>3),ch=lane&7; const u32x4 v=*(const u32x4*)(stg+row*64+ch*8); ATTN_STORE16(Ow+(long)row*PO+ch*8,v);
      float ss=0.f; _Pragma("unroll") for(int e=0;e<4;++e){const float lo=__uint_as_float(v[e]<<16),hh=__uint_as_float(v[e]&0xffff0000u); ss+=lo*lo+hh*hh;}
      ss=sum8(ss); if(ch==0)__hip_atomic_fetch_add(ssq+(rowbase+q0+wid*QBLK+row),ss,__ATOMIC_RELAXED,__HIP_MEMORY_SCOPE_AGENT);} }
  asm volatile("s_waitcnt lgkmcnt(0)\n\ts_barrier":::"memory");
  #undef DMA_K
  #undef DMA_V
  #undef CMASK
  #undef START
  #undef RESC
  #undef ROT
}
constexpr int ATTN_LDS_BYTES=LDS_BYTES;
#undef SBAR
#undef WAIT_BAR
}
namespace na_body {
using attn_body::bf16x8; using attn_body::s16x4; using attn_body::f32x16; using attn_body::u32x4;
#define NA_LAS __attribute__((address_space(3)))
constexpr int PQ = 2304, PO = 1024;
constexpr int COL_QB = 768, COL_KB = 1280, COL_VB = 1792, COL_OB = 512;
constexpr int T_GUARD = 48, T_FLOATS = T_GUARD + 15 * 32 + 48;
__device__ __forceinline__ int crow(int r, int hi) { return (r & 3) + 8 * (r >> 2) + 4 * hi; }
__device__ __forceinline__ unsigned cvtpk(float lo, float hi) { return attn_body::cvtpk_s(lo, hi); }

__device__ __forceinline__ void na_unit(unsigned char* __restrict__ ws, unsigned proj_off, unsigned o_off, unsigned ssq_off, int rowbase, int rows, int r, int h,
                                        NA_LAS unsigned char* wl, unsigned wl_addr, const NA_LAS float* T, NA_LAS float* wsf) {
    int tid_ = threadIdx.x; asm volatile("" : "+v"(tid_)); const int lane = tid_ & 63, r32 = lane & 31, hi = lane >> 5;
    const int r0 = min(max(r - 4, 0), rows - 8);
    const int qrow0 = rowbase + r * 64;
    const unsigned qoff = proj_off + (unsigned)((qrow0 + r32) * PQ + COL_QB + h * 64 + hi * 8) * 2u;
    bf16x8 qr[2][4];
#pragma unroll
    for (int qb2 = 0; qb2 < 2; ++qb2)
#pragma unroll
        for (int d0 = 0; d0 < 4; ++d0) qr[qb2][d0] = *(const bf16x8*)(ws + (size_t)(qoff + (unsigned)(qb2 * 32 * PQ + d0 * 16) * 2u));
    float mrun[2] = {-1e30f, -1e30f}, lrun[2] = {0.f, 0.f};
    f32x16 o[2][2];
#pragma unroll
    for (int a = 0; a < 2; ++a)
#pragma unroll
        for (int b = 0; b < 2; ++b) o[a][b] = f32x16{};
    const int lrow = lane >> 3, lc = lane & 7;
    const int vb = (int)wl_addr + 8192 + ((lane >> 4) & 1) * 32 + (lane & 3) * 8 + (4 * hi + ((lane & 15) >> 2)) * 64;
    unsigned kboff = proj_off + (unsigned)((rowbase + r0 * 64 + lrow) * PQ + COL_KB + h * 64 + lc * 8) * 2u;
    u32x4 kreg[8], vreg[8];
#pragma unroll
    for (int j = 0; j < 8; ++j) { kreg[j] = *(const u32x4*)(ws + (size_t)(kboff + (unsigned)(j * 8 * PQ) * 2u)); vreg[j] = *(const u32x4*)(ws + (size_t)(kboff + (unsigned)(COL_VB - COL_KB + j * 8 * PQ) * 2u)); }
    for (int i = 0; i < 8; ++i) {
#pragma unroll
        for (int j = 0; j < 8; ++j) { const int row = j * 8 + lrow;
            *(NA_LAS u32x4*)(wl + lc * 1024 + row * 16) = kreg[j];
            *(NA_LAS u32x4*)(wl + 8192 + (lc >> 2) * 4096 + (row >> 4) * 1024 + (row & 15) * 64 + (lc & 3) * 16) = vreg[j]; }
        kboff += (unsigned)(64 * PQ) * 2u;
        __builtin_amdgcn_sched_barrier(0);
        if (i < 7) {
#pragma unroll
            for (int j = 0; j < 8; ++j) { kreg[j] = *(const u32x4*)(ws + (size_t)(kboff + (unsigned)(j * 8 * PQ) * 2u)); vreg[j] = *(const u32x4*)(ws + (size_t)(kboff + (unsigned)(COL_VB - COL_KB + j * 8 * PQ) * 2u)); }
        }
        __builtin_amdgcn_sched_barrier(0);
        const int dr = r0 + i - r + 7;
#pragma unroll
        for (int qb2 = 0; qb2 < 2; ++qb2) {
            f32x16 p0 = f32x16{}, p1 = f32x16{};
#pragma unroll
            for (int d0 = 0; d0 < 4; ++d0) { const bf16x8 k0 = *(const NA_LAS bf16x8*)(wl + (2 * d0 + hi) * 1024 + r32 * 16), k1 = *(const NA_LAS bf16x8*)(wl + (2 * d0 + hi) * 1024 + 512 + r32 * 16);
                p0 = __builtin_amdgcn_mfma_f32_32x32x16_bf16(k0, qr[qb2][d0], p0, 0, 0, 0); p1 = __builtin_amdgcn_mfma_f32_32x32x16_bf16(k1, qr[qb2][d0], p1, 0, 0, 0); }
            const int c = qb2 * 32 + r32, c0 = min(max(c - 8, 0), 48);
            const NA_LAS float* tb = T + dr * 32 + 15 - c + 4 * hi;
            const int kofs = 4 * hi - c0;
            float rm = -1e30f;
#pragma unroll
            for (int rr = 0; rr < 16; ++rr) { const int kc = (rr & 3) + 8 * (rr >> 2);
                const float s0 = ((unsigned)(kc + kofs) < 16u) ? p0[rr] + tb[kc] : -1e30f;
                const float s1 = ((unsigned)(kc + 32 + kofs) < 16u) ? p1[rr] + tb[kc + 32] : -1e30f;
                p0[rr] = s0; p1[rr] = s1; rm = fmaxf(rm, fmaxf(s0, s1)); if ((rr & 3) == 3) __builtin_amdgcn_sched_barrier(0); }
            rm = attn_body::xmax32(rm);
            const float mn = fmaxf(mrun[qb2], rm), alpha = __builtin_amdgcn_exp2f(mrun[qb2] - mn);
            mrun[qb2] = mn;
            float sum = 0.f;
#pragma unroll
            for (int rr = 0; rr < 16; ++rr) { p0[rr] = __builtin_amdgcn_exp2f(p0[rr] - mn); p1[rr] = __builtin_amdgcn_exp2f(p1[rr] - mn); sum += p0[rr] + p1[rr]; }
            lrun[qb2] = lrun[qb2] * alpha + sum;
            if (__any(alpha != 1.0f)) {
                if (hi == 0) wsf[r32] = alpha;
#pragma unroll
                for (int rr = 0; rr < 16; ++rr) { const float a = wsf[crow(rr, hi)]; o[qb2][0][rr] *= a; o[qb2][1][rr] *= a; }
            }
            u32x4 pw0, pw1, pw2, pw3;
            pw0 = (u32x4){cvtpk(p0[0], p0[1]), cvtpk(p0[2], p0[3]), cvtpk(p0[4], p0[5]), cvtpk(p0[6], p0[7])};
            pw1 = (u32x4){cvtpk(p0[8], p0[9]), cvtpk(p0[10], p0[11]), cvtpk(p0[12], p0[13]), cvtpk(p0[14], p0[15])};
            pw2 = (u32x4){cvtpk(p1[0], p1[1]), cvtpk(p1[2], p1[3]), cvtpk(p1[4], p1[5]), cvtpk(p1[6], p1[7])};
            pw3 = (u32x4){cvtpk(p1[8], p1[9]), cvtpk(p1[10], p1[11]), cvtpk(p1[12], p1[13]), cvtpk(p1[14], p1[15])};
            attn_body::pv(o[qb2], vb, __builtin_bit_cast(bf16x8, pw0), __builtin_bit_cast(bf16x8, pw1), __builtin_bit_cast(bf16x8, pw2), __builtin_bit_cast(bf16x8, pw3));
        }
    }
#pragma unroll
    for (int qb2 = 0; qb2 < 2; ++qb2) {
        const float l = attn_body::xsum32(lrun[qb2]);
        if (hi == 0) wsf[r32] = __builtin_amdgcn_rcpf(l);
        NA_LAS unsigned short* stg = (NA_LAS unsigned short*)(wl + qb2 * 4096);
#pragma unroll
        for (int rr = 0; rr < 16; ++rr) { const int orow = crow(rr, hi); const float rl = wsf[orow];
#pragma unroll
            for (int d0 = 0; d0 < 2; ++d0) stg[orow * 64 + d0 * 32 + r32] = (unsigned short)(cvtpk(o[qb2][d0][rr] * rl, 0.f) & 0xffffu); }
        const unsigned ooff = o_off + (unsigned)((qrow0 + qb2 * 32) * PO + COL_OB + h * 64) * 2u;
#pragma unroll
        for (int k = 0; k < 4; ++k) { const int row = k * 8 + (lane >> 3), ch = lane & 7; const u32x4 v = *(const NA_LAS u32x4*)(stg + row * 64 + ch * 8); *(u32x4*)(ws + (size_t)(ooff + (unsigned)(row * PO + ch * 8) * 2u)) = v;
            float ss = 0.f;
#pragma unroll
            for (int e = 0; e < 4; ++e) { const float lo = __uint_as_float(v[e] << 16), hh = __uint_as_float(v[e] & 0xffff0000u); ss += lo * lo + hh * hh; }
            ss = attn_body::sum8(ss); if (ch == 0) __hip_atomic_fetch_add((float*)(ws + (size_t)(ssq_off + (unsigned)(qrow0 + qb2 * 32 + row) * 4u)), ss, __ATOMIC_RELAXED, __HIP_MEMORY_SCOPE_AGENT); }
    }
}
}
namespace cg = cooperative_groups;
constexpr int NWAVES = 8;
constexpr int DM = 1024, M_PROMPT = 32 * 2048, S_PROMPT = 2048, M_SAMPLE = 4 * 4096, S_SAMPLE = 4096, M_ALL = M_PROMPT + M_SAMPLE;
constexpr int NPROJ = 2304, DFF = 2816, NUP = 2 * DFF, PLE = 256;
constexpr int FFN_CHUNKS = 4, M_CHUNK = M_ALL / FFN_CHUNKS;
constexpr float C2 = 0.125f * 1.4426950408889634f;
constexpr float LOG2E = 1.4426950408889634f;
constexpr size_t MiB = 1u << 20;
constexpr size_t WS_SSQ2 = 0, WS_SSQ3 = 384 * 1024, WS_SSQ4 = 768 * 1024, WS_SSQA = 1152 * 1024, WS_SSQB = 1536 * 1024, WS_ROPE = 1984 * 1024, WS_BAR = 1992 * 1024, BAR_BYTES = 16384;
constexpr size_t WS_WIN = 2 * MiB, WS_WOUT = 7 * MiB, WS_WUP = 9 * MiB, WS_WDOWN = 20 * MiB, WS_WGATE = 26 * MiB, WS_WPLE = 28 * MiB;
constexpr size_t WS_PROJ = 32 * MiB;
constexpr size_t WS_XNO = 392 * MiB;
constexpr size_t WS_ACT = 32 * MiB;
constexpr size_t WS_H2B = 472 * MiB;
constexpr size_t WS_H3B = 32 * MiB;
constexpr size_t WS_E = 632 * MiB;
constexpr size_t WS_H1B = 824 * MiB;
constexpr size_t WS_PB = 984 * MiB;
constexpr size_t WS_END = 1024 * MiB;
static_assert(WS_PROJ + (size_t)M_ALL * NPROJ * 2 <= WS_XNO && WS_XNO + (size_t)M_ALL * DM * 2 <= WS_E && WS_ACT + (size_t)M_ALL * DFF * 2 <= WS_H2B && WS_H2B + (size_t)M_ALL * DM * 2 <= WS_E, "d_ws map");
static_assert(WS_E + (size_t)M_ALL * DM * 2 <= WS_H1B && WS_H1B + (size_t)M_ALL * DM * 2 <= WS_PB && WS_PB + (size_t)M_ALL * PLE * 2 <= WS_END && WS_H3B + (size_t)M_ALL * DM * 2 <= WS_H2B, "d_ws map 2");
static_assert(WS_BAR + BAR_BYTES <= WS_WIN && 3456 * 4 <= BAR_BYTES, "barrier words (XCD_BAR_WORDS = 3456)");
static_assert(WS_WIN + (size_t)NPROJ * DM * 2 <= WS_WOUT && WS_WUP + (size_t)NUP * DM * 2 <= WS_WDOWN && WS_WDOWN + (size_t)DM * DFF * 2 <= WS_WGATE, "weight map");
constexpr int RING_BYTES = 131072;
constexpr int NA_T_OFF = RING_BYTES, NA_T_BYTES = na_body::T_FLOATS * 4, NA_WSF_OFF = NA_T_OFF + NWAVES * NA_T_BYTES, XB_ST_OFF = NA_WSF_OFF + NWAVES * 256, LDS_BYTES = XB_ST_OFF + 256;
static_assert(LDS_BYTES <= 163840 && attn_body::ATTN_LDS_BYTES <= RING_BYTES, "LDS map");

#define LAS __attribute__((address_space(3)))
typedef unsigned short bf16;
typedef unsigned v4u __attribute__((ext_vector_type(4)));
typedef unsigned v2u __attribute__((ext_vector_type(2)));
typedef float f32x4 __attribute__((ext_vector_type(4)));
__device__ __forceinline__ unsigned pk2(float lo, float hi) { return pg8::cvt_pk_bf16(lo, hi); }
__device__ __forceinline__ float bflo(unsigned w) { return __uint_as_float(w << 16); }
__device__ __forceinline__ float bfhi(unsigned w) { return __uint_as_float(w & 0xffff0000u); }
__device__ __forceinline__ float wave_sum(float v) {
#pragma unroll
    for (int o = 1; o < 64; o <<= 1) v += __shfl_xor(v, o);
    return v;
}
__device__ __forceinline__ void p0_transpose_item(const float* W, int K, int N, bf16* WT, LAS float* scr, int item, int lane, const float* gain, const float* gain_hi, int ksplit, int nlo, int nhi, float nscale, bool upmap = false) {
    const int nblk = N / 32, kb = item / nblk, nb = item % nblk, k0 = 64 * kb, n0 = 32 * nb;
#pragma unroll 8
    for (int i = 0; i < 32; ++i) { const int kk = 2 * i + (lane >> 5); float w = W[(size_t)(k0 + kk) * N + n0 + (lane & 31)]; if (gain) w *= (k0 < ksplit ? gain[k0 + kk] : gain_hi[k0 + kk - ksplit]); scr[kk * 33 + (lane & 31)] = w; }
    asm volatile("s_waitcnt lgkmcnt(0)" ::: "memory");
    const int c = lane & 7;
#pragma unroll
    for (int j = 0; j < 4; ++j) { const int n = (lane >> 3) + 8 * j; const LAS float* s = scr + (8 * c) * 33 + n; const float ns = (n0 + n >= nlo && n0 + n < nhi) ? nscale : 1.0f;
        v4u o; o.x = pk2(s[0 * 33] * ns, s[1 * 33] * ns); o.y = pk2(s[2 * 33] * ns, s[3 * 33] * ns); o.z = pk2(s[4 * 33] * ns, s[5 * 33] * ns); o.w = pk2(s[6 * 33] * ns, s[7 * 33] * ns);
        int nn = n0 + n; if (upmap) nn = (nn < DFF) ? 256 * (nn / 128) + (nn % 128) : 256 * ((nn - DFF) / 128) + 128 + ((nn - DFF) % 128);
        *(v4u*)(WT + (size_t)nn * K + k0 + 8 * c) = o; }
    asm volatile("s_waitcnt lgkmcnt(0)" ::: "memory");
}
__device__ __forceinline__ void sincos_cw(float a, float& s, float& c) {
    const float k = rintf(a * 0.636619772367581343f);
    float r = fmaf(-k, 1.5703125f, a); r = fmaf(-k, 4.837512969970703125e-4f, r); r = fmaf(-k, 7.54978995489188216e-8f, r);
    const float r2 = r * r;
    const float sp = r + r * r2 * (-1.6666667163e-01f + r2 * (8.3333337680e-03f + r2 * (-1.9841270114e-04f + r2 * 2.7557314297e-06f)));
    const float cp = 1.0f + r2 * (-0.5f + r2 * (4.1666667908e-02f + r2 * (-1.3888889225e-03f + r2 * (2.4801587642e-05f + r2 * -2.7557314297e-07f))));
    const int q = (int)k & 3;
    s = (q == 0) ? sp : (q == 1) ? cp : (q == 2) ? -sp : -cp;
    c = (q == 0) ? cp : (q == 1) ? -sp : (q == 2) ? -cp : sp;
}

#define XB_TMO      128
#define XB_XCNT(j)  (256  + 64 * (j))
#define XB_XSUB(j)  (1280 + 64 * (j))
#define XB_XGEN(j)  (2304 + 64 * (j))
#define XB_TOP      3328
#define XB_TOPGEN   3392
#define XCD_BAR_WORDS 3456
#define XB_SPIN_CAP (1u << 18)

__device__ __forceinline__ unsigned xb_ld(unsigned* p)              { return __hip_atomic_load(p, __ATOMIC_RELAXED, __HIP_MEMORY_SCOPE_AGENT); }
__device__ __forceinline__ unsigned xb_add(unsigned* p, unsigned v) { return __hip_atomic_fetch_add(p, v, __ATOMIC_RELAXED, __HIP_MEMORY_SCOPE_AGENT); }
__device__ __forceinline__ unsigned xb_xcc_id() { return (unsigned)__builtin_amdgcn_s_getreg((3 << 11) | 20) & 0xFu; }
#define XB_SPIN(cond, bar) do { unsigned _sp = 0; while (cond) { __builtin_amdgcn_s_sleep(1); \
    if ((++_sp & 255u) == 0u) { if (xb_ld(&(bar)[XB_TMO])) break; if (_sp > XB_SPIN_CAP) { atomicAdd(&(bar)[XB_TMO], 1u); break; } } } } while (0)

struct XcdBarrier {
    unsigned* bar; unsigned x;
    volatile LAS unsigned* st;
};

__device__ __forceinline__ XcdBarrier xcd_barrier_post(unsigned* bar, volatile LAS unsigned* st) {
    XcdBarrier b; b.bar = bar; b.x = xb_xcc_id(); b.st = st;
    if (threadIdx.x == 0) (void)xb_add(&bar[XB_XCNT(b.x)], 1u);
    return b;
}
__device__ __forceinline__ void xcd_barrier_complete(unsigned* bar, unsigned x, unsigned& nloc, unsigned& nx) {
    const unsigned G = gridDim.x * gridDim.y * gridDim.z;
    unsigned sum, cnt, mine, sp = 0u;
    for (;;) {
        sum = 0u; cnt = 0u; mine = 0u;
#pragma unroll
        for (unsigned j = 0; j < 16; ++j) { const unsigned c = xb_ld(&bar[XB_XCNT(j)]); sum += c; cnt += (c > 0u) ? 1u : 0u; mine = (j == x) ? c : mine; }
        if (sum == G) break;
        __builtin_amdgcn_s_sleep(1);
        if ((++sp & 255u) == 0u) { if (xb_ld(&bar[XB_TMO])) break; if (sp > XB_SPIN_CAP) { atomicAdd(&bar[XB_TMO], 1u); break; } }
    }
    nloc = mine > 0u ? mine : 1u; nx = cnt > 0u ? cnt : 1u;
}

__device__ __forceinline__ void xcd_barrier(const XcdBarrier& b) {
    asm volatile("s_waitcnt vmcnt(0)" ::: "memory");
    __syncthreads();
    if (threadIdx.x == 0) {
        unsigned* bar = b.bar;
        __builtin_amdgcn_s_waitcnt(0);
        unsigned nloc = b.st[0], nx = b.st[1];
        if (nloc == 0u) { xcd_barrier_complete(bar, b.x, nloc, nx); b.st[0] = nloc; b.st[1] = nx; }
        const unsigned old = xb_add(&bar[XB_XSUB(b.x)], 1u);
        const unsigned gen = old / nloc;
        if (old + 1u == (gen + 1u) * nloc) {
            __builtin_amdgcn_fence(__ATOMIC_RELEASE, "agent");
            asm volatile("s_waitcnt vmcnt(0)" ::: "memory");
            const unsigned og = xb_add(&bar[XB_TOP], 1u);
            const unsigned tg = og / nx;
            if (og + 1u == (tg + 1u) * nx) xb_add(&bar[XB_TOPGEN], 1u);
            else XB_SPIN(xb_ld(&bar[XB_TOPGEN]) == tg, bar);
            __builtin_amdgcn_fence(__ATOMIC_ACQUIRE, "agent");
            xb_add(&bar[XB_XGEN(b.x)], 1u);
            asm volatile("s_waitcnt vmcnt(0)" ::: "memory");
        } else {
            XB_SPIN(xb_ld(&bar[XB_XGEN(b.x)]) == gen, bar);
            __builtin_amdgcn_fence(__ATOMIC_ACQUIRE, "agent");
            asm volatile("s_waitcnt vmcnt(0)" ::: "memory");
        }
    }
    __syncthreads();
}

typedef const __attribute__((address_space(4))) unsigned char* kptr_t;
struct Args { const float* in[21]; float* out; unsigned char* ws; };

__global__ void __launch_bounds__(NWAVES * 64, 2) hymba_fwd(Args args) {
    extern __shared__ __attribute__((aligned(16))) unsigned char lds[];
    cg::grid_group grid = cg::this_grid();
    LAS unsigned char* const L = (LAS unsigned char*)lds;
    const int wave = __builtin_amdgcn_readfirstlane(threadIdx.x >> 6);
    const int G = gridDim.x, bx = blockIdx.x, vcu = (G % 8 == 0) ? (bx % 8) * (G / 8) + bx / 8 : bx;
    const int gw = vcu * NWAVES + wave, NGW = G * NWAVES;
    if (threadIdx.x < 2) ((volatile LAS unsigned*)(L + XB_ST_OFF))[threadIdx.x] = 0u;
    __syncthreads();
    { kptr_t kp0 = (kptr_t)__builtin_amdgcn_kernarg_segment_ptr(); unsigned char* const ws0 = (unsigned char*)(*(const __attribute__((address_space(4))) unsigned long long*)(kp0 + 8 * 22));
      (void)xcd_barrier_post((unsigned*)(ws0 + WS_BAR), (volatile LAS unsigned*)(L + XB_ST_OFF)); }
#define SEAM_BAR() do { kptr_t kpb = (kptr_t)__builtin_amdgcn_kernarg_segment_ptr(); asm volatile("" : "+s"(kpb)); XcdBarrier xb_; xb_.bar = (unsigned*)((unsigned char*)(*(const __attribute__((address_space(4))) unsigned long long*)(kpb + 8 * 22)) + WS_BAR); \
        xb_.x = xb_xcc_id(); xb_.st = (volatile LAS unsigned*)(L + XB_ST_OFF); xcd_barrier(xb_); } while (0)
#define PHASE_PTRS() int tid = threadIdx.x; asm volatile("" : "+v"(tid)); const int lane = tid & 63; (void)lane; kptr_t kp = (kptr_t)__builtin_amdgcn_kernarg_segment_ptr(); asm volatile("" : "+s"(kp)); unsigned char* const ws = (unsigned char*)KLD(22); float* const out = (float*)KLD(21); (void)out; \
    float* const ssq2 = (float*)(ws + WS_SSQ2); float* const ssq3 = (float*)(ws + WS_SSQ3); float* const ssq4 = (float*)(ws + WS_SSQ4); float* const ssqA = (float*)(ws + WS_SSQA); float* const ssqB = (float*)(ws + WS_SSQB); (void)ssqA; (void)ssqB; float* const rope = (float*)(ws + WS_ROPE); (void)ssq2; (void)ssq3; (void)ssq4; (void)rope; \
    bf16* const PROJ = (bf16*)(ws + WS_PROJ); bf16* const XNO = (bf16*)(ws + WS_XNO); (void)PROJ; (void)XNO;
#define KLD(i) (*(const __attribute__((address_space(4))) unsigned long long*)(kp + 8 * (i)))
#define KIN(i) ((const float*)KLD(i))

    {
        PHASE_PTRS();
        const float* const x_prompt = KIN(0); const float* const x_sample = KIN(1); const float* const p_prompt = KIN(2); const float* const p_sample = KIN(3);
        bf16* const Win_t = (bf16*)(ws + WS_WIN); bf16* const Wout_t = (bf16*)(ws + WS_WOUT); bf16* const Wup_t = (bf16*)(ws + WS_WUP); bf16* const Wdown_t = (bf16*)(ws + WS_WDOWN);
        bf16* const Wgate_t = (bf16*)(ws + WS_WGATE); bf16* const Wple_t = (bf16*)(ws + WS_WPLE); bf16* const PB = (bf16*)(ws + WS_PB);
        LAS float* scr = (LAS float*)(L + wave * 16384);
        constexpr int I_IN = (DM / 64) * (NPROJ / 32), I_OUT = (DM / 64) * (DM / 32), I_UP = (DM / 64) * (NUP / 32), I_DOWN = (DFF / 64) * (DM / 32), I_GATE = I_OUT, I_PLE = (PLE / 64) * (DM / 32);
        constexpr int NITEMS = I_IN + I_OUT + I_UP + I_DOWN + I_GATE + I_PLE;
        for (int it = gw; it < NITEMS; it += NGW) {
            int r = it;
            if (r < I_IN) { p0_transpose_item(KIN(5), DM, NPROJ, Win_t, scr, r, lane, nullptr, nullptr, 0, na_body::COL_QB, na_body::COL_KB, C2); continue; } r -= I_IN;
            if (r < I_OUT) { p0_transpose_item(KIN(11), DM, DM, Wout_t, scr, r, lane, KIN(9), KIN(10), 512, 0, 0, 1.f); continue; } r -= I_OUT;
            if (r < I_UP) { p0_transpose_item(KIN(13), DM, NUP, Wup_t, scr, r, lane, KIN(12), nullptr, 1 << 30, 0, 0, 1.f, true); continue; } r -= I_UP;
            if (r < I_DOWN) { p0_transpose_item(KIN(16), DFF, DM, Wdown_t, scr, r, lane, nullptr, nullptr, 0, 0, 0, 1.f); continue; } r -= I_DOWN;
            if (r < I_GATE) { p0_transpose_item(KIN(18), DM, DM, Wgate_t, scr, r, lane, KIN(17), nullptr, 1 << 30, 0, 0, 1.f); continue; } r -= I_GATE;
            p0_transpose_item(KIN(19), PLE, DM, Wple_t, scr, r, lane, nullptr, nullptr, 0, 0, 0, 1.f);
        }
        const float* gain = KIN(4);
        for (int m = gw; m < M_ALL; m += NGW) {
            const float* xrow = (m < M_PROMPT) ? x_prompt + (size_t)m * DM : x_sample + (size_t)(m - M_PROMPT) * DM;
            const f32x4* xr = (const f32x4*)xrow + lane;
            f32x4 v[4]; float s = 0.f;
#pragma unroll
            for (int j = 0; j < 4; ++j) { v[j] = xr[64 * j]; s += (v[j].x * v[j].x + v[j].y * v[j].y) + (v[j].z * v[j].z + v[j].w * v[j].w); }
            const float rs = __builtin_amdgcn_rsqf(wave_sum(s) * (1.f / DM) + 1e-6f);
            unsigned long long* o8 = (unsigned long long*)(XNO + (size_t)m * DM) + lane;
#pragma unroll
            for (int j = 0; j < 4; ++j) { const f32x4 g = ((const f32x4*)gain)[lane + 64 * j];
                o8[64 * j] = (unsigned long long)pk2(v[j].x * rs * g.x, v[j].y * rs * g.y) | ((unsigned long long)pk2(v[j].z * rs * g.z, v[j].w * rs * g.w) << 32); }
            const float* prow = (m < M_PROMPT) ? p_prompt + (size_t)m * PLE : p_sample + (size_t)(m - M_PROMPT) * PLE;
            const f32x4 pv = ((const f32x4*)prow)[lane];
            ((unsigned long long*)(PB + (size_t)m * PLE))[lane] = (unsigned long long)pk2(pv.x, pv.y) | ((unsigned long long)pk2(pv.z, pv.w) << 32);
        }
        for (int e = bx * (NWAVES * 64) + tid; e < M_ALL; e += G * NWAVES * 64) { ssq2[e] = 0.f; ssq3[e] = 0.f; ssq4[e] = 0.f; ssqA[e] = 0.f; ssqB[e] = 0.f; }
        for (int e = bx * (NWAVES * 64) + tid; e < 1024; e += G * NWAVES * 64) { const int pos = e >> 4, i = e & 15;
            const float freq = exp2f(-(float)i * (13.287712379549449f / 16.0f)); float s, c; sincos_cw((float)pos * freq, s, c); rope[e] = c; rope[1024 + e] = s; }
    }
    grid.sync();

    {
        PHASE_PTRS(); bf16* const Win_t = (bf16*)(ws + WS_WIN);
        pg8::Gemm g{XNO, Win_t, M_ALL, NPROJ, DM}; pg8::StaticOrder S; S.init(M_ALL, NPROJ, G, bx);
        pg8::EpiBf16Rs E{PROJ, NPROJ, nullptr};
        pg8::gemm_phase<pg8::EpiBf16Rs, pg8::StaticOrder, true, true>(L, g, S, E);
#ifdef PROBE_P1X2
        pg8::gemm_phase<pg8::EpiBf16Rs, pg8::StaticOrder, true, true>(L, g, S, E);
#endif
    }
    {
        PHASE_PTRS(); bf16* const PB = (bf16*)(ws + WS_PB); bf16* const Wple_t = (bf16*)(ws + WS_WPLE); bf16* const EB = (bf16*)(ws + WS_E);
        pg8::Gemm g{PB, Wple_t, M_ALL, DM, PLE}; pg8::StaticOrder S; S.init(M_ALL, DM, G, bx);
        pg8::EpiBf16Rs E{EB, DM, nullptr};
        pg8::gemm_phase<pg8::EpiBf16Rs, pg8::StaticOrder, true, true>(L, g, S, E);
    }
    SEAM_BAR();

    {
        PHASE_PTRS();
        const float* qn = KIN(6); const float* kn = KIN(7);
        const int a = lane & 7;
        const long NIT = (long)M_ALL * 10 / 8;
        for (long it = gw; it < NIT; it += NGW) {
            const long item = it * 8 + (lane >> 3); const int m = (int)(item / 10), j = (int)(item % 10);
            const int t = (m < M_PROMPT) ? (m & (S_PROMPT - 1)) : (m & (S_SAMPLE - 1));
            bf16* p = PROJ + (size_t)m * NPROJ + j * 64 + a * 8;
            const v4u raw = *(const v4u*)p;
            float v[8] = {bflo(raw.x), bfhi(raw.x), bflo(raw.y), bfhi(raw.y), bflo(raw.z), bfhi(raw.z), bflo(raw.w), bfhi(raw.w)};
            float ss = 0.f;
#pragma unroll
            for (int i = 0; i < 8; ++i) ss += v[i] * v[i];
            ss += __shfl_xor(ss, 1); ss += __shfl_xor(ss, 2); ss += __shfl_xor(ss, 4);
            const float rs = __builtin_amdgcn_rsqf(ss * (1.f / 64.f) + 1e-6f);
            const float* gn = (j < 8 ? qn : kn) + a * 8;
            const int pos = (a < 4) ? (t >> 6) : (t & 63);
            const float* ct = rope + pos * 16 + (a & 1) * 8;
            const float sc = (j < 8) ? C2 : 1.0f;
            float o[8];
#pragma unroll
            for (int i = 0; i < 8; ++i) { const float y = v[i] * rs * gn[i]; const float py = __shfl_xor(y, 2); const float cs = ct[i], sn = ct[1024 + i];
                o[i] = ((a & 2) == 0 ? y * cs - py * sn : y * cs + py * sn) * sc; }
            v4u w; w.x = pk2(o[0], o[1]); w.y = pk2(o[2], o[3]); w.z = pk2(o[4], o[5]); w.w = pk2(o[6], o[7]);
            *(v4u*)p = w;
        }
    }
    SEAM_BAR();

    {
        PHASE_PTRS();
        const attn_body::bf16* Q = (const attn_body::bf16*)PROJ; const attn_body::bf16* K = Q + 512; const attn_body::bf16* V = Q + 640; attn_body::bf16* Ob = (attn_body::bf16*)XNO;
        for (int pair = vcu; pair < 256; pair += G) { const int b = pair >> 3, h = pair & 7;
            for (int qb = 0; qb < 8; ++qb) attn_body::attn_unit<8>((long)b * S_PROMPT, S_PROMPT / 64, h, h >> 2, qb, Q, K, V, Ob, ssqA, (char*)lds); }
        for (int su = vcu; su < 256; su += G) { const int pair = su >> 3, b = pair >> 3, h = pair & 7;
            for (int k = 0; k < 2; ++k) attn_body::attn_unit<8>((long)M_PROMPT + (long)b * S_SAMPLE, S_SAMPLE / 64, h, h >> 2, (su & 7) * 2 + k, Q, K, V, Ob, ssqA, (char*)lds); }
        __syncthreads();
        LAS float* Tb = (LAS float*)(L + NA_T_OFF + wave * NA_T_BYTES);
        LAS float* wsf = (LAS float*)(L + NA_WSF_OFF + wave * 256);
        for (int e = lane; e < na_body::T_FLOATS; e += 64) Tb[e] = 0.f;
        { const float* rpb = KIN(8) + wave * 15 * 31;
          for (int e = lane; e < 15 * 31; e += 64) { const int dr = e / 31, dc = e % 31; Tb[na_body::T_GUARD + dr * 32 + dc] = rpb[e] * LOG2E; } }
        LAS unsigned char* wl = L + wave * 16384;
        const unsigned wl_addr = (unsigned)(uintptr_t)(lds + wave * 16384);
#ifdef PROBE_NAX2
        for (int rep_ = 0; rep_ < 2; ++rep_)
#endif
        for (int bu = vcu; bu < 1280; bu += G) {
            int rowbase, rows, r;
            if (bu < 1024) { rowbase = (bu >> 5) * S_PROMPT; rows = 32; r = bu & 31; } else { const int s = bu - 1024; rowbase = M_PROMPT + (s >> 6) * S_SAMPLE; rows = 64; r = s & 63; }
#ifdef PROBE_NAX2
            na_body::na_unit(ws, (unsigned)WS_PROJ, (unsigned)WS_XNO, rep_ ? (unsigned)(800 * MiB) : (unsigned)WS_SSQB, rowbase, rows, r, wave, wl, wl_addr, Tb + na_body::T_GUARD, wsf);
#else
            na_body::na_unit(ws, (unsigned)WS_PROJ, (unsigned)WS_XNO, (unsigned)WS_SSQB, rowbase, rows, r, wave, wl, wl_addr, Tb + na_body::T_GUARD, wsf);
#endif
        }
    }
    SEAM_BAR();

    {
        PHASE_PTRS(); bf16* const Wout_t = (bf16*)(ws + WS_WOUT); bf16* const H1B = (bf16*)(ws + WS_H1B); const float* const x_prompt = KIN(0); const float* const x_sample = KIN(1);
        pg8::Gemm g{XNO, Wout_t, M_ALL, DM, DM}; pg8::StaticOrder S; S.init(M_ALL, DM, G, bx);
        pg8::EpiOutProj E{x_prompt, x_sample, M_PROMPT, H1B, ssq2, ssqA, ssqB};
        pg8::gemm_phase<pg8::EpiOutProj, pg8::StaticOrder, true, true>(L, g, S, E);
    }
    SEAM_BAR();

    {
        PHASE_PTRS(); bf16* const Wup_t = (bf16*)(ws + WS_WUP); bf16* const H1B = (bf16*)(ws + WS_H1B); bf16* const ACT = (bf16*)(ws + WS_ACT);
        constexpr int NM_UP = (M_ALL + 253) / 254;
        pg8::Gemm g{H1B - DM, Wup_t, NM_UP * 256, NUP, DM, (size_t)254 * DM * 2}; pg8::StaticOrder S; S.init(NM_UP * 256, NUP, G, bx);
        pg8::EpiConvGate E{ACT, ssq2, KIN(14), KIN(15), M_ALL, DFF};
        pg8::gemm_phase<pg8::EpiConvGate, pg8::StaticOrder, true, true>(L, g, S, E);
    }
    SEAM_BAR();

    {
        PHASE_PTRS(); bf16* const ACT = (bf16*)(ws + WS_ACT); bf16* const Wdown_t = (bf16*)(ws + WS_WDOWN); bf16* const H2B = (bf16*)(ws + WS_H2B); bf16* const H1B = (bf16*)(ws + WS_H1B);
        pg8::Gemm g{ACT, Wdown_t, M_ALL, DM, DFF}; pg8::StaticOrder S; S.init(M_ALL, DM, G, bx);
        pg8::EpiResB E{H1B, H2B, ssq3};
        pg8::gemm_phase<pg8::EpiResB, pg8::StaticOrder, true, true>(L, g, S, E);
    }
    SEAM_BAR();

    {
        PHASE_PTRS(); bf16* const H2B = (bf16*)(ws + WS_H2B); bf16* const Wgate_t = (bf16*)(ws + WS_WGATE); bf16* const EB = (bf16*)(ws + WS_E); bf16* const H3B = (bf16*)(ws + WS_H3B);
        pg8::Gemm g{H2B, Wgate_t, M_ALL, DM, DM}; pg8::StaticOrder S; S.init(M_ALL, DM, G, bx);
        pg8::EpiGate E{H2B, EB, H3B, ssq3, ssq4};
        pg8::gemm_phase<pg8::EpiGate, pg8::StaticOrder, true, true>(L, g, S, E);
    }
    SEAM_BAR();

    {
        PHASE_PTRS();
        const f32x4* fg = (const f32x4*)KIN(20) + lane;
        const f32x4 g0 = fg[0], g1 = fg[64], g2 = fg[128], g3 = fg[192];
        const bf16* const H3B = (const bf16*)(ws + WS_H3B);
        for (int m = gw; m < M_ALL; m += NGW) {
            f32x4* xr = (f32x4*)(out + (size_t)m * DM) + lane;
            const v2u* hr = (const v2u*)(H3B + (size_t)m * DM) + lane;
            const v2u h0 = hr[0], h1 = hr[64], h2 = hr[128], h3 = hr[192];
            const float rs = __builtin_amdgcn_rsqf(ssq4[m] * (1.f / DM) + 1e-6f);
            xr[0] = (f32x4){bflo(h0.x), bfhi(h0.x), bflo(h0.y), bfhi(h0.y)} * rs * g0; xr[64] = (f32x4){bflo(h1.x), bfhi(h1.x), bflo(h1.y), bfhi(h1.y)} * rs * g1;
            xr[128] = (f32x4){bflo(h2.x), bfhi(h2.x), bflo(h2.y), bfhi(h2.y)} * rs * g2; xr[192] = (f32x4){bflo(h3.x), bfhi(h3.x), bflo(h3.y), bfhi(h3.y)} * rs * g3;
        }
    }
}

extern "C" void kernel_launch(void* const* d_in, const int* in_sizes, int n_in, void* d_out, int out_size, void* d_ws, size_t ws_size, hipStream_t stream) {
    static int grid = 0;
    if (grid == 0) {
        if (n_in != 21 || in_sizes[0] != M_PROMPT * DM || out_size != M_ALL * DM || ws_size < WS_END) { fprintf(stderr, "kernel_launch: unexpected shapes (n_in %d, in0 %d, out %d, ws %zu); nothing launched\n", n_in, n_in > 0 ? in_sizes[0] : -1, out_size, ws_size); grid = -1; return; }
        int dev = 0, cus = 0, per_cu = 0;
        if (hipGetDevice(&dev) != hipSuccess || hipDeviceGetAttribute(&cus, hipDeviceAttributeMultiprocessorCount, dev) != hipSuccess) { grid = -1; return; }
        if (hipFuncSetAttribute((const void*)hymba_fwd, hipFuncAttributeMaxDynamicSharedMemorySize, LDS_BYTES) != hipSuccess) { fprintf(stderr, "kernel_launch: hipFuncSetAttribute failed\n"); grid = -1; return; }
        if (hipOccupancyMaxActiveBlocksPerMultiprocessor(&per_cu, (const void*)hymba_fwd, NWAVES * 64, LDS_BYTES) != hipSuccess || per_cu < 1) { fprintf(stderr, "kernel_launch: occupancy query says %d blocks per CU\n", per_cu); (void)hipGetLastError(); }
        grid = cus;
    }
    if (grid < 0) return;
    if (hipMemsetAsync((unsigned char*)d_ws + WS_BAR, 0, BAR_BYTES, stream) != hipSuccess) { fprintf(stderr, "kernel_launch: hipMemsetAsync failed\n"); return; }
    Args a{};
    for (int i = 0; i < 21; ++i) a.in[i] = (const float*)d_in[i];
    a.out = (float*)d_out; a.ws = (unsigned char*)d_ws;
    void* kargs[] = {&a};
    const hipError_t e = hipLaunchCooperativeKernel((const void*)hymba_fwd, dim3(grid), dim3(NWAVES * 64), kargs, LDS_BYTES, stream);
    if (e != hipSuccess) fprintf(stderr, "kernel_launch: cooperative launch failed: %s (grid %d)\n", hipGetErrorString(e), grid);
}
```

```cpp
#include <hip/hip_cooperative_groups.h>
#include <hip/hip_runtime.h>
#include <cstdio>
#include <cstdint>
namespace pg8 {
#define PG8_LAS __attribute__((address_space(3)))
typedef unsigned short bf16_t;
typedef short bf16x8 __attribute__((ext_vector_type(8)));
typedef float f32x4 __attribute__((ext_vector_type(4)));
typedef unsigned u32x4 __attribute__((ext_vector_type(4)));
constexpr int BM = 256, BK = 64, HALF = 128, HTB = HALF * BK * 2  , STAGE_BYTES = 8 * HTB, NXCD = 8, WGM = 8;

__host__ __device__ __forceinline__ int lds_byte(int r, int c) { const int st = (r >> 4) * 2 + (c >> 5), rr = r & 15, cc = c & 31, ob = rr * 64 + cc * 2; return st * 1024 + (ob ^ (((ob >> 9) & 1) << 5)); }
__host__ __device__ __forceinline__ void stage_rc(int b, int& R, int& C) { const int st = b / 1024, sb = b % 1024, swz = sb ^ (((sb >> 9) & 1) << 5); R = (st >> 1) * 16 + swz / 64; C = (st & 1) * 32 + (swz % 64) / 2; }
__host__ __device__ __forceinline__ int perm32(int rho) { const int n = rho >> 4, i = rho & 15; return 8 * (i >> 2) + 4 * n + (i & 3); }

struct Unit { int pm, pn; };
struct Gemm { const bf16_t* A; const bf16_t* Bt; int M, N, K; size_t a_tstep; };

struct StaticOrder {
    int nM, nN, nwg, G, c;
    __host__ __device__ void init(int M, int N, int G_, int c_) { nM = M / BM; nN = N / BM; nwg = nM * nN; G = G_; c = c_; }
    __host__ __device__ bool next(int i, Unit& u) const {
        const long L = (long)i * G + c; if (L >= nwg) return false;
        int wgid = (int)L; { const int q = nwg / NXCD, r = nwg % NXCD, xcd = wgid % NXCD, off = wgid / NXCD; wgid = (xcd < r ? xcd * (q + 1) : r * (q + 1) + (xcd - r) * q) + off; }
        const int nig = WGM * nN, gid = wgid / nig, fm = gid * WGM, gsz = (nM - fm) < WGM ? (nM - fm) : WGM;
        u.pm = fm + ((wgid % nig) % gsz); u.pn = (wgid % nig) / gsz; return true;
    }
    __device__ __forceinline__ void a_ready(const Unit&) const {}
    __device__ __forceinline__ void done(const Unit&) const {}
};

__device__ __forceinline__ unsigned cvt_pk_bf16(float lo, float hi) { unsigned r; asm volatile("v_cvt_pk_bf16_f32 %0, %1, %2" : "=v"(r) : "v"(lo), "v"(hi)); return r; }
typedef float f32x2 __attribute__((ext_vector_type(2)));
__device__ __forceinline__ f32x2 gelu_pk(f32x2 v) {
    const f32x2 av = __builtin_elementwise_abs(v), d = av * 0.2316418882f + 1.0f;
    f32x2 t; t.x = __builtin_amdgcn_rcpf(d.x); t.y = __builtin_amdgcn_rcpf(d.y);
    f32x2 q = t * 0.5307027145f + (-0.7265760135f); q = q * t + 0.7107068705f; q = q * t + (-0.142248368f); q = q * t + 0.127414796f; q = q * t;
    const f32x2 s = (v * v) * (-0.72134752044f);
    f32x2 e; e.x = __builtin_amdgcn_exp2f(s.x); e.y = __builtin_amdgcn_exp2f(s.y);
    const f32x2 m = v * (q * e), r = v - m;
    f32x2 o; o.x = v.x < 0.f ? m.x : r.x; o.y = v.y < 0.f ? m.y : r.y; return o;
}

template <int ACT  > struct EpiBf16 {
    static constexpr bool PERM = true, AFTER_DRAIN = false, MIDSCALE = false, FULL = false; static_assert(ACT == 0 || ACT == 1, "EpiBf16: ACT is 0 (none) or 1 (gelu_pk)");
    bf16_t* O; int ldc; const float* bias; int split_cols; size_t split_stride; float scale0;
    __device__ __forceinline__ void operator()(const f32x4 (&acc)[2][2][4][2], const Unit& u, int wr, int wc, int fr, int fq) const {
        const int row0 = u.pm * BM + wr * 64 + fr; int colt = u.pn * BM; bf16_t* base = O;
        float sc = 1.f; if (split_cols) { const int t = colt / split_cols; base += (size_t)t * split_stride; colt -= t * split_cols; if (t == 0) sc = scale0; }
        const int col0 = colt + wc * 32 + 8 * fq, bcol0 = u.pn * BM + wc * 32 + 8 * fq;
        f32x4 bv[2][2];
#pragma unroll
        for (int bj = 0; bj < 2; ++bj)
#pragma unroll
            for (int n = 0; n < 2; ++n) bv[bj][n] = bias ? *(const f32x4*)(bias + bcol0 + bj * HALF + 4 * n) : (f32x4){0.f, 0.f, 0.f, 0.f};
#pragma unroll
        for (int ai = 0; ai < 2; ++ai)
#pragma unroll
            for (int m = 0; m < 4; ++m) { bf16_t* rowp = base + (size_t)(row0 + ai * HALF + m * 16) * ldc + col0;
#pragma unroll
                for (int bj = 0; bj < 2; ++bj) { f32x4 v0 = acc[ai][bj][m][0] + bv[bj][0], v1 = acc[ai][bj][m][1] + bv[bj][1];
                    if (ACT == 1) { f32x2 a = gelu_pk((f32x2){v0[0], v0[1]}), b = gelu_pk((f32x2){v0[2], v0[3]}), c = gelu_pk((f32x2){v1[0], v1[1]}), d = gelu_pk((f32x2){v1[2], v1[3]});
                        v0 = (f32x4){a.x, a.y, b.x, b.y}; v1 = (f32x4){c.x, c.y, d.x, d.y}; }
                    v0 = v0 * sc; v1 = v1 * sc; u32x4 w; w.x = cvt_pk_bf16(v0[0], v0[1]); w.y = cvt_pk_bf16(v0[2], v0[3]); w.z = cvt_pk_bf16(v1[0], v1[1]); w.w = cvt_pk_bf16(v1[2], v1[3]);
                    *(u32x4*)(rowp + bj * HALF) = w; } }
    }
};
constexpr float RMS_EPS = 1e-6f;
typedef unsigned u32x2 __attribute__((ext_vector_type(2)));
__device__ __forceinline__ float f32_atomic_add(float* p, float v) { return __hip_atomic_fetch_add(p, v, __ATOMIC_RELAXED, __HIP_MEMORY_SCOPE_AGENT); }
__device__ __forceinline__ float bf_lo(unsigned w) { return __uint_as_float(w << 16); }
__device__ __forceinline__ float bf_hi(unsigned w) { return __uint_as_float(w & 0xffff0000u); }
__device__ __forceinline__ float sumsq8(const f32x4& v0, const f32x4& v1) { return (v0[0] * v0[0] + v0[1] * v0[1]) + (v0[2] * v0[2] + v0[3] * v0[3]) + (v1[0] * v1[0] + v1[1] * v1[1]) + (v1[2] * v1[2] + v1[3] * v1[3]); }
__device__ __forceinline__ u32x4 pack8(const f32x4& v0, const f32x4& v1) { u32x4 w; w.x = cvt_pk_bf16(v0[0], v0[1]); w.y = cvt_pk_bf16(v0[2], v0[3]); w.z = cvt_pk_bf16(v1[0], v1[1]); w.w = cvt_pk_bf16(v1[2], v1[3]); return w; }
struct EpiBf16Rs {
    static constexpr bool PERM = true, AFTER_DRAIN = false, MIDSCALE = false, FULL = false;
    bf16_t* O; int ldc; const float* ssq;
    __device__ __forceinline__ void operator()(const f32x4 (&acc)[2][2][4][2], const Unit& u, int wr, int wc, int fr, int fq) const {
        const int row0 = u.pm * BM + wr * 64 + fr, col0 = u.pn * BM + wc * 32 + 8 * fq;
#pragma unroll
        for (int ai = 0; ai < 2; ++ai)
#pragma unroll
            for (int m = 0; m < 4; ++m) { const int row = row0 + ai * HALF + m * 16; bf16_t* rowp = O + (size_t)row * ldc + col0;
                const float rs = ssq ? __builtin_amdgcn_rsqf(ssq[row] * (1.0f / 1024.0f) + RMS_EPS) : 1.0f;
#pragma unroll
                for (int bj = 0; bj < 2; ++bj) *(u32x4*)(rowp + bj * HALF) = pack8(acc[ai][bj][m][0] * rs, acc[ai][bj][m][1] * rs); }
    }
};
struct EpiOutProj {
    static constexpr bool PERM = true, AFTER_DRAIN = false, MIDSCALE = true, FULL = false;
    const float* base0; const float* base1; int split;
    bf16_t* hb; float* ssq; const float* ssqA; const float* ssqB;
    __device__ __forceinline__ void prep(PG8_LAS unsigned char* lds, int tid, const Unit& u, int wr, int fr) const {
        const int row0 = u.pm * BM + wr * 64 + fr; PG8_LAS f32x4* slot = (PG8_LAS f32x4*)(lds + STAGE_BYTES) + tid * 2;
#pragma unroll
        for (int ai = 0; ai < 2; ++ai) { f32x4 q;
#pragma unroll
            for (int m = 0; m < 4; ++m) { const int row = row0 + ai * HALF + m * 16;
                q[m] = __builtin_amdgcn_rsqf(ssqA[row] * (1.0f / 512.0f) + RMS_EPS) * __builtin_amdgcn_sqrtf(ssqB[row] * (1.0f / 512.0f) + RMS_EPS); }
            slot[ai] = q; }
    }
    __device__ __forceinline__ void midscale(f32x4 (&acc)[2][2][4][2], PG8_LAS unsigned char* lds, int tid) const {
        const PG8_LAS f32x4* slot = (const PG8_LAS f32x4*)(lds + STAGE_BYTES) + tid * 2;
#pragma unroll
        for (int ai = 0; ai < 2; ++ai) { const f32x4 q = slot[ai];
#pragma unroll
            for (int bj = 0; bj < 2; ++bj)
#pragma unroll
                for (int m = 0; m < 4; ++m)
#pragma unroll
                    for (int n = 0; n < 2; ++n) acc[ai][bj][m][n] *= q[m]; }
    }
    __device__ __forceinline__ void operator()(const f32x4 (&acc)[2][2][4][2], const Unit& u, int wr, int wc, int fr, int fq) const {
        const int row0 = u.pm * BM + wr * 64 + fr, col0 = u.pn * BM + wc * 32 + 8 * fq;
#pragma unroll
        for (int ai = 0; ai < 2; ++ai)
#pragma unroll
            for (int m = 0; m < 4; ++m) { const int row = row0 + ai * HALF + m * 16;
                const float* bp = (row < split ? base0 + (size_t)row * 1024 : base1 + (size_t)(row - split) * 1024) + col0;
                bf16_t* hp = hb + (size_t)row * 1024 + col0; float s = 0.f;
                const float rb = __builtin_amdgcn_rsqf(ssqB[row] * (1.0f / 512.0f) + RMS_EPS);
#pragma unroll
                for (int bj = 0; bj < 2; ++bj) { const f32x4 b0 = *(const f32x4*)(bp + bj * HALF), b1 = *(const f32x4*)(bp + bj * HALF + 4);
                    const f32x4 v0 = acc[ai][bj][m][0] * rb + b0, v1 = acc[ai][bj][m][1] * rb + b1;
                    *(u32x4*)(hp + bj * HALF) = pack8(v0, v1); s += sumsq8(v0, v1); }
                s += __shfl_xor(s, 16); s += __shfl_xor(s, 32);
                if (fq == 0) f32_atomic_add(ssq + row, s); }
    }
};
struct EpiResB {
    static constexpr bool PERM = true, AFTER_DRAIN = false, MIDSCALE = false, FULL = false;
    const bf16_t* hin; bf16_t* hout; float* ssq;
    __device__ __forceinline__ void operator()(const f32x4 (&acc)[2][2][4][2], const Unit& u, int wr, int wc, int fr, int fq) const {
        const int row0 = u.pm * BM + wr * 64 + fr, col0 = u.pn * BM + wc * 32 + 8 * fq;
#pragma unroll
        for (int ai = 0; ai < 2; ++ai)
#pragma unroll
            for (int m = 0; m < 4; ++m) { const int row = row0 + ai * HALF + m * 16;
                const bf16_t* bp = hin + (size_t)row * 1024 + col0; bf16_t* hp = hout + (size_t)row * 1024 + col0; float s = 0.f;
#pragma unroll
                for (int bj = 0; bj < 2; ++bj) { const u32x4 bw = *(const u32x4*)(bp + bj * HALF);
                    const f32x4 v0 = acc[ai][bj][m][0] + (f32x4){bf_lo(bw.x), bf_hi(bw.x), bf_lo(bw.y), bf_hi(bw.y)}, v1 = acc[ai][bj][m][1] + (f32x4){bf_lo(bw.z), bf_hi(bw.z), bf_lo(bw.w), bf_hi(bw.w)};
                    *(u32x4*)(hp + bj * HALF) = pack8(v0, v1); s += sumsq8(v0, v1); }
                s += __shfl_xor(s, 16); s += __shfl_xor(s, 32);
                if (fq == 0) f32_atomic_add(ssq + row, s); }
    }
};
struct EpiGate {
    static constexpr bool PERM = true, AFTER_DRAIN = false, MIDSCALE = false, FULL = false;
    const bf16_t* hin; const bf16_t* E; bf16_t* hout; const float* ssq_in; float* ssq_out;
    __device__ __forceinline__ void operator()(const f32x4 (&acc)[2][2][4][2], const Unit& u, int wr, int wc, int fr, int fq) const {
        const int row0 = u.pm * BM + wr * 64 + fr, col0 = u.pn * BM + wc * 32 + 8 * fq;
#pragma unroll
        for (int ai = 0; ai < 2; ++ai)
#pragma unroll
            for (int m = 0; m < 4; ++m) { const int row = row0 + ai * HALF + m * 16;
                const bf16_t* bp = hin + (size_t)row * 1024 + col0; const bf16_t* ep = E + (size_t)row * 1024 + col0; bf16_t* hp = hout + (size_t)row * 1024 + col0; float s = 0.f;
                const float rs = __builtin_amdgcn_rsqf(ssq_in[row] * (1.0f / 1024.0f) + RMS_EPS) * -1.4426950408889634f;
#pragma unroll
                for (int bj = 0; bj < 2; ++bj) { const u32x4 bw = *(const u32x4*)(bp + bj * HALF), ew = *(const u32x4*)(ep + bj * HALF);
                    const f32x4 b0 = (f32x4){bf_lo(bw.x), bf_hi(bw.x), bf_lo(bw.y), bf_hi(bw.y)}, b1 = (f32x4){bf_lo(bw.z), bf_hi(bw.z), bf_lo(bw.w), bf_hi(bw.w)};
                    const f32x4 e0 = (f32x4){bf_lo(ew.x), bf_hi(ew.x), bf_lo(ew.y), bf_hi(ew.y)}, e1 = (f32x4){bf_lo(ew.z), bf_hi(ew.z), bf_lo(ew.w), bf_hi(ew.w)};
                    f32x4 v0, v1;
#pragma unroll
                    for (int k = 0; k < 4; ++k) { const float g0 = __builtin_amdgcn_rcpf(1.0f + __builtin_amdgcn_exp2f(acc[ai][bj][m][0][k] * rs)), g1 = __builtin_amdgcn_rcpf(1.0f + __builtin_amdgcn_exp2f(acc[ai][bj][m][1][k] * rs));
                        v0[k] = b0[k] + g0 * e0[k]; v1[k] = b1[k] + g1 * e1[k]; }
                    *(u32x4*)(hp + bj * HALF) = pack8(v0, v1); s += sumsq8(v0, v1); }
                s += __shfl_xor(s, 16); s += __shfl_xor(s, 32);
                if (fq == 0) f32_atomic_add(ssq_out + row, s); }
    }
};

#define PG8_DPPF(oldv, srcv, ctrl, bc) __builtin_bit_cast(float, __builtin_amdgcn_update_dpp(__builtin_bit_cast(int, (float)(oldv)), __builtin_bit_cast(int, (float)(srcv)), (ctrl), 0xf, 0xf, (bc)))
struct EpiConvGate {
    static constexpr bool PERM = true, AFTER_DRAIN = false, MIDSCALE = false, FULL = true;
    bf16_t* ACT; const float* ssq; const float* cw; const float* cb; int Mrows; int dff;
    template <bool MASKED> __device__ __forceinline__ void conv(const f32x4 (&acc)[2][2][4][2], const PG8_LAS float* X, int wr, int rbase, int gbase, int col, int cbase, unsigned voff) const {
#pragma unroll
        for (int n = 0; n < 2; ++n) {
            f32x4 w[2][4];
#pragma unroll
            for (int bj = 0; bj < 2; ++bj) {
#pragma unroll
                for (int k = 0; k < 3; ++k) w[bj][k] = *(const f32x4*)((const char*)(cw + (size_t)k * 2 * dff + bj * dff + 4 * n) + voff);
                w[bj][3] = *(const f32x4*)((const char*)(cb + bj * dff + 4 * n) + voff); }
#pragma unroll
            for (int ai = 0; ai < 2; ++ai) { const int sg = 2 * ai + wr; const int slotP = (sg > 0) ? (sg - 1) * 2 + 1 : 8, slotN = (sg < 3) ? (sg + 1) * 2 : 8;
                f32x4 saved[2], haloN[2];
#pragma unroll
                for (int bj = 0; bj < 2; ++bj) { saved[bj] = *(const PG8_LAS f32x4*)(X + slotP * 256 + bj * HALF + col + 4 * n); haloN[bj] = *(const PG8_LAS f32x4*)(X + slotN * 256 + bj * HALF + col + 4 * n); }
#pragma unroll
                for (int m = 0; m < 4; ++m) { const int r = rbase + ai * HALF + m * 16, g = gbase + r;
                    float hp = 1.f, hn = 1.f;
                    if constexpr (MASKED) { const int S = (g < 65536) ? 2048 : 4096; const int t = g & (S - 1); hp = (t != 0) ? 1.f : 0.f; hn = (t != S - 1) ? 1.f : 0.f; }
                    f32x4 y[2];
#pragma unroll
                    for (int bj = 0; bj < 2; ++bj) { const f32x4 cur = acc[ai][bj][m][n]; const f32x4 nx = (m < 3) ? acc[ai][bj][m < 3 ? m + 1 : 3][n] : haloN[bj];
#pragma unroll
                        for (int i = 0; i < 4; ++i) {
                            float pin = PG8_DPPF(PG8_DPPF(0.f, saved[bj][i], 0x121, true), cur[i], 0x111, false);
                            float nin = PG8_DPPF(PG8_DPPF(0.f, nx[i], 0x12f, true), cur[i], 0x101, false);
                            if constexpr (MASKED) { pin *= hp; nin *= hn; }
                            y[bj][i] = (w[bj][1][i] * cur[i] + w[bj][3][i]) + (w[bj][0][i] * pin + w[bj][2][i] * nin); }
                        saved[bj] = cur; }
                    float o[4];
#pragma unroll
                    for (int i = 0; i < 4; ++i) { const float a = y[0][i], gg = y[1][i];
                        const float z = -2.302208198f * (gg + 0.044715f * gg * gg * gg);
                        o[i] = a * gg * __builtin_amdgcn_rcpf(1.0f + __builtin_amdgcn_exp2f(z)); }
                    u32x2 pk; pk.x = cvt_pk_bf16(o[0], o[1]); pk.y = cvt_pk_bf16(o[2], o[3]);
                    if (r >= 1 && r <= 254 && g < Mrows) *(u32x2*)(ACT + (size_t)g * dff + cbase + 4 * n) = pk;
                    __builtin_amdgcn_sched_barrier(0); } } }
    }
    __device__ __forceinline__ void full(f32x4 (&acc)[2][2][4][2], const Unit& u, int wr_, int wc_, int fr_, int fq_, PG8_LAS unsigned char* lds, int tid_) const {
        int tid = tid_; asm volatile("" : "+v"(tid));
        const int wid = __builtin_amdgcn_readfirstlane(tid >> 6), lane = tid & 63, wr = wid >> 2, wc = wid & 3, fr = lane & 15, fq = lane >> 4; (void)wr_; (void)wc_; (void)fr_; (void)fq_;
        const int gbase = u.pm * 254 - 1, rbase = wr * 64 + fr, col = wc * 32 + 8 * fq, cbase = u.pn * HALF + col;
        const unsigned voff = (unsigned)cbase * 4u;
        PG8_LAS float* X = (PG8_LAS float*)(lds + STAGE_BYTES);
#pragma unroll
        for (int ai = 0; ai < 2; ++ai)
#pragma unroll
            for (int m = 0; m < 4; ++m) { const int g = gbase + rbase + ai * HALF + m * 16; const int gc = g < 0 ? 0 : (g >= Mrows ? Mrows - 1 : g);
                const float rs = __builtin_amdgcn_rsqf(ssq[gc] * (1.0f / 1024.0f) + RMS_EPS);
#pragma unroll
                for (int bj = 0; bj < 2; ++bj)
#pragma unroll
                    for (int n = 0; n < 2; ++n) { acc[ai][bj][m][n] *= rs; asm volatile("" : "+v"(acc[ai][bj][m][n])); }
                __builtin_amdgcn_sched_barrier(0); }
        if (tid < 64) *(PG8_LAS f32x4*)(X + 8 * 256 + tid * 4) = (f32x4){0.f, 0.f, 0.f, 0.f};
        if (fr == 0) {
#pragma unroll
            for (int ai = 0; ai < 2; ++ai)
#pragma unroll
                for (int bj = 0; bj < 2; ++bj)
#pragma unroll
                    for (int n = 0; n < 2; ++n) *(PG8_LAS f32x4*)(X + ((2 * ai + wr) * 2 + 0) * 256 + bj * HALF + col + 4 * n) = acc[ai][bj][0][n]; }
        if (fr == 15) {
#pragma unroll
            for (int ai = 0; ai < 2; ++ai)
#pragma unroll
                for (int bj = 0; bj < 2; ++bj)
#pragma unroll
                    for (int n = 0; n < 2; ++n) *(PG8_LAS f32x4*)(X + ((2 * ai + wr) * 2 + 1) * 256 + bj * HALF + col + 4 * n) = acc[ai][bj][3][n]; }
        asm volatile("s_waitcnt lgkmcnt(0)" ::: "memory"); __builtin_amdgcn_s_barrier(); asm volatile("" ::: "memory");
        const bool boundary = ((gbase + 256) >> 11) != (gbase >> 11);
        (void)boundary; conv<true>(acc, X, wr, rbase, gbase, col, cbase, voff);
    }
};

template <class Epi, class Sched, bool ALIGN_EPI = false, bool SP2 = false>
__device__ __forceinline__ void gemm_phase(PG8_LAS unsigned char* lds, const Gemm g, const Sched& S, const Epi& E) {
    int tid = threadIdx.x; asm volatile("" : "+v"(tid));
    const int wid = __builtin_amdgcn_readfirstlane(tid >> 6), lane = tid & 63, wr = wid >> 2, wc = wid & 3, fr = lane & 15, fq = lane >> 4;
    const int K = g.K, nt = K / BK;
    unsigned voffA[2], voffB[2];
#pragma unroll
    for (int i = 0; i < 2; ++i) { int R, C; stage_rc(tid * 16 + i * 8192, R, C); const int Rb = Epi::PERM ? ((R & ~31) + perm32(R & 31)) : R;
        voffA[i] = (unsigned)(R * K + C) * 2u; voffB[i] = (unsigned)(Rb * K + C) * 2u; }
    const size_t kstep = (size_t)(BK * 2);
    const size_t hstep = (size_t)HALF * K * 2;
    const size_t tstep = 2 * hstep;
    const size_t tstepA = g.a_tstep ? g.a_tstep : tstep;
    const unsigned ldsw = (unsigned)wid * 1024u;
    const int aoff = lds_byte(wr * 64 + fr, fq * 8), boff = lds_byte(wc * 32 + fr, fq * 8);
#define PG8_SA(b, h) (((b) * 2 + (h)) * HTB)
#define PG8_SB(b, h) ((4 + (b) * 2 + (h)) * HTB)
#define PG8_STAGE(bufoff, gbase, voff) do { _Pragma("unroll") for (int _i = 0; _i < 2; ++_i) \
        __builtin_amdgcn_global_load_lds((const unsigned*)((const char*)(gbase) + (voff)[_i]), (PG8_LAS unsigned*)(lds + (bufoff) + ldsw + _i * 8192), 16, 0, 0); } while (0)
#define PG8_LDA(dst, b, h) do { _Pragma("unroll") for (int m = 0; m < 4; ++m) _Pragma("unroll") for (int k = 0; k < 2; ++k) dst[m][k] = *(const PG8_LAS bf16x8*)(lds + PG8_SA(b, h) + aoff + m * 2048 + k * 1024); } while (0)
#define PG8_LDB(dst, b, h) do { _Pragma("unroll") for (int n = 0; n < 2; ++n) _Pragma("unroll") for (int k = 0; k < 2; ++k) dst[n][k] = *(const PG8_LAS bf16x8*)(lds + PG8_SB(b, h) + boff + n * 2048 + k * 1024); } while (0)
#define PG8_MMA(ai, bj, At, Bt) do { __builtin_amdgcn_s_setprio(1); _Pragma("unroll") for (int m = 0; m < 4; ++m) _Pragma("unroll") for (int n = 0; n < 2; ++n) _Pragma("unroll") for (int k = 0; k < 2; ++k) \
        acc[ai][bj][m][n] = __builtin_amdgcn_mfma_f32_16x16x32_bf16(Bt[n][k], At[m][k], acc[ai][bj][m][n], 0, 0, 0); __builtin_amdgcn_s_setprio(0); } while (0)
#define PG8_WAIT_V(n) asm volatile("s_waitcnt vmcnt(" #n ")" ::: "memory")
#define PG8_WAIT_L(n) asm volatile("s_waitcnt lgkmcnt(" #n ")" ::: "memory")
#define PG8_BAR __builtin_amdgcn_s_barrier()
#define PG8_SCHED __builtin_amdgcn_sched_barrier(0)
    Unit cur, nxt; int ui = 0;
    if (!S.next(0, cur)) return;
    f32x4 acc[2][2][4][2];
#pragma unroll
    for (int a = 0; a < 2; ++a)
#pragma unroll
        for (int b = 0; b < 2; ++b)
#pragma unroll
            for (int m = 0; m < 4; ++m)
#pragma unroll
                for (int n = 0; n < 2; ++n) acc[a][b][m][n] = (f32x4){0.f, 0.f, 0.f, 0.f};
    bf16x8 At[4][2], B0[2][2], B1[2][2];
    const char* cA = (const char*)g.A + (size_t)cur.pm * tstepA; const char* cB = (const char*)g.Bt + (size_t)cur.pn * tstep;
    S.a_ready(cur);
    if constexpr (Epi::MIDSCALE) E.prep(lds, tid, cur, wr, fr);
    if constexpr (SP2) {
        PG8_STAGE(PG8_SB(0, 0), cB, voffB); PG8_STAGE(PG8_SB(0, 1), cB + hstep, voffB); PG8_STAGE(PG8_SA(0, 0), cA, voffA); PG8_STAGE(PG8_SA(0, 1), cA + hstep, voffA);
        if (wr == 1) PG8_BAR;
        PG8_WAIT_V(2); PG8_BAR;
        PG8_STAGE(PG8_SB(1, 0), cB + kstep, voffB); PG8_STAGE(PG8_SA(1, 0), cA + kstep, voffA); PG8_STAGE(PG8_SB(1, 1), cB + hstep + kstep, voffB);
        PG8_WAIT_V(6); PG8_BAR;
    } else {
        PG8_STAGE(PG8_SB(0, 0), cB, voffB); PG8_STAGE(PG8_SA(0, 0), cA, voffA); PG8_STAGE(PG8_SB(0, 1), cB + hstep, voffB); PG8_STAGE(PG8_SA(0, 1), cA + hstep, voffA);
        if (wr == 1) PG8_BAR;
        PG8_WAIT_V(4); PG8_BAR;
        PG8_STAGE(PG8_SB(1, 0), cB + kstep, voffB); PG8_STAGE(PG8_SA(1, 0), cA + kstep, voffA); PG8_STAGE(PG8_SB(1, 1), cB + hstep + kstep, voffB);
        PG8_WAIT_V(6); PG8_BAR;
    }
    for (;;) {
        const bool has_next = S.next(ui + 1, nxt);
        const char* nA = has_next ? (const char*)g.A + (size_t)nxt.pm * tstepA : cA; const char* nB = has_next ? (const char*)g.Bt + (size_t)nxt.pn * tstep : cB;
        for (int t = 0; t < nt; t += 2) {
            if constexpr (Epi::MIDSCALE) { if (t == (nt >> 1)) E.midscale(acc, lds, tid); }
            const bool last = (t == nt - 2);
            const char* a1 = cA + (size_t)(t + 1) * kstep;
            const char* a2 = last ? nA : cA + (size_t)(t + 2) * kstep; const char* b2 = last ? nB : cB + (size_t)(t + 2) * kstep;
            const char* a3 = a2 + kstep; const char* b3 = b2 + kstep;
            if (last && has_next) S.a_ready(nxt);
            if constexpr (SP2) {
            PG8_LDB(B0, 0, 0); PG8_LDB(B1, 0, 1); PG8_SCHED; PG8_LDA(At, 0, 0); PG8_STAGE(PG8_SA(1, 1), a1 + hstep, voffA);
            PG8_WAIT_V(8); PG8_WAIT_L(0); PG8_BAR; PG8_MMA(0, 0, At, B0); PG8_MMA(0, 1, At, B1); PG8_BAR; PG8_SCHED;
            PG8_LDA(At, 0, 1); PG8_STAGE(PG8_SB(0, 0), b2, voffB); PG8_STAGE(PG8_SB(0, 1), b2 + hstep, voffB); PG8_STAGE(PG8_SA(0, 0), a2, voffA);
            PG8_WAIT_V(8); PG8_WAIT_L(0); PG8_BAR; PG8_MMA(1, 0, At, B0); PG8_MMA(1, 1, At, B1); PG8_BAR; PG8_SCHED;
            PG8_LDB(B0, 1, 0); PG8_LDB(B1, 1, 1); PG8_SCHED; PG8_LDA(At, 1, 0); PG8_STAGE(PG8_SA(0, 1), a2 + hstep, voffA);
            PG8_WAIT_V(8); PG8_WAIT_L(0); PG8_BAR; PG8_MMA(0, 0, At, B0); PG8_MMA(0, 1, At, B1); PG8_BAR; PG8_SCHED;
            PG8_LDA(At, 1, 1); PG8_STAGE(PG8_SB(1, 0), b3, voffB); PG8_STAGE(PG8_SB(1, 1), b3 + hstep, voffB); PG8_STAGE(PG8_SA(1, 0), a3, voffA);
            PG8_WAIT_V(8); PG8_WAIT_L(0); PG8_BAR; PG8_MMA(1, 0, At, B0); PG8_MMA(1, 1, At, B1); PG8_BAR; PG8_SCHED;
            } else {
            PG8_LDB(B0, 0, 0); PG8_SCHED; PG8_LDA(At, 0, 0); PG8_STAGE(PG8_SA(1, 1), a1 + hstep, voffA);
            PG8_WAIT_L(8); PG8_BAR; PG8_WAIT_L(0); PG8_MMA(0, 0, At, B0); PG8_BAR; PG8_SCHED;
            PG8_LDB(B1, 0, 1); PG8_STAGE(PG8_SB(0, 0), b2, voffB);
            PG8_BAR; PG8_WAIT_L(0); PG8_MMA(0, 1, At, B1); PG8_BAR;
            PG8_LDA(At, 0, 1); PG8_STAGE(PG8_SA(0, 0), a2, voffA);
            PG8_BAR; PG8_WAIT_L(0); PG8_MMA(1, 0, At, B0); PG8_BAR; PG8_SCHED;
            PG8_STAGE(PG8_SB(0, 1), b2 + hstep, voffB);
            PG8_WAIT_V(6); PG8_BAR; PG8_MMA(1, 1, At, B1); PG8_BAR;
            PG8_LDB(B0, 1, 0); PG8_SCHED; PG8_LDA(At, 1, 0); PG8_STAGE(PG8_SA(0, 1), a2 + hstep, voffA);
            PG8_WAIT_L(8); PG8_BAR; PG8_WAIT_L(0); PG8_MMA(0, 0, At, B0); PG8_BAR; PG8_SCHED;
            PG8_LDB(B1, 1, 1); PG8_STAGE(PG8_SB(1, 0), b3, voffB);
            PG8_BAR; PG8_WAIT_L(0); PG8_MMA(0, 1, At, B1); PG8_BAR;
            PG8_LDA(At, 1, 1); PG8_STAGE(PG8_SA(1, 0), a3, voffA);
            PG8_BAR; PG8_WAIT_L(0); PG8_MMA(1, 0, At, B0); PG8_BAR; PG8_SCHED;
            PG8_STAGE(PG8_SB(1, 1), b3 + hstep, voffB);
            PG8_WAIT_V(6); PG8_BAR; PG8_MMA(1, 1, At, B1); PG8_BAR;
            }
        }
        if constexpr (ALIGN_EPI) { if (wr == 0) PG8_BAR; }
        if constexpr (Epi::FULL) { E.full(acc, cur, wr, wc, fr, fq, lds, tid); S.done(cur); } else if constexpr (!Epi::AFTER_DRAIN) { E(acc, cur, wr, wc, fr, fq); S.done(cur); }
        if (!has_next) break;
#pragma unroll
        for (int a = 0; a < 2; ++a)
#pragma unroll
            for (int b = 0; b < 2; ++b)
#pragma unroll
                for (int m = 0; m < 4; ++m)
#pragma unroll
                    for (int n = 0; n < 2; ++n) acc[a][b][m][n] = (f32x4){0.f, 0.f, 0.f, 0.f};
        cur = nxt; cA = nA; cB = nB; ++ui;
        if constexpr (Epi::MIDSCALE) E.prep(lds, tid, cur, wr, fr);
        if constexpr (ALIGN_EPI) { if (wr == 1) PG8_BAR; }
    }
    PG8_WAIT_V(0);
    if constexpr (!ALIGN_EPI) { if (wr == 0) PG8_BAR; }
    PG8_BAR;
    if constexpr (Epi::AFTER_DRAIN) { E.fused(acc, cur, wr, wc, fr, fq, lds, wid, lane); S.done(cur); }
#undef PG8_SA
#undef PG8_SB
#undef PG8_STAGE
#undef PG8_LDA
#undef PG8_LDB
#undef PG8_MMA
#undef PG8_WAIT_V
#undef PG8_WAIT_L
#undef PG8_BAR
#undef PG8_SCHED
}
}
#include <hip/hip_bf16.h>
#include <cmath>
namespace attn_body {
using bf16=__hip_bfloat16;
using bf16x8=__attribute__((ext_vector_type(8)))short;
using s16x4=__attribute__((ext_vector_type(4)))short;
using f32x16=__attribute__((ext_vector_type(16)))float;
using u32x4=__attribute__((ext_vector_type(4)))unsigned;
constexpr int D=64,PQ=2304,PO=1024;
constexpr int NW=8,QBLK=32,QB=QBLK*NW,KVBLK=64;
__device__ __forceinline__ int crow(int r,int hi){return (r&3)+8*(r>>2)+4*hi;}
#define SBAR() __builtin_amdgcn_sched_barrier(0)
__device__ __forceinline__ void cmask(f32x16&p0,f32x16&p1,int jb,int qrel,int hi){
  const float NEG=-INFINITY; int kb=64*jb+4*hi;
  #pragma unroll
  for(int r=0;r<16;++r){int kv=kb+(r&3)+8*(r>>2); if(kv>qrel)p0[r]=NEG; if(kv+32>qrel)p1[r]=NEG;}
}

constexpr int NSLOT=3, SLOTB=8192;
constexpr int LDS_K=0, LDS_V=NSLOT*SLOTB, LDS_WS=2*NSLOT*SLOTB, LDS_OST=LDS_WS+NW*64*4, LDS_BYTES=LDS_OST+NW*4096;
constexpr float C2=0.125f*1.4426950408889634f;
__device__ __forceinline__ void glds16(const void*gsrc,unsigned lds_dst){unsigned keep;
  asm volatile("s_mov_b32 %0, m0\n\ts_mov_b32 m0, %2\n\ts_nop 0\n\tglobal_load_lds_dwordx4 %1, off\n\ts_mov_b32 m0, %0":"=&s"(keep):"v"(gsrc),"s"(lds_dst):"memory");}
#define ATT_DPPF(srcv, ctrl) __builtin_bit_cast(float, __builtin_amdgcn_update_dpp(0, __builtin_bit_cast(int, (float)(srcv)), (ctrl), 0xf, 0xf, true))
__device__ __forceinline__ float sum8(float x){ x+=ATT_DPPF(x,0xB1); x+=ATT_DPPF(x,0x4E); x+=ATT_DPPF(x,0x141); return x; }
__device__ __forceinline__ float xsum32(float x){ auto rr=__builtin_amdgcn_permlane32_swap(__float_as_uint(x),__float_as_uint(x),false,false); return __uint_as_float(rr[0])+__uint_as_float(rr[1]); }
__device__ __forceinline__ float xmax32(float x){ auto rr=__builtin_amdgcn_permlane32_swap(__float_as_uint(x),__float_as_uint(x),false,false); return __builtin_fmaxf(__uint_as_float(rr[0]),__uint_as_float(rr[1])); }
__device__ __forceinline__ float max3f(float a,float b,float c){float r;asm("v_max3_f32 %0, %1, %2, %3":"=v"(r):"v"(a),"v"(b),"v"(c));return r;}
__device__ __forceinline__ float max2f(float a,float b){float r;asm("v_max_f32_e32 %0, %1, %2":"=v"(r):"v"(a),"v"(b));return r;}
__device__ __forceinline__ float fadd_s(float a,float b){float r;asm("v_add_f32_e32 %0, %1, %2":"=v"(r):"v"(a),"v"(b));return r;}
__device__ __forceinline__ float fsub_s(float a,float b){float r;asm("v_sub_f32_e32 %0, %1, %2":"=v"(r):"v"(a),"v"(b));return r;}
typedef float f32x2_t __attribute__((ext_vector_type(2))); typedef __bf16 bf16x2_t __attribute__((ext_vector_type(2)));
__device__ __forceinline__ unsigned cvtpk_s(float lo,float hi){f32x2_t v={lo,hi};bf16x2_t b=__builtin_convertvector(v,bf16x2_t);return __builtin_bit_cast(unsigned,b);}
#define WAIT_BAR(N) asm volatile("s_waitcnt vmcnt(" #N ") lgkmcnt(0)\n\ts_barrier":::"memory")

__device__ __forceinline__ void qkt(f32x16&p0,f32x16&p1,const char*Kslot,const bf16x8*qr,const f32x16&negm,int r32,int hi){
  const char*kb=Kslot+hi*1024+r32*16;
  #pragma unroll
  for(int d0=0;d0<4;++d0){
    const bf16x8 b0=*reinterpret_cast<const bf16x8*>(kb+d0*2048);
    const bf16x8 b1=*reinterpret_cast<const bf16x8*>(kb+d0*2048+512);
    if(d0==0){p0=__builtin_amdgcn_mfma_f32_32x32x16_bf16(b0,qr[0],negm,0,0,0);p1=__builtin_amdgcn_mfma_f32_32x32x16_bf16(b1,qr[0],negm,0,0,0);}
    else{p0=__builtin_amdgcn_mfma_f32_32x32x16_bf16(b0,qr[d0],p0,0,0,0);p1=__builtin_amdgcn_mfma_f32_32x32x16_bf16(b1,qr[d0],p1,0,0,0);}}
}
typedef __attribute__((address_space(3))) const char* lds_cptr;
typedef short v4i16_t __attribute__((ext_vector_type(4)));
__device__ __forceinline__ void kload8(bf16x8*kf,lds_cptr kp){
  kf[0]=*(const __attribute__((address_space(3))) bf16x8*)(kp);      kf[1]=*(const __attribute__((address_space(3))) bf16x8*)(kp+512);
  kf[2]=*(const __attribute__((address_space(3))) bf16x8*)(kp+2048); kf[3]=*(const __attribute__((address_space(3))) bf16x8*)(kp+2560);
  kf[4]=*(const __attribute__((address_space(3))) bf16x8*)(kp+4096); kf[5]=*(const __attribute__((address_space(3))) bf16x8*)(kp+4608);
  kf[6]=*(const __attribute__((address_space(3))) bf16x8*)(kp+6144); kf[7]=*(const __attribute__((address_space(3))) bf16x8*)(kp+6656);
}
__device__ __forceinline__ void kload2(bf16x8*kf,lds_cptr kp,int j){ kf[2*j]=*(const __attribute__((address_space(3))) bf16x8*)(kp+j*2048); kf[2*j+1]=*(const __attribute__((address_space(3))) bf16x8*)(kp+j*2048+512); }
__device__ __forceinline__ s16x4 vtr(lds_cptr p){ return __builtin_bit_cast(s16x4,__builtin_amdgcn_ds_read_tr16_b64_v4i16((__attribute__((address_space(3))) v4i16_t*)p)); }
__device__ __forceinline__ float rowmax(const f32x16&p0,const f32x16&p1){
  float a=max3f(p0[0],p0[1],p1[0]),b=max3f(p0[2],p0[3],p1[1]);a=max3f(a,p1[2],p1[3]);
  #pragma unroll
  for(int r=4;r<16;r+=4){a=max3f(a,p0[r],p0[r+1]);b=max3f(b,p0[r+2],p0[r+3]);a=max3f(a,p1[r],p1[r+1]);b=max3f(b,p1[r+2],p1[r+3]);}
  const float m=max2f(a,b);
  auto rr=__builtin_amdgcn_permlane32_swap(__float_as_uint(m),__float_as_uint(m),false,false);
  return max2f(__uint_as_float(rr[0]),__uint_as_float(rr[1]));
}
__device__ __forceinline__ void pv(f32x16*o,int vb,bf16x8 pa0,bf16x8 pa1,bf16x8 pa2,bf16x8 pa3){
  #pragma unroll
  for(int d0=0;d0<2;++d0){s16x4 lo[4],hi[4];
    #pragma unroll
    for(int ks=0;ks<4;++ks){
      asm volatile("ds_read_b64_tr_b16 %0,%1 offset:%c2":"=&v"(lo[ks]):"v"(vb),"i"(d0*4096+ks*1024):"memory");
      asm volatile("ds_read_b64_tr_b16 %0,%1 offset:%c2":"=&v"(hi[ks]):"v"(vb),"i"(d0*4096+ks*1024+512):"memory");}
    asm volatile("s_waitcnt lgkmcnt(0)":::"memory");SBAR();
    #define PK(k) (bf16x8){lo[k][0],lo[k][1],lo[k][2],lo[k][3],hi[k][0],hi[k][1],hi[k][2],hi[k][3]}
    o[d0]=__builtin_amdgcn_mfma_f32_32x32x16_bf16(pa0,PK(0),o[d0],0,0,0);
    o[d0]=__builtin_amdgcn_mfma_f32_32x32x16_bf16(pa1,PK(1),o[d0],0,0,0);
    o[d0]=__builtin_amdgcn_mfma_f32_32x32x16_bf16(pa2,PK(2),o[d0],0,0,0);
    o[d0]=__builtin_amdgcn_mfma_f32_32x32x16_bf16(pa3,PK(3),o[d0],0,0,0);
    #undef PK
  }
}

#ifndef ATTN_STORE16
#define ATTN_STORE16(p,v) (*(u32x4*)(p)=(v))
#endif
template<int THRL> __device__ __forceinline__ void attn_unit(long rowbase,int NT,int h,int kvh,int qb,const bf16*Q,const bf16*__restrict__ K,const bf16*__restrict__ V,bf16*O,float*ssq,char*shm){
  int tid=threadIdx.x; asm volatile("":"+v"(tid)); const int lane=tid&63,r32=lane&31,hi=lane>>5; const int wid=__builtin_amdgcn_readfirstlane(tid>>6);
  const int q0=qb*QB;
  const bf16*Qw=Q+(rowbase+q0+wid*QBLK)*PQ+h*D;
  const bf16*Kh=K+rowbase*PQ+kvh*D,*Vh=V+rowbase*PQ+kvh*D;
  const unsigned lds0=(unsigned)(uintptr_t)shm;
  float*wsf=(float*)(shm+LDS_WS)+wid*64;
  const bf16*ksrc=Kh+(long)lane*PQ+wid*8;
  const bf16*vsrc=Vh+(long)(16*(wid&3)+(lane>>2))*PQ+(wid>>2)*32+(lane&3)*8;
  const unsigned kdst=lds0+LDS_K+wid*1024, vdst=lds0+LDS_V+wid*1024;
  #define DMA_K(t,slot) glds16(ksrc+(long)(t)*KVBLK*PQ,(unsigned)__builtin_amdgcn_readfirstlane(kdst+(slot)))
  #define DMA_V(t,slot) glds16(vsrc+(long)(t)*KVBLK*PQ,(unsigned)__builtin_amdgcn_readfirstlane(vdst+(slot)))
  const int vb0=(int)(lds0+LDS_V)+((lane>>4)&1)*32+(lane&3)*8+(4*hi+((lane&15)>>2))*64;
  const char*Kbase=shm+LDS_K; bf16x8 kf[8];
  const lds_cptr shm3=(lds_cptr)shm; const lds_cptr kp0=shm3+LDS_K+hi*1024+r32*16; const lds_cptr vp0=shm3+LDS_V+((lane>>4)&1)*32+(lane&3)*8+(4*hi+((lane&15)>>2))*64;
  DMA_K(0,0);DMA_V(0,0);DMA_K(1,SLOTB);
  bf16x8 qr[4];
  #pragma unroll
  for(int d0=0;d0<4;++d0)qr[d0]=*reinterpret_cast<const bf16x8*>(&Qw[(long)r32*PQ+d0*16+hi*8]);
  float mhat=0.f,l_reg=0.f;f32x16 o[2];o[0]=f32x16{};o[1]=f32x16{};f32x16 negm=f32x16{};asm volatile("":"+v"(negm));
  const int qrel=wid*QBLK+r32;
  #define CMASK(P0,P1,t) do{int jb_=(t)-(NT-4); (void)jb_;(void)qrel;}while(0)
  bool resc=false;
  #define START(P0,P1) do{ const float rm=rowmax(P0,P1); resc=false; \
    { const float dl=rm; mhat=fadd_s(mhat,dl); \
      _Pragma("unroll") for(int r=0;r<16;++r){P0[r]=fsub_s(P0[r],dl);P1[r]=fsub_s(P1[r],dl);} \
      _Pragma("unroll") for(int r=0;r<16;++r)negm[r]=-mhat; asm volatile("":"+v"(negm)); } \
    _Pragma("unroll") for(int r=0;r<16;++r)P0[r]=__builtin_amdgcn_exp2f(P0[r]); }while(0)
  #define RESC() do{ if(resc){ asm volatile("s_waitcnt lgkmcnt(0)":::"memory"); \
      _Pragma("unroll") for(int d_=0;d_<2;++d_) _Pragma("unroll") for(int r=0;r<16;++r)o[d_][r]*=wsf[crow(r,hi)]; } }while(0)
  f32x16 pA0,pA1,pB0,pB1;
  int sl_prev=0,sl_cur=0,sl_next=SLOTB;
  #define ROT() do{sl_prev=sl_cur;sl_cur=sl_next;sl_next=(sl_next==(NSLOT-1)*SLOTB)?0:sl_next+SLOTB;}while(0)
  DMA_K(2,2*SLOTB);
  WAIT_BAR(3);
  qkt(pA0,pA1,Kbase,qr,negm,r32,hi);asm volatile("s_nop 15\n\ts_nop 7":"+v"(pA0),"+v"(pA1));CMASK(pA0,pA1,0);
  START(pA0,pA1);
  _Pragma("unroll") for(int r=0;r<16;++r)pA1[r]=__builtin_amdgcn_exp2f(pA1[r]);
  WAIT_BAR(0);
  DMA_K(3,0);DMA_V(1,SLOTB);
  ROT();
  kload8(kf,kp0+sl_cur);
  WAIT_BAR(2);
  s16x4 vlo[8],vhi[8]; u32x4 pw0,pw1,pw2,pw3;
  #define PKW(P,B) cvtpk_s(P[B],P[B+1])
  #define PAF(k) __builtin_bit_cast(bf16x8,pw##k)
  #define VFR(i) (bf16x8){vlo[i][0],vlo[i][1],vlo[i][2],vlo[i][3],vhi[i][0],vhi[i][1],vhi[i][2],vhi[i][3]}
  #define PIN(x) asm volatile("":"+v"(x))
  #define MX3(a,b,c) __builtin_fmaxf(__builtin_fmaxf((a),(b)),(c))
  #define GAPA(MF,A0,A1,A2,A3,W0,W1,PW) do{ MF; sacc+=A0; sacc+=A1; sacc+=A2; sacc+=A3; PIN(sacc); W0; W1; PIN(PW); SBAR(); }while(0)
  #define EX(v) __builtin_amdgcn_exp2f(v)
  #define GAPB(MF,X,B) do{ MF; X[B]=EX(X[B]); X[B+1]=EX(X[B+1]); X[B+2]=EX(X[B+2]); X[B+3]=EX(X[B+3]); PIN(X); SBAR(); }while(0)
  #define VRD(i) do{ vlo[i]=vtr(vp_+(((i)>>2)*4096+((i)&3)*1024)); vhi[i]=vtr(vp_+(((i)>>2)*4096+((i)&3)*1024+512)); }while(0)
  #define KRD(G,j) do{ if(G){ kload2(kf,kp0+sl_next,j); SBAR(); } }while(0)
  #define STEP(C0,C1,P0,P1,t,GK,GV,GL) do{ SBAR(); \
    const lds_cptr vp_=vp0+sl_prev; \
    VRD(0); SBAR(); float sacc=(P0[0]+P0[1]); \
    GAPA(C0=__builtin_amdgcn_mfma_f32_32x32x16_bf16(kf[0],qr[0],negm,0,0,0), P0[2],P0[3],P0[4],P0[5],     pw0[0]=PKW(P0,0), pw0[1]=PKW(P0,2), pw0); \
    VRD(4); SBAR(); GAPA(C1=__builtin_amdgcn_mfma_f32_32x32x16_bf16(kf[1],qr[0],negm,0,0,0), P0[6],P0[7],P0[8],P0[9],     pw0[2]=PKW(P0,4), pw0[3]=PKW(P0,6), pw0); \
    VRD(1); SBAR(); GAPA(C0=__builtin_amdgcn_mfma_f32_32x32x16_bf16(kf[2],qr[1],C0,0,0,0),   P0[10],P0[11],P0[12],P0[13], pw1[0]=PKW(P0,8), pw1[1]=PKW(P0,10), pw1); \
    VRD(5); SBAR(); GAPA(C1=__builtin_amdgcn_mfma_f32_32x32x16_bf16(kf[3],qr[1],C1,0,0,0),   P0[14],P0[15],P1[0],P1[1],   pw1[2]=PKW(P0,12),pw1[3]=PKW(P0,14), pw1); \
    VRD(2); SBAR(); GAPA(C0=__builtin_amdgcn_mfma_f32_32x32x16_bf16(kf[4],qr[2],C0,0,0,0),   P1[2],P1[3],P1[4],P1[5],     pw2[0]=PKW(P1,0), pw2[1]=PKW(P1,2), pw2); \
    VRD(6); SBAR(); GAPA(C1=__builtin_amdgcn_mfma_f32_32x32x16_bf16(kf[5],qr[2],C1,0,0,0),   P1[6],P1[7],P1[8],P1[9],     pw2[2]=PKW(P1,4), pw2[3]=PKW(P1,6), pw2); \
    VRD(3); SBAR(); GAPA(C0=__builtin_amdgcn_mfma_f32_32x32x16_bf16(kf[6],qr[3],C0,0,0,0),   P1[10],P1[11],P1[12],P1[13], pw3[0]=PKW(P1,8), pw3[1]=PKW(P1,10), pw3); \
    VRD(7); SBAR(); GAPA(C1=__builtin_amdgcn_mfma_f32_32x32x16_bf16(kf[7],qr[3],C1,0,0,0),   P1[14],P1[15],0.f,0.f,       pw3[2]=PKW(P1,12),pw3[3]=PKW(P1,14), pw3); \
    l_reg+=sacc; \
    if(GK){DMA_K((t)+3,sl_cur);} if(GV){DMA_V((t)+1,sl_next);} \
    CMASK(C0,C1,t); \
    { float a=MX3(C0[0],C0[1],C1[0]),b=MX3(C0[2],C0[3],C1[1]); a=MX3(a,C1[2],C1[3]); \
      _Pragma("unroll") for(int r=4;r<16;r+=4){a=MX3(a,C0[r],C0[r+1]);b=MX3(b,C0[r+2],C0[r+3]);a=MX3(a,C1[r],C1[r+1]);b=MX3(b,C1[r+2],C1[r+3]);} \
      float rm=__builtin_fmaxf(a,b); { auto rr=__builtin_amdgcn_permlane32_swap(__float_as_uint(rm),__float_as_uint(rm),false,false); rm=__builtin_fmaxf(__uint_as_float(rr[0]),__uint_as_float(rr[1])); } \
      resc=false; \
      if(__builtin_expect(__any(rm>(float)THRL),0)){ const float dl=__builtin_fmaxf(rm,0.f); mhat+=dl; \
        _Pragma("unroll") for(int r=0;r<16;++r){C0[r]-=dl;C1[r]-=dl;} \
        _Pragma("unroll") for(int r=0;r<16;++r)negm[r]=-mhat; asm volatile("":"+v"(negm)); \
        const float f=__builtin_amdgcn_exp2f(-dl); l_reg*=f; if(hi==0)wsf[r32]=f; resc=true; } } \
    SBAR(); \
    GAPB(o[0]=__builtin_amdgcn_mfma_f32_32x32x16_bf16(PAF(0),VFR(0),o[0],0,0,0), C0,0); \
    GAPB(o[1]=__builtin_amdgcn_mfma_f32_32x32x16_bf16(PAF(0),VFR(4),o[1],0,0,0), C0,4); \
    KRD(GL,0); GAPB(o[0]=__builtin_amdgcn_mfma_f32_32x32x16_bf16(PAF(1),VFR(1),o[0],0,0,0), C0,8); \
    KRD(GL,1); GAPB(o[1]=__builtin_amdgcn_mfma_f32_32x32x16_bf16(PAF(1),VFR(5),o[1],0,0,0), C0,12); \
    KRD(GL,2); GAPB(o[0]=__builtin_amdgcn_mfma_f32_32x32x16_bf16(PAF(2),VFR(2),o[0],0,0,0), C1,0); \
    KRD(GL,3); GAPB(o[1]=__builtin_amdgcn_mfma_f32_32x32x16_bf16(PAF(2),VFR(6),o[1],0,0,0), C1,4); \
    GAPB(o[0]=__builtin_amdgcn_mfma_f32_32x32x16_bf16(PAF(3),VFR(3),o[0],0,0,0), C1,8); \
    GAPB(o[1]=__builtin_amdgcn_mfma_f32_32x32x16_bf16(PAF(3),VFR(7),o[1],0,0,0), C1,12); \
    }while(0)
  int t=1;
  #undef CMASK
  #define CMASK(P0,P1,t) do{}while(0)
  for(;t+5<NT;t+=2){
    STEP(pB0,pB1,pA0,pA1,t,true,true,true);     WAIT_BAR(2); RESC(); ROT();
    STEP(pA0,pA1,pB0,pB1,t+1,true,true,true);   WAIT_BAR(2); RESC(); ROT();
  }
  #undef CMASK
  #define CMASK(P0,P1,t) do{int jb_=(t)-(NT-4); (void)jb_;(void)qrel;}while(0)
  #define ENDW(tt) do{ if((tt)+3<NT){WAIT_BAR(2);} else if((tt)+2<NT){WAIT_BAR(1);} else {WAIT_BAR(0);} }while(0)
  for(;t+1<NT;t+=2){
    STEP(pB0,pB1,pA0,pA1,t,(t+3<NT),(t+1<NT),(t+1<NT));       ENDW(t);   RESC(); ROT();
    STEP(pA0,pA1,pB0,pB1,t+1,(t+4<NT),(t+2<NT),(t+2<NT));     ENDW(t+1); RESC(); ROT();
  }
  STEP(pB0,pB1,pA0,pA1,NT-1,false,false,false); RESC();
  { float sacc=pB0[0]+pB0[1]; _Pragma("unroll") for(int r=2;r<16;++r)sacc+=pB0[r]; _Pragma("unroll") for(int r=0;r<16;++r)sacc+=pB1[r]; l_reg+=sacc;
    pw0=(u32x4){PKW(pB0,0),PKW(pB0,2),PKW(pB0,4),PKW(pB0,6)};pw1=(u32x4){PKW(pB0,8),PKW(pB0,10),PKW(pB0,12),PKW(pB0,14)};pw2=(u32x4){PKW(pB1,0),PKW(pB1,2),PKW(pB1,4),PKW(pB1,6)};pw3=(u32x4){PKW(pB1,8),PKW(pB1,10),PKW(pB1,12),PKW(pB1,14)};
    SBAR(); pv(o,vb0+sl_cur,PAF(0),PAF(1),PAF(2),PAF(3)); }
  #undef PKW
  #undef PAF
  #undef VFR
  #undef PIN
  #undef MX3
  #undef GAPA
  #undef GAPB
  #undef EX
  #undef VRD
  #undef KRD
  #undef STEP
  #undef ENDW
  {auto rr=__builtin_amdgcn_permlane32_swap(__float_as_uint(l_reg),__float_as_uint(l_reg),false,false);l_reg=__uint_as_float(rr[0])+__uint_as_float(rr[1]);}
  if(hi==0)wsf[32+r32]=l_reg;asm volatile("s_waitcnt lgkmcnt(0)":::"memory");
  float rli[16];
  #pragma unroll
  for(int r=0;r<16;++r)rli[r]=__builtin_amdgcn_rcpf(wsf[32+crow(r,hi)]);
  bf16*Ow=O+(rowbase+q0+wid*QBLK)*PO+h*D;
  { bf16*stg=(bf16*)(shm+LDS_OST)+wid*2048;
    #pragma unroll
    for(int r=0;r<16;++r){const int orow=crow(r,hi);
      #pragma unroll
      for(int d0=0;d0<2;++d0)stg[orow*64+d0*32+r32]=__float2bfloat16(o[d0][r]*rli[r]);}
    asm volatile("s_waitcnt lgkmcnt(0)":::"memory");
    #pragma unroll
    for(int i=0;i<4;++i){const int row=i*8+(lane>>3),ch=lane&7; const u32x4 v=*(const u32x4*)(stg+row*64+ch*8); ATTN_STORE16(Ow+(long)row*PO+ch*8,v);
      float ss=0.f; _Pragma("unroll") for(int e=0;e<4;++e){const float lo=__uint_as_float(v[e]<<16),hh=__uint_as_float(v[e]&0xffff0000u); ss+=lo*lo+hh*hh;}
      ss=sum8(ss); if(ch==0)__hip_atomic_fetch_add(ssq+(rowbase+q0+wid*QBLK+row),ss,__ATOMIC_RELAXED,__HIP_MEMORY_SCOPE_AGENT);} }
  asm volatile("s_waitcnt lgkmcnt(0)\n\ts_barrier":::"memory");
  #undef DMA_K
  #undef DMA_V
  #undef CMASK
  #undef START
  #undef RESC
  #undef ROT
}
constexpr int ATTN_LDS_BYTES=LDS_BYTES;
#undef SBAR
#undef WAIT_BAR
}
namespace na_body {
using attn_body::bf16x8; using attn_body::s16x4; using attn_body::f32x16; using attn_body::u32x4;
#define NA_LAS __attribute__((address_space(3)))
constexpr int PQ = 2304, PO = 1024;
constexpr int COL_QB = 768, COL_KB = 1280, COL_VB = 1792, COL_OB = 512;
constexpr int KROW = 144, K_BYTES = 64 * KROW, TILE_BYTES = K_BYTES + 8192;
constexpr int T_GUARD = 48, T_FLOATS = T_GUARD + 15 * 32 + 48;
__device__ __forceinline__ int crow(int r, int hi) { return (r & 3) + 8 * (r >> 2) + 4 * hi; }
__device__ __forceinline__ unsigned cvtpk(float lo, float hi) { return attn_body::cvtpk_s(lo, hi); }

__device__ __forceinline__ void na_unit(unsigned char* __restrict__ ws, unsigned proj_off, unsigned o_off, unsigned ssq_off, int rowbase, int rows, int r, int h,
                                        NA_LAS unsigned char* wl, unsigned wl_addr, const NA_LAS float* T, NA_LAS float* wsf) {
    int tid_ = threadIdx.x; asm volatile("" : "+v"(tid_)); const int lane = tid_ & 63, r32 = lane & 31, hi = lane >> 5;
    const int r0 = min(max(r - 4, 0), rows - 8);
    const int qrow0 = rowbase + r * 64;
    const unsigned qoff = proj_off + (unsigned)((qrow0 + r32) * PQ + COL_QB + h * 64 + hi * 8) * 2u;
    bf16x8 qr[2][4];
#pragma unroll
    for (int qb2 = 0; qb2 < 2; ++qb2)
#pragma unroll
        for (int d0 = 0; d0 < 4; ++d0) qr[qb2][d0] = *(const bf16x8*)(ws + (size_t)(qoff + (unsigned)(qb2 * 32 * PQ + d0 * 16) * 2u));
    float mrun[2] = {-1e30f, -1e30f}, lrun[2] = {0.f, 0.f};
    f32x16 o[2][2];
#pragma unroll
    for (int a = 0; a < 2; ++a)
#pragma unroll
        for (int b = 0; b < 2; ++b) o[a][b] = f32x16{};
    const int lrow = lane >> 3, lc = lane & 7;
    const int vb = (int)wl_addr + K_BYTES + ((lane >> 4) & 1) * 32 + (lane & 3) * 8 + (4 * hi + ((lane & 15) >> 2)) * 64;
    unsigned kboff = proj_off + (unsigned)((rowbase + r0 * 64 + lrow) * PQ + COL_KB + h * 64 + lc * 8) * 2u;
    u32x4 kreg[8], vreg[8];
#pragma unroll
    for (int j = 0; j < 8; ++j) { kreg[j] = *(const u32x4*)(ws + (size_t)(kboff + (unsigned)(j * 8 * PQ) * 2u)); vreg[j] = *(const u32x4*)(ws + (size_t)(kboff + (unsigned)(COL_VB - COL_KB + j * 8 * PQ) * 2u)); }
    for (int i = 0; i < 8; ++i) {
#pragma unroll
        for (int j = 0; j < 8; ++j) { const int row = j * 8 + lrow;
            *(NA_LAS u32x4*)(wl + row * KROW + lc * 16) = kreg[j];
            *(NA_LAS u32x4*)(wl + K_BYTES + (lc >> 2) * 4096 + (row >> 4) * 1024 + (row & 15) * 64 + (lc & 3) * 16) = vreg[j]; }
        kboff += (unsigned)(64 * PQ) * 2u;
        __builtin_amdgcn_sched_barrier(0);
        if (i < 7) {
#pragma unroll
            for (int j = 0; j < 8; ++j) { kreg[j] = *(const u32x4*)(ws + (size_t)(kboff + (unsigned)(j * 8 * PQ) * 2u)); vreg[j] = *(const u32x4*)(ws + (size_t)(kboff + (unsigned)(COL_VB - COL_KB + j * 8 * PQ) * 2u)); }
        }
        __builtin_amdgcn_sched_barrier(0);
        const int dr = r0 + i - r + 7;
#pragma unroll
        for (int qb2 = 0; qb2 < 2; ++qb2) {
            f32x16 p0 = f32x16{}, p1 = f32x16{};
#pragma unroll
            for (int d0 = 0; d0 < 4; ++d0) { const bf16x8 k0 = *(const NA_LAS bf16x8*)(wl + r32 * KROW + (2 * d0 + hi) * 16), k1 = *(const NA_LAS bf16x8*)(wl + (r32 + 32) * KROW + (2 * d0 + hi) * 16);
                p0 = __builtin_amdgcn_mfma_f32_32x32x16_bf16(k0, qr[qb2][d0], p0, 0, 0, 0); p1 = __builtin_amdgcn_mfma_f32_32x32x16_bf16(k1, qr[qb2][d0], p1, 0, 0, 0); }
            const int c = qb2 * 32 + r32, c0 = min(max(c - 8, 0), 48);
            const NA_LAS float* tb = T + dr * 32 + 15 - c + 4 * hi;
            const int kofs = 4 * hi - c0;
#define NA_USE0(rr) (qb2 == 0 || (rr) >= 12)
#define NA_USE1(rr) (qb2 == 1 || (rr) < 4)
            float rm = -1e30f;
#pragma unroll
            for (int rr = 0; rr < 16; ++rr) { const int kc = (rr & 3) + 8 * (rr >> 2);
                if (NA_USE0(rr)) { const float s0 = ((unsigned)(kc + kofs) < 16u) ? p0[rr] + tb[kc] : -1e30f; p0[rr] = s0; rm = fmaxf(rm, s0); }
                if (NA_USE1(rr)) { const float s1 = ((unsigned)(kc + 32 + kofs) < 16u) ? p1[rr] + tb[kc + 32] : -1e30f; p1[rr] = s1; rm = fmaxf(rm, s1); }
                if ((rr & 3) == 3) __builtin_amdgcn_sched_barrier(0); }
            rm = attn_body::xmax32(rm);
            const float mn = fmaxf(mrun[qb2], rm), alpha = __builtin_amdgcn_exp2f(mrun[qb2] - mn);
            mrun[qb2] = mn;
            float sum = 0.f;
#pragma unroll
            for (int rr = 0; rr < 16; ++rr) {
                if (NA_USE0(rr)) { p0[rr] = __builtin_amdgcn_exp2f(p0[rr] - mn); sum += p0[rr]; } else p0[rr] = 0.f;
                if (NA_USE1(rr)) { p1[rr] = __builtin_amdgcn_exp2f(p1[rr] - mn); sum += p1[rr]; } else p1[rr] = 0.f; }
            lrun[qb2] = lrun[qb2] * alpha + sum;
            if (__any(alpha != 1.0f)) {
                if (hi == 0) wsf[r32] = alpha;
#pragma unroll
                for (int rr = 0; rr < 16; ++rr) { const float a = wsf[crow(rr, hi)]; o[qb2][0][rr] *= a; o[qb2][1][rr] *= a; }
            }
            u32x4 pw0, pw1, pw2, pw3;
            pw0 = (u32x4){cvtpk(p0[0], p0[1]), cvtpk(p0[2], p0[3]), cvtpk(p0[4], p0[5]), cvtpk(p0[6], p0[7])};
            pw1 = (u32x4){cvtpk(p0[8], p0[9]), cvtpk(p0[10], p0[11]), cvtpk(p0[12], p0[13]), cvtpk(p0[14], p0[15])};
            pw2 = (u32x4){cvtpk(p1[0], p1[1]), cvtpk(p1[2], p1[3]), cvtpk(p1[4], p1[5]), cvtpk(p1[6], p1[7])};
            pw3 = (u32x4){cvtpk(p1[8], p1[9]), cvtpk(p1[10], p1[11]), cvtpk(p1[12], p1[13]), cvtpk(p1[14], p1[15])};
#undef NA_USE0
#undef NA_USE1
            attn_body::pv(o[qb2], vb, __builtin_bit_cast(bf16x8, pw0), __builtin_bit_cast(bf16x8, pw1), __builtin_bit_cast(bf16x8, pw2), __builtin_bit_cast(bf16x8, pw3));
        }
    }
#pragma unroll
    for (int qb2 = 0; qb2 < 2; ++qb2) {
        const float l = attn_body::xsum32(lrun[qb2]);
        if (hi == 0) wsf[r32] = __builtin_amdgcn_rcpf(l);
        NA_LAS unsigned short* stg = (NA_LAS unsigned short*)(wl + qb2 * 4096);
#pragma unroll
        for (int rr = 0; rr < 16; ++rr) { const int orow = crow(rr, hi); const float rl = wsf[orow];
#pragma unroll
            for (int d0 = 0; d0 < 2; ++d0) stg[orow * 64 + d0 * 32 + r32] = (unsigned short)(cvtpk(o[qb2][d0][rr] * rl, 0.f) & 0xffffu); }
        const unsigned ooff = o_off + (unsigned)((qrow0 + qb2 * 32) * PO + COL_OB + h * 64) * 2u;
#pragma unroll
        for (int k = 0; k < 4; ++k) { const int row = k * 8 + (lane >> 3), ch = lane & 7; const u32x4 v = *(const NA_LAS u32x4*)(stg + row * 64 + ch * 8); *(u32x4*)(ws + (size_t)(ooff + (unsigned)(row * PO + ch * 8) * 2u)) = v;
            float ss = 0.f;
#pragma unroll
            for (int e = 0; e < 4; ++e) { const float lo = __uint_as_float(v[e] << 16), hh = __uint_as_float(v[e] & 0xffff0000u); ss += lo * lo + hh * hh; }
            ss = attn_body::sum8(ss); if (ch == 0) __hip_atomic_fetch_add((float*)(ws + (size_t)(ssq_off + (unsigned)(qrow0 + qb2 * 32 + row) * 4u)), ss, __ATOMIC_RELAXED, __HIP_MEMORY_SCOPE_AGENT); }
    }
}
}
namespace cg = cooperative_groups;
constexpr int NWAVES = 8;
constexpr int DM = 1024, M_PROMPT = 32 * 2048, S_PROMPT = 2048, M_SAMPLE = 4 * 4096, S_SAMPLE = 4096, M_ALL = M_PROMPT + M_SAMPLE;
constexpr int NPROJ = 2304, DFF = 2816, NUP = 2 * DFF, PLE = 256;
constexpr int FFN_CHUNKS = 4, M_CHUNK = M_ALL / FFN_CHUNKS;
constexpr float C2 = 0.125f * 1.4426950408889634f;
constexpr float LOG2E = 1.4426950408889634f;
constexpr size_t MiB = 1u << 20;
constexpr size_t WS_SSQ2 = 0, WS_SSQ3 = 384 * 1024, WS_SSQ4 = 768 * 1024, WS_SSQA = 1152 * 1024, WS_SSQB = 1536 * 1024, WS_ROPE = 1984 * 1024, WS_BAR = 1992 * 1024, BAR_BYTES = 16384;
constexpr size_t WS_WIN = 2 * MiB, WS_WOUT = 7 * MiB, WS_WUP = 9 * MiB, WS_WDOWN = 20 * MiB, WS_WGATE = 26 * MiB, WS_WPLE = 28 * MiB;
constexpr size_t WS_PROJ = 32 * MiB;
constexpr size_t WS_XNO = 392 * MiB;
constexpr size_t WS_ACT = 32 * MiB;
constexpr size_t WS_H2B = 472 * MiB;
constexpr size_t WS_H3B = 32 * MiB;
constexpr size_t WS_E = 632 * MiB;
constexpr size_t WS_H1B = 824 * MiB;
constexpr size_t WS_PB = 984 * MiB;
constexpr size_t WS_END = 1024 * MiB;
static_assert(WS_PROJ + (size_t)M_ALL * NPROJ * 2 <= WS_XNO && WS_XNO + (size_t)M_ALL * DM * 2 <= WS_E && WS_ACT + (size_t)M_ALL * DFF * 2 <= WS_H2B && WS_H2B + (size_t)M_ALL * DM * 2 <= WS_E, "d_ws map");
static_assert(WS_E + (size_t)M_ALL * DM * 2 <= WS_H1B && WS_H1B + (size_t)M_ALL * DM * 2 <= WS_PB && WS_PB + (size_t)M_ALL * PLE * 2 <= WS_END && WS_H3B + (size_t)M_ALL * DM * 2 <= WS_H2B, "d_ws map 2");
static_assert(WS_BAR + BAR_BYTES <= WS_WIN && 3456 * 4 <= BAR_BYTES, "barrier words (XCD_BAR_WORDS = 3456)");
static_assert(WS_WIN + (size_t)NPROJ * DM * 2 <= WS_WOUT && WS_WUP + (size_t)NUP * DM * 2 <= WS_WDOWN && WS_WDOWN + (size_t)DM * DFF * 2 <= WS_WGATE, "weight map");
constexpr int RING_BYTES = 131072;
constexpr int NA_T_OFF = NWAVES * na_body::TILE_BYTES, NA_T_BYTES = na_body::T_FLOATS * 4, NA_WSF_OFF = NA_T_OFF + NWAVES * NA_T_BYTES, XB_ST_OFF = NA_WSF_OFF + NWAVES * 256, LDS_BYTES = XB_ST_OFF + 256;
static_assert(NA_T_OFF >= RING_BYTES + 16384 - 8192 && LDS_BYTES <= 163840 && attn_body::ATTN_LDS_BYTES <= RING_BYTES, "LDS map");

#define LAS __attribute__((address_space(3)))
typedef unsigned short bf16;
typedef unsigned v4u __attribute__((ext_vector_type(4)));
typedef unsigned v2u __attribute__((ext_vector_type(2)));
typedef float f32x4 __attribute__((ext_vector_type(4)));
__device__ __forceinline__ unsigned pk2(float lo, float hi) { return pg8::cvt_pk_bf16(lo, hi); }
__device__ __forceinline__ float bflo(unsigned w) { return __uint_as_float(w << 16); }
__device__ __forceinline__ float bfhi(unsigned w) { return __uint_as_float(w & 0xffff0000u); }
__device__ __forceinline__ float wave_sum(float v) {
#pragma unroll
    for (int o = 1; o < 64; o <<= 1) v += __shfl_xor(v, o);
    return v;
}
__device__ __forceinline__ void p0_transpose_item(const float* W, int K, int N, bf16* WT, LAS float* scr, int item, int lane, const float* gain, const float* gain_hi, int ksplit, int nlo, int nhi, float nscale, bool upmap = false) {
    const int nblk = N / 32, kb = item / nblk, nb = item % nblk, k0 = 64 * kb, n0 = 32 * nb;
#pragma unroll 8
    for (int i = 0; i < 32; ++i) { const int kk = 2 * i + (lane >> 5); float w = W[(size_t)(k0 + kk) * N + n0 + (lane & 31)]; if (gain) w *= (k0 < ksplit ? gain[k0 + kk] : gain_hi[k0 + kk - ksplit]); scr[kk * 33 + (lane & 31)] = w; }
    asm volatile("s_waitcnt lgkmcnt(0)" ::: "memory");
    const int c = lane & 7;
#pragma unroll
    for (int j = 0; j < 4; ++j) { const int n = (lane >> 3) + 8 * j; const LAS float* s = scr + (8 * c) * 33 + n; const float ns = (n0 + n >= nlo && n0 + n < nhi) ? nscale : 1.0f;
        v4u o; o.x = pk2(s[0 * 33] * ns, s[1 * 33] * ns); o.y = pk2(s[2 * 33] * ns, s[3 * 33] * ns); o.z = pk2(s[4 * 33] * ns, s[5 * 33] * ns); o.w = pk2(s[6 * 33] * ns, s[7 * 33] * ns);
        int nn = n0 + n; if (upmap) nn = (nn < DFF) ? 256 * (nn / 128) + (nn % 128) : 256 * ((nn - DFF) / 128) + 128 + ((nn - DFF) % 128);
        *(v4u*)(WT + (size_t)nn * K + k0 + 8 * c) = o; }
    asm volatile("s_waitcnt lgkmcnt(0)" ::: "memory");
}
__device__ __forceinline__ void sincos_cw(float a, float& s, float& c) {
    const float k = rintf(a * 0.636619772367581343f);
    float r = fmaf(-k, 1.5703125f, a); r = fmaf(-k, 4.837512969970703125e-4f, r); r = fmaf(-k, 7.54978995489188216e-8f, r);
    const float r2 = r * r;
    const float sp = r + r * r2 * (-1.6666667163e-01f + r2 * (8.3333337680e-03f + r2 * (-1.9841270114e-04f + r2 * 2.7557314297e-06f)));
    const float cp = 1.0f + r2 * (-0.5f + r2 * (4.1666667908e-02f + r2 * (-1.3888889225e-03f + r2 * (2.4801587642e-05f + r2 * -2.7557314297e-07f))));
    const int q = (int)k & 3;
    s = (q == 0) ? sp : (q == 1) ? cp : (q == 2) ? -sp : -cp;
    c = (q == 0) ? cp : (q == 1) ? -sp : (q == 2) ? -cp : sp;
}

#define XB_TMO      128
#define XB_XCNT(j)  (256  + 64 * (j))
#define XB_XSUB(j)  (1280 + 64 * (j))
#define XB_XGEN(j)  (2304 + 64 * (j))
#define XB_TOP      3328
#define XB_TOPGEN   3392
#define XCD_BAR_WORDS 3456
#define XB_SPIN_CAP (1u << 18)

__device__ __forceinline__ unsigned xb_ld(unsigned* p)              { return __hip_atomic_load(p, __ATOMIC_RELAXED, __HIP_MEMORY_SCOPE_AGENT); }
__device__ __forceinline__ unsigned xb_add(unsigned* p, unsigned v) { return __hip_atomic_fetch_add(p, v, __ATOMIC_RELAXED, __HIP_MEMORY_SCOPE_AGENT); }
__device__ __forceinline__ unsigned xb_xcc_id() { return (unsigned)__builtin_amdgcn_s_getreg((3 << 11) | 20) & 0xFu; }
#define XB_SPIN(cond, bar) do { unsigned _sp = 0; while (cond) { __builtin_amdgcn_s_sleep(1); \
    if ((++_sp & 255u) == 0u) { if (xb_ld(&(bar)[XB_TMO])) break; if (_sp > XB_SPIN_CAP) { atomicAdd(&(bar)[XB_TMO], 1u); break; } } } } while (0)

struct XcdBarrier {
    unsigned* bar; unsigned x;
    volatile LAS unsigned* st;
};

__device__ __forceinline__ XcdBarrier xcd_barrier_post(unsigned* bar, volatile LAS unsigned* st) {
    XcdBarrier b; b.bar = bar; b.x = xb_xcc_id(); b.st = st;
    if (threadIdx.x == 0) (void)xb_add(&bar[XB_XCNT(b.x)], 1u);
    return b;
}
__device__ __forceinline__ void xcd_barrier_complete(unsigned* bar, unsigned x, unsigned& nloc, unsigned& nx) {
    const unsigned G = gridDim.x * gridDim.y * gridDim.z;
    unsigned sum, cnt, mine, sp = 0u;
    for (;;) {
        sum = 0u; cnt = 0u; mine = 0u;
#pragma unroll
        for (unsigned j = 0; j < 16; ++j) { const unsigned c = xb_ld(&bar[XB_XCNT(j)]); sum += c; cnt += (c > 0u) ? 1u : 0u; mine = (j == x) ? c : mine; }
        if (sum == G) break;
        __builtin_amdgcn_s_sleep(1);
        if ((++sp & 255u) == 0u) { if (xb_ld(&bar[XB_TMO])) break; if (sp > XB_SPIN_CAP) { atomicAdd(&bar[XB_TMO], 1u); break; } }
    }
    nloc = mine > 0u ? mine : 1u; nx = cnt > 0u ? cnt : 1u;
}

__device__ __forceinline__ void xcd_barrier(const XcdBarrier& b) {
    asm volatile("s_waitcnt vmcnt(0)" ::: "memory");
    __syncthreads();
    if (threadIdx.x == 0) {
        unsigned* bar = b.bar;
        __builtin_amdgcn_s_waitcnt(0);
        unsigned nloc = b.st[0], nx = b.st[1];
        if (nloc == 0u) { xcd_barrier_complete(bar, b.x, nloc, nx); b.st[0] = nloc; b.st[1] = nx; }
        const unsigned old = xb_add(&bar[XB_XSUB(b.x)], 1u);
        const unsigned gen = old / nloc;
        if (old + 1u == (gen + 1u) * nloc) {
            __builtin_amdgcn_fence(__ATOMIC_RELEASE, "agent");
            asm volatile("s_waitcnt vmcnt(0)" ::: "memory");
            const unsigned og = xb_add(&bar[XB_TOP], 1u);
            const unsigned tg = og / nx;
            if (og + 1u == (tg + 1u) * nx) xb_add(&bar[XB_TOPGEN], 1u);
            else XB_SPIN(xb_ld(&bar[XB_TOPGEN]) == tg, bar);
            __builtin_amdgcn_fence(__ATOMIC_ACQUIRE, "agent");
            xb_add(&bar[XB_XGEN(b.x)], 1u);
            asm volatile("s_waitcnt vmcnt(0)" ::: "memory");
        } else {
            XB_SPIN(xb_ld(&bar[XB_XGEN(b.x)]) == gen, bar);
            __builtin_amdgcn_fence(__ATOMIC_ACQUIRE, "agent");
            asm volatile("s_waitcnt vmcnt(0)" ::: "memory");
        }
    }
    __syncthreads();
}

typedef const __attribute__((address_space(4))) unsigned char* kptr_t;
struct Args { const float* in[21]; float* out; unsigned char* ws; };

__global__ void __launch_bounds__(NWAVES * 64, 2) hymba_fwd(Args args) {
    extern __shared__ __attribute__((aligned(16))) unsigned char lds[];
    cg::grid_group grid = cg::this_grid();
    LAS unsigned char* const L = (LAS unsigned char*)lds;
    const int wave = __builtin_amdgcn_readfirstlane(threadIdx.x >> 6);
    const int G = gridDim.x, bx = blockIdx.x, vcu = (G % 8 == 0) ? (bx % 8) * (G / 8) + bx / 8 : bx;
    const int gw = vcu * NWAVES + wave, NGW = G * NWAVES;
    if (threadIdx.x < 2) ((volatile LAS unsigned*)(L + XB_ST_OFF))[threadIdx.x] = 0u;
    __syncthreads();
    { kptr_t kp0 = (kptr_t)__builtin_amdgcn_kernarg_segment_ptr(); unsigned char* const ws0 = (unsigned char*)(*(const __attribute__((address_space(4))) unsigned long long*)(kp0 + 8 * 22));
      (void)xcd_barrier_post((unsigned*)(ws0 + WS_BAR), (volatile LAS unsigned*)(L + XB_ST_OFF)); }
#define SEAM_BAR() do { kptr_t kpb = (kptr_t)__builtin_amdgcn_kernarg_segment_ptr(); asm volatile("" : "+s"(kpb)); XcdBarrier xb_; xb_.bar = (unsigned*)((unsigned char*)(*(const __attribute__((address_space(4))) unsigned long long*)(kpb + 8 * 22)) + WS_BAR); \
        xb_.x = xb_xcc_id(); xb_.st = (volatile LAS unsigned*)(L + XB_ST_OFF); xcd_barrier(xb_); } while (0)
#define PHASE_PTRS() int tid = threadIdx.x; asm volatile("" : "+v"(tid)); const int lane = tid & 63; (void)lane; kptr_t kp = (kptr_t)__builtin_amdgcn_kernarg_segment_ptr(); asm volatile("" : "+s"(kp)); unsigned char* const ws = (unsigned char*)KLD(22); float* const out = (float*)KLD(21); (void)out; \
    float* const ssq2 = (float*)(ws + WS_SSQ2); float* const ssq3 = (float*)(ws + WS_SSQ3); float* const ssq4 = (float*)(ws + WS_SSQ4); float* const ssqA = (float*)(ws + WS_SSQA); float* const ssqB = (float*)(ws + WS_SSQB); (void)ssqA; (void)ssqB; float* const rope = (float*)(ws + WS_ROPE); (void)ssq2; (void)ssq3; (void)ssq4; (void)rope; \
    bf16* const PROJ = (bf16*)(ws + WS_PROJ); bf16* const XNO = (bf16*)(ws + WS_XNO); (void)PROJ; (void)XNO;
#define KLD(i) (*(const __attribute__((address_space(4))) unsigned long long*)(kp + 8 * (i)))
#define KIN(i) ((const float*)KLD(i))

    {
        PHASE_PTRS();
        const float* const x_prompt = KIN(0); const float* const x_sample = KIN(1); const float* const p_prompt = KIN(2); const float* const p_sample = KIN(3);
        bf16* const Win_t = (bf16*)(ws + WS_WIN); bf16* const Wout_t = (bf16*)(ws + WS_WOUT); bf16* const Wup_t = (bf16*)(ws + WS_WUP); bf16* const Wdown_t = (bf16*)(ws + WS_WDOWN);
        bf16* const Wgate_t = (bf16*)(ws + WS_WGATE); bf16* const Wple_t = (bf16*)(ws + WS_WPLE); bf16* const PB = (bf16*)(ws + WS_PB);
        LAS float* scr = (LAS float*)(L + wave * 16384);
        constexpr int I_IN = (DM / 64) * (NPROJ / 32), I_OUT = (DM / 64) * (DM / 32), I_UP = (DM / 64) * (NUP / 32), I_DOWN = (DFF / 64) * (DM / 32), I_GATE = I_OUT, I_PLE = (PLE / 64) * (DM / 32);
        constexpr int NITEMS = I_IN + I_OUT + I_UP + I_DOWN + I_GATE + I_PLE;
        for (int it = gw; it < NITEMS; it += NGW) {
            int r = it;
            if (r < I_IN) { p0_transpose_item(KIN(5), DM, NPROJ, Win_t, scr, r, lane, nullptr, nullptr, 0, na_body::COL_QB, na_body::COL_KB, C2); continue; } r -= I_IN;
            if (r < I_OUT) { p0_transpose_item(KIN(11), DM, DM, Wout_t, scr, r, lane, KIN(9), KIN(10), 512, 0, 0, 1.f); continue; } r -= I_OUT;
            if (r < I_UP) { p0_transpose_item(KIN(13), DM, NUP, Wup_t, scr, r, lane, KIN(12), nullptr, 1 << 30, 0, 0, 1.f, true); continue; } r -= I_UP;
            if (r < I_DOWN) { p0_transpose_item(KIN(16), DFF, DM, Wdown_t, scr, r, lane, nullptr, nullptr, 0, 0, 0, 1.f); continue; } r -= I_DOWN;
            if (r < I_GATE) { p0_transpose_item(KIN(18), DM, DM, Wgate_t, scr, r, lane, KIN(17), nullptr, 1 << 30, 0, 0, 1.f); continue; } r -= I_GATE;
            p0_transpose_item(KIN(19), PLE, DM, Wple_t, scr, r, lane, nullptr, nullptr, 0, 0, 0, 1.f);
        }
        const float* gain = KIN(4);
        for (int m0 = gw; m0 < M_ALL; m0 += 2 * NGW) {
            const int m1 = m0 + NGW; const bool has1 = m1 < M_ALL; const int m1c = has1 ? m1 : m0;
            const float* xrow0 = (m0 < M_PROMPT) ? x_prompt + (size_t)m0 * DM : x_sample + (size_t)(m0 - M_PROMPT) * DM;
            const float* xrow1 = (m1c < M_PROMPT) ? x_prompt + (size_t)m1c * DM : x_sample + (size_t)(m1c - M_PROMPT) * DM;
            const float* prow0 = (m0 < M_PROMPT) ? p_prompt + (size_t)m0 * PLE : p_sample + (size_t)(m0 - M_PROMPT) * PLE;
            const float* prow1 = (m1c < M_PROMPT) ? p_prompt + (size_t)m1c * PLE : p_sample + (size_t)(m1c - M_PROMPT) * PLE;
            const f32x4* xr0 = (const f32x4*)xrow0 + lane; const f32x4* xr1 = (const f32x4*)xrow1 + lane;
            f32x4 v0[4], v1[4]; float s0 = 0.f, s1 = 0.f;
#pragma unroll
            for (int j = 0; j < 4; ++j) { v0[j] = xr0[64 * j]; v1[j] = xr1[64 * j]; }
            const f32x4 pv0 = ((const f32x4*)prow0)[lane], pv1 = ((const f32x4*)prow1)[lane];
#pragma unroll
            for (int j = 0; j < 4; ++j) { s0 += (v0[j].x * v0[j].x + v0[j].y * v0[j].y) + (v0[j].z * v0[j].z + v0[j].w * v0[j].w); s1 += (v1[j].x * v1[j].x + v1[j].y * v1[j].y) + (v1[j].z * v1[j].z + v1[j].w * v1[j].w); }
            const float rs0 = __builtin_amdgcn_rsqf(wave_sum(s0) * (1.f / DM) + 1e-6f), rs1 = __builtin_amdgcn_rsqf(wave_sum(s1) * (1.f / DM) + 1e-6f);
            unsigned long long* o80 = (unsigned long long*)(XNO + (size_t)m0 * DM) + lane; unsigned long long* o81 = (unsigned long long*)(XNO + (size_t)m1c * DM) + lane;
#pragma unroll
            for (int j = 0; j < 4; ++j) { const f32x4 g = ((const f32x4*)gain)[lane + 64 * j];
                o80[64 * j] = (unsigned long long)pk2(v0[j].x * rs0 * g.x, v0[j].y * rs0 * g.y) | ((unsigned long long)pk2(v0[j].z * rs0 * g.z, v0[j].w * rs0 * g.w) << 32);
                if (has1) o81[64 * j] = (unsigned long long)pk2(v1[j].x * rs1 * g.x, v1[j].y * rs1 * g.y) | ((unsigned long long)pk2(v1[j].z * rs1 * g.z, v1[j].w * rs1 * g.w) << 32); }
            ((unsigned long long*)(PB + (size_t)m0 * PLE))[lane] = (unsigned long long)pk2(pv0.x, pv0.y) | ((unsigned long long)pk2(pv0.z, pv0.w) << 32);
            if (has1) ((unsigned long long*)(PB + (size_t)m1 * PLE))[lane] = (unsigned long long)pk2(pv1.x, pv1.y) | ((unsigned long long)pk2(pv1.z, pv1.w) << 32);
        }
        for (int e = bx * (NWAVES * 64) + tid; e < M_ALL; e += G * NWAVES * 64) { ssq2[e] = 0.f; ssq3[e] = 0.f; ssq4[e] = 0.f; ssqA[e] = 0.f; ssqB[e] = 0.f; }
        for (int e = bx * (NWAVES * 64) + tid; e < 1024; e += G * NWAVES * 64) { const int pos = e >> 4, i = e & 15;
            const float freq = exp2f(-(float)i * (13.287712379549449f / 16.0f)); float s, c; sincos_cw((float)pos * freq, s, c); rope[e] = c; rope[1024 + e] = s; }
    }
    grid.sync();

    {
        PHASE_PTRS(); bf16* const Win_t = (bf16*)(ws + WS_WIN);
        pg8::Gemm g{XNO, Win_t, M_ALL, NPROJ, DM}; pg8::StaticOrder S; S.init(M_ALL, NPROJ, G, bx);
        pg8::EpiBf16Rs E{PROJ, NPROJ, nullptr};
        pg8::gemm_phase<pg8::EpiBf16Rs, pg8::StaticOrder, true, true>(L, g, S, E);
#ifdef PROBE_P1X2
        pg8::gemm_phase<pg8::EpiBf16Rs, pg8::StaticOrder, true, true>(L, g, S, E);
#endif
    }
    {
        PHASE_PTRS(); bf16* const PB = (bf16*)(ws + WS_PB); bf16* const Wple_t = (bf16*)(ws + WS_WPLE); bf16* const EB = (bf16*)(ws + WS_E);
        pg8::Gemm g{PB, Wple_t, M_ALL, DM, PLE}; pg8::StaticOrder S; S.init(M_ALL, DM, G, bx);
        pg8::EpiBf16Rs E{EB, DM, nullptr};
        pg8::gemm_phase<pg8::EpiBf16Rs, pg8::StaticOrder, true, true>(L, g, S, E);
    }
    SEAM_BAR();

    {
        PHASE_PTRS();
        const float* qn = KIN(6); const float* kn = KIN(7);
        const int a = lane & 7;
        const long NIT = (long)M_ALL * 10 / 8;
        for (long it = gw; it < NIT; it += NGW) {
            const long item = it * 8 + (lane >> 3); const int m = (int)(item / 10), j = (int)(item % 10);
            const int t = (m < M_PROMPT) ? (m & (S_PROMPT - 1)) : (m & (S_SAMPLE - 1));
            bf16* p = PROJ + (size_t)m * NPROJ + j * 64 + a * 8;
            const v4u raw = *(const v4u*)p;
            float v[8] = {bflo(raw.x), bfhi(raw.x), bflo(raw.y), bfhi(raw.y), bflo(raw.z), bfhi(raw.z), bflo(raw.w), bfhi(raw.w)};
            float ss = 0.f;
#pragma unroll
            for (int i = 0; i < 8; ++i) ss += v[i] * v[i];
            ss += __shfl_xor(ss, 1); ss += __shfl_xor(ss, 2); ss += __shfl_xor(ss, 4);
            const float rs = __builtin_amdgcn_rsqf(ss * (1.f / 64.f) + 1e-6f);
            const float* gn = (j < 8 ? qn : kn) + a * 8;
            const int pos = (a < 4) ? (t >> 6) : (t & 63);
            const float* ct = rope + pos * 16 + (a & 1) * 8;
            const float sc = (j < 8) ? C2 : 1.0f;
            float o[8];
#pragma unroll
            for (int i = 0; i < 8; ++i) { const float y = v[i] * rs * gn[i]; const float py = __shfl_xor(y, 2); const float cs = ct[i], sn = ct[1024 + i];
                o[i] = ((a & 2) == 0 ? y * cs - py * sn : y * cs + py * sn) * sc; }
            v4u w; w.x = pk2(o[0], o[1]); w.y = pk2(o[2], o[3]); w.z = pk2(o[4], o[5]); w.w = pk2(o[6], o[7]);
            *(v4u*)p = w;
        }
    }
    SEAM_BAR();

    {
        PHASE_PTRS();
        const attn_body::bf16* Q = (const attn_body::bf16*)PROJ; const attn_body::bf16* K = Q + 512; const attn_body::bf16* V = Q + 640; attn_body::bf16* Ob = (attn_body::bf16*)XNO;
        for (int pair = vcu; pair < 256; pair += G) { const int b = pair >> 3, h = pair & 7;
            for (int qb = 0; qb < 8; ++qb) attn_body::attn_unit<8>((long)b * S_PROMPT, S_PROMPT / 64, h, h >> 2, qb, Q, K, V, Ob, ssqA, (char*)lds); }
        for (int su = vcu; su < 256; su += G) { const int pair = su >> 3, b = pair >> 3, h = pair & 7;
            for (int k = 0; k < 2; ++k) attn_body::attn_unit<8>((long)M_PROMPT + (long)b * S_SAMPLE, S_SAMPLE / 64, h, h >> 2, (su & 7) * 2 + k, Q, K, V, Ob, ssqA, (char*)lds); }
        __syncthreads();
        LAS float* Tb = (LAS float*)(L + NA_T_OFF + wave * NA_T_BYTES);
        LAS float* wsf = (LAS float*)(L + NA_WSF_OFF + wave * 256);
        for (int e = lane; e < na_body::T_FLOATS; e += 64) Tb[e] = 0.f;
        { const float* rpb = KIN(8) + wave * 15 * 31;
          for (int e = lane; e < 15 * 31; e += 64) { const int dr = e / 31, dc = e % 31; Tb[na_body::T_GUARD + dr * 32 + dc] = rpb[e] * LOG2E; } }
        LAS unsigned char* wl = L + wave * na_body::TILE_BYTES;
        const unsigned wl_addr = (unsigned)(uintptr_t)(lds + wave * na_body::TILE_BYTES);
#ifdef PROBE_NAX2
        for (int rep_ = 0; rep_ < 2; ++rep_)
#endif
        for (int bu = vcu; bu < 1280; bu += G) {
            int rowbase, rows, r;
            if (bu < 1024) { rowbase = (bu >> 5) * S_PROMPT; rows = 32; r = bu & 31; } else { const int s = bu - 1024; rowbase = M_PROMPT + (s >> 6) * S_SAMPLE; rows = 64; r = s & 63; }
#ifdef PROBE_NAX2
            na_body::na_unit(ws, (unsigned)WS_PROJ, (unsigned)WS_XNO, rep_ ? (unsigned)(800 * MiB) : (unsigned)WS_SSQB, rowbase, rows, r, wave, wl, wl_addr, Tb + na_body::T_GUARD, wsf);
#else
            na_body::na_unit(ws, (unsigned)WS_PROJ, (unsigned)WS_XNO, (unsigned)WS_SSQB, rowbase, rows, r, wave, wl, wl_addr, Tb + na_body::T_GUARD, wsf);
#endif
        }
    }
    SEAM_BAR();

    {
        PHASE_PTRS(); bf16* const Wout_t = (bf16*)(ws + WS_WOUT); bf16* const H1B = (bf16*)(ws + WS_H1B); const float* const x_prompt = KIN(0); const float* const x_sample = KIN(1);
        pg8::Gemm g{XNO, Wout_t, M_ALL, DM, DM}; pg8::StaticOrder S; S.init(M_ALL, DM, G, bx);
        pg8::EpiOutProj E{x_prompt, x_sample, M_PROMPT, H1B, ssq2, ssqA, ssqB};
        pg8::gemm_phase<pg8::EpiOutProj, pg8::StaticOrder, true, true>(L, g, S, E);
    }
    SEAM_BAR();

    {
        PHASE_PTRS(); bf16* const Wup_t = (bf16*)(ws + WS_WUP); bf16* const H1B = (bf16*)(ws + WS_H1B); bf16* const ACT = (bf16*)(ws + WS_ACT);
        constexpr int NM_UP = (M_ALL + 253) / 254;
        pg8::Gemm g{H1B - DM, Wup_t, NM_UP * 256, NUP, DM, (size_t)254 * DM * 2}; pg8::StaticOrder S; S.init(NM_UP * 256, NUP, G, bx);
        pg8::EpiConvGate E{ACT, ssq2, KIN(14), KIN(15), M_ALL, DFF};
        pg8::gemm_phase<pg8::EpiConvGate, pg8::StaticOrder, true, true>(L, g, S, E);
    }
    SEAM_BAR();

    {
        PHASE_PTRS(); bf16* const ACT = (bf16*)(ws + WS_ACT); bf16* const Wdown_t = (bf16*)(ws + WS_WDOWN); bf16* const H2B = (bf16*)(ws + WS_H2B); bf16* const H1B = (bf16*)(ws + WS_H1B);
        pg8::Gemm g{ACT, Wdown_t, M_ALL, DM, DFF}; pg8::StaticOrder S; S.init(M_ALL, DM, G, bx);
        pg8::EpiResB E{H1B, H2B, ssq3};
        pg8::gemm_phase<pg8::EpiResB, pg8::StaticOrder, true, true>(L, g, S, E);
    }
    SEAM_BAR();

    {
        PHASE_PTRS(); bf16* const H2B = (bf16*)(ws + WS_H2B); bf16* const Wgate_t = (bf16*)(ws + WS_WGATE); bf16* const EB = (bf16*)(ws + WS_E); bf16* const H3B = (bf16*)(ws + WS_H3B);
        pg8::Gemm g{H2B, Wgate_t, M_ALL, DM, DM}; pg8::StaticOrder S; S.init(M_ALL, DM, G, bx);
        pg8::EpiGate E{H2B, EB, H3B, ssq3, ssq4};
        pg8::gemm_phase<pg8::EpiGate, pg8::StaticOrder, true, true>(L, g, S, E);
    }
    SEAM_BAR();

    {
        PHASE_PTRS();
        const f32x4* fg = (const f32x4*)KIN(20) + lane;
        const f32x4 g0 = fg[0], g1 = fg[64], g2 = fg[128], g3 = fg[192];
        const bf16* const H3B = (const bf16*)(ws + WS_H3B);
        for (int m0 = gw; m0 < M_ALL; m0 += 2 * NGW) {
            const int m1 = m0 + NGW; const bool has1 = m1 < M_ALL; const int m1c = has1 ? m1 : m0;
            const v2u* hr0 = (const v2u*)(H3B + (size_t)m0 * DM) + lane; const v2u* hr1 = (const v2u*)(H3B + (size_t)m1c * DM) + lane;
            v2u a[4], b[4];
#pragma unroll
            for (int j = 0; j < 4; ++j) { a[j] = hr0[64 * j]; b[j] = hr1[64 * j]; }
            const float rs0 = __builtin_amdgcn_rsqf(ssq4[m0] * (1.f / DM) + 1e-6f), rs1 = __builtin_amdgcn_rsqf(ssq4[m1c] * (1.f / DM) + 1e-6f);
            f32x4* xr0 = (f32x4*)(out + (size_t)m0 * DM) + lane; f32x4* xr1 = (f32x4*)(out + (size_t)m1c * DM) + lane;
            const f32x4 gg[4] = {g0, g1, g2, g3};
#pragma unroll
            for (int j = 0; j < 4; ++j) { xr0[64 * j] = (f32x4){bflo(a[j].x), bfhi(a[j].x), bflo(a[j].y), bfhi(a[j].y)} * rs0 * gg[j];
                if (has1) xr1[64 * j] = (f32x4){bflo(b[j].x), bfhi(b[j].x), bflo(b[j].y), bfhi(b[j].y)} * rs1 * gg[j]; }
        }
    }
}

extern "C" void kernel_launch(void* const* d_in, const int* in_sizes, int n_in, void* d_out, int out_size, void* d_ws, size_t ws_size, hipStream_t stream) {
    static int grid = 0;
    if (grid == 0) {
        if (n_in != 21 || in_sizes[0] != M_PROMPT * DM || out_size != M_ALL * DM || ws_size < WS_END) { fprintf(stderr, "kernel_launch: unexpected shapes (n_in %d, in0 %d, out %d, ws %zu); nothing launched\n", n_in, n_in > 0 ? in_sizes[0] : -1, out_size, ws_size); grid = -1; return; }
        int dev = 0, cus = 0, per_cu = 0;
        if (hipGetDevice(&dev) != hipSuccess || hipDeviceGetAttribute(&cus, hipDeviceAttributeMultiprocessorCount, dev) != hipSuccess) { grid = -1; return; }
        if (hipFuncSetAttribute((const void*)hymba_fwd, hipFuncAttributeMaxDynamicSharedMemorySize, LDS_BYTES) != hipSuccess) { fprintf(stderr, "kernel_launch: hipFuncSetAttribute failed\n"); grid = -1; return; }
        if (hipOccupancyMaxActiveBlocksPerMultiprocessor(&per_cu, (const void*)hymba_fwd, NWAVES * 64, LDS_BYTES) != hipSuccess || per_cu < 1) { fprintf(stderr, "kernel_launch: occupancy query says %d blocks per CU\n", per_cu); (void)hipGetLastError(); }
        grid = cus;
    }
    if (grid < 0) return;
    if (hipMemsetAsync((unsigned char*)d_ws + WS_BAR, 0, BAR_BYTES, stream) != hipSuccess) { fprintf(stderr, "kernel_launch: hipMemsetAsync failed\n"); return; }
    Args a{};
    for (int i = 0; i < 21; ++i) a.in[i] = (const float*)d_in[i];
    a.out = (float*)d_out; a.ws = (unsigned char*)d_ws;
    void* kargs[] = {&a};
    const hipError_t e = hipLaunchCooperativeKernel((const void*)hymba_fwd, dim3(grid), dim3(NWAVES * 64), kargs, LDS_BYTES, stream);
    if (e != hipSuccess) fprintf(stderr, "kernel_launch: cooperative launch failed: %s (grid %d)\n", hipGetErrorString(e), grid);
}
```

```cpp
#include <hip/hip_cooperative_groups.h>
#include <hip/hip_runtime.h>
#include <cstdio>
#include <cstdint>
namespace pg8 {
#define PG8_LAS __attribute__((address_space(3)))
typedef unsigned short bf16_t;
typedef short bf16x8 __attribute__((ext_vector_type(8)));
typedef float f32x4 __attribute__((ext_vector_type(4)));
typedef unsigned u32x4 __attribute__((ext_vector_type(4)));
constexpr int BM = 256, BK = 64, HALF = 128, HTB = HALF * BK * 2  , STAGE_BYTES = 8 * HTB, NXCD = 8, WGM = 8;

__host__ __device__ __forceinline__ int lds_byte(int r, int c) { const int st = (r >> 4) * 2 + (c >> 5), rr = r & 15, cc = c & 31, ob = rr * 64 + cc * 2; return st * 1024 + (ob ^ (((ob >> 9) & 1) << 5)); }
__host__ __device__ __forceinline__ void stage_rc(int b, int& R, int& C) { const int st = b / 1024, sb = b % 1024, swz = sb ^ (((sb >> 9) & 1) << 5); R = (st >> 1) * 16 + swz / 64; C = (st & 1) * 32 + (swz % 64) / 2; }
__host__ __device__ __forceinline__ int perm32(int rho) { const int n = rho >> 4, i = rho & 15; return 8 * (i >> 2) + 4 * n + (i & 3); }

struct Unit { int pm, pn; };
struct Gemm { const bf16_t* A; const bf16_t* Bt; int M, N, K; size_t a_tstep; };

struct StaticOrder {
    int nM, nN, nwg, G, c;
    __host__ __device__ void init(int M, int N, int G_, int c_) { nM = M / BM; nN = N / BM; nwg = nM * nN; G = G_; c = c_; }
    __host__ __device__ bool next(int i, Unit& u) const {
        const long L = (long)i * G + c; if (L >= nwg) return false;
        int wgid = (int)L; { const int q = nwg / NXCD, r = nwg % NXCD, xcd = wgid % NXCD, off = wgid / NXCD; wgid = (xcd < r ? xcd * (q + 1) : r * (q + 1) + (xcd - r) * q) + off; }
        const int nig = WGM * nN, gid = wgid / nig, fm = gid * WGM, gsz = (nM - fm) < WGM ? (nM - fm) : WGM;
        u.pm = fm + ((wgid % nig) % gsz); u.pn = (wgid % nig) / gsz; return true;
    }
    __device__ __forceinline__ void a_ready(const Unit&) const {}
    __device__ __forceinline__ void done(const Unit&) const {}
};

__device__ __forceinline__ unsigned cvt_pk_bf16(float lo, float hi) { unsigned r; asm volatile("v_cvt_pk_bf16_f32 %0, %1, %2" : "=v"(r) : "v"(lo), "v"(hi)); return r; }
typedef float f32x2 __attribute__((ext_vector_type(2)));
__device__ __forceinline__ f32x2 gelu_pk(f32x2 v) {
    const f32x2 av = __builtin_elementwise_abs(v), d = av * 0.2316418882f + 1.0f;
    f32x2 t; t.x = __builtin_amdgcn_rcpf(d.x); t.y = __builtin_amdgcn_rcpf(d.y);
    f32x2 q = t * 0.5307027145f + (-0.7265760135f); q = q * t + 0.7107068705f; q = q * t + (-0.142248368f); q = q * t + 0.127414796f; q = q * t;
    const f32x2 s = (v * v) * (-0.72134752044f);
    f32x2 e; e.x = __builtin_amdgcn_exp2f(s.x); e.y = __builtin_amdgcn_exp2f(s.y);
    const f32x2 m = v * (q * e), r = v - m;
    f32x2 o; o.x = v.x < 0.f ? m.x : r.x; o.y = v.y < 0.f ? m.y : r.y; return o;
}

template <int ACT  > struct EpiBf16 {
    static constexpr bool PERM = true, AFTER_DRAIN = false, MIDSCALE = false, FULL = false; static_assert(ACT == 0 || ACT == 1, "EpiBf16: ACT is 0 (none) or 1 (gelu_pk)");
    bf16_t* O; int ldc; const float* bias; int split_cols; size_t split_stride; float scale0;
    __device__ __forceinline__ void operator()(const f32x4 (&acc)[2][2][4][2], const Unit& u, int wr, int wc, int fr, int fq) const {
        const int row0 = u.pm * BM + wr * 64 + fr; int colt = u.pn * BM; bf16_t* base = O;
        float sc = 1.f; if (split_cols) { const int t = colt / split_cols; base += (size_t)t * split_stride; colt -= t * split_cols; if (t == 0) sc = scale0; }
        const int col0 = colt + wc * 32 + 8 * fq, bcol0 = u.pn * BM + wc * 32 + 8 * fq;
        f32x4 bv[2][2];
#pragma unroll
        for (int bj = 0; bj < 2; ++bj)
#pragma unroll
            for (int n = 0; n < 2; ++n) bv[bj][n] = bias ? *(const f32x4*)(bias + bcol0 + bj * HALF + 4 * n) : (f32x4){0.f, 0.f, 0.f, 0.f};
#pragma unroll
        for (int ai = 0; ai < 2; ++ai)
#pragma unroll
            for (int m = 0; m < 4; ++m) { bf16_t* rowp = base + (size_t)(row0 + ai * HALF + m * 16) * ldc + col0;
#pragma unroll
                for (int bj = 0; bj < 2; ++bj) { f32x4 v0 = acc[ai][bj][m][0] + bv[bj][0], v1 = acc[ai][bj][m][1] + bv[bj][1];
                    if (ACT == 1) { f32x2 a = gelu_pk((f32x2){v0[0], v0[1]}), b = gelu_pk((f32x2){v0[2], v0[3]}), c = gelu_pk((f32x2){v1[0], v1[1]}), d = gelu_pk((f32x2){v1[2], v1[3]});
                        v0 = (f32x4){a.x, a.y, b.x, b.y}; v1 = (f32x4){c.x, c.y, d.x, d.y}; }
                    v0 = v0 * sc; v1 = v1 * sc; u32x4 w; w.x = cvt_pk_bf16(v0[0], v0[1]); w.y = cvt_pk_bf16(v0[2], v0[3]); w.z = cvt_pk_bf16(v1[0], v1[1]); w.w = cvt_pk_bf16(v1[2], v1[3]);
                    *(u32x4*)(rowp + bj * HALF) = w; } }
    }
};
constexpr float RMS_EPS = 1e-6f;
typedef unsigned u32x2 __attribute__((ext_vector_type(2)));
__device__ __forceinline__ float f32_atomic_add(float* p, float v) { return __hip_atomic_fetch_add(p, v, __ATOMIC_RELAXED, __HIP_MEMORY_SCOPE_AGENT); }
__device__ __forceinline__ float bf_lo(unsigned w) { return __uint_as_float(w << 16); }
__device__ __forceinline__ float bf_hi(unsigned w) { return __uint_as_float(w & 0xffff0000u); }
__device__ __forceinline__ float sumsq8(const f32x4& v0, const f32x4& v1) { return (v0[0] * v0[0] + v0[1] * v0[1]) + (v0[2] * v0[2] + v0[3] * v0[3]) + (v1[0] * v1[0] + v1[1] * v1[1]) + (v1[2] * v1[2] + v1[3] * v1[3]); }
__device__ __forceinline__ u32x4 pack8(const f32x4& v0, const f32x4& v1) { u32x4 w; w.x = cvt_pk_bf16(v0[0], v0[1]); w.y = cvt_pk_bf16(v0[2], v0[3]); w.z = cvt_pk_bf16(v1[0], v1[1]); w.w = cvt_pk_bf16(v1[2], v1[3]); return w; }
struct EpiBf16Rs {
    static constexpr bool PERM = true, AFTER_DRAIN = false, MIDSCALE = false, FULL = false;
    bf16_t* O; int ldc; const float* ssq;
    __device__ __forceinline__ void operator()(const f32x4 (&acc)[2][2][4][2], const Unit& u, int wr, int wc, int fr, int fq) const {
        const int row0 = u.pm * BM + wr * 64 + fr, col0 = u.pn * BM + wc * 32 + 8 * fq;
#pragma unroll
        for (int ai = 0; ai < 2; ++ai)
#pragma unroll
            for (int m = 0; m < 4; ++m) { const int row = row0 + ai * HALF + m * 16; bf16_t* rowp = O + (size_t)row * ldc + col0;
                const float rs = ssq ? __builtin_amdgcn_rsqf(ssq[row] * (1.0f / 1024.0f) + RMS_EPS) : 1.0f;
#pragma unroll
                for (int bj = 0; bj < 2; ++bj) *(u32x4*)(rowp + bj * HALF) = pack8(acc[ai][bj][m][0] * rs, acc[ai][bj][m][1] * rs); }
    }
};
struct EpiOutProj {
    static constexpr bool PERM = true, AFTER_DRAIN = false, MIDSCALE = true, FULL = false;
    const float* base0; const float* base1; int split;
    bf16_t* hb; float* ssq; const float* ssqA; const float* ssqB;
    __device__ __forceinline__ void prep(PG8_LAS unsigned char* lds, int tid, const Unit& u, int wr, int fr) const {
        const int row0 = u.pm * BM + wr * 64 + fr; PG8_LAS f32x4* slot = (PG8_LAS f32x4*)(lds + STAGE_BYTES) + tid * 2;
#pragma unroll
        for (int ai = 0; ai < 2; ++ai) { f32x4 q;
#pragma unroll
            for (int m = 0; m < 4; ++m) { const int row = row0 + ai * HALF + m * 16;
                q[m] = __builtin_amdgcn_rsqf(ssqA[row] * (1.0f / 512.0f) + RMS_EPS) * __builtin_amdgcn_sqrtf(ssqB[row] * (1.0f / 512.0f) + RMS_EPS); }
            slot[ai] = q; }
    }
    __device__ __forceinline__ void midscale(f32x4 (&acc)[2][2][4][2], PG8_LAS unsigned char* lds, int tid) const {
        const PG8_LAS f32x4* slot = (const PG8_LAS f32x4*)(lds + STAGE_BYTES) + tid * 2;
#pragma unroll
        for (int ai = 0; ai < 2; ++ai) { const f32x4 q = slot[ai];
#pragma unroll
            for (int bj = 0; bj < 2; ++bj)
#pragma unroll
                for (int m = 0; m < 4; ++m)
#pragma unroll
                    for (int n = 0; n < 2; ++n) acc[ai][bj][m][n] *= q[m]; }
    }
    __device__ __forceinline__ void operator()(const f32x4 (&acc)[2][2][4][2], const Unit& u, int wr, int wc, int fr, int fq) const {
        const int row0 = u.pm * BM + wr * 64 + fr, col0 = u.pn * BM + wc * 32 + 8 * fq;
#pragma unroll
        for (int ai = 0; ai < 2; ++ai)
#pragma unroll
            for (int m = 0; m < 4; ++m) { const int row = row0 + ai * HALF + m * 16;
                const float* bp = (row < split ? base0 + (size_t)row * 1024 : base1 + (size_t)(row - split) * 1024) + col0;
                bf16_t* hp = hb + (size_t)row * 1024 + col0; float s = 0.f;
                const float rb = __builtin_amdgcn_rsqf(ssqB[row] * (1.0f / 512.0f) + RMS_EPS);
#pragma unroll
                for (int bj = 0; bj < 2; ++bj) { const f32x4 b0 = *(const f32x4*)(bp + bj * HALF), b1 = *(const f32x4*)(bp + bj * HALF + 4);
                    const f32x4 v0 = acc[ai][bj][m][0] * rb + b0, v1 = acc[ai][bj][m][1] * rb + b1;
                    *(u32x4*)(hp + bj * HALF) = pack8(v0, v1); s += sumsq8(v0, v1); }
                s += __shfl_xor(s, 16); s += __shfl_xor(s, 32);
                if (fq == 0) f32_atomic_add(ssq + row, s); }
    }
};
struct EpiResB {
    static constexpr bool PERM = true, AFTER_DRAIN = false, MIDSCALE = false, FULL = false;
    const bf16_t* hin; bf16_t* hout; float* ssq;
    __device__ __forceinline__ void operator()(const f32x4 (&acc)[2][2][4][2], const Unit& u, int wr, int wc, int fr, int fq) const {
        const int row0 = u.pm * BM + wr * 64 + fr, col0 = u.pn * BM + wc * 32 + 8 * fq;
#pragma unroll
        for (int ai = 0; ai < 2; ++ai)
#pragma unroll
            for (int m = 0; m < 4; ++m) { const int row = row0 + ai * HALF + m * 16;
                const bf16_t* bp = hin + (size_t)row * 1024 + col0; bf16_t* hp = hout + (size_t)row * 1024 + col0; float s = 0.f;
#pragma unroll
                for (int bj = 0; bj < 2; ++bj) { const u32x4 bw = *(const u32x4*)(bp + bj * HALF);
                    const f32x4 v0 = acc[ai][bj][m][0] + (f32x4){bf_lo(bw.x), bf_hi(bw.x), bf_lo(bw.y), bf_hi(bw.y)}, v1 = acc[ai][bj][m][1] + (f32x4){bf_lo(bw.z), bf_hi(bw.z), bf_lo(bw.w), bf_hi(bw.w)};
                    *(u32x4*)(hp + bj * HALF) = pack8(v0, v1); s += sumsq8(v0, v1); }
                s += __shfl_xor(s, 16); s += __shfl_xor(s, 32);
                if (fq == 0) f32_atomic_add(ssq + row, s); }
    }
};
struct EpiGate {
    static constexpr bool PERM = true, AFTER_DRAIN = false, MIDSCALE = false, FULL = false;
    const bf16_t* hin; const bf16_t* E; bf16_t* hout; const float* ssq_in; float* ssq_out;
    __device__ __forceinline__ void operator()(const f32x4 (&acc)[2][2][4][2], const Unit& u, int wr, int wc, int fr, int fq) const {
        const int row0 = u.pm * BM + wr * 64 + fr, col0 = u.pn * BM + wc * 32 + 8 * fq;
#pragma unroll
        for (int ai = 0; ai < 2; ++ai)
#pragma unroll
            for (int m = 0; m < 4; ++m) { const int row = row0 + ai * HALF + m * 16;
                const bf16_t* bp = hin + (size_t)row * 1024 + col0; const bf16_t* ep = E + (size_t)row * 1024 + col0; bf16_t* hp = hout + (size_t)row * 1024 + col0; float s = 0.f;
                const float rs = __builtin_amdgcn_rsqf(ssq_in[row] * (1.0f / 1024.0f) + RMS_EPS) * -1.4426950408889634f;
#pragma unroll
                for (int bj = 0; bj < 2; ++bj) { const u32x4 bw = *(const u32x4*)(bp + bj * HALF), ew = *(const u32x4*)(ep + bj * HALF);
                    const f32x4 b0 = (f32x4){bf_lo(bw.x), bf_hi(bw.x), bf_lo(bw.y), bf_hi(bw.y)}, b1 = (f32x4){bf_lo(bw.z), bf_hi(bw.z), bf_lo(bw.w), bf_hi(bw.w)};
                    const f32x4 e0 = (f32x4){bf_lo(ew.x), bf_hi(ew.x), bf_lo(ew.y), bf_hi(ew.y)}, e1 = (f32x4){bf_lo(ew.z), bf_hi(ew.z), bf_lo(ew.w), bf_hi(ew.w)};
                    f32x4 v0, v1;
#pragma unroll
                    for (int k = 0; k < 4; ++k) { const float g0 = __builtin_amdgcn_rcpf(1.0f + __builtin_amdgcn_exp2f(acc[ai][bj][m][0][k] * rs)), g1 = __builtin_amdgcn_rcpf(1.0f + __builtin_amdgcn_exp2f(acc[ai][bj][m][1][k] * rs));
                        v0[k] = b0[k] + g0 * e0[k]; v1[k] = b1[k] + g1 * e1[k]; }
                    *(u32x4*)(hp + bj * HALF) = pack8(v0, v1); s += sumsq8(v0, v1); }
                s += __shfl_xor(s, 16); s += __shfl_xor(s, 32);
                if (fq == 0) f32_atomic_add(ssq_out + row, s); }
    }
};

#define PG8_DPPF(oldv, srcv, ctrl, bc) __builtin_bit_cast(float, __builtin_amdgcn_update_dpp(__builtin_bit_cast(int, (float)(oldv)), __builtin_bit_cast(int, (float)(srcv)), (ctrl), 0xf, 0xf, (bc)))
struct EpiConvGate {
    static constexpr bool PERM = true, AFTER_DRAIN = false, MIDSCALE = false, FULL = true;
    bf16_t* ACT; const float* ssq; const float* cw; const float* cb; int Mrows; int dff;
    static constexpr int PF_W_OFF = 9216, PF_S_OFF = 9216 + 8192;
    __device__ __forceinline__ void prefetch(PG8_LAS unsigned char* lds, int tid, const Unit& u, int ui) const {
        const int wid = __builtin_amdgcn_readfirstlane(tid >> 6), lane = tid & 63, par = ui & 1;
        if (wid < 4) { const int cc = lane * 4, bj = cc >> 7, c = cc & 127;
            const float* src = (wid < 3 ? cw + (size_t)wid * 2 * dff : cb) + bj * dff + u.pn * HALF + c;
            __builtin_amdgcn_global_load_lds((const unsigned*)src, (PG8_LAS unsigned*)(lds + STAGE_BYTES + PF_W_OFF + par * 4096 + wid * 1024), 16, 0, 0);
        } else { const int g = u.pm * 254 - 1 + (wid - 4) * 64 + lane; const int gc = g < 0 ? 0 : (g >= Mrows ? Mrows - 1 : g);
            __builtin_amdgcn_global_load_lds((const unsigned*)(ssq + gc), (PG8_LAS unsigned*)(lds + STAGE_BYTES + PF_S_OFF + par * 1024 + (wid - 4) * 256), 4, 0, 0); }
    }
    template <bool MASKED> __device__ __forceinline__ void conv(const f32x4 (&acc)[2][2][4][2], const PG8_LAS float* Wl, const PG8_LAS float* X, int wr, int rbase, int gbase, int col, int cbase) const {
#pragma unroll
        for (int n = 0; n < 2; ++n) {
            f32x4 w[2][4];
#pragma unroll
            for (int bj = 0; bj < 2; ++bj)
#pragma unroll
                for (int k = 0; k < 4; ++k) w[bj][k] = *(const PG8_LAS f32x4*)(Wl + k * 256 + bj * HALF + col + 4 * n);
#pragma unroll
            for (int ai = 0; ai < 2; ++ai) { const int sg = 2 * ai + wr; const int slotP = (sg > 0) ? (sg - 1) * 2 + 1 : 8, slotN = (sg < 3) ? (sg + 1) * 2 : 8;
                f32x4 saved[2], haloN[2];
#pragma unroll
                for (int bj = 0; bj < 2; ++bj) { saved[bj] = *(const PG8_LAS f32x4*)(X + slotP * 256 + bj * HALF + col + 4 * n); haloN[bj] = *(const PG8_LAS f32x4*)(X + slotN * 256 + bj * HALF + col + 4 * n); }
#pragma unroll
                for (int m = 0; m < 4; ++m) { const int r = rbase + ai * HALF + m * 16, g = gbase + r;
                    f32x2 hp = (f32x2){1.f, 1.f}, hn = hp;
                    if constexpr (MASKED) { const int S = (g < 65536) ? 2048 : 4096; const int t = g & (S - 1); const float a = (t != 0) ? 1.f : 0.f, b = (t != S - 1) ? 1.f : 0.f; hp = (f32x2){a, a}; hn = (f32x2){b, b}; }
                    f32x2 y[2][2];
#pragma unroll
                    for (int bj = 0; bj < 2; ++bj) { const f32x4 cur = acc[ai][bj][m][n]; const f32x4 nx = (m < 3) ? acc[ai][bj][m < 3 ? m + 1 : 3][n] : haloN[bj];
#pragma unroll
                        for (int h2 = 0; h2 < 2; ++h2) { const int i0 = 2 * h2, i1 = 2 * h2 + 1;
                            f32x2 pin, nin;
                            pin.x = PG8_DPPF(PG8_DPPF(0.f, saved[bj][i0], 0x121, true), cur[i0], 0x111, false); pin.y = PG8_DPPF(PG8_DPPF(0.f, saved[bj][i1], 0x121, true), cur[i1], 0x111, false);
                            nin.x = PG8_DPPF(PG8_DPPF(0.f, nx[i0], 0x12f, true), cur[i0], 0x101, false);        nin.y = PG8_DPPF(PG8_DPPF(0.f, nx[i1], 0x12f, true), cur[i1], 0x101, false);
                            if constexpr (MASKED) { pin *= hp; nin *= hn; }
                            const f32x2 c2 = (f32x2){cur[i0], cur[i1]}, w0 = (f32x2){w[bj][0][i0], w[bj][0][i1]}, w1 = (f32x2){w[bj][1][i0], w[bj][1][i1]}, w2 = (f32x2){w[bj][2][i0], w[bj][2][i1]}, bb = (f32x2){w[bj][3][i0], w[bj][3][i1]};
                            y[bj][h2] = __builtin_elementwise_fma(w2, nin, __builtin_elementwise_fma(w0, pin, __builtin_elementwise_fma(w1, c2, bb))); }
                        saved[bj] = cur; }
                    u32x2 pk;
#pragma unroll
                    for (int h2 = 0; h2 < 2; ++h2) { const f32x2 a = y[0][h2], gg = y[1][h2];
                        const f32x2 g2 = gg * gg, u3 = __builtin_elementwise_fma(g2 * gg, (f32x2){0.044715f, 0.044715f}, gg), z = u3 * -2.302208198f;
                        f32x2 d; d.x = __builtin_amdgcn_exp2f(z.x); d.y = __builtin_amdgcn_exp2f(z.y); d = d + 1.0f;
                        f32x2 rc; rc.x = __builtin_amdgcn_rcpf(d.x); rc.y = __builtin_amdgcn_rcpf(d.y);
                        const f32x2 o = (a * gg) * rc;
                        pk[h2] = cvt_pk_bf16(o.x, o.y); }
                    if (r >= 1 && r <= 254 && g < Mrows) *(u32x2*)(ACT + (size_t)g * dff + cbase + 4 * n) = pk;
                    __builtin_amdgcn_sched_barrier(0); } } }
    }
    __device__ __forceinline__ void full(f32x4 (&acc)[2][2][4][2], const Unit& u, int wr_, int wc_, int fr_, int fq_, PG8_LAS unsigned char* lds, int tid_, int ui) const {
        int tid = tid_; asm volatile("" : "+v"(tid));
        const int wid = __builtin_amdgcn_readfirstlane(tid >> 6), lane = tid & 63, wr = wid >> 2, wc = wid & 3, fr = lane & 15, fq = lane >> 4; (void)wr_; (void)wc_; (void)fr_; (void)fq_;
        const int gbase = u.pm * 254 - 1, rbase = wr * 64 + fr, col = wc * 32 + 8 * fq, cbase = u.pn * HALF + col;
        const unsigned voff = (unsigned)cbase * 4u;
        const int par = ui & 1;
        const PG8_LAS float* Wl = (const PG8_LAS float*)(lds + STAGE_BYTES + PF_W_OFF + par * 4096);
        const PG8_LAS float* Sl = (const PG8_LAS float*)(lds + STAGE_BYTES + PF_S_OFF + par * 1024);
        PG8_LAS float* X = (PG8_LAS float*)(lds + STAGE_BYTES);
#pragma unroll
        for (int ai = 0; ai < 2; ++ai)
#pragma unroll
            for (int m = 0; m < 4; ++m) {
                const float rs = __builtin_amdgcn_rsqf(Sl[rbase + ai * HALF + m * 16] * (1.0f / 1024.0f) + RMS_EPS);
#pragma unroll
                for (int bj = 0; bj < 2; ++bj)
#pragma unroll
                    for (int n = 0; n < 2; ++n) { acc[ai][bj][m][n] *= rs; asm volatile("" : "+v"(acc[ai][bj][m][n])); }
                __builtin_amdgcn_sched_barrier(0); }
        if (tid < 64) *(PG8_LAS f32x4*)(X + 8 * 256 + tid * 4) = (f32x4){0.f, 0.f, 0.f, 0.f};
        if (fr == 0) {
#pragma unroll
            for (int ai = 0; ai < 2; ++ai)
#pragma unroll
                for (int bj = 0; bj < 2; ++bj)
#pragma unroll
                    for (int n = 0; n < 2; ++n) *(PG8_LAS f32x4*)(X + ((2 * ai + wr) * 2 + 0) * 256 + bj * HALF + col + 4 * n) = acc[ai][bj][0][n]; }
        if (fr == 15) {
#pragma unroll
            for (int ai = 0; ai < 2; ++ai)
#pragma unroll
                for (int bj = 0; bj < 2; ++bj)
#pragma unroll
                    for (int n = 0; n < 2; ++n) *(PG8_LAS f32x4*)(X + ((2 * ai + wr) * 2 + 1) * 256 + bj * HALF + col + 4 * n) = acc[ai][bj][3][n]; }
        asm volatile("s_waitcnt lgkmcnt(0)" ::: "memory"); __builtin_amdgcn_s_barrier(); asm volatile("" ::: "memory");
        const bool boundary = ((gbase + 256) >> 11) != (gbase >> 11);
        (void)boundary; conv<true>(acc, Wl, X, wr, rbase, gbase, col, cbase);
    }
};

template <class Epi, class Sched, bool ALIGN_EPI = false, bool SP2 = false>
__device__ __forceinline__ void gemm_phase(PG8_LAS unsigned char* lds, const Gemm g, const Sched& S, const Epi& E) {
    int tid = threadIdx.x; asm volatile("" : "+v"(tid));
    const int wid = __builtin_amdgcn_readfirstlane(tid >> 6), lane = tid & 63, wr = wid >> 2, wc = wid & 3, fr = lane & 15, fq = lane >> 4;
    const int K = g.K, nt = K / BK;
    unsigned voffA[2], voffB[2];
#pragma unroll
    for (int i = 0; i < 2; ++i) { int R, C; stage_rc(tid * 16 + i * 8192, R, C); const int Rb = Epi::PERM ? ((R & ~31) + perm32(R & 31)) : R;
        voffA[i] = (unsigned)(R * K + C) * 2u; voffB[i] = (unsigned)(Rb * K + C) * 2u; }
    const size_t kstep = (size_t)(BK * 2);
    const size_t hstep = (size_t)HALF * K * 2;
    const size_t tstep = 2 * hstep;
    const size_t tstepA = g.a_tstep ? g.a_tstep : tstep;
    const unsigned ldsw = (unsigned)wid * 1024u;
    const int aoff = lds_byte(wr * 64 + fr, fq * 8), boff = lds_byte(wc * 32 + fr, fq * 8);
#define PG8_SA(b, h) (((b) * 2 + (h)) * HTB)
#define PG8_SB(b, h) ((4 + (b) * 2 + (h)) * HTB)
#define PG8_STAGE(bufoff, gbase, voff) do { _Pragma("unroll") for (int _i = 0; _i < 2; ++_i) \
        __builtin_amdgcn_global_load_lds((const unsigned*)((const char*)(gbase) + (voff)[_i]), (PG8_LAS unsigned*)(lds + (bufoff) + ldsw + _i * 8192), 16, 0, 0); } while (0)
#define PG8_LDA(dst, b, h) do { _Pragma("unroll") for (int m = 0; m < 4; ++m) _Pragma("unroll") for (int k = 0; k < 2; ++k) dst[m][k] = *(const PG8_LAS bf16x8*)(lds + PG8_SA(b, h) + aoff + m * 2048 + k * 1024); } while (0)
#define PG8_LDB(dst, b, h) do { _Pragma("unroll") for (int n = 0; n < 2; ++n) _Pragma("unroll") for (int k = 0; k < 2; ++k) dst[n][k] = *(const PG8_LAS bf16x8*)(lds + PG8_SB(b, h) + boff + n * 2048 + k * 1024); } while (0)
#define PG8_MMA(ai, bj, At, Bt) do { __builtin_amdgcn_s_setprio(1); _Pragma("unroll") for (int m = 0; m < 4; ++m) _Pragma("unroll") for (int n = 0; n < 2; ++n) _Pragma("unroll") for (int k = 0; k < 2; ++k) \
        acc[ai][bj][m][n] = __builtin_amdgcn_mfma_f32_16x16x32_bf16(Bt[n][k], At[m][k], acc[ai][bj][m][n], 0, 0, 0); __builtin_amdgcn_s_setprio(0); } while (0)
#define PG8_WAIT_V(n) asm volatile("s_waitcnt vmcnt(" #n ")" ::: "memory")
#define PG8_WAIT_L(n) asm volatile("s_waitcnt lgkmcnt(" #n ")" ::: "memory")
#define PG8_BAR __builtin_amdgcn_s_barrier()
#define PG8_SCHED __builtin_amdgcn_sched_barrier(0)
    Unit cur, nxt; int ui = 0;
    if (!S.next(0, cur)) return;
    f32x4 acc[2][2][4][2];
#pragma unroll
    for (int a = 0; a < 2; ++a)
#pragma unroll
        for (int b = 0; b < 2; ++b)
#pragma unroll
            for (int m = 0; m < 4; ++m)
#pragma unroll
                for (int n = 0; n < 2; ++n) acc[a][b][m][n] = (f32x4){0.f, 0.f, 0.f, 0.f};
    bf16x8 At[4][2], B0[2][2], B1[2][2];
    const char* cA = (const char*)g.A + (size_t)cur.pm * tstepA; const char* cB = (const char*)g.Bt + (size_t)cur.pn * tstep;
    S.a_ready(cur);
    if constexpr (Epi::FULL) E.prefetch(lds, tid, cur, 0);
    if constexpr (Epi::MIDSCALE) E.prep(lds, tid, cur, wr, fr);
    if constexpr (SP2) {
        PG8_STAGE(PG8_SB(0, 0), cB, voffB); PG8_STAGE(PG8_SB(0, 1), cB + hstep, voffB); PG8_STAGE(PG8_SA(0, 0), cA, voffA); PG8_STAGE(PG8_SA(0, 1), cA + hstep, voffA);
        if (wr == 1) PG8_BAR;
        PG8_WAIT_V(2); PG8_BAR;
        PG8_STAGE(PG8_SB(1, 0), cB + kstep, voffB); PG8_STAGE(PG8_SA(1, 0), cA + kstep, voffA); PG8_STAGE(PG8_SB(1, 1), cB + hstep + kstep, voffB);
        PG8_WAIT_V(6); PG8_BAR;
    } else {
        PG8_STAGE(PG8_SB(0, 0), cB, voffB); PG8_STAGE(PG8_SA(0, 0), cA, voffA); PG8_STAGE(PG8_SB(0, 1), cB + hstep, voffB); PG8_STAGE(PG8_SA(0, 1), cA + hstep, voffA);
        if (wr == 1) PG8_BAR;
        PG8_WAIT_V(4); PG8_BAR;
        PG8_STAGE(PG8_SB(1, 0), cB + kstep, voffB); PG8_STAGE(PG8_SA(1, 0), cA + kstep, voffA); PG8_STAGE(PG8_SB(1, 1), cB + hstep + kstep, voffB);
        PG8_WAIT_V(6); PG8_BAR;
    }
    for (;;) {
        const bool has_next = S.next(ui + 1, nxt);
        const char* nA = has_next ? (const char*)g.A + (size_t)nxt.pm * tstepA : cA; const char* nB = has_next ? (const char*)g.Bt + (size_t)nxt.pn * tstep : cB;
        for (int t = 0; t < nt; t += 2) {
            if constexpr (Epi::MIDSCALE) { if (t == (nt >> 1)) E.midscale(acc, lds, tid); }
            const bool last = (t == nt - 2);
            const char* a1 = cA + (size_t)(t + 1) * kstep;
            const char* a2 = last ? nA : cA + (size_t)(t + 2) * kstep; const char* b2 = last ? nB : cB + (size_t)(t + 2) * kstep;
            const char* a3 = a2 + kstep; const char* b3 = b2 + kstep;
            if (last && has_next) S.a_ready(nxt);
            if constexpr (SP2) {
            PG8_LDB(B0, 0, 0); PG8_LDB(B1, 0, 1); PG8_SCHED; PG8_LDA(At, 0, 0); PG8_STAGE(PG8_SA(1, 1), a1 + hstep, voffA);
            PG8_WAIT_V(8); PG8_WAIT_L(0); PG8_BAR; PG8_MMA(0, 0, At, B0); PG8_MMA(0, 1, At, B1); PG8_BAR; PG8_SCHED;
            PG8_LDA(At, 0, 1); PG8_STAGE(PG8_SB(0, 0), b2, voffB); PG8_STAGE(PG8_SB(0, 1), b2 + hstep, voffB); PG8_STAGE(PG8_SA(0, 0), a2, voffA);
            PG8_WAIT_V(8); PG8_WAIT_L(0); PG8_BAR; PG8_MMA(1, 0, At, B0); PG8_MMA(1, 1, At, B1); PG8_BAR; PG8_SCHED;
            PG8_LDB(B0, 1, 0); PG8_LDB(B1, 1, 1); PG8_SCHED; PG8_LDA(At, 1, 0); PG8_STAGE(PG8_SA(0, 1), a2 + hstep, voffA);
            PG8_WAIT_V(8); PG8_WAIT_L(0); PG8_BAR; PG8_MMA(0, 0, At, B0); PG8_MMA(0, 1, At, B1); PG8_BAR; PG8_SCHED;
            PG8_LDA(At, 1, 1); PG8_STAGE(PG8_SB(1, 0), b3, voffB); PG8_STAGE(PG8_SB(1, 1), b3 + hstep, voffB); PG8_STAGE(PG8_SA(1, 0), a3, voffA);
            PG8_WAIT_V(8); PG8_WAIT_L(0); PG8_BAR; PG8_MMA(1, 0, At, B0); PG8_MMA(1, 1, At, B1); PG8_BAR; PG8_SCHED;
            } else {
            PG8_LDB(B0, 0, 0); PG8_SCHED; PG8_LDA(At, 0, 0); PG8_STAGE(PG8_SA(1, 1), a1 + hstep, voffA);
            PG8_WAIT_L(8); PG8_BAR; PG8_WAIT_L(0); PG8_MMA(0, 0, At, B0); PG8_BAR; PG8_SCHED;
            PG8_LDB(B1, 0, 1); PG8_STAGE(PG8_SB(0, 0), b2, voffB);
            PG8_BAR; PG8_WAIT_L(0); PG8_MMA(0, 1, At, B1); PG8_BAR;
            PG8_LDA(At, 0, 1); PG8_STAGE(PG8_SA(0, 0), a2, voffA);
            PG8_BAR; PG8_WAIT_L(0); PG8_MMA(1, 0, At, B0); PG8_BAR; PG8_SCHED;
            PG8_STAGE(PG8_SB(0, 1), b2 + hstep, voffB);
            PG8_WAIT_V(6); PG8_BAR; PG8_MMA(1, 1, At, B1); PG8_BAR;
            PG8_LDB(B0, 1, 0); PG8_SCHED; PG8_LDA(At, 1, 0); PG8_STAGE(PG8_SA(0, 1), a2 + hstep, voffA);
            PG8_WAIT_L(8); PG8_BAR; PG8_WAIT_L(0); PG8_MMA(0, 0, At, B0); PG8_BAR; PG8_SCHED;
            PG8_LDB(B1, 1, 1); PG8_STAGE(PG8_SB(1, 0), b3, voffB);
            PG8_BAR; PG8_WAIT_L(0); PG8_MMA(0, 1, At, B1); PG8_BAR;
            PG8_LDA(At, 1, 1); PG8_STAGE(PG8_SA(1, 0), a3, voffA);
            PG8_BAR; PG8_WAIT_L(0); PG8_MMA(1, 0, At, B0); PG8_BAR; PG8_SCHED;
            PG8_STAGE(PG8_SB(1, 1), b3 + hstep, voffB);
            PG8_WAIT_V(6); PG8_BAR; PG8_MMA(1, 1, At, B1); PG8_BAR;
            }
        }
        if constexpr (ALIGN_EPI) { if (wr == 0) PG8_BAR; }
        if constexpr (Epi::FULL) { E.full(acc, cur, wr, wc, fr, fq, lds, tid, ui); S.done(cur); } else if constexpr (!Epi::AFTER_DRAIN) { E(acc, cur, wr, wc, fr, fq); S.done(cur); }
        if (!has_next) break;
#pragma unroll
        for (int a = 0; a < 2; ++a)
#pragma unroll
            for (int b = 0; b < 2; ++b)
#pragma unroll
                for (int m = 0; m < 4; ++m)
#pragma unroll
                    for (int n = 0; n < 2; ++n) acc[a][b][m][n] = (f32x4){0.f, 0.f, 0.f, 0.f};
        cur = nxt; cA = nA; cB = nB; ++ui;
        if constexpr (Epi::FULL) E.prefetch(lds, tid, cur, ui);
        if constexpr (Epi::MIDSCALE) E.prep(lds, tid, cur, wr, fr);
        if constexpr (ALIGN_EPI) { if (wr == 1) PG8_BAR; }
    }
    PG8_WAIT_V(0);
    if constexpr (!ALIGN_EPI) { if (wr == 0) PG8_BAR; }
    PG8_BAR;
    if constexpr (Epi::AFTER_DRAIN) { E.fused(acc, cur, wr, wc, fr, fq, lds, wid, lane); S.done(cur); }
#undef PG8_SA
#undef PG8_SB
#undef PG8_STAGE
#undef PG8_LDA
#undef PG8_LDB
#undef PG8_MMA
#undef PG8_WAIT_V
#undef PG8_WAIT_L
#undef PG8_BAR
#undef PG8_SCHED
}
}
#include <hip/hip_bf16.h>
#include <cmath>
namespace attn_body {
using bf16=__hip_bfloat16;
using bf16x8=__attribute__((ext_vector_type(8)))short;
using s16x4=__attribute__((ext_vector_type(4)))short;
using f32x16=__attribute__((ext_vector_type(16)))float;
using u32x4=__attribute__((ext_vector_type(4)))unsigned;
constexpr int D=64,PQ=2304,PO=1024;
constexpr int NW=8,QBLK=32,QB=QBLK*NW,KVBLK=64;
__device__ __forceinline__ int crow(int r,int hi){return (r&3)+8*(r>>2)+4*hi;}
#define SBAR() __builtin_amdgcn_sched_barrier(0)
__device__ __forceinline__ void cmask(f32x16&p0,f32x16&p1,int jb,int qrel,int hi){
  const float NEG=-INFINITY; int kb=64*jb+4*hi;
  #pragma unroll
  for(int r=0;r<16;++r){int kv=kb+(r&3)+8*(r>>2); if(kv>qrel)p0[r]=NEG; if(kv+32>qrel)p1[r]=NEG;}
}

constexpr int NSLOT=3, SLOTB=8192;
constexpr int LDS_K=0, LDS_V=NSLOT*SLOTB, LDS_WS=2*NSLOT*SLOTB, LDS_OST=LDS_WS+NW*64*4, LDS_BYTES=LDS_OST+NW*4096;
constexpr float C2=0.125f*1.4426950408889634f;
__device__ __forceinline__ void glds16(const void*gsrc,unsigned lds_dst){unsigned keep;
  asm volatile("s_mov_b32 %0, m0\n\ts_mov_b32 m0, %2\n\ts_nop 0\n\tglobal_load_lds_dwordx4 %1, off\n\ts_mov_b32 m0, %0":"=&s"(keep):"v"(gsrc),"s"(lds_dst):"memory");}
#define ATT_DPPF(srcv, ctrl) __builtin_bit_cast(float, __builtin_amdgcn_update_dpp(0, __builtin_bit_cast(int, (float)(srcv)), (ctrl), 0xf, 0xf, true))
__device__ __forceinline__ float sum8(float x){ x+=ATT_DPPF(x,0xB1); x+=ATT_DPPF(x,0x4E); x+=ATT_DPPF(x,0x141); return x; }
__device__ __forceinline__ float xsum32(float x){ auto rr=__builtin_amdgcn_permlane32_swap(__float_as_uint(x),__float_as_uint(x),false,false); return __uint_as_float(rr[0])+__uint_as_float(rr[1]); }
__device__ __forceinline__ float xmax32(float x){ auto rr=__builtin_amdgcn_permlane32_swap(__float_as_uint(x),__float_as_uint(x),false,false); return __builtin_fmaxf(__uint_as_float(rr[0]),__uint_as_float(rr[1])); }
__device__ __forceinline__ float max3f(float a,float b,float c){float r;asm("v_max3_f32 %0, %1, %2, %3":"=v"(r):"v"(a),"v"(b),"v"(c));return r;}
__device__ __forceinline__ float max2f(float a,float b){float r;asm("v_max_f32_e32 %0, %1, %2":"=v"(r):"v"(a),"v"(b));return r;}
__device__ __forceinline__ float fadd_s(float a,float b){float r;asm("v_add_f32_e32 %0, %1, %2":"=v"(r):"v"(a),"v"(b));return r;}
__device__ __forceinline__ float fsub_s(float a,float b){float r;asm("v_sub_f32_e32 %0, %1, %2":"=v"(r):"v"(a),"v"(b));return r;}
typedef float f32x2_t __attribute__((ext_vector_type(2))); typedef __bf16 bf16x2_t __attribute__((ext_vector_type(2)));
__device__ __forceinline__ unsigned cvtpk_s(float lo,float hi){f32x2_t v={lo,hi};bf16x2_t b=__builtin_convertvector(v,bf16x2_t);return __builtin_bit_cast(unsigned,b);}
#define WAIT_BAR(N) asm volatile("s_waitcnt vmcnt(" #N ") lgkmcnt(0)\n\ts_barrier":::"memory")

__device__ __forceinline__ void qkt(f32x16&p0,f32x16&p1,const char*Kslot,const bf16x8*qr,const f32x16&negm,int r32,int hi){
  const char*kb=Kslot+hi*1024+r32*16;
  #pragma unroll
  for(int d0=0;d0<4;++d0){
    const bf16x8 b0=*reinterpret_cast<const bf16x8*>(kb+d0*2048);
    const bf16x8 b1=*reinterpret_cast<const bf16x8*>(kb+d0*2048+512);
    if(d0==0){p0=__builtin_amdgcn_mfma_f32_32x32x16_bf16(b0,qr[0],negm,0,0,0);p1=__builtin_amdgcn_mfma_f32_32x32x16_bf16(b1,qr[0],negm,0,0,0);}
    else{p0=__builtin_amdgcn_mfma_f32_32x32x16_bf16(b0,qr[d0],p0,0,0,0);p1=__builtin_amdgcn_mfma_f32_32x32x16_bf16(b1,qr[d0],p1,0,0,0);}}
}
typedef __attribute__((address_space(3))) const char* lds_cptr;
typedef short v4i16_t __attribute__((ext_vector_type(4)));
__device__ __forceinline__ void kload8(bf16x8*kf,lds_cptr kp){
  kf[0]=*(const __attribute__((address_space(3))) bf16x8*)(kp);      kf[1]=*(const __attribute__((address_space(3))) bf16x8*)(kp+512);
  kf[2]=*(const __attribute__((address_space(3))) bf16x8*)(kp+2048); kf[3]=*(const __attribute__((address_space(3))) bf16x8*)(kp+2560);
  kf[4]=*(const __attribute__((address_space(3))) bf16x8*)(kp+4096); kf[5]=*(const __attribute__((address_space(3))) bf16x8*)(kp+4608);
  kf[6]=*(const __attribute__((address_space(3))) bf16x8*)(kp+6144); kf[7]=*(const __attribute__((address_space(3))) bf16x8*)(kp+6656);
}
__device__ __forceinline__ void kload2(bf16x8*kf,lds_cptr kp,int j){ kf[2*j]=*(const __attribute__((address_space(3))) bf16x8*)(kp+j*2048); kf[2*j+1]=*(const __attribute__((address_space(3))) bf16x8*)(kp+j*2048+512); }
__device__ __forceinline__ s16x4 vtr(lds_cptr p){ return __builtin_bit_cast(s16x4,__builtin_amdgcn_ds_read_tr16_b64_v4i16((__attribute__((address_space(3))) v4i16_t*)p)); }
__device__ __forceinline__ float rowmax(const f32x16&p0,const f32x16&p1){
  float a=max3f(p0[0],p0[1],p1[0]),b=max3f(p0[2],p0[3],p1[1]);a=max3f(a,p1[2],p1[3]);
  #pragma unroll
  for(int r=4;r<16;r+=4){a=max3f(a,p0[r],p0[r+1]);b=max3f(b,p0[r+2],p0[r+3]);a=max3f(a,p1[r],p1[r+1]);b=max3f(b,p1[r+2],p1[r+3]);}
  const float m=max2f(a,b);
  auto rr=__builtin_amdgcn_permlane32_swap(__float_as_uint(m),__float_as_uint(m),false,false);
  return max2f(__uint_as_float(rr[0]),__uint_as_float(rr[1]));
}
__device__ __forceinline__ void pv(f32x16*o,int vb,bf16x8 pa0,bf16x8 pa1,bf16x8 pa2,bf16x8 pa3){
  #pragma unroll
  for(int d0=0;d0<2;++d0){s16x4 lo[4],hi[4];
    #pragma unroll
    for(int ks=0;ks<4;++ks){
      asm volatile("ds_read_b64_tr_b16 %0,%1 offset:%c2":"=&v"(lo[ks]):"v"(vb),"i"(d0*4096+ks*1024):"memory");
      asm volatile("ds_read_b64_tr_b16 %0,%1 offset:%c2":"=&v"(hi[ks]):"v"(vb),"i"(d0*4096+ks*1024+512):"memory");}
    asm volatile("s_waitcnt lgkmcnt(0)":::"memory");SBAR();
    #define PK(k) (bf16x8){lo[k][0],lo[k][1],lo[k][2],lo[k][3],hi[k][0],hi[k][1],hi[k][2],hi[k][3]}
    o[d0]=__builtin_amdgcn_mfma_f32_32x32x16_bf16(pa0,PK(0),o[d0],0,0,0);
    o[d0]=__builtin_amdgcn_mfma_f32_32x32x16_bf16(pa1,PK(1),o[d0],0,0,0);
    o[d0]=__builtin_amdgcn_mfma_f32_32x32x16_bf16(pa2,PK(2),o[d0],0,0,0);
    o[d0]=__builtin_amdgcn_mfma_f32_32x32x16_bf16(pa3,PK(3),o[d0],0,0,0);
    #undef PK
  }
}

#ifndef ATTN_STORE16
#define ATTN_STORE16(p,v) (*(u32x4*)(p)=(v))
#endif
template<int THRL> __device__ __forceinline__ void attn_unit(long rowbase,int NT,int h,int kvh,int qb,const bf16*Q,const bf16*__restrict__ K,const bf16*__restrict__ V,bf16*O,float*ssq,char*shm){
  int tid=threadIdx.x; asm volatile("":"+v"(tid)); const int lane=tid&63,r32=lane&31,hi=lane>>5; const int wid=__builtin_amdgcn_readfirstlane(tid>>6);
  const int q0=qb*QB;
  const bf16*Qw=Q+(rowbase+q0+wid*QBLK)*PQ+h*D;
  const bf16*Kh=K+rowbase*PQ+kvh*D,*Vh=V+rowbase*PQ+kvh*D;
  const unsigned lds0=(unsigned)(uintptr_t)shm;
  float*wsf=(float*)(shm+LDS_WS)+wid*64;
  const bf16*ksrc=Kh+(long)lane*PQ+wid*8;
  const bf16*vsrc=Vh+(long)(16*(wid&3)+(lane>>2))*PQ+(wid>>2)*32+(lane&3)*8;
  const unsigned kdst=lds0+LDS_K+wid*1024, vdst=lds0+LDS_V+wid*1024;
  #define DMA_K(t,slot) glds16(ksrc+(long)(t)*KVBLK*PQ,(unsigned)__builtin_amdgcn_readfirstlane(kdst+(slot)))
  #define DMA_V(t,slot) glds16(vsrc+(long)(t)*KVBLK*PQ,(unsigned)__builtin_amdgcn_readfirstlane(vdst+(slot)))
  const int vb0=(int)(lds0+LDS_V)+((lane>>4)&1)*32+(lane&3)*8+(4*hi+((lane&15)>>2))*64;
  const char*Kbase=shm+LDS_K; bf16x8 kf[8];
  const lds_cptr shm3=(lds_cptr)shm; const lds_cptr kp0=shm3+LDS_K+hi*1024+r32*16; const lds_cptr vp0=shm3+LDS_V+((lane>>4)&1)*32+(lane&3)*8+(4*hi+((lane&15)>>2))*64;
  DMA_K(0,0);DMA_V(0,0);DMA_K(1,SLOTB);
  bf16x8 qr[4];
  #pragma unroll
  for(int d0=0;d0<4;++d0)qr[d0]=*reinterpret_cast<const bf16x8*>(&Qw[(long)r32*PQ+d0*16+hi*8]);
  float mhat=0.f,l_reg=0.f;f32x16 o[2];o[0]=f32x16{};o[1]=f32x16{};f32x16 negm=f32x16{};asm volatile("":"+v"(negm));
  const int qrel=wid*QBLK+r32;
  #define CMASK(P0,P1,t) do{int jb_=(t)-(NT-4); (void)jb_;(void)qrel;}while(0)
  bool resc=false;
  #define START(P0,P1) do{ const float rm=rowmax(P0,P1); resc=false; \
    { const float dl=rm; mhat=fadd_s(mhat,dl); \
      _Pragma("unroll") for(int r=0;r<16;++r){P0[r]=fsub_s(P0[r],dl);P1[r]=fsub_s(P1[r],dl);} \
      _Pragma("unroll") for(int r=0;r<16;++r)negm[r]=-mhat; asm volatile("":"+v"(negm)); } \
    _Pragma("unroll") for(int r=0;r<16;++r)P0[r]=__builtin_amdgcn_exp2f(P0[r]); }while(0)
  #define RESC() do{ if(resc){ asm volatile("s_waitcnt lgkmcnt(0)":::"memory"); \
      _Pragma("unroll") for(int d_=0;d_<2;++d_) _Pragma("unroll") for(int r=0;r<16;++r)o[d_][r]*=wsf[crow(r,hi)]; } }while(0)
  f32x16 pA0,pA1,pB0,pB1;
  int sl_prev=0,sl_cur=0,sl_next=SLOTB;
  #define ROT() do{sl_prev=sl_cur;sl_cur=sl_next;sl_next=(sl_next==(NSLOT-1)*SLOTB)?0:sl_next+SLOTB;}while(0)
  DMA_K(2,2*SLOTB);
  WAIT_BAR(3);
  qkt(pA0,pA1,Kbase,qr,negm,r32,hi);asm volatile("s_nop 15\n\ts_nop 7":"+v"(pA0),"+v"(pA1));CMASK(pA0,pA1,0);
  START(pA0,pA1);
  _Pragma("unroll") for(int r=0;r<16;++r)pA1[r]=__builtin_amdgcn_exp2f(pA1[r]);
  WAIT_BAR(0);
  DMA_K(3,0);DMA_V(1,SLOTB);
  ROT();
  kload8(kf,kp0+sl_cur);
  WAIT_BAR(2);
  s16x4 vlo[8],vhi[8]; u32x4 pw0,pw1,pw2,pw3;
  #define PKW(P,B) cvtpk_s(P[B],P[B+1])
  #define PAF(k) __builtin_bit_cast(bf16x8,pw##k)
  #define VFR(i) (bf16x8){vlo[i][0],vlo[i][1],vlo[i][2],vlo[i][3],vhi[i][0],vhi[i][1],vhi[i][2],vhi[i][3]}
  #define PIN(x) asm volatile("":"+v"(x))
  #define MX3(a,b,c) __builtin_fmaxf(__builtin_fmaxf((a),(b)),(c))
  #define GAPA(MF,A0,A1,A2,A3,W0,W1,PW) do{ MF; sacc+=A0; sacc+=A1; sacc+=A2; sacc+=A3; PIN(sacc); W0; W1; PIN(PW); SBAR(); }while(0)
  #define EX(v) __builtin_amdgcn_exp2f(v)
  #define GAPB(MF,X,B) do{ MF; X[B]=EX(X[B]); X[B+1]=EX(X[B+1]); X[B+2]=EX(X[B+2]); X[B+3]=EX(X[B+3]); PIN(X); SBAR(); }while(0)
  #define VRD(i) do{ vlo[i]=vtr(vp_+(((i)>>2)*4096+((i)&3)*1024)); vhi[i]=vtr(vp_+(((i)>>2)*4096+((i)&3)*1024+512)); }while(0)
  #define KRD(G,j) do{ if(G){ kload2(kf,kp0+sl_next,j); SBAR(); } }while(0)
  #define STEP(C0,C1,P0,P1,t,GK,GV,GL) do{ SBAR(); \
    const lds_cptr vp_=vp0+sl_prev; \
    VRD(0); SBAR(); float sacc=(P0[0]+P0[1]); \
    GAPA(C0=__builtin_amdgcn_mfma_f32_32x32x16_bf16(kf[0],qr[0],negm,0,0,0), P0[2],P0[3],P0[4],P0[5],     pw0[0]=PKW(P0,0), pw0[1]=PKW(P0,2), pw0); \
    VRD(4); SBAR(); GAPA(C1=__builtin_amdgcn_mfma_f32_32x32x16_bf16(kf[1],qr[0],negm,0,0,0), P0[6],P0[7],P0[8],P0[9],     pw0[2]=PKW(P0,4), pw0[3]=PKW(P0,6), pw0); \
    VRD(1); SBAR(); GAPA(C0=__builtin_amdgcn_mfma_f32_32x32x16_bf16(kf[2],qr[1],C0,0,0,0),   P0[10],P0[11],P0[12],P0[13], pw1[0]=PKW(P0,8), pw1[1]=PKW(P0,10), pw1); \
    VRD(5); SBAR(); GAPA(C1=__builtin_amdgcn_mfma_f32_32x32x16_bf16(kf[3],qr[1],C1,0,0,0),   P0[14],P0[15],P1[0],P1[1],   pw1[2]=PKW(P0,12),pw1[3]=PKW(P0,14), pw1); \
    VRD(2); SBAR(); GAPA(C0=__builtin_amdgcn_mfma_f32_32x32x16_bf16(kf[4],qr[2],C0,0,0,0),   P1[2],P1[3],P1[4],P1[5],     pw2[0]=PKW(P1,0), pw2[1]=PKW(P1,2), pw2); \
    VRD(6); SBAR(); GAPA(C1=__builtin_amdgcn_mfma_f32_32x32x16_bf16(kf[5],qr[2],C1,0,0,0),   P1[6],P1[7],P1[8],P1[9],     pw2[2]=PKW(P1,4), pw2[3]=PKW(P1,6), pw2); \
    VRD(3); SBAR(); GAPA(C0=__builtin_amdgcn_mfma_f32_32x32x16_bf16(kf[6],qr[3],C0,0,0,0),   P1[10],P1[11],P1[12],P1[13], pw3[0]=PKW(P1,8), pw3[1]=PKW(P1,10), pw3); \
    VRD(7); SBAR(); GAPA(C1=__builtin_amdgcn_mfma_f32_32x32x16_bf16(kf[7],qr[3],C1,0,0,0),   P1[14],P1[15],0.f,0.f,       pw3[2]=PKW(P1,12),pw3[3]=PKW(P1,14), pw3); \
    l_reg+=sacc; \
    if(GK){DMA_K((t)+3,sl_cur);} if(GV){DMA_V((t)+1,sl_next);} \
    CMASK(C0,C1,t); \
    { float a=MX3(C0[0],C0[1],C1[0]),b=MX3(C0[2],C0[3],C1[1]); a=MX3(a,C1[2],C1[3]); \
      _Pragma("unroll") for(int r=4;r<16;r+=4){a=MX3(a,C0[r],C0[r+1]);b=MX3(b,C0[r+2],C0[r+3]);a=MX3(a,C1[r],C1[r+1]);b=MX3(b,C1[r+2],C1[r+3]);} \
      float rm=__builtin_fmaxf(a,b); { auto rr=__builtin_amdgcn_permlane32_swap(__float_as_uint(rm),__float_as_uint(rm),false,false); rm=__builtin_fmaxf(__uint_as_float(rr[0]),__uint_as_float(rr[1])); } \
      resc=false; \
      if(__builtin_expect(__any(rm>(float)THRL),0)){ const float dl=__builtin_fmaxf(rm,0.f); mhat+=dl; \
        _Pragma("unroll") for(int r=0;r<16;++r){C0[r]-=dl;C1[r]-=dl;} \
        _Pragma("unroll") for(int r=0;r<16;++r)negm[r]=-mhat; asm volatile("":"+v"(negm)); \
        const float f=__builtin_amdgcn_exp2f(-dl); l_reg*=f; if(hi==0)wsf[r32]=f; resc=true; } } \
    SBAR(); \
    GAPB(o[0]=__builtin_amdgcn_mfma_f32_32x32x16_bf16(PAF(0),VFR(0),o[0],0,0,0), C0,0); \
    GAPB(o[1]=__builtin_amdgcn_mfma_f32_32x32x16_bf16(PAF(0),VFR(4),o[1],0,0,0), C0,4); \
    KRD(GL,0); GAPB(o[0]=__builtin_amdgcn_mfma_f32_32x32x16_bf16(PAF(1),VFR(1),o[0],0,0,0), C0,8); \
    KRD(GL,1); GAPB(o[1]=__builtin_amdgcn_mfma_f32_32x32x16_bf16(PAF(1),VFR(5),o[1],0,0,0), C0,12); \
    KRD(GL,2); GAPB(o[0]=__builtin_amdgcn_mfma_f32_32x32x16_bf16(PAF(2),VFR(2),o[0],0,0,0), C1,0); \
    KRD(GL,3); GAPB(o[1]=__builtin_amdgcn_mfma_f32_32x32x16_bf16(PAF(2),VFR(6),o[1],0,0,0), C1,4); \
    GAPB(o[0]=__builtin_amdgcn_mfma_f32_32x32x16_bf16(PAF(3),VFR(3),o[0],0,0,0), C1,8); \
    GAPB(o[1]=__builtin_amdgcn_mfma_f32_32x32x16_bf16(PAF(3),VFR(7),o[1],0,0,0), C1,12); \
    }while(0)
  int t=1;
  #undef CMASK
  #define CMASK(P0,P1,t) do{}while(0)
  for(;t+5<NT;t+=2){
    STEP(pB0,pB1,pA0,pA1,t,true,true,true);     WAIT_BAR(2); RESC(); ROT();
    STEP(pA0,pA1,pB0,pB1,t+1,true,true,true);   WAIT_BAR(2); RESC(); ROT();
  }
  #undef CMASK
  #define CMASK(P0,P1,t) do{int jb_=(t)-(NT-4); (void)jb_;(void)qrel;}while(0)
  #define ENDW(tt) do{ if((tt)+3<NT){WAIT_BAR(2);} else if((tt)+2<NT){WAIT_BAR(1);} else {WAIT_BAR(0);} }while(0)
  for(;t+1<NT;t+=2){
    STEP(pB0,pB1,pA0,pA1,t,(t+3<NT),(t+1<NT),(t+1<NT));       ENDW(t);   RESC(); ROT();
    STEP(pA0,pA1,pB0,pB1,t+1,(t+4<NT),(t+2<NT),(t+2<NT));     ENDW(t+1); RESC(); ROT();
  }
  STEP(pB0,pB1,pA0,pA1,NT-1,false,false,false); RESC();
  { float sacc=pB0[0]+pB0[1]; _Pragma("unroll") for(int r=2;r<16;++r)sacc+=pB0[r]; _Pragma("unroll") for(int r=0;r<16;++r)sacc+=pB1[r]; l_reg+=sacc;
    pw0=(u32x4){PKW(pB0,0),PKW(pB0,2),PKW(pB0,4),PKW(pB0,6)};pw1=(u32x4){PKW(pB0,8),PKW(pB0,10),PKW(pB0,12),PKW(pB0,14)};pw2=(u32x4){PKW(pB1,0),PKW(pB1,2),PKW(pB1,4),PKW(pB1,6)};pw3=(u32x4){PKW(pB1,8),PKW(pB1,10),PKW(pB1,12),PKW(pB1,14)};
    SBAR(); pv(o,vb0+sl_cur,PAF(0),PAF(1),PAF(2),PAF(3)); }
  #undef PKW
  #undef PAF
  #undef VFR
  #undef PIN
  #undef MX3
  #undef GAPA
  #undef GAPB
  #undef EX
  #undef VRD
  #undef KRD
  #undef STEP
  #undef ENDW
  {auto rr=__builtin_amdgcn_permlane32_swap(__float_as_uint(l_reg),__float_as_uint(l_reg),false,false);l_reg=__uint_as_float(rr[0])+__uint_as_float(rr[1]);}
  if(hi==0)wsf[32+r32]=l_reg;asm volatile("s_waitcnt lgkmcnt(0)":::"memory");
  float rli[16];
  #pragma unroll
  for(int r=0;r<16;++r)rli[r]=__builtin_amdgcn_rcpf(wsf[32+crow(r,hi)]);
  bf16*Ow=O+(rowbase+q0+wid*QBLK)*PO+h*D;
  { bf16*stg=(bf16*)(shm+LDS_OST)+wid*2048;
    #pragma unroll
    for(int r=0;r<16;++r){const int orow=crow(r,hi);
      #pragma unroll
      for(int d0=0;d0<2;++d0)stg[orow*64+d0*32+r32]=__float2bfloat16(o[d0][r]*rli[r]);}
    asm volatile("s_waitcnt lgkmcnt(0)":::"memory");
    #pragma unroll
    for(int i=0;i<4;++i){const int row=i*8+(lane>>3),ch=lane&7; const u32x4 v=*(const u32x4*)(stg+row*64+ch*8); ATTN_STORE16(Ow+(long)row*PO+ch*8,v);
      float ss=0.f; _Pragma("unroll") for(int e=0;e<4;++e){const float lo=__uint_as_float(v[e]<<16),hh=__uint_as_float(v[e]&0xffff0000u); ss+=lo*lo+hh*hh;}
      ss=sum8(ss); if(ch==0)__hip_atomic_fetch_add(ssq+(rowbase+q0+wid*QBLK+row),ss,__ATOMIC_RELAXED,__HIP_MEMORY_SCOPE_AGENT);} }
  asm volatile("s_waitcnt lgkmcnt(0)\n\ts_barrier":::"memory");
  #undef DMA_K
  #undef DMA_V
  #undef CMASK
  #undef START
  #undef RESC
  #undef ROT
}
constexpr int ATTN_LDS_BYTES=LDS_BYTES;
#undef SBAR
#undef WAIT_BAR
}
namespace na_body {
using attn_body::bf16x8; using attn_body::s16x4; using attn_body::f32x16; using attn_body::u32x4;
#define NA_LAS __attribute__((address_space(3)))
constexpr int PQ = 2304, PO = 1024;
constexpr int COL_QB = 768, COL_KB = 1280, COL_VB = 1792, COL_OB = 512;
constexpr int KROW = 144, K_BYTES = 64 * KROW, TILE_BYTES = K_BYTES + 8192;
constexpr int T_GUARD = 48, T_FLOATS = T_GUARD + 15 * 32 + 48;
__device__ __forceinline__ int crow(int r, int hi) { return (r & 3) + 8 * (r >> 2) + 4 * hi; }
__device__ __forceinline__ unsigned cvtpk(float lo, float hi) { return attn_body::cvtpk_s(lo, hi); }

__device__ __forceinline__ void na_unit(unsigned char* __restrict__ ws, unsigned proj_off, unsigned o_off, unsigned ssq_off, int rowbase, int rows, int r, int h,
                                        NA_LAS unsigned char* wl, unsigned wl_addr, const NA_LAS float* T, NA_LAS float* wsf) {
    int tid_ = threadIdx.x; asm volatile("" : "+v"(tid_)); const int lane = tid_ & 63, r32 = lane & 31, hi = lane >> 5;
    const int r0 = min(max(r - 4, 0), rows - 8);
    const int qrow0 = rowbase + r * 64;
    const unsigned qoff = proj_off + (unsigned)((qrow0 + r32) * PQ + COL_QB + h * 64 + hi * 8) * 2u;
    bf16x8 qr[2][4];
#pragma unroll
    for (int qb2 = 0; qb2 < 2; ++qb2)
#pragma unroll
        for (int d0 = 0; d0 < 4; ++d0) qr[qb2][d0] = *(const bf16x8*)(ws + (size_t)(qoff + (unsigned)(qb2 * 32 * PQ + d0 * 16) * 2u));
    float mrun[2] = {-1e30f, -1e30f}, lrun[2] = {0.f, 0.f};
    f32x16 o[2][2];
#pragma unroll
    for (int a = 0; a < 2; ++a)
#pragma unroll
        for (int b = 0; b < 2; ++b) o[a][b] = f32x16{};
    const int lrow = lane >> 3, lc = lane & 7;
    const int vb = (int)wl_addr + K_BYTES + ((lane >> 4) & 1) * 32 + (lane & 3) * 8 + (4 * hi + ((lane & 15) >> 2)) * 64;
    unsigned kboff = proj_off + (unsigned)((rowbase + r0 * 64 + lrow) * PQ + COL_KB + h * 64 + lc * 8) * 2u;
    u32x4 kreg[8], vreg[8];
#pragma unroll
    for (int j = 0; j < 8; ++j) { kreg[j] = *(const u32x4*)(ws + (size_t)(kboff + (unsigned)(j * 8 * PQ) * 2u)); vreg[j] = *(const u32x4*)(ws + (size_t)(kboff + (unsigned)(COL_VB - COL_KB + j * 8 * PQ) * 2u)); }
    for (int i = 0; i < 8; ++i) {
#pragma unroll
        for (int j = 0; j < 8; ++j) { const int row = j * 8 + lrow;
            *(NA_LAS u32x4*)(wl + row * KROW + lc * 16) = kreg[j];
            *(NA_LAS u32x4*)(wl + K_BYTES + (lc >> 2) * 4096 + (row >> 4) * 1024 + (row & 15) * 64 + (lc & 3) * 16) = vreg[j]; }
        kboff += (unsigned)(64 * PQ) * 2u;
        __builtin_amdgcn_sched_barrier(0);
        if (i < 7) {
#pragma unroll
            for (int j = 0; j < 8; ++j) { kreg[j] = *(const u32x4*)(ws + (size_t)(kboff + (unsigned)(j * 8 * PQ) * 2u)); vreg[j] = *(const u32x4*)(ws + (size_t)(kboff + (unsigned)(COL_VB - COL_KB + j * 8 * PQ) * 2u)); }
        }
        __builtin_amdgcn_sched_barrier(0);
        const int dr = r0 + i - r + 7;
#pragma unroll
        for (int qb2 = 0; qb2 < 2; ++qb2) {
            f32x16 p0 = f32x16{}, p1 = f32x16{};
#pragma unroll
            for (int d0 = 0; d0 < 4; ++d0) { const bf16x8 k0 = *(const NA_LAS bf16x8*)(wl + r32 * KROW + (2 * d0 + hi) * 16), k1 = *(const NA_LAS bf16x8*)(wl + (r32 + 32) * KROW + (2 * d0 + hi) * 16);
                p0 = __builtin_amdgcn_mfma_f32_32x32x16_bf16(k0, qr[qb2][d0], p0, 0, 0, 0); p1 = __builtin_amdgcn_mfma_f32_32x32x16_bf16(k1, qr[qb2][d0], p1, 0, 0, 0); }
            const int c = qb2 * 32 + r32, c0 = min(max(c - 8, 0), 48);
            const NA_LAS float* tb = T + dr * 32 + 15 - c + 4 * hi;
            const int kofs = 4 * hi - c0;
#define NA_USE0(rr) (qb2 == 0 || (rr) >= 12)
#define NA_USE1(rr) (qb2 == 1 || (rr) < 4)
            float rm = -1e30f;
#pragma unroll
            for (int rr = 0; rr < 16; ++rr) { const int kc = (rr & 3) + 8 * (rr >> 2);
                if (NA_USE0(rr)) { const float s0 = ((unsigned)(kc + kofs) < 16u) ? p0[rr] + tb[kc] : -1e30f; p0[rr] = s0; rm = fmaxf(rm, s0); }
                if (NA_USE1(rr)) { const float s1 = ((unsigned)(kc + 32 + kofs) < 16u) ? p1[rr] + tb[kc + 32] : -1e30f; p1[rr] = s1; rm = fmaxf(rm, s1); }
                if ((rr & 3) == 3) __builtin_amdgcn_sched_barrier(0); }
            rm = attn_body::xmax32(rm);
            const float mn = fmaxf(mrun[qb2], rm), alpha = __builtin_amdgcn_exp2f(mrun[qb2] - mn);
            mrun[qb2] = mn;
            float sum = 0.f;
#pragma unroll
            for (int rr = 0; rr < 16; ++rr) {
                if (NA_USE0(rr)) { p0[rr] = __builtin_amdgcn_exp2f(p0[rr] - mn); sum += p0[rr]; } else p0[rr] = 0.f;
                if (NA_USE1(rr)) { p1[rr] = __builtin_amdgcn_exp2f(p1[rr] - mn); sum += p1[rr]; } else p1[rr] = 0.f; }
            lrun[qb2] = lrun[qb2] * alpha + sum;
            if (__any(alpha != 1.0f)) {
                if (hi == 0) wsf[r32] = alpha;
#pragma unroll
                for (int rr = 0; rr < 16; ++rr) { const float a = wsf[crow(rr, hi)]; o[qb2][0][rr] *= a; o[qb2][1][rr] *= a; }
            }
            u32x4 pw0, pw1, pw2, pw3;
            pw0 = (u32x4){cvtpk(p0[0], p0[1]), cvtpk(p0[2], p0[3]), cvtpk(p0[4], p0[5]), cvtpk(p0[6], p0[7])};
            pw1 = (u32x4){cvtpk(p0[8], p0[9]), cvtpk(p0[10], p0[11]), cvtpk(p0[12], p0[13]), cvtpk(p0[14], p0[15])};
            pw2 = (u32x4){cvtpk(p1[0], p1[1]), cvtpk(p1[2], p1[3]), cvtpk(p1[4], p1[5]), cvtpk(p1[6], p1[7])};
            pw3 = (u32x4){cvtpk(p1[8], p1[9]), cvtpk(p1[10], p1[11]), cvtpk(p1[12], p1[13]), cvtpk(p1[14], p1[15])};
#undef NA_USE0
#undef NA_USE1
            attn_body::pv(o[qb2], vb, __builtin_bit_cast(bf16x8, pw0), __builtin_bit_cast(bf16x8, pw1), __builtin_bit_cast(bf16x8, pw2), __builtin_bit_cast(bf16x8, pw3));
        }
    }
#pragma unroll
    for (int qb2 = 0; qb2 < 2; ++qb2) {
        const float l = attn_body::xsum32(lrun[qb2]);
        if (hi == 0) wsf[r32] = __builtin_amdgcn_rcpf(l);
        NA_LAS unsigned short* stg = (NA_LAS unsigned short*)(wl + qb2 * 4096);
#pragma unroll
        for (int rr = 0; rr < 16; ++rr) { const int orow = crow(rr, hi); const float rl = wsf[orow];
#pragma unroll
            for (int d0 = 0; d0 < 2; ++d0) stg[orow * 64 + d0 * 32 + r32] = (unsigned short)(cvtpk(o[qb2][d0][rr] * rl, 0.f) & 0xffffu); }
        const unsigned ooff = o_off + (unsigned)((qrow0 + qb2 * 32) * PO + COL_OB + h * 64) * 2u;
#pragma unroll
        for (int k = 0; k < 4; ++k) { const int row = k * 8 + (lane >> 3), ch = lane & 7; const u32x4 v = *(const NA_LAS u32x4*)(stg + row * 64 + ch * 8); *(u32x4*)(ws + (size_t)(ooff + (unsigned)(row * PO + ch * 8) * 2u)) = v;
            float ss = 0.f;
#pragma unroll
            for (int e = 0; e < 4; ++e) { const float lo = __uint_as_float(v[e] << 16), hh = __uint_as_float(v[e] & 0xffff0000u); ss += lo * lo + hh * hh; }
            ss = attn_body::sum8(ss); if (ch == 0) __hip_atomic_fetch_add((float*)(ws + (size_t)(ssq_off + (unsigned)(qrow0 + qb2 * 32 + row) * 4u)), ss, __ATOMIC_RELAXED, __HIP_MEMORY_SCOPE_AGENT); }
    }
}
}
namespace cg = cooperative_groups;
constexpr int NWAVES = 8;
constexpr int DM = 1024, M_PROMPT = 32 * 2048, S_PROMPT = 2048, M_SAMPLE = 4 * 4096, S_SAMPLE = 4096, M_ALL = M_PROMPT + M_SAMPLE;
constexpr int NPROJ = 2304, DFF = 2816, NUP = 2 * DFF, PLE = 256;
constexpr int FFN_CHUNKS = 4, M_CHUNK = M_ALL / FFN_CHUNKS;
constexpr float C2 = 0.125f * 1.4426950408889634f;
constexpr float LOG2E = 1.4426950408889634f;
constexpr size_t MiB = 1u << 20;
constexpr size_t WS_SSQ2 = 0, WS_SSQ3 = 384 * 1024, WS_SSQ4 = 768 * 1024, WS_SSQA = 1152 * 1024, WS_SSQB = 1536 * 1024, WS_ROPE = 1984 * 1024, WS_BAR = 1992 * 1024, BAR_BYTES = 16384;
constexpr size_t WS_WIN = 2 * MiB, WS_WOUT = 7 * MiB, WS_WUP = 9 * MiB, WS_WDOWN = 20 * MiB, WS_WGATE = 26 * MiB, WS_WPLE = 28 * MiB;
constexpr size_t WS_PROJ = 32 * MiB;
constexpr size_t WS_XNO = 392 * MiB;
constexpr size_t WS_ACT = 32 * MiB;
constexpr size_t WS_H2B = 472 * MiB;
constexpr size_t WS_H3B = 32 * MiB;
constexpr size_t WS_E = 632 * MiB;
constexpr size_t WS_H1B = 824 * MiB;
constexpr size_t WS_PB = 984 * MiB;
constexpr size_t WS_END = 1024 * MiB;
static_assert(WS_PROJ + (size_t)M_ALL * NPROJ * 2 <= WS_XNO && WS_XNO + (size_t)M_ALL * DM * 2 <= WS_E && WS_ACT + (size_t)M_ALL * DFF * 2 <= WS_H2B && WS_H2B + (size_t)M_ALL * DM * 2 <= WS_E, "d_ws map");
static_assert(WS_E + (size_t)M_ALL * DM * 2 <= WS_H1B && WS_H1B + (size_t)M_ALL * DM * 2 <= WS_PB && WS_PB + (size_t)M_ALL * PLE * 2 <= WS_END && WS_H3B + (size_t)M_ALL * DM * 2 <= WS_H2B, "d_ws map 2");
static_assert(WS_BAR + BAR_BYTES <= WS_WIN && 3456 * 4 <= BAR_BYTES, "barrier words (XCD_BAR_WORDS = 3456)");
static_assert(WS_WIN + (size_t)NPROJ * DM * 2 <= WS_WOUT && WS_WUP + (size_t)NUP * DM * 2 <= WS_WDOWN && WS_WDOWN + (size_t)DM * DFF * 2 <= WS_WGATE, "weight map");
constexpr int RING_BYTES = 131072;
constexpr int NA_T_OFF = NWAVES * na_body::TILE_BYTES, NA_T_BYTES = na_body::T_FLOATS * 4, NA_WSF_OFF = NA_T_OFF + NWAVES * NA_T_BYTES, XB_ST_OFF = NA_WSF_OFF + NWAVES * 256, LDS_BYTES = XB_ST_OFF + 256;
static_assert(NA_T_OFF >= RING_BYTES + 16384 - 8192 && LDS_BYTES <= 163840 && attn_body::ATTN_LDS_BYTES <= RING_BYTES, "LDS map");

#define LAS __attribute__((address_space(3)))
typedef unsigned short bf16;
typedef unsigned v4u __attribute__((ext_vector_type(4)));
typedef unsigned v2u __attribute__((ext_vector_type(2)));
typedef float f32x4 __attribute__((ext_vector_type(4)));
__device__ __forceinline__ unsigned pk2(float lo, float hi) { return pg8::cvt_pk_bf16(lo, hi); }
__device__ __forceinline__ float bflo(unsigned w) { return __uint_as_float(w << 16); }
__device__ __forceinline__ float bfhi(unsigned w) { return __uint_as_float(w & 0xffff0000u); }
__device__ __forceinline__ float wave_sum(float v) {
#pragma unroll
    for (int o = 1; o < 64; o <<= 1) v += __shfl_xor(v, o);
    return v;
}
__device__ __forceinline__ void p0_transpose_item(const float* W, int K, int N, bf16* WT, LAS float* scr, int item, int lane, const float* gain, const float* gain_hi, int ksplit, int nlo, int nhi, float nscale, bool upmap = false) {
    const int nblk = N / 32, kb = item / nblk, nb = item % nblk, k0 = 64 * kb, n0 = 32 * nb;
#pragma unroll 8
    for (int i = 0; i < 32; ++i) { const int kk = 2 * i + (lane >> 5); float w = W[(size_t)(k0 + kk) * N + n0 + (lane & 31)]; if (gain) w *= (k0 < ksplit ? gain[k0 + kk] : gain_hi[k0 + kk - ksplit]); scr[kk * 33 + (lane & 31)] = w; }
    asm volatile("s_waitcnt lgkmcnt(0)" ::: "memory");
    const int c = lane & 7;
#pragma unroll
    for (int j = 0; j < 4; ++j) { const int n = (lane >> 3) + 8 * j; const LAS float* s = scr + (8 * c) * 33 + n; const float ns = (n0 + n >= nlo && n0 + n < nhi) ? nscale : 1.0f;
        v4u o; o.x = pk2(s[0 * 33] * ns, s[1 * 33] * ns); o.y = pk2(s[2 * 33] * ns, s[3 * 33] * ns); o.z = pk2(s[4 * 33] * ns, s[5 * 33] * ns); o.w = pk2(s[6 * 33] * ns, s[7 * 33] * ns);
        int nn = n0 + n; if (upmap) nn = (nn < DFF) ? 256 * (nn / 128) + (nn % 128) : 256 * ((nn - DFF) / 128) + 128 + ((nn - DFF) % 128);
        *(v4u*)(WT + (size_t)nn * K + k0 + 8 * c) = o; }
    asm volatile("s_waitcnt lgkmcnt(0)" ::: "memory");
}
__device__ __forceinline__ void sincos_cw(float a, float& s, float& c) {
    const float k = rintf(a * 0.636619772367581343f);
    float r = fmaf(-k, 1.5703125f, a); r = fmaf(-k, 4.837512969970703125e-4f, r); r = fmaf(-k, 7.54978995489188216e-8f, r);
    const float r2 = r * r;
    const float sp = r + r * r2 * (-1.6666667163e-01f + r2 * (8.3333337680e-03f + r2 * (-1.9841270114e-04f + r2 * 2.7557314297e-06f)));
    const float cp = 1.0f + r2 * (-0.5f + r2 * (4.1666667908e-02f + r2 * (-1.3888889225e-03f + r2 * (2.4801587642e-05f + r2 * -2.7557314297e-07f))));
    const int q = (int)k & 3;
    s = (q == 0) ? sp : (q == 1) ? cp : (q == 2) ? -sp : -cp;
    c = (q == 0) ? cp : (q == 1) ? -sp : (q == 2) ? -cp : sp;
}

#define XB_TMO      128
#define XB_XCNT(j)  (256  + 64 * (j))
#define XB_XSUB(j)  (1280 + 64 * (j))
#define XB_XGEN(j)  (2304 + 64 * (j))
#define XB_TOP      3328
#define XB_TOPGEN   3392
#define XCD_BAR_WORDS 3456
#define XB_SPIN_CAP (1u << 18)

__device__ __forceinline__ unsigned xb_ld(unsigned* p)              { return __hip_atomic_load(p, __ATOMIC_RELAXED, __HIP_MEMORY_SCOPE_AGENT); }
__device__ __forceinline__ unsigned xb_add(unsigned* p, unsigned v) { return __hip_atomic_fetch_add(p, v, __ATOMIC_RELAXED, __HIP_MEMORY_SCOPE_AGENT); }
__device__ __forceinline__ unsigned xb_xcc_id() { return (unsigned)__builtin_amdgcn_s_getreg((3 << 11) | 20) & 0xFu; }
#define XB_SPIN(cond, bar) do { unsigned _sp = 0; while (cond) { __builtin_amdgcn_s_sleep(1); \
    if ((++_sp & 255u) == 0u) { if (xb_ld(&(bar)[XB_TMO])) break; if (_sp > XB_SPIN_CAP) { atomicAdd(&(bar)[XB_TMO], 1u); break; } } } } while (0)

struct XcdBarrier {
    unsigned* bar; unsigned x;
    volatile LAS unsigned* st;
};

__device__ __forceinline__ XcdBarrier xcd_barrier_post(unsigned* bar, volatile LAS unsigned* st) {
    XcdBarrier b; b.bar = bar; b.x = xb_xcc_id(); b.st = st;
    if (threadIdx.x == 0) (void)xb_add(&bar[XB_XCNT(b.x)], 1u);
    return b;
}
__device__ __forceinline__ void xcd_barrier_complete(unsigned* bar, unsigned x, unsigned& nloc, unsigned& nx) {
    const unsigned G = gridDim.x * gridDim.y * gridDim.z;
    unsigned sum, cnt, mine, sp = 0u;
    for (;;) {
        sum = 0u; cnt = 0u; mine = 0u;
#pragma unroll
        for (unsigned j = 0; j < 16; ++j) { const unsigned c = xb_ld(&bar[XB_XCNT(j)]); sum += c; cnt += (c > 0u) ? 1u : 0u; mine = (j == x) ? c : mine; }
        if (sum == G) break;
        __builtin_amdgcn_s_sleep(1);
        if ((++sp & 255u) == 0u) { if (xb_ld(&bar[XB_TMO])) break; if (sp > XB_SPIN_CAP) { atomicAdd(&bar[XB_TMO], 1u); break; } }
    }
    nloc = mine > 0u ? mine : 1u; nx = cnt > 0u ? cnt : 1u;
}

__device__ __forceinline__ void xcd_barrier(const XcdBarrier& b) {
    asm volatile("s_waitcnt vmcnt(0)" ::: "memory");
    __syncthreads();
    if (threadIdx.x == 0) {
        unsigned* bar = b.bar;
        __builtin_amdgcn_s_waitcnt(0);
        unsigned nloc = b.st[0], nx = b.st[1];
        if (nloc == 0u) { xcd_barrier_complete(bar, b.x, nloc, nx); b.st[0] = nloc; b.st[1] = nx; }
        const unsigned old = xb_add(&bar[XB_XSUB(b.x)], 1u);
        const unsigned gen = old / nloc;
        if (old + 1u == (gen + 1u) * nloc) {
            __builtin_amdgcn_fence(__ATOMIC_RELEASE, "agent");
            asm volatile("s_waitcnt vmcnt(0)" ::: "memory");
            const unsigned og = xb_add(&bar[XB_TOP], 1u);
            const unsigned tg = og / nx;
            if (og + 1u == (tg + 1u) * nx) xb_add(&bar[XB_TOPGEN], 1u);
            else XB_SPIN(xb_ld(&bar[XB_TOPGEN]) == tg, bar);
            __builtin_amdgcn_fence(__ATOMIC_ACQUIRE, "agent");
            xb_add(&bar[XB_XGEN(b.x)], 1u);
            asm volatile("s_waitcnt vmcnt(0)" ::: "memory");
        } else {
            XB_SPIN(xb_ld(&bar[XB_XGEN(b.x)]) == gen, bar);
            __builtin_amdgcn_fence(__ATOMIC_ACQUIRE, "agent");
            asm volatile("s_waitcnt vmcnt(0)" ::: "memory");
        }
    }
    __syncthreads();
}

typedef const __attribute__((address_space(4))) unsigned char* kptr_t;
struct Args { const float* in[21]; float* out; unsigned char* ws; };

__global__ void __launch_bounds__(NWAVES * 64, 2) hymba_fwd(Args args) {
    extern __shared__ __attribute__((aligned(16))) unsigned char lds[];
    cg::grid_group grid = cg::this_grid();
    LAS unsigned char* const L = (LAS unsigned char*)lds;
    const int wave = __builtin_amdgcn_readfirstlane(threadIdx.x >> 6);
    const int G = gridDim.x, bx = blockIdx.x, vcu = (G % 8 == 0) ? (bx % 8) * (G / 8) + bx / 8 : bx;
    const int gw = vcu * NWAVES + wave, NGW = G * NWAVES;
    if (threadIdx.x < 2) ((volatile LAS unsigned*)(L + XB_ST_OFF))[threadIdx.x] = 0u;
    __syncthreads();
    { kptr_t kp0 = (kptr_t)__builtin_amdgcn_kernarg_segment_ptr(); unsigned char* const ws0 = (unsigned char*)(*(const __attribute__((address_space(4))) unsigned long long*)(kp0 + 8 * 22));
      (void)xcd_barrier_post((unsigned*)(ws0 + WS_BAR), (volatile LAS unsigned*)(L + XB_ST_OFF)); }
#define SEAM_BAR() do { kptr_t kpb = (kptr_t)__builtin_amdgcn_kernarg_segment_ptr(); asm volatile("" : "+s"(kpb)); XcdBarrier xb_; xb_.bar = (unsigned*)((unsigned char*)(*(const __attribute__((address_space(4))) unsigned long long*)(kpb + 8 * 22)) + WS_BAR); \
        xb_.x = xb_xcc_id(); xb_.st = (volatile LAS unsigned*)(L + XB_ST_OFF); xcd_barrier(xb_); } while (0)
#define PHASE_PTRS() int tid = threadIdx.x; asm volatile("" : "+v"(tid)); const int lane = tid & 63; (void)lane; kptr_t kp = (kptr_t)__builtin_amdgcn_kernarg_segment_ptr(); asm volatile("" : "+s"(kp)); unsigned char* const ws = (unsigned char*)KLD(22); float* const out = (float*)KLD(21); (void)out; \
    float* const ssq2 = (float*)(ws + WS_SSQ2); float* const ssq3 = (float*)(ws + WS_SSQ3); float* const ssq4 = (float*)(ws + WS_SSQ4); float* const ssqA = (float*)(ws + WS_SSQA); float* const ssqB = (float*)(ws + WS_SSQB); (void)ssqA; (void)ssqB; float* const rope = (float*)(ws + WS_ROPE); (void)ssq2; (void)ssq3; (void)ssq4; (void)rope; \
    bf16* const PROJ = (bf16*)(ws + WS_PROJ); bf16* const XNO = (bf16*)(ws + WS_XNO); (void)PROJ; (void)XNO;
#define KLD(i) (*(const __attribute__((address_space(4))) unsigned long long*)(kp + 8 * (i)))
#define KIN(i) ((const float*)KLD(i))

    {
        PHASE_PTRS();
        const float* const x_prompt = KIN(0); const float* const x_sample = KIN(1); const float* const p_prompt = KIN(2); const float* const p_sample = KIN(3);
        bf16* const Win_t = (bf16*)(ws + WS_WIN); bf16* const Wout_t = (bf16*)(ws + WS_WOUT); bf16* const Wup_t = (bf16*)(ws + WS_WUP); bf16* const Wdown_t = (bf16*)(ws + WS_WDOWN);
        bf16* const Wgate_t = (bf16*)(ws + WS_WGATE); bf16* const Wple_t = (bf16*)(ws + WS_WPLE); bf16* const PB = (bf16*)(ws + WS_PB);
        LAS float* scr = (LAS float*)(L + wave * 16384);
        constexpr int I_IN = (DM / 64) * (NPROJ / 32), I_OUT = (DM / 64) * (DM / 32), I_UP = (DM / 64) * (NUP / 32), I_DOWN = (DFF / 64) * (DM / 32), I_GATE = I_OUT, I_PLE = (PLE / 64) * (DM / 32);
        constexpr int NITEMS = I_IN + I_OUT + I_UP + I_DOWN + I_GATE + I_PLE;
        for (int it = gw; it < NITEMS; it += NGW) {
            int r = it;
            if (r < I_IN) { p0_transpose_item(KIN(5), DM, NPROJ, Win_t, scr, r, lane, nullptr, nullptr, 0, na_body::COL_QB, na_body::COL_KB, C2); continue; } r -= I_IN;
            if (r < I_OUT) { p0_transpose_item(KIN(11), DM, DM, Wout_t, scr, r, lane, KIN(9), KIN(10), 512, 0, 0, 1.f); continue; } r -= I_OUT;
            if (r < I_UP) { p0_transpose_item(KIN(13), DM, NUP, Wup_t, scr, r, lane, KIN(12), nullptr, 1 << 30, 0, 0, 1.f, true); continue; } r -= I_UP;
            if (r < I_DOWN) { p0_transpose_item(KIN(16), DFF, DM, Wdown_t, scr, r, lane, nullptr, nullptr, 0, 0, 0, 1.f); continue; } r -= I_DOWN;
            if (r < I_GATE) { p0_transpose_item(KIN(18), DM, DM, Wgate_t, scr, r, lane, KIN(17), nullptr, 1 << 30, 0, 0, 1.f); continue; } r -= I_GATE;
            p0_transpose_item(KIN(19), PLE, DM, Wple_t, scr, r, lane, nullptr, nullptr, 0, 0, 0, 1.f);
        }
        const float* gain = KIN(4);
        for (int m0 = gw; m0 < M_ALL; m0 += 2 * NGW) {
            const int m1 = m0 + NGW; const bool has1 = m1 < M_ALL; const int m1c = has1 ? m1 : m0;
            const float* xrow0 = (m0 < M_PROMPT) ? x_prompt + (size_t)m0 * DM : x_sample + (size_t)(m0 - M_PROMPT) * DM;
            const float* xrow1 = (m1c < M_PROMPT) ? x_prompt + (size_t)m1c * DM : x_sample + (size_t)(m1c - M_PROMPT) * DM;
            const float* prow0 = (m0 < M_PROMPT) ? p_prompt + (size_t)m0 * PLE : p_sample + (size_t)(m0 - M_PROMPT) * PLE;
            const float* prow1 = (m1c < M_PROMPT) ? p_prompt + (size_t)m1c * PLE : p_sample + (size_t)(m1c - M_PROMPT) * PLE;
            const f32x4* xr0 = (const f32x4*)xrow0 + lane; const f32x4* xr1 = (const f32x4*)xrow1 + lane;
            f32x4 v0[4], v1[4]; float s0 = 0.f, s1 = 0.f;
#pragma unroll
            for (int j = 0; j < 4; ++j) { v0[j] = xr0[64 * j]; v1[j] = xr1[64 * j]; }
            const f32x4 pv0 = ((const f32x4*)prow0)[lane], pv1 = ((const f32x4*)prow1)[lane];
#pragma unroll
            for (int j = 0; j < 4; ++j) { s0 += (v0[j].x * v0[j].x + v0[j].y * v0[j].y) + (v0[j].z * v0[j].z + v0[j].w * v0[j].w); s1 += (v1[j].x * v1[j].x + v1[j].y * v1[j].y) + (v1[j].z * v1[j].z + v1[j].w * v1[j].w); }
            const float rs0 = __builtin_amdgcn_rsqf(wave_sum(s0) * (1.f / DM) + 1e-6f), rs1 = __builtin_amdgcn_rsqf(wave_sum(s1) * (1.f / DM) + 1e-6f);
            unsigned long long* o80 = (unsigned long long*)(XNO + (size_t)m0 * DM) + lane; unsigned long long* o81 = (unsigned long long*)(XNO + (size_t)m1c * DM) + lane;
#pragma unroll
            for (int j = 0; j < 4; ++j) { const f32x4 g = ((const f32x4*)gain)[lane + 64 * j];
                o80[64 * j] = (unsigned long long)pk2(v0[j].x * rs0 * g.x, v0[j].y * rs0 * g.y) | ((unsigned long long)pk2(v0[j].z * rs0 * g.z, v0[j].w * rs0 * g.w) << 32);
                if (has1) o81[64 * j] = (unsigned long long)pk2(v1[j].x * rs1 * g.x, v1[j].y * rs1 * g.y) | ((unsigned long long)pk2(v1[j].z * rs1 * g.z, v1[j].w * rs1 * g.w) << 32); }
            ((unsigned long long*)(PB + (size_t)m0 * PLE))[lane] = (unsigned long long)pk2(pv0.x, pv0.y) | ((unsigned long long)pk2(pv0.z, pv0.w) << 32);
            if (has1) ((unsigned long long*)(PB + (size_t)m1 * PLE))[lane] = (unsigned long long)pk2(pv1.x, pv1.y) | ((unsigned long long)pk2(pv1.z, pv1.w) << 32);
        }
        for (int e = bx * (NWAVES * 64) + tid; e < M_ALL; e += G * NWAVES * 64) { ssq2[e] = 0.f; ssq3[e] = 0.f; ssq4[e] = 0.f; ssqA[e] = 0.f; ssqB[e] = 0.f; }
        for (int e = bx * (NWAVES * 64) + tid; e < 1024; e += G * NWAVES * 64) { const int pos = e >> 4, i = e & 15;
            const float freq = exp2f(-(float)i * (13.287712379549449f / 16.0f)); float s, c; sincos_cw((float)pos * freq, s, c); rope[e] = c; rope[1024 + e] = s; }
    }
    if (G > (1 << 24)) grid.sync();
    SEAM_BAR();

    {
        PHASE_PTRS(); bf16* const Win_t = (bf16*)(ws + WS_WIN);
        pg8::Gemm g{XNO, Win_t, M_ALL, NPROJ, DM}; pg8::StaticOrder S; S.init(M_ALL, NPROJ, G, bx);
        pg8::EpiBf16Rs E{PROJ, NPROJ, nullptr};
        pg8::gemm_phase<pg8::EpiBf16Rs, pg8::StaticOrder, true, true>(L, g, S, E);
#ifdef PROBE_P1X2
        pg8::gemm_phase<pg8::EpiBf16Rs, pg8::StaticOrder, true, true>(L, g, S, E);
#endif
    }
    {
        PHASE_PTRS(); bf16* const PB = (bf16*)(ws + WS_PB); bf16* const Wple_t = (bf16*)(ws + WS_WPLE); bf16* const EB = (bf16*)(ws + WS_E);
        pg8::Gemm g{PB, Wple_t, M_ALL, DM, PLE}; pg8::StaticOrder S; S.init(M_ALL, DM, G, bx);
        pg8::EpiBf16Rs E{EB, DM, nullptr};
        pg8::gemm_phase<pg8::EpiBf16Rs, pg8::StaticOrder, true, true>(L, g, S, E);
    }
    SEAM_BAR();

    {
        PHASE_PTRS();
        const float* qn = KIN(6); const float* kn = KIN(7);
        const int a = lane & 7;
        const long NIT = (long)M_ALL * 10 / 8;
        for (long it = gw; it < NIT; it += NGW) {
            const long item = it * 8 + (lane >> 3); const int m = (int)(item / 10), j = (int)(item % 10);
            const int t = (m < M_PROMPT) ? (m & (S_PROMPT - 1)) : (m & (S_SAMPLE - 1));
            bf16* p = PROJ + (size_t)m * NPROJ + j * 64 + a * 8;
            const v4u raw = *(const v4u*)p;
            float v[8] = {bflo(raw.x), bfhi(raw.x), bflo(raw.y), bfhi(raw.y), bflo(raw.z), bfhi(raw.z), bflo(raw.w), bfhi(raw.w)};
            float ss = 0.f;
#pragma unroll
            for (int i = 0; i < 8; ++i) ss += v[i] * v[i];
            ss += __shfl_xor(ss, 1); ss += __shfl_xor(ss, 2); ss += __shfl_xor(ss, 4);
            const float rs = __builtin_amdgcn_rsqf(ss * (1.f / 64.f) + 1e-6f);
            const float* gn = (j < 8 ? qn : kn) + a * 8;
            const int pos = (a < 4) ? (t >> 6) : (t & 63);
            const float* ct = rope + pos * 16 + (a & 1) * 8;
            const float sc = (j < 8) ? C2 : 1.0f;
            float o[8];
#pragma unroll
            for (int i = 0; i < 8; ++i) { const float y = v[i] * rs * gn[i]; const float py = __shfl_xor(y, 2); const float cs = ct[i], sn = ct[1024 + i];
                o[i] = ((a & 2) == 0 ? y * cs - py * sn : y * cs + py * sn) * sc; }
            v4u w; w.x = pk2(o[0], o[1]); w.y = pk2(o[2], o[3]); w.z = pk2(o[4], o[5]); w.w = pk2(o[6], o[7]);
            *(v4u*)p = w;
        }
    }
    SEAM_BAR();

    {
        PHASE_PTRS();
        const attn_body::bf16* Q = (const attn_body::bf16*)PROJ; const attn_body::bf16* K = Q + 512; const attn_body::bf16* V = Q + 640; attn_body::bf16* Ob = (attn_body::bf16*)XNO;
        for (int pair = vcu; pair < 256; pair += G) { const int b = pair >> 3, h = pair & 7;
            for (int qb = 0; qb < 8; ++qb) attn_body::attn_unit<8>((long)b * S_PROMPT, S_PROMPT / 64, h, h >> 2, qb, Q, K, V, Ob, ssqA, (char*)lds); }
        for (int su = vcu; su < 256; su += G) { const int pair = su >> 3, b = pair >> 3, h = pair & 7;
            for (int k = 0; k < 2; ++k) attn_body::attn_unit<8>((long)M_PROMPT + (long)b * S_SAMPLE, S_SAMPLE / 64, h, h >> 2, (su & 7) * 2 + k, Q, K, V, Ob, ssqA, (char*)lds); }
        __syncthreads();
        LAS float* Tb = (LAS float*)(L + NA_T_OFF + wave * NA_T_BYTES);
        LAS float* wsf = (LAS float*)(L + NA_WSF_OFF + wave * 256);
        for (int e = lane; e < na_body::T_FLOATS; e += 64) Tb[e] = 0.f;
        { const float* rpb = KIN(8) + wave * 15 * 31;
          for (int e = lane; e < 15 * 31; e += 64) { const int dr = e / 31, dc = e % 31; Tb[na_body::T_GUARD + dr * 32 + dc] = rpb[e] * LOG2E; } }
        LAS unsigned char* wl = L + wave * na_body::TILE_BYTES;
        const unsigned wl_addr = (unsigned)(uintptr_t)(lds + wave * na_body::TILE_BYTES);
#ifdef PROBE_NAX2
        for (int rep_ = 0; rep_ < 2; ++rep_)
#endif
        for (int bu = vcu; bu < 1280; bu += G) {
            int rowbase, rows, r;
            if (bu < 1024) { rowbase = (bu >> 5) * S_PROMPT; rows = 32; r = bu & 31; } else { const int s = bu - 1024; rowbase = M_PROMPT + (s >> 6) * S_SAMPLE; rows = 64; r = s & 63; }
#ifdef PROBE_NAX2
            na_body::na_unit(ws, (unsigned)WS_PROJ, (unsigned)WS_XNO, rep_ ? (unsigned)(800 * MiB) : (unsigned)WS_SSQB, rowbase, rows, r, wave, wl, wl_addr, Tb + na_body::T_GUARD, wsf);
#else
            na_body::na_unit(ws, (unsigned)WS_PROJ, (unsigned)WS_XNO, (unsigned)WS_SSQB, rowbase, rows, r, wave, wl, wl_addr, Tb + na_body::T_GUARD, wsf);
#endif
        }
    }
    SEAM_BAR();

    {
        PHASE_PTRS(); bf16* const Wout_t = (bf16*)(ws + WS_WOUT); bf16* const H1B = (bf16*)(ws + WS_H1B); const float* const x_prompt = KIN(0); const float* const x_sample = KIN(1);
        pg8::Gemm g{XNO, Wout_t, M_ALL, DM, DM}; pg8::StaticOrder S; S.init(M_ALL, DM, G, bx);
        pg8::EpiOutProj E{x_prompt, x_sample, M_PROMPT, H1B, ssq2, ssqA, ssqB};
        pg8::gemm_phase<pg8::EpiOutProj, pg8::StaticOrder, true, true>(L, g, S, E);
    }
    SEAM_BAR();

    {
        PHASE_PTRS(); bf16* const Wup_t = (bf16*)(ws + WS_WUP); bf16* const H1B = (bf16*)(ws + WS_H1B); bf16* const ACT = (bf16*)(ws + WS_ACT);
        constexpr int NM_UP = (M_ALL + 253) / 254;
        pg8::Gemm g{H1B - DM, Wup_t, NM_UP * 256, NUP, DM, (size_t)254 * DM * 2}; pg8::StaticOrder S; S.init(NM_UP * 256, NUP, G, bx);
        pg8::EpiConvGate E{ACT, ssq2, KIN(14), KIN(15), M_ALL, DFF};
        pg8::gemm_phase<pg8::EpiConvGate, pg8::StaticOrder, true, true>(L, g, S, E);
#ifdef PROBE_P5X2
        pg8::gemm_phase<pg8::EpiConvGate, pg8::StaticOrder, true, true>(L, g, S, E);
#endif
    }
    SEAM_BAR();

    {
        PHASE_PTRS(); bf16* const ACT = (bf16*)(ws + WS_ACT); bf16* const Wdown_t = (bf16*)(ws + WS_WDOWN); bf16* const H2B = (bf16*)(ws + WS_H2B); bf16* const H1B = (bf16*)(ws + WS_H1B);
        pg8::Gemm g{ACT, Wdown_t, M_ALL, DM, DFF}; pg8::StaticOrder S; S.init(M_ALL, DM, G, bx);
        pg8::EpiResB E{H1B, H2B, ssq3};
        pg8::gemm_phase<pg8::EpiResB, pg8::StaticOrder, true, true>(L, g, S, E);
    }
    SEAM_BAR();

    {
        PHASE_PTRS(); bf16* const H2B = (bf16*)(ws + WS_H2B); bf16* const Wgate_t = (bf16*)(ws + WS_WGATE); bf16* const EB = (bf16*)(ws + WS_E); bf16* const H3B = (bf16*)(ws + WS_H3B);
        pg8::Gemm g{H2B, Wgate_t, M_ALL, DM, DM}; pg8::StaticOrder S; S.init(M_ALL, DM, G, bx);
        pg8::EpiGate E{H2B, EB, H3B, ssq3, ssq4};
        pg8::gemm_phase<pg8::EpiGate, pg8::StaticOrder, true, true>(L, g, S, E);
    }
    SEAM_BAR();

    {
        PHASE_PTRS();
        const f32x4* fg = (const f32x4*)KIN(20) + lane;
        const f32x4 g0 = fg[0], g1 = fg[64], g2 = fg[128], g3 = fg[192];
        const bf16* const H3B = (const bf16*)(ws + WS_H3B);
        for (int m0 = gw; m0 < M_ALL; m0 += 2 * NGW) {
            const int m1 = m0 + NGW; const bool has1 = m1 < M_ALL; const int m1c = has1 ? m1 : m0;
            const v2u* hr0 = (const v2u*)(H3B + (size_t)m0 * DM) + lane; const v2u* hr1 = (const v2u*)(H3B + (size_t)m1c * DM) + lane;
            v2u a[4], b[4];
#pragma unroll
            for (int j = 0; j < 4; ++j) { a[j] = hr0[64 * j]; b[j] = hr1[64 * j]; }
            const float rs0 = __builtin_amdgcn_rsqf(ssq4[m0] * (1.f / DM) + 1e-6f), rs1 = __builtin_amdgcn_rsqf(ssq4[m1c] * (1.f / DM) + 1e-6f);
            f32x4* xr0 = (f32x4*)(out + (size_t)m0 * DM) + lane; f32x4* xr1 = (f32x4*)(out + (size_t)m1c * DM) + lane;
            const f32x4 gg[4] = {g0, g1, g2, g3};
#pragma unroll
            for (int j = 0; j < 4; ++j) { xr0[64 * j] = (f32x4){bflo(a[j].x), bfhi(a[j].x), bflo(a[j].y), bfhi(a[j].y)} * rs0 * gg[j];
                if (has1) xr1[64 * j] = (f32x4){bflo(b[j].x), bfhi(b[j].x), bflo(b[j].y), bfhi(b[j].y)} * rs1 * gg[j]; }
        }
    }
}

extern "C" void kernel_launch(void* const* d_in, const int* in_sizes, int n_in, void* d_out, int out_size, void* d_ws, size_t ws_size, hipStream_t stream) {
    static int grid = 0;
    if (grid == 0) {
        if (n_in != 21 || in_sizes[0] != M_PROMPT * DM || out_size != M_ALL * DM || ws_size < WS_END) { fprintf(stderr, "kernel_launch: unexpected shapes (n_in %d, in0 %d, out %d, ws %zu); nothing launched\n", n_in, n_in > 0 ? in_sizes[0] : -1, out_size, ws_size); grid = -1; return; }
        int dev = 0, cus = 0, per_cu = 0;
        if (hipGetDevice(&dev) != hipSuccess || hipDeviceGetAttribute(&cus, hipDeviceAttributeMultiprocessorCount, dev) != hipSuccess) { grid = -1; return; }
        if (hipFuncSetAttribute((const void*)hymba_fwd, hipFuncAttributeMaxDynamicSharedMemorySize, LDS_BYTES) != hipSuccess) { fprintf(stderr, "kernel_launch: hipFuncSetAttribute failed\n"); grid = -1; return; }
        if (hipOccupancyMaxActiveBlocksPerMultiprocessor(&per_cu, (const void*)hymba_fwd, NWAVES * 64, LDS_BYTES) != hipSuccess || per_cu < 1) { fprintf(stderr, "kernel_launch: occupancy query says %d blocks per CU\n", per_cu); (void)hipGetLastError(); }
        grid = cus;
    }
    if (grid < 0) return;
    if (hipMemsetAsync((unsigned char*)d_ws + WS_BAR, 0, BAR_BYTES, stream) != hipSuccess) { fprintf(stderr, "kernel_launch: hipMemsetAsync failed\n"); return; }
    Args a{};
    for (int i = 0; i < 21; ++i) a.in[i] = (const float*)d_in[i];
    a.out = (float*)d_out; a.ws = (unsigned char*)d_ws;
    void* kargs[] = {&a};
    const hipError_t e = hipLaunchCooperativeKernel((const void*)hymba_fwd, dim3(grid), dim3(NWAVES * 64), kargs, LDS_BYTES, stream);
    if (e != hipSuccess) fprintf(stderr, "kernel_launch: cooperative launch failed: %s (grid %d)\n", hipGetErrorString(e), grid);
}
```

```cpp
#include <hip/hip_cooperative_groups.h>
#include <hip/hip_runtime.h>
#include <cstdio>
#include <cstdint>
namespace pg8 {
#define PG8_LAS __attribute__((address_space(3)))
typedef unsigned short bf16_t;
typedef short bf16x8 __attribute__((ext_vector_type(8)));
typedef float f32x4 __attribute__((ext_vector_type(4)));
typedef unsigned u32x4 __attribute__((ext_vector_type(4)));
constexpr int BM = 256, BK = 64, HALF = 128, HTB = HALF * BK * 2  , STAGE_BYTES = 8 * HTB, NXCD = 8, WGM = 8;

__host__ __device__ __forceinline__ int lds_byte(int r, int c) { const int st = (r >> 4) * 2 + (c >> 5), rr = r & 15, cc = c & 31, ob = rr * 64 + cc * 2; return st * 1024 + (ob ^ (((ob >> 9) & 1) << 5)); }
__host__ __device__ __forceinline__ void stage_rc(int b, int& R, int& C) { const int st = b / 1024, sb = b % 1024, swz = sb ^ (((sb >> 9) & 1) << 5); R = (st >> 1) * 16 + swz / 64; C = (st & 1) * 32 + (swz % 64) / 2; }
__host__ __device__ __forceinline__ int perm32(int rho) { const int n = rho >> 4, i = rho & 15; return 8 * (i >> 2) + 4 * n + (i & 3); }

struct Unit { int pm, pn; };
struct Gemm { const bf16_t* A; const bf16_t* Bt; int M, N, K; size_t a_tstep; };

struct StaticOrder {
    int nM, nN, nwg, G, c;
    __host__ __device__ void init(int M, int N, int G_, int c_) { nM = M / BM; nN = N / BM; nwg = nM * nN; G = G_; c = c_; }
    __host__ __device__ bool next(int i, Unit& u) const {
        const long L = (long)i * G + c; if (L >= nwg) return false;
        int wgid = (int)L; { const int q = nwg / NXCD, r = nwg % NXCD, xcd = wgid % NXCD, off = wgid / NXCD; wgid = (xcd < r ? xcd * (q + 1) : r * (q + 1) + (xcd - r) * q) + off; }
        const int nig = WGM * nN, gid = wgid / nig, fm = gid * WGM, gsz = (nM - fm) < WGM ? (nM - fm) : WGM;
        u.pm = fm + ((wgid % nig) % gsz); u.pn = (wgid % nig) / gsz; return true;
    }
    __device__ __forceinline__ void a_ready(const Unit&) const {}
    __device__ __forceinline__ void done(const Unit&) const {}
};

__device__ __forceinline__ unsigned cvt_pk_bf16(float lo, float hi) { unsigned r; asm volatile("v_cvt_pk_bf16_f32 %0, %1, %2" : "=v"(r) : "v"(lo), "v"(hi)); return r; }
typedef float f32x2 __attribute__((ext_vector_type(2)));
__device__ __forceinline__ f32x2 gelu_pk(f32x2 v) {
    const f32x2 av = __builtin_elementwise_abs(v), d = av * 0.2316418882f + 1.0f;
    f32x2 t; t.x = __builtin_amdgcn_rcpf(d.x); t.y = __builtin_amdgcn_rcpf(d.y);
    f32x2 q = t * 0.5307027145f + (-0.7265760135f); q = q * t + 0.7107068705f; q = q * t + (-0.142248368f); q = q * t + 0.127414796f; q = q * t;
    const f32x2 s = (v * v) * (-0.72134752044f);
    f32x2 e; e.x = __builtin_amdgcn_exp2f(s.x); e.y = __builtin_amdgcn_exp2f(s.y);
    const f32x2 m = v * (q * e), r = v - m;
    f32x2 o; o.x = v.x < 0.f ? m.x : r.x; o.y = v.y < 0.f ? m.y : r.y; return o;
}

template <int ACT  > struct EpiBf16 {
    static constexpr bool PERM = true, AFTER_DRAIN = false, MIDSCALE = false, FULL = false; static_assert(ACT == 0 || ACT == 1, "EpiBf16: ACT is 0 (none) or 1 (gelu_pk)");
    bf16_t* O; int ldc; const float* bias; int split_cols; size_t split_stride; float scale0;
    __device__ __forceinline__ void operator()(const f32x4 (&acc)[2][2][4][2], const Unit& u, int wr, int wc, int fr, int fq) const {
        const int row0 = u.pm * BM + wr * 64 + fr; int colt = u.pn * BM; bf16_t* base = O;
        float sc = 1.f; if (split_cols) { const int t = colt / split_cols; base += (size_t)t * split_stride; colt -= t * split_cols; if (t == 0) sc = scale0; }
        const int col0 = colt + wc * 32 + 8 * fq, bcol0 = u.pn * BM + wc * 32 + 8 * fq;
        f32x4 bv[2][2];
#pragma unroll
        for (int bj = 0; bj < 2; ++bj)
#pragma unroll
            for (int n = 0; n < 2; ++n) bv[bj][n] = bias ? *(const f32x4*)(bias + bcol0 + bj * HALF + 4 * n) : (f32x4){0.f, 0.f, 0.f, 0.f};
#pragma unroll
        for (int ai = 0; ai < 2; ++ai)
#pragma unroll
            for (int m = 0; m < 4; ++m) { bf16_t* rowp = base + (size_t)(row0 + ai * HALF + m * 16) * ldc + col0;
#pragma unroll
                for (int bj = 0; bj < 2; ++bj) { f32x4 v0 = acc[ai][bj][m][0] + bv[bj][0], v1 = acc[ai][bj][m][1] + bv[bj][1];
                    if (ACT == 1) { f32x2 a = gelu_pk((f32x2){v0[0], v0[1]}), b = gelu_pk((f32x2){v0[2], v0[3]}), c = gelu_pk((f32x2){v1[0], v1[1]}), d = gelu_pk((f32x2){v1[2], v1[3]});
                        v0 = (f32x4){a.x, a.y, b.x, b.y}; v1 = (f32x4){c.x, c.y, d.x, d.y}; }
                    v0 = v0 * sc; v1 = v1 * sc; u32x4 w; w.x = cvt_pk_bf16(v0[0], v0[1]); w.y = cvt_pk_bf16(v0[2], v0[3]); w.z = cvt_pk_bf16(v1[0], v1[1]); w.w = cvt_pk_bf16(v1[2], v1[3]);
                    *(u32x4*)(rowp + bj * HALF) = w; } }
    }
};
constexpr float RMS_EPS = 1e-6f;
typedef unsigned u32x2 __attribute__((ext_vector_type(2)));
__device__ __forceinline__ float f32_atomic_add(float* p, float v) { return __hip_atomic_fetch_add(p, v, __ATOMIC_RELAXED, __HIP_MEMORY_SCOPE_AGENT); }
__device__ __forceinline__ float bf_lo(unsigned w) { return __uint_as_float(w << 16); }
__device__ __forceinline__ float bf_hi(unsigned w) { return __uint_as_float(w & 0xffff0000u); }
__device__ __forceinline__ float sumsq8(const f32x4& v0, const f32x4& v1) { return (v0[0] * v0[0] + v0[1] * v0[1]) + (v0[2] * v0[2] + v0[3] * v0[3]) + (v1[0] * v1[0] + v1[1] * v1[1]) + (v1[2] * v1[2] + v1[3] * v1[3]); }
__device__ __forceinline__ u32x4 pack8(const f32x4& v0, const f32x4& v1) { u32x4 w; w.x = cvt_pk_bf16(v0[0], v0[1]); w.y = cvt_pk_bf16(v0[2], v0[3]); w.z = cvt_pk_bf16(v1[0], v1[1]); w.w = cvt_pk_bf16(v1[2], v1[3]); return w; }
struct EpiBf16Rs {
    static constexpr bool PERM = true, AFTER_DRAIN = false, MIDSCALE = false, FULL = false;
    bf16_t* O; int ldc; const float* ssq;
    __device__ __forceinline__ void operator()(const f32x4 (&acc)[2][2][4][2], const Unit& u, int wr, int wc, int fr, int fq) const {
        const int row0 = u.pm * BM + wr * 64 + fr, col0 = u.pn * BM + wc * 32 + 8 * fq;
#pragma unroll
        for (int ai = 0; ai < 2; ++ai)
#pragma unroll
            for (int m = 0; m < 4; ++m) { const int row = row0 + ai * HALF + m * 16; bf16_t* rowp = O + (size_t)row * ldc + col0;
                const float rs = ssq ? __builtin_amdgcn_rsqf(ssq[row] * (1.0f / 1024.0f) + RMS_EPS) : 1.0f;
#pragma unroll
                for (int bj = 0; bj < 2; ++bj) *(u32x4*)(rowp + bj * HALF) = pack8(acc[ai][bj][m][0] * rs, acc[ai][bj][m][1] * rs); }
    }
};
struct EpiOutProj {
    static constexpr bool PERM = true, AFTER_DRAIN = false, MIDSCALE = true, FULL = false;
    const float* base0; const float* base1; int split;
    bf16_t* hb; float* ssq; const float* ssqA; const float* ssqB;
    __device__ __forceinline__ void prep(PG8_LAS unsigned char* lds, int tid, const Unit& u, int wr, int fr) const {
        const int row0 = u.pm * BM + wr * 64 + fr; PG8_LAS f32x4* slot = (PG8_LAS f32x4*)(lds + STAGE_BYTES) + tid * 2;
#pragma unroll
        for (int ai = 0; ai < 2; ++ai) { f32x4 q;
#pragma unroll
            for (int m = 0; m < 4; ++m) { const int row = row0 + ai * HALF + m * 16;
                q[m] = __builtin_amdgcn_rsqf(ssqA[row] * (1.0f / 512.0f) + RMS_EPS) * __builtin_amdgcn_sqrtf(ssqB[row] * (1.0f / 512.0f) + RMS_EPS); }
            slot[ai] = q; }
    }
    __device__ __forceinline__ void midscale(f32x4 (&acc)[2][2][4][2], PG8_LAS unsigned char* lds, int tid) const {
        const PG8_LAS f32x4* slot = (const PG8_LAS f32x4*)(lds + STAGE_BYTES) + tid * 2;
#pragma unroll
        for (int ai = 0; ai < 2; ++ai) { const f32x4 q = slot[ai];
#pragma unroll
            for (int bj = 0; bj < 2; ++bj)
#pragma unroll
                for (int m = 0; m < 4; ++m)
#pragma unroll
                    for (int n = 0; n < 2; ++n) acc[ai][bj][m][n] *= q[m]; }
    }
    __device__ __forceinline__ void operator()(const f32x4 (&acc)[2][2][4][2], const Unit& u, int wr, int wc, int fr, int fq) const {
        const int row0 = u.pm * BM + wr * 64 + fr, col0 = u.pn * BM + wc * 32 + 8 * fq;
#pragma unroll
        for (int ai = 0; ai < 2; ++ai)
#pragma unroll
            for (int m = 0; m < 4; ++m) { const int row = row0 + ai * HALF + m * 16;
                const float* bp = (row < split ? base0 + (size_t)row * 1024 : base1 + (size_t)(row - split) * 1024) + col0;
                bf16_t* hp = hb + (size_t)row * 1024 + col0; float s = 0.f;
                const float rb = __builtin_amdgcn_rsqf(ssqB[row] * (1.0f / 512.0f) + RMS_EPS);
#pragma unroll
                for (int bj = 0; bj < 2; ++bj) { const f32x4 b0 = *(const f32x4*)(bp + bj * HALF), b1 = *(const f32x4*)(bp + bj * HALF + 4);
                    const f32x4 v0 = acc[ai][bj][m][0] * rb + b0, v1 = acc[ai][bj][m][1] * rb + b1;
                    *(u32x4*)(hp + bj * HALF) = pack8(v0, v1); s += sumsq8(v0, v1); }
                s += __shfl_xor(s, 16); s += __shfl_xor(s, 32);
                if (fq == 0) f32_atomic_add(ssq + row, s); }
    }
};
struct EpiResB {
    static constexpr bool PERM = true, AFTER_DRAIN = false, MIDSCALE = false, FULL = false;
    const bf16_t* hin; bf16_t* hout; float* ssq;
    __device__ __forceinline__ void operator()(const f32x4 (&acc)[2][2][4][2], const Unit& u, int wr, int wc, int fr, int fq) const {
        const int row0 = u.pm * BM + wr * 64 + fr, col0 = u.pn * BM + wc * 32 + 8 * fq;
#pragma unroll
        for (int ai = 0; ai < 2; ++ai)
#pragma unroll
            for (int m = 0; m < 4; ++m) { const int row = row0 + ai * HALF + m * 16;
                const bf16_t* bp = hin + (size_t)row * 1024 + col0; bf16_t* hp = hout + (size_t)row * 1024 + col0; float s = 0.f;
#pragma unroll
                for (int bj = 0; bj < 2; ++bj) { const u32x4 bw = *(const u32x4*)(bp + bj * HALF);
                    const f32x4 v0 = acc[ai][bj][m][0] + (f32x4){bf_lo(bw.x), bf_hi(bw.x), bf_lo(bw.y), bf_hi(bw.y)}, v1 = acc[ai][bj][m][1] + (f32x4){bf_lo(bw.z), bf_hi(bw.z), bf_lo(bw.w), bf_hi(bw.w)};
                    *(u32x4*)(hp + bj * HALF) = pack8(v0, v1); s += sumsq8(v0, v1); }
                s += __shfl_xor(s, 16); s += __shfl_xor(s, 32);
                if (fq == 0) f32_atomic_add(ssq + row, s); }
    }
};
struct EpiGate {
    static constexpr bool PERM = true, AFTER_DRAIN = false, MIDSCALE = false, FULL = false;
    const bf16_t* hin; const bf16_t* E; bf16_t* hout; const float* ssq_in; float* ssq_out;
    __device__ __forceinline__ void operator()(const f32x4 (&acc)[2][2][4][2], const Unit& u, int wr, int wc, int fr, int fq) const {
        const int row0 = u.pm * BM + wr * 64 + fr, col0 = u.pn * BM + wc * 32 + 8 * fq;
#pragma unroll
        for (int ai = 0; ai < 2; ++ai)
#pragma unroll
            for (int m = 0; m < 4; ++m) { const int row = row0 + ai * HALF + m * 16;
                const bf16_t* bp = hin + (size_t)row * 1024 + col0; const bf16_t* ep = E + (size_t)row * 1024 + col0; bf16_t* hp = hout + (size_t)row * 1024 + col0; float s = 0.f;
                const float rs = __builtin_amdgcn_rsqf(ssq_in[row] * (1.0f / 1024.0f) + RMS_EPS) * -1.4426950408889634f;
#pragma unroll
                for (int bj = 0; bj < 2; ++bj) { const u32x4 bw = *(const u32x4*)(bp + bj * HALF), ew = *(const u32x4*)(ep + bj * HALF);
                    const f32x4 b0 = (f32x4){bf_lo(bw.x), bf_hi(bw.x), bf_lo(bw.y), bf_hi(bw.y)}, b1 = (f32x4){bf_lo(bw.z), bf_hi(bw.z), bf_lo(bw.w), bf_hi(bw.w)};
                    const f32x4 e0 = (f32x4){bf_lo(ew.x), bf_hi(ew.x), bf_lo(ew.y), bf_hi(ew.y)}, e1 = (f32x4){bf_lo(ew.z), bf_hi(ew.z), bf_lo(ew.w), bf_hi(ew.w)};
                    f32x4 v0, v1;
#pragma unroll
                    for (int k = 0; k < 4; ++k) { const float g0 = __builtin_amdgcn_rcpf(1.0f + __builtin_amdgcn_exp2f(acc[ai][bj][m][0][k] * rs)), g1 = __builtin_amdgcn_rcpf(1.0f + __builtin_amdgcn_exp2f(acc[ai][bj][m][1][k] * rs));
                        v0[k] = b0[k] + g0 * e0[k]; v1[k] = b1[k] + g1 * e1[k]; }
                    *(u32x4*)(hp + bj * HALF) = pack8(v0, v1); s += sumsq8(v0, v1); }
                s += __shfl_xor(s, 16); s += __shfl_xor(s, 32);
                if (fq == 0) f32_atomic_add(ssq_out + row, s); }
    }
};

#define PG8_DPPF(oldv, srcv, ctrl, bc) __builtin_bit_cast(float, __builtin_amdgcn_update_dpp(__builtin_bit_cast(int, (float)(oldv)), __builtin_bit_cast(int, (float)(srcv)), (ctrl), 0xf, 0xf, (bc)))
struct EpiConvGate {
    static constexpr bool PERM = true, AFTER_DRAIN = false, MIDSCALE = false, FULL = true;
    bf16_t* ACT; const float* ssq; const float* cw; const float* cb; int Mrows; int dff;
    static constexpr int PF_W_OFF = 9216, PF_S_OFF = 9216 + 8192;
    __device__ __forceinline__ void prefetch(PG8_LAS unsigned char* lds, int tid, const Unit& u, int ui) const {
        const int wid = __builtin_amdgcn_readfirstlane(tid >> 6), lane = tid & 63, par = ui & 1;
        if (wid < 4) { const int cc = lane * 4, bj = cc >> 7, c = cc & 127;
            const float* src = (wid < 3 ? cw + (size_t)wid * 2 * dff : cb) + bj * dff + u.pn * HALF + c;
            __builtin_amdgcn_global_load_lds((const unsigned*)src, (PG8_LAS unsigned*)(lds + STAGE_BYTES + PF_W_OFF + par * 4096 + wid * 1024), 16, 0, 0);
        } else { const int g = u.pm * 254 - 1 + (wid - 4) * 64 + lane; const int gc = g < 0 ? 0 : (g >= Mrows ? Mrows - 1 : g);
            __builtin_amdgcn_global_load_lds((const unsigned*)(ssq + gc), (PG8_LAS unsigned*)(lds + STAGE_BYTES + PF_S_OFF + par * 1024 + (wid - 4) * 256), 4, 0, 0); }
    }
    template <bool MASKED> __device__ __forceinline__ void conv(const f32x4 (&acc)[2][2][4][2], const PG8_LAS float* Wl, const PG8_LAS float* X, int wr, int rbase, int gbase, int col, int cbase) const {
#pragma unroll
        for (int n = 0; n < 2; ++n) {
            f32x4 w[2][4];
#pragma unroll
            for (int bj = 0; bj < 2; ++bj)
#pragma unroll
                for (int k = 0; k < 4; ++k) w[bj][k] = *(const PG8_LAS f32x4*)(Wl + k * 256 + bj * HALF + col + 4 * n);
#pragma unroll
            for (int ai = 0; ai < 2; ++ai) { const int sg = 2 * ai + wr; const int slotP = (sg > 0) ? (sg - 1) * 2 + 1 : 8, slotN = (sg < 3) ? (sg + 1) * 2 : 8;
                f32x4 saved[2], haloN[2];
#pragma unroll
                for (int bj = 0; bj < 2; ++bj) { saved[bj] = *(const PG8_LAS f32x4*)(X + slotP * 256 + bj * HALF + col + 4 * n); haloN[bj] = *(const PG8_LAS f32x4*)(X + slotN * 256 + bj * HALF + col + 4 * n); }
#pragma unroll
                for (int m = 0; m < 4; ++m) { const int r = rbase + ai * HALF + m * 16, g = gbase + r;
                    f32x2 hp = (f32x2){1.f, 1.f}, hn = hp;
                    if constexpr (MASKED) { const int S = (g < 65536) ? 2048 : 4096; const int t = g & (S - 1); const float a = (t != 0) ? 1.f : 0.f, b = (t != S - 1) ? 1.f : 0.f; hp = (f32x2){a, a}; hn = (f32x2){b, b}; }
                    f32x2 y[2][2];
#pragma unroll
                    for (int bj = 0; bj < 2; ++bj) { const f32x4 cur = acc[ai][bj][m][n]; const f32x4 nx = (m < 3) ? acc[ai][bj][m < 3 ? m + 1 : 3][n] : haloN[bj];
#pragma unroll
                        for (int h2 = 0; h2 < 2; ++h2) { const int i0 = 2 * h2, i1 = 2 * h2 + 1;
                            f32x2 pin, nin;
                            pin.x = PG8_DPPF(PG8_DPPF(0.f, saved[bj][i0], 0x121, true), cur[i0], 0x111, false); pin.y = PG8_DPPF(PG8_DPPF(0.f, saved[bj][i1], 0x121, true), cur[i1], 0x111, false);
                            nin.x = PG8_DPPF(PG8_DPPF(0.f, nx[i0], 0x12f, true), cur[i0], 0x101, false);        nin.y = PG8_DPPF(PG8_DPPF(0.f, nx[i1], 0x12f, true), cur[i1], 0x101, false);
                            if constexpr (MASKED) { pin *= hp; nin *= hn; }
                            const f32x2 c2 = (f32x2){cur[i0], cur[i1]}, w0 = (f32x2){w[bj][0][i0], w[bj][0][i1]}, w1 = (f32x2){w[bj][1][i0], w[bj][1][i1]}, w2 = (f32x2){w[bj][2][i0], w[bj][2][i1]}, bb = (f32x2){w[bj][3][i0], w[bj][3][i1]};
                            y[bj][h2] = __builtin_elementwise_fma(w2, nin, __builtin_elementwise_fma(w0, pin, __builtin_elementwise_fma(w1, c2, bb))); }
                        saved[bj] = cur; }
                    u32x2 pk;
#pragma unroll
                    for (int h2 = 0; h2 < 2; ++h2) { const f32x2 a = y[0][h2], gg = y[1][h2];
                        const f32x2 g2 = gg * gg, u3 = __builtin_elementwise_fma(g2 * gg, (f32x2){0.044715f, 0.044715f}, gg), z = u3 * -2.302208198f;
                        f32x2 d; d.x = __builtin_amdgcn_exp2f(z.x); d.y = __builtin_amdgcn_exp2f(z.y); d = d + 1.0f;
                        f32x2 rc; rc.x = __builtin_amdgcn_rcpf(d.x); rc.y = __builtin_amdgcn_rcpf(d.y);
                        const f32x2 o = (a * gg) * rc;
                        pk[h2] = cvt_pk_bf16(o.x, o.y); }
                    if (r >= 1 && r <= 254 && g < Mrows) *(u32x2*)(ACT + (size_t)g * dff + cbase + 4 * n) = pk;
                    __builtin_amdgcn_sched_barrier(0); } } }
    }
    __device__ __forceinline__ void full(f32x4 (&acc)[2][2][4][2], const Unit& u, int wr_, int wc_, int fr_, int fq_, PG8_LAS unsigned char* lds, int tid_, int ui) const {
        int tid = tid_; asm volatile("" : "+v"(tid));
        const int wid = __builtin_amdgcn_readfirstlane(tid >> 6), lane = tid & 63, wr = wid >> 2, wc = wid & 3, fr = lane & 15, fq = lane >> 4; (void)wr_; (void)wc_; (void)fr_; (void)fq_;
        const int gbase = u.pm * 254 - 1, rbase = wr * 64 + fr, col = wc * 32 + 8 * fq, cbase = u.pn * HALF + col;
        const unsigned voff = (unsigned)cbase * 4u;
        const int par = ui & 1;
        const PG8_LAS float* Wl = (const PG8_LAS float*)(lds + STAGE_BYTES + PF_W_OFF + par * 4096);
        const PG8_LAS float* Sl = (const PG8_LAS float*)(lds + STAGE_BYTES + PF_S_OFF + par * 1024);
        PG8_LAS float* X = (PG8_LAS float*)(lds + STAGE_BYTES);
#pragma unroll
        for (int ai = 0; ai < 2; ++ai)
#pragma unroll
            for (int m = 0; m < 4; ++m) {
                const float rs = __builtin_amdgcn_rsqf(Sl[rbase + ai * HALF + m * 16] * (1.0f / 1024.0f) + RMS_EPS);
#pragma unroll
                for (int bj = 0; bj < 2; ++bj)
#pragma unroll
                    for (int n = 0; n < 2; ++n) { acc[ai][bj][m][n] *= rs; asm volatile("" : "+v"(acc[ai][bj][m][n])); }
                __builtin_amdgcn_sched_barrier(0); }
        if (tid < 64) *(PG8_LAS f32x4*)(X + 8 * 256 + tid * 4) = (f32x4){0.f, 0.f, 0.f, 0.f};
        if (fr == 0) {
#pragma unroll
            for (int ai = 0; ai < 2; ++ai)
#pragma unroll
                for (int bj = 0; bj < 2; ++bj)
#pragma unroll
                    for (int n = 0; n < 2; ++n) *(PG8_LAS f32x4*)(X + ((2 * ai + wr) * 2 + 0) * 256 + bj * HALF + col + 4 * n) = acc[ai][bj][0][n]; }
        if (fr == 15) {
#pragma unroll
            for (int ai = 0; ai < 2; ++ai)
#pragma unroll
                for (int bj = 0; bj < 2; ++bj)
#pragma unroll
                    for (int n = 0; n < 2; ++n) *(PG8_LAS f32x4*)(X + ((2 * ai + wr) * 2 + 1) * 256 + bj * HALF + col + 4 * n) = acc[ai][bj][3][n]; }
        asm volatile("s_waitcnt lgkmcnt(0)" ::: "memory"); __builtin_amdgcn_s_barrier(); asm volatile("" ::: "memory");
        const bool boundary = ((gbase + 256) >> 11) != (gbase >> 11);
        (void)boundary; conv<true>(acc, Wl, X, wr, rbase, gbase, col, cbase);
    }
};

__device__ __forceinline__ float xsum16_(float x) { auto rr = __builtin_amdgcn_permlane16_swap(__float_as_uint(x), __float_as_uint(x), false, false); return __uint_as_float(rr[0]) + __uint_as_float(rr[1]); }
__device__ __forceinline__ float xsum32_(float x) { auto rr = __builtin_amdgcn_permlane32_swap(__float_as_uint(x), __float_as_uint(x), false, false); return __uint_as_float(rr[0]) + __uint_as_float(rr[1]); }
__device__ __forceinline__ float xlane32_(float x, bool lo) { auto rr = __builtin_amdgcn_permlane32_swap(__float_as_uint(x), __float_as_uint(x), false, false); return __uint_as_float(lo ? rr[1] : rr[0]); }
struct EpiProj {
    static constexpr bool PERM = true, AFTER_DRAIN = false, MIDSCALE = false, FULL = true;
    bf16_t* O; int ldc; const float* qn; const float* kn; const float* rope; float qscale;
    __device__ __forceinline__ void prefetch(PG8_LAS unsigned char*, int, const Unit&, int) const {}
    __device__ __forceinline__ void full(f32x4 (&acc)[2][2][4][2], const Unit& u, int wr_, int wc_, int fr_, int fq_, PG8_LAS unsigned char* lds, int tid_, int) const {
        int tid = tid_; asm volatile("" : "+v"(tid));
        const int wid = __builtin_amdgcn_readfirstlane(tid >> 6), lane = tid & 63, wr = wid >> 2, wc = wid & 3, fr = lane & 15, fq = lane >> 4; (void)wr_; (void)wc_; (void)fr_; (void)fq_;
        const int rbase = wr * 64 + fr, col = wc * 32 + 8 * fq;
        bf16_t* const obase = O + (size_t)(u.pm * BM + rbase) * ldc + u.pn * BM + col;
        if (u.pn > 2) {
#pragma unroll
            for (int ai = 0; ai < 2; ++ai)
#pragma unroll
                for (int m = 0; m < 4; ++m)
#pragma unroll
                    for (int bj = 0; bj < 2; ++bj) *(u32x4*)(obase + (size_t)(ai * HALF + m * 16) * ldc + bj * HALF) = pack8(acc[ai][bj][m][0], acc[ai][bj][m][1]);
            return;
        }
        PG8_LAS float* Xs = (PG8_LAS float*)(lds + STAGE_BYTES);
        float ssl[2][4][2];
#pragma unroll
        for (int ai = 0; ai < 2; ++ai)
#pragma unroll
            for (int m = 0; m < 4; ++m)
#pragma unroll
                for (int bj = 0; bj < 2; ++bj) { float s = sumsq8(acc[ai][bj][m][0], acc[ai][bj][m][1]); s = xsum16_(s); s = xsum32_(s); ssl[ai][m][bj] = s;
                    if (fq == 0) Xs[((ai * HALF + rbase + m * 16) * 2 + bj) * 4 + wc] = s; }
        asm volatile("s_waitcnt lgkmcnt(0)" ::: "memory"); __builtin_amdgcn_s_barrier(); asm volatile("" ::: "memory");
        const bool isq = u.pn < 2, lo = fq < 2;
        const float* gp = (isq ? qn : kn) + 32 * (wc & 1) + 8 * fq;
        const f32x4 g0 = *(const f32x4*)gp, g1 = *(const f32x4*)(gp + 4);
        const float sc = isq ? qscale : 1.0f;
#pragma unroll
        for (int ai = 0; ai < 2; ++ai)
#pragma unroll
            for (int m = 0; m < 4; ++m) { const int r = ai * HALF + rbase + m * 16, grow = u.pm * BM + r;
                const int t = (grow < 65536) ? (grow & 2047) : (grow & 4095); const int pos = (wc & 1) ? (t & 63) : (t >> 6);
                const float* ct = rope + pos * 16 + 8 * (fq & 1);
                const f32x4 c0 = *(const f32x4*)ct, c1 = *(const f32x4*)(ct + 4), s0 = *(const f32x4*)(ct + 1024), s1 = *(const f32x4*)(ct + 1028);
#pragma unroll
                for (int bj = 0; bj < 2; ++bj) { f32x4 v0 = acc[ai][bj][m][0], v1 = acc[ai][bj][m][1];
                    if (isq || bj == 0) {
                        const float tot = ssl[ai][m][bj] + Xs[(r * 2 + bj) * 4 + (wc ^ 1)];
                        const float rs = __builtin_amdgcn_rsqf(tot * (1.0f / 64.0f) + RMS_EPS) * sc;
                        const f32x4 y0 = v0 * rs * g0, y1 = v1 * rs * g1; f32x4 p0, p1;
#pragma unroll
                        for (int i = 0; i < 4; ++i) { p0[i] = xlane32_(y0[i], lo); p1[i] = xlane32_(y1[i], lo); }
                        const f32x4 sg0 = lo ? -s0 : s0, sg1 = lo ? -s1 : s1;
                        v0 = y0 * c0 + p0 * sg0; v1 = y1 * c1 + p1 * sg1; }
                    *(u32x4*)(obase + (size_t)(ai * HALF + m * 16) * ldc + bj * HALF) = pack8(v0, v1); }
                __builtin_amdgcn_sched_barrier(0); }
    }
};

template <class Epi, class Sched, bool ALIGN_EPI = false, bool SP2 = false>
__device__ __forceinline__ void gemm_phase(PG8_LAS unsigned char* lds, const Gemm g, const Sched& S, const Epi& E) {
    int tid = threadIdx.x; asm volatile("" : "+v"(tid));
    const int wid = __builtin_amdgcn_readfirstlane(tid >> 6), lane = tid & 63, wr = wid >> 2, wc = wid & 3, fr = lane & 15, fq = lane >> 4;
    const int K = g.K, nt = K / BK;
    unsigned voffA[2], voffB[2];
#pragma unroll
    for (int i = 0; i < 2; ++i) { int R, C; stage_rc(tid * 16 + i * 8192, R, C); const int Rb = Epi::PERM ? ((R & ~31) + perm32(R & 31)) : R;
        voffA[i] = (unsigned)(R * K + C) * 2u; voffB[i] = (unsigned)(Rb * K + C) * 2u; }
    const size_t kstep = (size_t)(BK * 2);
    const size_t hstep = (size_t)HALF * K * 2;
    const size_t tstep = 2 * hstep;
    const size_t tstepA = g.a_tstep ? g.a_tstep : tstep;
    const unsigned ldsw = (unsigned)wid * 1024u;
    const int aoff = lds_byte(wr * 64 + fr, fq * 8), boff = lds_byte(wc * 32 + fr, fq * 8);
#define PG8_SA(b, h) (((b) * 2 + (h)) * HTB)
#define PG8_SB(b, h) ((4 + (b) * 2 + (h)) * HTB)
#define PG8_STAGE(bufoff, gbase, voff) do { _Pragma("unroll") for (int _i = 0; _i < 2; ++_i) \
        __builtin_amdgcn_global_load_lds((const unsigned*)((const char*)(gbase) + (voff)[_i]), (PG8_LAS unsigned*)(lds + (bufoff) + ldsw + _i * 8192), 16, 0, 0); } while (0)
#define PG8_LDA(dst, b, h) do { _Pragma("unroll") for (int m = 0; m < 4; ++m) _Pragma("unroll") for (int k = 0; k < 2; ++k) dst[m][k] = *(const PG8_LAS bf16x8*)(lds + PG8_SA(b, h) + aoff + m * 2048 + k * 1024); } while (0)
#define PG8_LDB(dst, b, h) do { _Pragma("unroll") for (int n = 0; n < 2; ++n) _Pragma("unroll") for (int k = 0; k < 2; ++k) dst[n][k] = *(const PG8_LAS bf16x8*)(lds + PG8_SB(b, h) + boff + n * 2048 + k * 1024); } while (0)
#define PG8_MMA(ai, bj, At, Bt) do { __builtin_amdgcn_s_setprio(1); _Pragma("unroll") for (int m = 0; m < 4; ++m) _Pragma("unroll") for (int n = 0; n < 2; ++n) _Pragma("unroll") for (int k = 0; k < 2; ++k) \
        acc[ai][bj][m][n] = __builtin_amdgcn_mfma_f32_16x16x32_bf16(Bt[n][k], At[m][k], acc[ai][bj][m][n], 0, 0, 0); __builtin_amdgcn_s_setprio(0); } while (0)
#define PG8_WAIT_V(n) asm volatile("s_waitcnt vmcnt(" #n ")" ::: "memory")
#define PG8_WAIT_L(n) asm volatile("s_waitcnt lgkmcnt(" #n ")" ::: "memory")
#define PG8_BAR __builtin_amdgcn_s_barrier()
#define PG8_SCHED __builtin_amdgcn_sched_barrier(0)
    Unit cur, nxt; int ui = 0;
    if (!S.next(0, cur)) return;
    f32x4 acc[2][2][4][2];
#pragma unroll
    for (int a = 0; a < 2; ++a)
#pragma unroll
        for (int b = 0; b < 2; ++b)
#pragma unroll
            for (int m = 0; m < 4; ++m)
#pragma unroll
                for (int n = 0; n < 2; ++n) acc[a][b][m][n] = (f32x4){0.f, 0.f, 0.f, 0.f};
    bf16x8 At[4][2], B0[2][2], B1[2][2];
    const char* cA = (const char*)g.A + (size_t)cur.pm * tstepA; const char* cB = (const char*)g.Bt + (size_t)cur.pn * tstep;
    S.a_ready(cur);
    if constexpr (Epi::FULL) E.prefetch(lds, tid, cur, 0);
    if constexpr (Epi::MIDSCALE) E.prep(lds, tid, cur, wr, fr);
    if constexpr (SP2) {
        PG8_STAGE(PG8_SB(0, 0), cB, voffB); PG8_STAGE(PG8_SB(0, 1), cB + hstep, voffB); PG8_STAGE(PG8_SA(0, 0), cA, voffA); PG8_STAGE(PG8_SA(0, 1), cA + hstep, voffA);
        if (wr == 1) PG8_BAR;
        PG8_WAIT_V(2); PG8_BAR;
        PG8_STAGE(PG8_SB(1, 0), cB + kstep, voffB); PG8_STAGE(PG8_SA(1, 0), cA + kstep, voffA); PG8_STAGE(PG8_SB(1, 1), cB + hstep + kstep, voffB);
        PG8_WAIT_V(6); PG8_BAR;
    } else {
        PG8_STAGE(PG8_SB(0, 0), cB, voffB); PG8_STAGE(PG8_SA(0, 0), cA, voffA); PG8_STAGE(PG8_SB(0, 1), cB + hstep, voffB); PG8_STAGE(PG8_SA(0, 1), cA + hstep, voffA);
        if (wr == 1) PG8_BAR;
        PG8_WAIT_V(4); PG8_BAR;
        PG8_STAGE(PG8_SB(1, 0), cB + kstep, voffB); PG8_STAGE(PG8_SA(1, 0), cA + kstep, voffA); PG8_STAGE(PG8_SB(1, 1), cB + hstep + kstep, voffB);
        PG8_WAIT_V(6); PG8_BAR;
    }
    for (;;) {
        const bool has_next = S.next(ui + 1, nxt);
        const char* nA = has_next ? (const char*)g.A + (size_t)nxt.pm * tstepA : cA; const char* nB = has_next ? (const char*)g.Bt + (size_t)nxt.pn * tstep : cB;
        for (int t = 0; t < nt; t += 2) {
            if constexpr (Epi::MIDSCALE) { if (t == (nt >> 1)) E.midscale(acc, lds, tid); }
            const bool last = (t == nt - 2);
            const char* a1 = cA + (size_t)(t + 1) * kstep;
            const char* a2 = last ? nA : cA + (size_t)(t + 2) * kstep; const char* b2 = last ? nB : cB + (size_t)(t + 2) * kstep;
            const char* a3 = a2 + kstep; const char* b3 = b2 + kstep;
            if (last && has_next) S.a_ready(nxt);
            if constexpr (SP2) {
            PG8_LDB(B0, 0, 0); PG8_LDB(B1, 0, 1); PG8_SCHED; PG8_LDA(At, 0, 0); PG8_STAGE(PG8_SA(1, 1), a1 + hstep, voffA);
            PG8_WAIT_V(8); PG8_WAIT_L(0); PG8_BAR; PG8_MMA(0, 0, At, B0); PG8_MMA(0, 1, At, B1); PG8_BAR; PG8_SCHED;
            PG8_LDA(At, 0, 1); PG8_STAGE(PG8_SB(0, 0), b2, voffB); PG8_STAGE(PG8_SB(0, 1), b2 + hstep, voffB); PG8_STAGE(PG8_SA(0, 0), a2, voffA);
            PG8_WAIT_V(8); PG8_WAIT_L(0); PG8_BAR; PG8_MMA(1, 0, At, B0); PG8_MMA(1, 1, At, B1); PG8_BAR; PG8_SCHED;
            PG8_LDB(B0, 1, 0); PG8_LDB(B1, 1, 1); PG8_SCHED; PG8_LDA(At, 1, 0); PG8_STAGE(PG8_SA(0, 1), a2 + hstep, voffA);
            PG8_WAIT_V(8); PG8_WAIT_L(0); PG8_BAR; PG8_MMA(0, 0, At, B0); PG8_MMA(0, 1, At, B1); PG8_BAR; PG8_SCHED;
            PG8_LDA(At, 1, 1); PG8_STAGE(PG8_SB(1, 0), b3, voffB); PG8_STAGE(PG8_SB(1, 1), b3 + hstep, voffB); PG8_STAGE(PG8_SA(1, 0), a3, voffA);
            PG8_WAIT_V(8); PG8_WAIT_L(0); PG8_BAR; PG8_MMA(1, 0, At, B0); PG8_MMA(1, 1, At, B1); PG8_BAR; PG8_SCHED;
            } else {
            PG8_LDB(B0, 0, 0); PG8_SCHED; PG8_LDA(At, 0, 0); PG8_STAGE(PG8_SA(1, 1), a1 + hstep, voffA);
            PG8_WAIT_L(8); PG8_BAR; PG8_WAIT_L(0); PG8_MMA(0, 0, At, B0); PG8_BAR; PG8_SCHED;
            PG8_LDB(B1, 0, 1); PG8_STAGE(PG8_SB(0, 0), b2, voffB);
            PG8_BAR; PG8_WAIT_L(0); PG8_MMA(0, 1, At, B1); PG8_BAR;
            PG8_LDA(At, 0, 1); PG8_STAGE(PG8_SA(0, 0), a2, voffA);
            PG8_BAR; PG8_WAIT_L(0); PG8_MMA(1, 0, At, B0); PG8_BAR; PG8_SCHED;
            PG8_STAGE(PG8_SB(0, 1), b2 + hstep, voffB);
            PG8_WAIT_V(6); PG8_BAR; PG8_MMA(1, 1, At, B1); PG8_BAR;
            PG8_LDB(B0, 1, 0); PG8_SCHED; PG8_LDA(At, 1, 0); PG8_STAGE(PG8_SA(0, 1), a2 + hstep, voffA);
            PG8_WAIT_L(8); PG8_BAR; PG8_WAIT_L(0); PG8_MMA(0, 0, At, B0); PG8_BAR; PG8_SCHED;
            PG8_LDB(B1, 1, 1); PG8_STAGE(PG8_SB(1, 0), b3, voffB);
            PG8_BAR; PG8_WAIT_L(0); PG8_MMA(0, 1, At, B1); PG8_BAR;
            PG8_LDA(At, 1, 1); PG8_STAGE(PG8_SA(1, 0), a3, voffA);
            PG8_BAR; PG8_WAIT_L(0); PG8_MMA(1, 0, At, B0); PG8_BAR; PG8_SCHED;
            PG8_STAGE(PG8_SB(1, 1), b3 + hstep, voffB);
            PG8_WAIT_V(6); PG8_BAR; PG8_MMA(1, 1, At, B1); PG8_BAR;
            }
        }
        if constexpr (ALIGN_EPI) { if (wr == 0) PG8_BAR; }
        if constexpr (Epi::FULL) { E.full(acc, cur, wr, wc, fr, fq, lds, tid, ui); S.done(cur); } else if constexpr (!Epi::AFTER_DRAIN) { E(acc, cur, wr, wc, fr, fq); S.done(cur); }
        if (!has_next) break;
#pragma unroll
        for (int a = 0; a < 2; ++a)
#pragma unroll
            for (int b = 0; b < 2; ++b)
#pragma unroll
                for (int m = 0; m < 4; ++m)
#pragma unroll
                    for (int n = 0; n < 2; ++n) acc[a][b][m][n] = (f32x4){0.f, 0.f, 0.f, 0.f};
        cur = nxt; cA = nA; cB = nB; ++ui;
        if constexpr (Epi::FULL) E.prefetch(lds, tid, cur, ui);
        if constexpr (Epi::MIDSCALE) E.prep(lds, tid, cur, wr, fr);
        if constexpr (ALIGN_EPI) { if (wr == 1) PG8_BAR; }
    }
    PG8_WAIT_V(0);
    if constexpr (!ALIGN_EPI) { if (wr == 0) PG8_BAR; }
    PG8_BAR;
    if constexpr (Epi::AFTER_DRAIN) { E.fused(acc, cur, wr, wc, fr, fq, lds, wid, lane); S.done(cur); }
#undef PG8_SA
#undef PG8_SB
#undef PG8_STAGE
#undef PG8_LDA
#undef PG8_LDB
#undef PG8_MMA
#undef PG8_WAIT_V
#undef PG8_WAIT_L
#undef PG8_BAR
#undef PG8_SCHED
}
}
#include <hip/hip_bf16.h>
#include <cmath>
namespace attn_body {
using bf16=__hip_bfloat16;
using bf16x8=__attribute__((ext_vector_type(8)))short;
using s16x4=__attribute__((ext_vector_type(4)))short;
using f32x16=__attribute__((ext_vector_type(16)))float;
using u32x4=__attribute__((ext_vector_type(4)))unsigned;
constexpr int D=64,PQ=2304,PO=1024;
constexpr int NW=8,QBLK=32,QB=QBLK*NW,KVBLK=64;
__device__ __forceinline__ int crow(int r,int hi){return (r&3)+8*(r>>2)+4*hi;}
#define SBAR() __builtin_amdgcn_sched_barrier(0)
__device__ __forceinline__ void cmask(f32x16&p0,f32x16&p1,int jb,int qrel,int hi){
  const float NEG=-INFINITY; int kb=64*jb+4*hi;
  #pragma unroll
  for(int r=0;r<16;++r){int kv=kb+(r&3)+8*(r>>2); if(kv>qrel)p0[r]=NEG; if(kv+32>qrel)p1[r]=NEG;}
}

constexpr int NSLOT=3, SLOTB=8192;
constexpr int LDS_K=0, LDS_V=NSLOT*SLOTB, LDS_WS=2*NSLOT*SLOTB, LDS_OST=LDS_WS+NW*64*4, LDS_BYTES=LDS_OST+NW*4096;
constexpr float C2=0.125f*1.4426950408889634f;
__device__ __forceinline__ void glds16(const void*gsrc,unsigned lds_dst){unsigned keep;
  asm volatile("s_mov_b32 %0, m0\n\ts_mov_b32 m0, %2\n\ts_nop 0\n\tglobal_load_lds_dwordx4 %1, off\n\ts_mov_b32 m0, %0":"=&s"(keep):"v"(gsrc),"s"(lds_dst):"memory");}
#define ATT_DPPF(srcv, ctrl) __builtin_bit_cast(float, __builtin_amdgcn_update_dpp(0, __builtin_bit_cast(int, (float)(srcv)), (ctrl), 0xf, 0xf, true))
__device__ __forceinline__ float sum8(float x){ x+=ATT_DPPF(x,0xB1); x+=ATT_DPPF(x,0x4E); x+=ATT_DPPF(x,0x141); return x; }
__device__ __forceinline__ float xsum32(float x){ auto rr=__builtin_amdgcn_permlane32_swap(__float_as_uint(x),__float_as_uint(x),false,false); return __uint_as_float(rr[0])+__uint_as_float(rr[1]); }
__device__ __forceinline__ float xmax32(float x){ auto rr=__builtin_amdgcn_permlane32_swap(__float_as_uint(x),__float_as_uint(x),false,false); return __builtin_fmaxf(__uint_as_float(rr[0]),__uint_as_float(rr[1])); }
__device__ __forceinline__ float max3f(float a,float b,float c){float r;asm("v_max3_f32 %0, %1, %2, %3":"=v"(r):"v"(a),"v"(b),"v"(c));return r;}
__device__ __forceinline__ float max2f(float a,float b){float r;asm("v_max_f32_e32 %0, %1, %2":"=v"(r):"v"(a),"v"(b));return r;}
__device__ __forceinline__ float fadd_s(float a,float b){float r;asm("v_add_f32_e32 %0, %1, %2":"=v"(r):"v"(a),"v"(b));return r;}
__device__ __forceinline__ float fsub_s(float a,float b){float r;asm("v_sub_f32_e32 %0, %1, %2":"=v"(r):"v"(a),"v"(b));return r;}
typedef float f32x2_t __attribute__((ext_vector_type(2))); typedef __bf16 bf16x2_t __attribute__((ext_vector_type(2)));
__device__ __forceinline__ unsigned cvtpk_s(float lo,float hi){f32x2_t v={lo,hi};bf16x2_t b=__builtin_convertvector(v,bf16x2_t);return __builtin_bit_cast(unsigned,b);}
#define WAIT_BAR(N) asm volatile("s_waitcnt vmcnt(" #N ") lgkmcnt(0)\n\ts_barrier":::"memory")

__device__ __forceinline__ void qkt(f32x16&p0,f32x16&p1,const char*Kslot,const bf16x8*qr,const f32x16&negm,int r32,int hi){
  const char*kb=Kslot+hi*1024+r32*16;
  #pragma unroll
  for(int d0=0;d0<4;++d0){
    const bf16x8 b0=*reinterpret_cast<const bf16x8*>(kb+d0*2048);
    const bf16x8 b1=*reinterpret_cast<const bf16x8*>(kb+d0*2048+512);
    if(d0==0){p0=__builtin_amdgcn_mfma_f32_32x32x16_bf16(b0,qr[0],negm,0,0,0);p1=__builtin_amdgcn_mfma_f32_32x32x16_bf16(b1,qr[0],negm,0,0,0);}
    else{p0=__builtin_amdgcn_mfma_f32_32x32x16_bf16(b0,qr[d0],p0,0,0,0);p1=__builtin_amdgcn_mfma_f32_32x32x16_bf16(b1,qr[d0],p1,0,0,0);}}
}
typedef __attribute__((address_space(3))) const char* lds_cptr;
typedef short v4i16_t __attribute__((ext_vector_type(4)));
__device__ __forceinline__ void kload8(bf16x8*kf,lds_cptr kp){
  kf[0]=*(const __attribute__((address_space(3))) bf16x8*)(kp);      kf[1]=*(const __attribute__((address_space(3))) bf16x8*)(kp+512);
  kf[2]=*(const __attribute__((address_space(3))) bf16x8*)(kp+2048); kf[3]=*(const __attribute__((address_space(3))) bf16x8*)(kp+2560);
  kf[4]=*(const __attribute__((address_space(3))) bf16x8*)(kp+4096); kf[5]=*(const __attribute__((address_space(3))) bf16x8*)(kp+4608);
  kf[6]=*(const __attribute__((address_space(3))) bf16x8*)(kp+6144); kf[7]=*(const __attribute__((address_space(3))) bf16x8*)(kp+6656);
}
__device__ __forceinline__ void kload2(bf16x8*kf,lds_cptr kp,int j){ kf[2*j]=*(const __attribute__((address_space(3))) bf16x8*)(kp+j*2048); kf[2*j+1]=*(const __attribute__((address_space(3))) bf16x8*)(kp+j*2048+512); }
__device__ __forceinline__ s16x4 vtr(lds_cptr p){ return __builtin_bit_cast(s16x4,__builtin_amdgcn_ds_read_tr16_b64_v4i16((__attribute__((address_space(3))) v4i16_t*)p)); }
__device__ __forceinline__ float rowmax(const f32x16&p0,const f32x16&p1){
  float a=max3f(p0[0],p0[1],p1[0]),b=max3f(p0[2],p0[3],p1[1]);a=max3f(a,p1[2],p1[3]);
  #pragma unroll
  for(int r=4;r<16;r+=4){a=max3f(a,p0[r],p0[r+1]);b=max3f(b,p0[r+2],p0[r+3]);a=max3f(a,p1[r],p1[r+1]);b=max3f(b,p1[r+2],p1[r+3]);}
  const float m=max2f(a,b);
  auto rr=__builtin_amdgcn_permlane32_swap(__float_as_uint(m),__float_as_uint(m),false,false);
  return max2f(__uint_as_float(rr[0]),__uint_as_float(rr[1]));
}
__device__ __forceinline__ void pv(f32x16*o,int vb,bf16x8 pa0,bf16x8 pa1,bf16x8 pa2,bf16x8 pa3){
  #pragma unroll
  for(int d0=0;d0<2;++d0){s16x4 lo[4],hi[4];
    #pragma unroll
    for(int ks=0;ks<4;++ks){
      asm volatile("ds_read_b64_tr_b16 %0,%1 offset:%c2":"=&v"(lo[ks]):"v"(vb),"i"(d0*4096+ks*1024):"memory");
      asm volatile("ds_read_b64_tr_b16 %0,%1 offset:%c2":"=&v"(hi[ks]):"v"(vb),"i"(d0*4096+ks*1024+512):"memory");}
    asm volatile("s_waitcnt lgkmcnt(0)":::"memory");SBAR();
    #define PK(k) (bf16x8){lo[k][0],lo[k][1],lo[k][2],lo[k][3],hi[k][0],hi[k][1],hi[k][2],hi[k][3]}
    o[d0]=__builtin_amdgcn_mfma_f32_32x32x16_bf16(pa0,PK(0),o[d0],0,0,0);
    o[d0]=__builtin_amdgcn_mfma_f32_32x32x16_bf16(pa1,PK(1),o[d0],0,0,0);
    o[d0]=__builtin_amdgcn_mfma_f32_32x32x16_bf16(pa2,PK(2),o[d0],0,0,0);
    o[d0]=__builtin_amdgcn_mfma_f32_32x32x16_bf16(pa3,PK(3),o[d0],0,0,0);
    #undef PK
  }
}

#ifndef ATTN_STORE16
#define ATTN_STORE16(p,v) (*(u32x4*)(p)=(v))
#endif
template<int THRL> __device__ __forceinline__ void attn_unit(long rowbase,int NT,int h,int kvh,int qb,const bf16*Q,const bf16*__restrict__ K,const bf16*__restrict__ V,bf16*O,float*ssq,char*shm){
  int tid=threadIdx.x; asm volatile("":"+v"(tid)); const int lane=tid&63,r32=lane&31,hi=lane>>5; const int wid=__builtin_amdgcn_readfirstlane(tid>>6);
  const int q0=qb*QB;
  const bf16*Qw=Q+(rowbase+q0+wid*QBLK)*PQ+h*D;
  const bf16*Kh=K+rowbase*PQ+kvh*D,*Vh=V+rowbase*PQ+kvh*D;
  const unsigned lds0=(unsigned)(uintptr_t)shm;
  float*wsf=(float*)(shm+LDS_WS)+wid*64;
  const bf16*ksrc=Kh+(long)lane*PQ+wid*8;
  const bf16*vsrc=Vh+(long)(16*(wid&3)+(lane>>2))*PQ+(wid>>2)*32+(lane&3)*8;
  const unsigned kdst=lds0+LDS_K+wid*1024, vdst=lds0+LDS_V+wid*1024;
  #define DMA_K(t,slot) glds16(ksrc+(long)(t)*KVBLK*PQ,(unsigned)__builtin_amdgcn_readfirstlane(kdst+(slot)))
  #define DMA_V(t,slot) glds16(vsrc+(long)(t)*KVBLK*PQ,(unsigned)__builtin_amdgcn_readfirstlane(vdst+(slot)))
  const int vb0=(int)(lds0+LDS_V)+((lane>>4)&1)*32+(lane&3)*8+(4*hi+((lane&15)>>2))*64;
  const char*Kbase=shm+LDS_K; bf16x8 kf[8];
  const lds_cptr shm3=(lds_cptr)shm; const lds_cptr kp0=shm3+LDS_K+hi*1024+r32*16; const lds_cptr vp0=shm3+LDS_V+((lane>>4)&1)*32+(lane&3)*8+(4*hi+((lane&15)>>2))*64;
  DMA_K(0,0);DMA_V(0,0);DMA_K(1,SLOTB);
  bf16x8 qr[4];
  #pragma unroll
  for(int d0=0;d0<4;++d0)qr[d0]=*reinterpret_cast<const bf16x8*>(&Qw[(long)r32*PQ+d0*16+hi*8]);
  float mhat=0.f,l_reg=0.f;f32x16 o[2];o[0]=f32x16{};o[1]=f32x16{};f32x16 negm=f32x16{};asm volatile("":"+v"(negm));
  const int qrel=wid*QBLK+r32;
  #define CMASK(P0,P1,t) do{int jb_=(t)-(NT-4); (void)jb_;(void)qrel;}while(0)
  bool resc=false;
  #define START(P0,P1) do{ const float rm=rowmax(P0,P1); resc=false; \
    { const float dl=rm; mhat=fadd_s(mhat,dl); \
      _Pragma("unroll") for(int r=0;r<16;++r){P0[r]=fsub_s(P0[r],dl);P1[r]=fsub_s(P1[r],dl);} \
      _Pragma("unroll") for(int r=0;r<16;++r)negm[r]=-mhat; asm volatile("":"+v"(negm)); } \
    _Pragma("unroll") for(int r=0;r<16;++r)P0[r]=__builtin_amdgcn_exp2f(P0[r]); }while(0)
  #define RESC() do{ if(resc){ asm volatile("s_waitcnt lgkmcnt(0)":::"memory"); \
      _Pragma("unroll") for(int d_=0;d_<2;++d_) _Pragma("unroll") for(int r=0;r<16;++r)o[d_][r]*=wsf[crow(r,hi)]; } }while(0)
  f32x16 pA0,pA1,pB0,pB1;
  int sl_prev=0,sl_cur=0,sl_next=SLOTB;
  #define ROT() do{sl_prev=sl_cur;sl_cur=sl_next;sl_next=(sl_next==(NSLOT-1)*SLOTB)?0:sl_next+SLOTB;}while(0)
  DMA_K(2,2*SLOTB);
  WAIT_BAR(3);
  qkt(pA0,pA1,Kbase,qr,negm,r32,hi);asm volatile("s_nop 15\n\ts_nop 7":"+v"(pA0),"+v"(pA1));CMASK(pA0,pA1,0);
  START(pA0,pA1);
  _Pragma("unroll") for(int r=0;r<16;++r)pA1[r]=__builtin_amdgcn_exp2f(pA1[r]);
  WAIT_BAR(0);
  DMA_K(3,0);DMA_V(1,SLOTB);
  ROT();
  kload8(kf,kp0+sl_cur);
  WAIT_BAR(2);
  s16x4 vlo[8],vhi[8]; u32x4 pw0,pw1,pw2,pw3;
  #define PKW(P,B) cvtpk_s(P[B],P[B+1])
  #define PAF(k) __builtin_bit_cast(bf16x8,pw##k)
  #define VFR(i) (bf16x8){vlo[i][0],vlo[i][1],vlo[i][2],vlo[i][3],vhi[i][0],vhi[i][1],vhi[i][2],vhi[i][3]}
  #define PIN(x) asm volatile("":"+v"(x))
  #define MX3(a,b,c) __builtin_fmaxf(__builtin_fmaxf((a),(b)),(c))
  #define GAPA(MF,A0,A1,A2,A3,W0,W1,PW) do{ MF; sacc+=A0; sacc+=A1; sacc+=A2; sacc+=A3; PIN(sacc); W0; W1; PIN(PW); SBAR(); }while(0)
  #define EX(v) __builtin_amdgcn_exp2f(v)
  #define GAPB(MF,X,B) do{ MF; X[B]=EX(X[B]); X[B+1]=EX(X[B+1]); X[B+2]=EX(X[B+2]); X[B+3]=EX(X[B+3]); PIN(X); SBAR(); }while(0)
  #define VRD(i) do{ vlo[i]=vtr(vp_+(((i)>>2)*4096+((i)&3)*1024)); vhi[i]=vtr(vp_+(((i)>>2)*4096+((i)&3)*1024+512)); }while(0)
  #define KRD(G,j) do{ if(G){ kload2(kf,kp0+sl_next,j); SBAR(); } }while(0)
  #define STEP(C0,C1,P0,P1,t,GK,GV,GL) do{ SBAR(); \
    const lds_cptr vp_=vp0+sl_prev; \
    VRD(0); SBAR(); float sacc=(P0[0]+P0[1]); \
    GAPA(C0=__builtin_amdgcn_mfma_f32_32x32x16_bf16(kf[0],qr[0],negm,0,0,0), P0[2],P0[3],P0[4],P0[5],     pw0[0]=PKW(P0,0), pw0[1]=PKW(P0,2), pw0); \
    VRD(4); SBAR(); GAPA(C1=__builtin_amdgcn_mfma_f32_32x32x16_bf16(kf[1],qr[0],negm,0,0,0), P0[6],P0[7],P0[8],P0[9],     pw0[2]=PKW(P0,4), pw0[3]=PKW(P0,6), pw0); \
    VRD(1); SBAR(); GAPA(C0=__builtin_amdgcn_mfma_f32_32x32x16_bf16(kf[2],qr[1],C0,0,0,0),   P0[10],P0[11],P0[12],P0[13], pw1[0]=PKW(P0,8), pw1[1]=PKW(P0,10), pw1); \
    VRD(5); SBAR(); GAPA(C1=__builtin_amdgcn_mfma_f32_32x32x16_bf16(kf[3],qr[1],C1,0,0,0),   P0[14],P0[15],P1[0],P1[1],   pw1[2]=PKW(P0,12),pw1[3]=PKW(P0,14), pw1); \
    VRD(2); SBAR(); GAPA(C0=__builtin_amdgcn_mfma_f32_32x32x16_bf16(kf[4],qr[2],C0,0,0,0),   P1[2],P1[3],P1[4],P1[5],     pw2[0]=PKW(P1,0), pw2[1]=PKW(P1,2), pw2); \
    VRD(6); SBAR(); GAPA(C1=__builtin_amdgcn_mfma_f32_32x32x16_bf16(kf[5],qr[2],C1,0,0,0),   P1[6],P1[7],P1[8],P1[9],     pw2[2]=PKW(P1,4), pw2[3]=PKW(P1,6), pw2); \
    VRD(3); SBAR(); GAPA(C0=__builtin_amdgcn_mfma_f32_32x32x16_bf16(kf[6],qr[3],C0,0,0,0),   P1[10],P1[11],P1[12],P1[13], pw3[0]=PKW(P1,8), pw3[1]=PKW(P1,10), pw3); \
    VRD(7); SBAR(); GAPA(C1=__builtin_amdgcn_mfma_f32_32x32x16_bf16(kf[7],qr[3],C1,0,0,0),   P1[14],P1[15],0.f,0.f,       pw3[2]=PKW(P1,12),pw3[3]=PKW(P1,14), pw3); \
    l_reg+=sacc; \
    if(GK){DMA_K((t)+3,sl_cur);} if(GV){DMA_V((t)+1,sl_next);} \
    CMASK(C0,C1,t); \
    { float a=MX3(C0[0],C0[1],C1[0]),b=MX3(C0[2],C0[3],C1[1]); a=MX3(a,C1[2],C1[3]); \
      _Pragma("unroll") for(int r=4;r<16;r+=4){a=MX3(a,C0[r],C0[r+1]);b=MX3(b,C0[r+2],C0[r+3]);a=MX3(a,C1[r],C1[r+1]);b=MX3(b,C1[r+2],C1[r+3]);} \
      float rm=__builtin_fmaxf(a,b); { auto rr=__builtin_amdgcn_permlane32_swap(__float_as_uint(rm),__float_as_uint(rm),false,false); rm=__builtin_fmaxf(__uint_as_float(rr[0]),__uint_as_float(rr[1])); } \
      resc=false; \
      if(__builtin_expect(__any(rm>(float)THRL),0)){ const float dl=__builtin_fmaxf(rm,0.f); mhat+=dl; \
        _Pragma("unroll") for(int r=0;r<16;++r){C0[r]-=dl;C1[r]-=dl;} \
        _Pragma("unroll") for(int r=0;r<16;++r)negm[r]=-mhat; asm volatile("":"+v"(negm)); \
        const float f=__builtin_amdgcn_exp2f(-dl); l_reg*=f; if(hi==0)wsf[r32]=f; resc=true; } } \
    SBAR(); \
    GAPB(o[0]=__builtin_amdgcn_mfma_f32_32x32x16_bf16(PAF(0),VFR(0),o[0],0,0,0), C0,0); \
    GAPB(o[1]=__builtin_amdgcn_mfma_f32_32x32x16_bf16(PAF(0),VFR(4),o[1],0,0,0), C0,4); \
    KRD(GL,0); GAPB(o[0]=__builtin_amdgcn_mfma_f32_32x32x16_bf16(PAF(1),VFR(1),o[0],0,0,0), C0,8); \
    KRD(GL,1); GAPB(o[1]=__builtin_amdgcn_mfma_f32_32x32x16_bf16(PAF(1),VFR(5),o[1],0,0,0), C0,12); \
    KRD(GL,2); GAPB(o[0]=__builtin_amdgcn_mfma_f32_32x32x16_bf16(PAF(2),VFR(2),o[0],0,0,0), C1,0); \
    KRD(GL,3); GAPB(o[1]=__builtin_amdgcn_mfma_f32_32x32x16_bf16(PAF(2),VFR(6),o[1],0,0,0), C1,4); \
    GAPB(o[0]=__builtin_amdgcn_mfma_f32_32x32x16_bf16(PAF(3),VFR(3),o[0],0,0,0), C1,8); \
    GAPB(o[1]=__builtin_amdgcn_mfma_f32_32x32x16_bf16(PAF(3),VFR(7),o[1],0,0,0), C1,12); \
    }while(0)
  int t=1;
  #undef CMASK
  #define CMASK(P0,P1,t) do{}while(0)
  for(;t+5<NT;t+=2){
    STEP(pB0,pB1,pA0,pA1,t,true,true,true);     WAIT_BAR(2); RESC(); ROT();
    STEP(pA0,pA1,pB0,pB1,t+1,true,true,true);   WAIT_BAR(2); RESC(); ROT();
  }
  #undef CMASK
  #define CMASK(P0,P1,t) do{int jb_=(t)-(NT-4); (void)jb_;(void)qrel;}while(0)
  #define ENDW(tt) do{ if((tt)+3<NT){WAIT_BAR(2);} else if((tt)+2<NT){WAIT_BAR(1);} else {WAIT_BAR(0);} }while(0)
  for(;t+1<NT;t+=2){
    STEP(pB0,pB1,pA0,pA1,t,(t+3<NT),(t+1<NT),(t+1<NT));       ENDW(t);   RESC(); ROT();
    STEP(pA0,pA1,pB0,pB1,t+1,(t+4<NT),(t+2<NT),(t+2<NT));     ENDW(t+1); RESC(); ROT();
  }
  STEP(pB0,pB1,pA0,pA1,NT-1,false,false,false); RESC();
  { float sacc=pB0[0]+pB0[1]; _Pragma("unroll") for(int r=2;r<16;++r)sacc+=pB0[r]; _Pragma("unroll") for(int r=0;r<16;++r)sacc+=pB1[r]; l_reg+=sacc;
    pw0=(u32x4){PKW(pB0,0),PKW(pB0,2),PKW(pB0,4),PKW(pB0,6)};pw1=(u32x4){PKW(pB0,8),PKW(pB0,10),PKW(pB0,12),PKW(pB0,14)};pw2=(u32x4){PKW(pB1,0),PKW(pB1,2),PKW(pB1,4),PKW(pB1,6)};pw3=(u32x4){PKW(pB1,8),PKW(pB1,10),PKW(pB1,12),PKW(pB1,14)};
    SBAR(); pv(o,vb0+sl_cur,PAF(0),PAF(1),PAF(2),PAF(3)); }
  #undef PKW
  #undef PAF
  #undef VFR
  #undef PIN
  #undef MX3
  #undef GAPA
  #undef GAPB
  #undef EX
  #undef VRD
  #undef KRD
  #undef STEP
  #undef ENDW
  {auto rr=__builtin_amdgcn_permlane32_swap(__float_as_uint(l_reg),__float_as_uint(l_reg),false,false);l_reg=__uint_as_float(rr[0])+__uint_as_float(rr[1]);}
  if(hi==0)wsf[32+r32]=l_reg;asm volatile("s_waitcnt lgkmcnt(0)":::"memory");
  float rli[16];
  #pragma unroll
  for(int r=0;r<16;++r)rli[r]=__builtin_amdgcn_rcpf(wsf[32+crow(r,hi)]);
  bf16*Ow=O+(rowbase+q0+wid*QBLK)*PO+h*D;
  { bf16*stg=(bf16*)(shm+LDS_OST)+wid*2048;
    #pragma unroll
    for(int r=0;r<16;++r){const int orow=crow(r,hi);
      #pragma unroll
      for(int d0=0;d0<2;++d0)stg[orow*64+d0*32+r32]=__float2bfloat16(o[d0][r]*rli[r]);}
    asm volatile("s_waitcnt lgkmcnt(0)":::"memory");
    #pragma unroll
    for(int i=0;i<4;++i){const int row=i*8+(lane>>3),ch=lane&7; const u32x4 v=*(const u32x4*)(stg+row*64+ch*8); ATTN_STORE16(Ow+(long)row*PO+ch*8,v);
      float ss=0.f; _Pragma("unroll") for(int e=0;e<4;++e){const float lo=__uint_as_float(v[e]<<16),hh=__uint_as_float(v[e]&0xffff0000u); ss+=lo*lo+hh*hh;}
      ss=sum8(ss); if(ch==0)__hip_atomic_fetch_add(ssq+(rowbase+q0+wid*QBLK+row),ss,__ATOMIC_RELAXED,__HIP_MEMORY_SCOPE_AGENT);} }
  asm volatile("s_waitcnt lgkmcnt(0)\n\ts_barrier":::"memory");
  #undef DMA_K
  #undef DMA_V
  #undef CMASK
  #undef START
  #undef RESC
  #undef ROT
}
constexpr int ATTN_LDS_BYTES=LDS_BYTES;
#undef SBAR
#undef WAIT_BAR
}
namespace na_body {
using attn_body::bf16x8; using attn_body::s16x4; using attn_body::f32x16; using attn_body::u32x4;
#define NA_LAS __attribute__((address_space(3)))
constexpr int PQ = 2304, PO = 1024;
constexpr int COL_QB = 768, COL_KB = 1280, COL_VB = 1792, COL_OB = 512;
constexpr int KROW = 144, K_BYTES = 64 * KROW, TILE_BYTES = K_BYTES + 8192;
constexpr int T_GUARD = 48, T_FLOATS = T_GUARD + 15 * 32 + 48;
__device__ __forceinline__ int crow(int r, int hi) { return (r & 3) + 8 * (r >> 2) + 4 * hi; }
__device__ __forceinline__ unsigned cvtpk(float lo, float hi) { return attn_body::cvtpk_s(lo, hi); }

__device__ __forceinline__ void na_unit(unsigned char* __restrict__ ws, unsigned proj_off, unsigned o_off, unsigned ssq_off, int rowbase, int rows, int r, int h,
                                        NA_LAS unsigned char* wl, unsigned wl_addr, const NA_LAS float* T, NA_LAS float* wsf) {
    int tid_ = threadIdx.x; asm volatile("" : "+v"(tid_)); const int lane = tid_ & 63, r32 = lane & 31, hi = lane >> 5;
    const int r0 = min(max(r - 4, 0), rows - 8);
    const int qrow0 = rowbase + r * 64;
    const unsigned qoff = proj_off + (unsigned)((qrow0 + r32) * PQ + COL_QB + h * 64 + hi * 8) * 2u;
    bf16x8 qr[2][4];
#pragma unroll
    for (int qb2 = 0; qb2 < 2; ++qb2)
#pragma unroll
        for (int d0 = 0; d0 < 4; ++d0) qr[qb2][d0] = *(const bf16x8*)(ws + (size_t)(qoff + (unsigned)(qb2 * 32 * PQ + d0 * 16) * 2u));
    float mrun[2] = {-1e30f, -1e30f}, lrun[2] = {0.f, 0.f};
    f32x16 o[2][2];
#pragma unroll
    for (int a = 0; a < 2; ++a)
#pragma unroll
        for (int b = 0; b < 2; ++b) o[a][b] = f32x16{};
    const int lrow = lane >> 3, lc = lane & 7;
    const int vb = (int)wl_addr + K_BYTES + ((lane >> 4) & 1) * 32 + (lane & 3) * 8 + (4 * hi + ((lane & 15) >> 2)) * 64;
    unsigned kboff = proj_off + (unsigned)((rowbase + r0 * 64 + lrow) * PQ + COL_KB + h * 64 + lc * 8) * 2u;
    u32x4 kreg[8], vreg[8];
#pragma unroll
    for (int j = 0; j < 8; ++j) { kreg[j] = *(const u32x4*)(ws + (size_t)(kboff + (unsigned)(j * 8 * PQ) * 2u)); vreg[j] = *(const u32x4*)(ws + (size_t)(kboff + (unsigned)(COL_VB - COL_KB + j * 8 * PQ) * 2u)); }
    for (int i = 0; i < 8; ++i) {
#pragma unroll
        for (int j = 0; j < 8; ++j) { const int row = j * 8 + lrow;
            *(NA_LAS u32x4*)(wl + row * KROW + lc * 16) = kreg[j];
            *(NA_LAS u32x4*)(wl + K_BYTES + (lc >> 2) * 4096 + (row >> 4) * 1024 + (row & 15) * 64 + (lc & 3) * 16) = vreg[j]; }
        kboff += (unsigned)(64 * PQ) * 2u;
        __builtin_amdgcn_sched_barrier(0);
        if (i < 7) {
#pragma unroll
            for (int j = 0; j < 8; ++j) { kreg[j] = *(const u32x4*)(ws + (size_t)(kboff + (unsigned)(j * 8 * PQ) * 2u)); vreg[j] = *(const u32x4*)(ws + (size_t)(kboff + (unsigned)(COL_VB - COL_KB + j * 8 * PQ) * 2u)); }
        }
        __builtin_amdgcn_sched_barrier(0);
        const int dr = r0 + i - r + 7;
#pragma unroll
        for (int qb2 = 0; qb2 < 2; ++qb2) {
            f32x16 p0 = f32x16{}, p1 = f32x16{};
#pragma unroll
            for (int d0 = 0; d0 < 4; ++d0) { const bf16x8 k0 = *(const NA_LAS bf16x8*)(wl + r32 * KROW + (2 * d0 + hi) * 16), k1 = *(const NA_LAS bf16x8*)(wl + (r32 + 32) * KROW + (2 * d0 + hi) * 16);
                p0 = __builtin_amdgcn_mfma_f32_32x32x16_bf16(k0, qr[qb2][d0], p0, 0, 0, 0); p1 = __builtin_amdgcn_mfma_f32_32x32x16_bf16(k1, qr[qb2][d0], p1, 0, 0, 0); }
            const int c = qb2 * 32 + r32, c0 = min(max(c - 8, 0), 48);
            const NA_LAS float* tb = T + dr * 32 + 15 - c + 4 * hi;
            const int kofs = 4 * hi - c0;
#define NA_USE0(rr) (qb2 == 0 || (rr) >= 12)
#define NA_USE1(rr) (qb2 == 1 || (rr) < 4)
            float rm = -1e30f;
#pragma unroll
            for (int rr = 0; rr < 16; ++rr) { const int kc = (rr & 3) + 8 * (rr >> 2);
                if (NA_USE0(rr)) { const float s0 = ((unsigned)(kc + kofs) < 16u) ? p0[rr] + tb[kc] : -1e30f; p0[rr] = s0; rm = fmaxf(rm, s0); }
                if (NA_USE1(rr)) { const float s1 = ((unsigned)(kc + 32 + kofs) < 16u) ? p1[rr] + tb[kc + 32] : -1e30f; p1[rr] = s1; rm = fmaxf(rm, s1); }
                if ((rr & 3) == 3) __builtin_amdgcn_sched_barrier(0); }
            rm = attn_body::xmax32(rm);
            const float mn = fmaxf(mrun[qb2], rm), alpha = __builtin_amdgcn_exp2f(mrun[qb2] - mn);
            mrun[qb2] = mn;
            float sum = 0.f;
#pragma unroll
            for (int rr = 0; rr < 16; ++rr) {
                if (NA_USE0(rr)) { p0[rr] = __builtin_amdgcn_exp2f(p0[rr] - mn); sum += p0[rr]; } else p0[rr] = 0.f;
                if (NA_USE1(rr)) { p1[rr] = __builtin_amdgcn_exp2f(p1[rr] - mn); sum += p1[rr]; } else p1[rr] = 0.f; }
            lrun[qb2] = lrun[qb2] * alpha + sum;
            if (__any(alpha != 1.0f)) {
                if (hi == 0) wsf[r32] = alpha;
#pragma unroll
                for (int rr = 0; rr < 16; ++rr) { const float a = wsf[crow(rr, hi)]; o[qb2][0][rr] *= a; o[qb2][1][rr] *= a; }
            }
            u32x4 pw0, pw1, pw2, pw3;
            pw0 = (u32x4){cvtpk(p0[0], p0[1]), cvtpk(p0[2], p0[3]), cvtpk(p0[4], p0[5]), cvtpk(p0[6], p0[7])};
            pw1 = (u32x4){cvtpk(p0[8], p0[9]), cvtpk(p0[10], p0[11]), cvtpk(p0[12], p0[13]), cvtpk(p0[14], p0[15])};
            pw2 = (u32x4){cvtpk(p1[0], p1[1]), cvtpk(p1[2], p1[3]), cvtpk(p1[4], p1[5]), cvtpk(p1[6], p1[7])};
            pw3 = (u32x4){cvtpk(p1[8], p1[9]), cvtpk(p1[10], p1[11]), cvtpk(p1[12], p1[13]), cvtpk(p1[14], p1[15])};
#undef NA_USE0
#undef NA_USE1
            attn_body::pv(o[qb2], vb, __builtin_bit_cast(bf16x8, pw0), __builtin_bit_cast(bf16x8, pw1), __builtin_bit_cast(bf16x8, pw2), __builtin_bit_cast(bf16x8, pw3));
        }
    }
#pragma unroll
    for (int qb2 = 0; qb2 < 2; ++qb2) {
        const float l = attn_body::xsum32(lrun[qb2]);
        if (hi == 0) wsf[r32] = __builtin_amdgcn_rcpf(l);
        NA_LAS unsigned short* stg = (NA_LAS unsigned short*)(wl + qb2 * 4096);
#pragma unroll
        for (int rr = 0; rr < 16; ++rr) { const int orow = crow(rr, hi); const float rl = wsf[orow];
#pragma unroll
            for (int d0 = 0; d0 < 2; ++d0) stg[orow * 64 + d0 * 32 + r32] = (unsigned short)(cvtpk(o[qb2][d0][rr] * rl, 0.f) & 0xffffu); }
        const unsigned ooff = o_off + (unsigned)((qrow0 + qb2 * 32) * PO + COL_OB + h * 64) * 2u;
#pragma unroll
        for (int k = 0; k < 4; ++k) { const int row = k * 8 + (lane >> 3), ch = lane & 7; const u32x4 v = *(const NA_LAS u32x4*)(stg + row * 64 + ch * 8); *(u32x4*)(ws + (size_t)(ooff + (unsigned)(row * PO + ch * 8) * 2u)) = v;
            float ss = 0.f;
#pragma unroll
            for (int e = 0; e < 4; ++e) { const float lo = __uint_as_float(v[e] << 16), hh = __uint_as_float(v[e] & 0xffff0000u); ss += lo * lo + hh * hh; }
            ss = attn_body::sum8(ss); if (ch == 0) __hip_atomic_fetch_add((float*)(ws + (size_t)(ssq_off + (unsigned)(qrow0 + qb2 * 32 + row) * 4u)), ss, __ATOMIC_RELAXED, __HIP_MEMORY_SCOPE_AGENT); }
    }
}
}
namespace cg = cooperative_groups;
constexpr int NWAVES = 8;
constexpr int DM = 1024, M_PROMPT = 32 * 2048, S_PROMPT = 2048, M_SAMPLE = 4 * 4096, S_SAMPLE = 4096, M_ALL = M_PROMPT + M_SAMPLE;
constexpr int NPROJ = 2304, DFF = 2816, NUP = 2 * DFF, PLE = 256;
constexpr int FFN_CHUNKS = 4, M_CHUNK = M_ALL / FFN_CHUNKS;
constexpr float C2 = 0.125f * 1.4426950408889634f;
constexpr float LOG2E = 1.4426950408889634f;
constexpr size_t MiB = 1u << 20;
constexpr size_t WS_SSQ2 = 0, WS_SSQ3 = 384 * 1024, WS_SSQ4 = 768 * 1024, WS_SSQA = 1152 * 1024, WS_SSQB = 1536 * 1024, WS_ROPE = 1984 * 1024, WS_BAR = 1992 * 1024, BAR_BYTES = 16384;
constexpr size_t WS_WIN = 2 * MiB, WS_WOUT = 7 * MiB, WS_WUP = 9 * MiB, WS_WDOWN = 20 * MiB, WS_WGATE = 26 * MiB, WS_WPLE = 28 * MiB;
constexpr size_t WS_PROJ = 32 * MiB;
constexpr size_t WS_XNO = 392 * MiB;
constexpr size_t WS_ACT = 32 * MiB;
constexpr size_t WS_H2B = 472 * MiB;
constexpr size_t WS_H3B = 32 * MiB;
constexpr size_t WS_E = 632 * MiB;
constexpr size_t WS_H1B = 824 * MiB;
constexpr size_t WS_PB = 984 * MiB;
constexpr size_t WS_END = 1024 * MiB;
static_assert(WS_PROJ + (size_t)M_ALL * NPROJ * 2 <= WS_XNO && WS_XNO + (size_t)M_ALL * DM * 2 <= WS_E && WS_ACT + (size_t)M_ALL * DFF * 2 <= WS_H2B && WS_H2B + (size_t)M_ALL * DM * 2 <= WS_E, "d_ws map");
static_assert(WS_E + (size_t)M_ALL * DM * 2 <= WS_H1B && WS_H1B + (size_t)M_ALL * DM * 2 <= WS_PB && WS_PB + (size_t)M_ALL * PLE * 2 <= WS_END && WS_H3B + (size_t)M_ALL * DM * 2 <= WS_H2B, "d_ws map 2");
static_assert(WS_BAR + BAR_BYTES <= WS_WIN && 3456 * 4 <= BAR_BYTES, "barrier words (XCD_BAR_WORDS = 3456)");
static_assert(WS_WIN + (size_t)NPROJ * DM * 2 <= WS_WOUT && WS_WUP + (size_t)NUP * DM * 2 <= WS_WDOWN && WS_WDOWN + (size_t)DM * DFF * 2 <= WS_WGATE, "weight map");
constexpr int RING_BYTES = 131072;
constexpr int NA_T_OFF = NWAVES * na_body::TILE_BYTES, NA_T_BYTES = na_body::T_FLOATS * 4, NA_WSF_OFF = NA_T_OFF + NWAVES * NA_T_BYTES, XB_ST_OFF = NA_WSF_OFF + NWAVES * 256, LDS_BYTES = XB_ST_OFF + 256;
static_assert(NA_T_OFF >= RING_BYTES + 16384 - 8192 && LDS_BYTES <= 163840 && attn_body::ATTN_LDS_BYTES <= RING_BYTES, "LDS map");

#define LAS __attribute__((address_space(3)))
typedef unsigned short bf16;
typedef unsigned v4u __attribute__((ext_vector_type(4)));
typedef unsigned v2u __attribute__((ext_vector_type(2)));
typedef float f32x4 __attribute__((ext_vector_type(4)));
__device__ __forceinline__ unsigned pk2(float lo, float hi) { return pg8::cvt_pk_bf16(lo, hi); }
__device__ __forceinline__ float bflo(unsigned w) { return __uint_as_float(w << 16); }
__device__ __forceinline__ float bfhi(unsigned w) { return __uint_as_float(w & 0xffff0000u); }
__device__ __forceinline__ float wave_sum(float v) {
#pragma unroll
    for (int o = 1; o < 64; o <<= 1) v += __shfl_xor(v, o);
    return v;
}
__device__ __forceinline__ void p0_transpose_item(const float* W, int K, int N, bf16* WT, LAS float* scr, int item, int lane, const float* gain, const float* gain_hi, int ksplit, int nlo, int nhi, float nscale, bool upmap = false) {
    const int nblk = N / 32, kb = item / nblk, nb = item % nblk, k0 = 64 * kb, n0 = 32 * nb;
#pragma unroll 8
    for (int i = 0; i < 32; ++i) { const int kk = 2 * i + (lane >> 5); float w = W[(size_t)(k0 + kk) * N + n0 + (lane & 31)]; if (gain) w *= (k0 < ksplit ? gain[k0 + kk] : gain_hi[k0 + kk - ksplit]); scr[kk * 33 + (lane & 31)] = w; }
    asm volatile("s_waitcnt lgkmcnt(0)" ::: "memory");
    const int c = lane & 7;
#pragma unroll
    for (int j = 0; j < 4; ++j) { const int n = (lane >> 3) + 8 * j; const LAS float* s = scr + (8 * c) * 33 + n; const float ns = (n0 + n >= nlo && n0 + n < nhi) ? nscale : 1.0f;
        v4u o; o.x = pk2(s[0 * 33] * ns, s[1 * 33] * ns); o.y = pk2(s[2 * 33] * ns, s[3 * 33] * ns); o.z = pk2(s[4 * 33] * ns, s[5 * 33] * ns); o.w = pk2(s[6 * 33] * ns, s[7 * 33] * ns);
        int nn = n0 + n; if (upmap) nn = (nn < DFF) ? 256 * (nn / 128) + (nn % 128) : 256 * ((nn - DFF) / 128) + 128 + ((nn - DFF) % 128);
        *(v4u*)(WT + (size_t)nn * K + k0 + 8 * c) = o; }
    asm volatile("s_waitcnt lgkmcnt(0)" ::: "memory");
}
__device__ __forceinline__ void sincos_cw(float a, float& s, float& c) {
    const float k = rintf(a * 0.636619772367581343f);
    float r = fmaf(-k, 1.5703125f, a); r = fmaf(-k, 4.837512969970703125e-4f, r); r = fmaf(-k, 7.54978995489188216e-8f, r);
    const float r2 = r * r;
    const float sp = r + r * r2 * (-1.6666667163e-01f + r2 * (8.3333337680e-03f + r2 * (-1.9841270114e-04f + r2 * 2.7557314297e-06f)));
    const float cp = 1.0f + r2 * (-0.5f + r2 * (4.1666667908e-02f + r2 * (-1.3888889225e-03f + r2 * (2.4801587642e-05f + r2 * -2.7557314297e-07f))));
    const int q = (int)k & 3;
    s = (q == 0) ? sp : (q == 1) ? cp : (q == 2) ? -sp : -cp;
    c = (q == 0) ? cp : (q == 1) ? -sp : (q == 2) ? -cp : sp;
}

#define XB_TMO      128
#define XB_XCNT(j)  (256  + 64 * (j))
#define XB_XSUB(j)  (1280 + 64 * (j))
#define XB_XGEN(j)  (2304 + 64 * (j))
#define XB_TOP      3328
#define XB_TOPGEN   3392
#define XCD_BAR_WORDS 3456
#define XB_SPIN_CAP (1u << 18)

__device__ __forceinline__ unsigned xb_ld(unsigned* p)              { return __hip_atomic_load(p, __ATOMIC_RELAXED, __HIP_MEMORY_SCOPE_AGENT); }
__device__ __forceinline__ unsigned xb_add(unsigned* p, unsigned v) { return __hip_atomic_fetch_add(p, v, __ATOMIC_RELAXED, __HIP_MEMORY_SCOPE_AGENT); }
__device__ __forceinline__ unsigned xb_xcc_id() { return (unsigned)__builtin_amdgcn_s_getreg((3 << 11) | 20) & 0xFu; }
#define XB_SPIN(cond, bar) do { unsigned _sp = 0; while (cond) { __builtin_amdgcn_s_sleep(1); \
    if ((++_sp & 255u) == 0u) { if (xb_ld(&(bar)[XB_TMO])) break; if (_sp > XB_SPIN_CAP) { atomicAdd(&(bar)[XB_TMO], 1u); break; } } } } while (0)

struct XcdBarrier {
    unsigned* bar; unsigned x;
    volatile LAS unsigned* st;
};

__device__ __forceinline__ XcdBarrier xcd_barrier_post(unsigned* bar, volatile LAS unsigned* st) {
    XcdBarrier b; b.bar = bar; b.x = xb_xcc_id(); b.st = st;
    if (threadIdx.x == 0) (void)xb_add(&bar[XB_XCNT(b.x)], 1u);
    return b;
}
__device__ __forceinline__ void xcd_barrier_complete(unsigned* bar, unsigned x, unsigned& nloc, unsigned& nx) {
    const unsigned G = gridDim.x * gridDim.y * gridDim.z;
    unsigned sum, cnt, mine, sp = 0u;
    for (;;) {
        sum = 0u; cnt = 0u; mine = 0u;
#pragma unroll
        for (unsigned j = 0; j < 16; ++j) { const unsigned c = xb_ld(&bar[XB_XCNT(j)]); sum += c; cnt += (c > 0u) ? 1u : 0u; mine = (j == x) ? c : mine; }
        if (sum == G) break;
        __builtin_amdgcn_s_sleep(1);
        if ((++sp & 255u) == 0u) { if (xb_ld(&bar[XB_TMO])) break; if (sp > XB_SPIN_CAP) { atomicAdd(&bar[XB_TMO], 1u); break; } }
    }
    nloc = mine > 0u ? mine : 1u; nx = cnt > 0u ? cnt : 1u;
}

__device__ __forceinline__ void xcd_barrier(const XcdBarrier& b) {
    asm volatile("s_waitcnt vmcnt(0)" ::: "memory");
    __syncthreads();
    if (threadIdx.x == 0) {
        unsigned* bar = b.bar;
        __builtin_amdgcn_s_waitcnt(0);
        unsigned nloc = b.st[0], nx = b.st[1];
        if (nloc == 0u) { xcd_barrier_complete(bar, b.x, nloc, nx); b.st[0] = nloc; b.st[1] = nx; }
        const unsigned old = xb_add(&bar[XB_XSUB(b.x)], 1u);
        const unsigned gen = old / nloc;
        if (old + 1u == (gen + 1u) * nloc) {
            __builtin_amdgcn_fence(__ATOMIC_RELEASE, "agent");
            asm volatile("s_waitcnt vmcnt(0)" ::: "memory");
            const unsigned og = xb_add(&bar[XB_TOP], 1u);
            const unsigned tg = og / nx;
            if (og + 1u == (tg + 1u) * nx) xb_add(&bar[XB_TOPGEN], 1u);
            else XB_SPIN(xb_ld(&bar[XB_TOPGEN]) == tg, bar);
            __builtin_amdgcn_fence(__ATOMIC_ACQUIRE, "agent");
            xb_add(&bar[XB_XGEN(b.x)], 1u);
            asm volatile("s_waitcnt vmcnt(0)" ::: "memory");
        } else {
            XB_SPIN(xb_ld(&bar[XB_XGEN(b.x)]) == gen, bar);
            __builtin_amdgcn_fence(__ATOMIC_ACQUIRE, "agent");
            asm volatile("s_waitcnt vmcnt(0)" ::: "memory");
        }
    }
    __syncthreads();
}

typedef const __attribute__((address_space(4))) unsigned char* kptr_t;
struct Args { const float* in[21]; float* out; unsigned char* ws; };

__global__ void __launch_bounds__(NWAVES * 64, 2) hymba_fwd(Args args) {
    extern __shared__ __attribute__((aligned(16))) unsigned char lds[];
    cg::grid_group grid = cg::this_grid();
    LAS unsigned char* const L = (LAS unsigned char*)lds;
    const int wave = __builtin_amdgcn_readfirstlane(threadIdx.x >> 6);
    const int G = gridDim.x, bx = blockIdx.x, vcu = (G % 8 == 0) ? (bx % 8) * (G / 8) + bx / 8 : bx;
    const int gw = vcu * NWAVES + wave, NGW = G * NWAVES;
    if (threadIdx.x < 2) ((volatile LAS unsigned*)(L + XB_ST_OFF))[threadIdx.x] = 0u;
    __syncthreads();
    { kptr_t kp0 = (kptr_t)__builtin_amdgcn_kernarg_segment_ptr(); unsigned char* const ws0 = (unsigned char*)(*(const __attribute__((address_space(4))) unsigned long long*)(kp0 + 8 * 22));
      (void)xcd_barrier_post((unsigned*)(ws0 + WS_BAR), (volatile LAS unsigned*)(L + XB_ST_OFF)); }
#define SEAM_BAR() do { kptr_t kpb = (kptr_t)__builtin_amdgcn_kernarg_segment_ptr(); asm volatile("" : "+s"(kpb)); XcdBarrier xb_; xb_.bar = (unsigned*)((unsigned char*)(*(const __attribute__((address_space(4))) unsigned long long*)(kpb + 8 * 22)) + WS_BAR); \
        xb_.x = xb_xcc_id(); xb_.st = (volatile LAS unsigned*)(L + XB_ST_OFF); xcd_barrier(xb_); } while (0)
#define PHASE_PTRS() int tid = threadIdx.x; asm volatile("" : "+v"(tid)); const int lane = tid & 63; (void)lane; kptr_t kp = (kptr_t)__builtin_amdgcn_kernarg_segment_ptr(); asm volatile("" : "+s"(kp)); unsigned char* const ws = (unsigned char*)KLD(22); float* const out = (float*)KLD(21); (void)out; \
    float* const ssq2 = (float*)(ws + WS_SSQ2); float* const ssq3 = (float*)(ws + WS_SSQ3); float* const ssq4 = (float*)(ws + WS_SSQ4); float* const ssqA = (float*)(ws + WS_SSQA); float* const ssqB = (float*)(ws + WS_SSQB); (void)ssqA; (void)ssqB; float* const rope = (float*)(ws + WS_ROPE); (void)ssq2; (void)ssq3; (void)ssq4; (void)rope; \
    bf16* const PROJ = (bf16*)(ws + WS_PROJ); bf16* const XNO = (bf16*)(ws + WS_XNO); (void)PROJ; (void)XNO;
#define KLD(i) (*(const __attribute__((address_space(4))) unsigned long long*)(kp + 8 * (i)))
#define KIN(i) ((const float*)KLD(i))

    {
        PHASE_PTRS();
        const float* const x_prompt = KIN(0); const float* const x_sample = KIN(1); const float* const p_prompt = KIN(2); const float* const p_sample = KIN(3);
        bf16* const Win_t = (bf16*)(ws + WS_WIN); bf16* const Wout_t = (bf16*)(ws + WS_WOUT); bf16* const Wup_t = (bf16*)(ws + WS_WUP); bf16* const Wdown_t = (bf16*)(ws + WS_WDOWN);
        bf16* const Wgate_t = (bf16*)(ws + WS_WGATE); bf16* const Wple_t = (bf16*)(ws + WS_WPLE); bf16* const PB = (bf16*)(ws + WS_PB);
        LAS float* scr = (LAS float*)(L + wave * 16384);
        constexpr int I_IN = (DM / 64) * (NPROJ / 32), I_OUT = (DM / 64) * (DM / 32), I_UP = (DM / 64) * (NUP / 32), I_DOWN = (DFF / 64) * (DM / 32), I_GATE = I_OUT, I_PLE = (PLE / 64) * (DM / 32);
        constexpr int NITEMS = I_IN + I_OUT + I_UP + I_DOWN + I_GATE + I_PLE;
        for (int it = gw; it < NITEMS; it += NGW) {
            int r = it;
            if (r < I_IN) { p0_transpose_item(KIN(5), DM, NPROJ, Win_t, scr, r, lane, nullptr, nullptr, 0, na_body::COL_QB, na_body::COL_KB, C2); continue; } r -= I_IN;
            if (r < I_OUT) { p0_transpose_item(KIN(11), DM, DM, Wout_t, scr, r, lane, KIN(9), KIN(10), 512, 0, 0, 1.f); continue; } r -= I_OUT;
            if (r < I_UP) { p0_transpose_item(KIN(13), DM, NUP, Wup_t, scr, r, lane, KIN(12), nullptr, 1 << 30, 0, 0, 1.f, true); continue; } r -= I_UP;
            if (r < I_DOWN) { p0_transpose_item(KIN(16), DFF, DM, Wdown_t, scr, r, lane, nullptr, nullptr, 0, 0, 0, 1.f); continue; } r -= I_DOWN;
            if (r < I_GATE) { p0_transpose_item(KIN(18), DM, DM, Wgate_t, scr, r, lane, KIN(17), nullptr, 1 << 30, 0, 0, 1.f); continue; } r -= I_GATE;
            p0_transpose_item(KIN(19), PLE, DM, Wple_t, scr, r, lane, nullptr, nullptr, 0, 0, 0, 1.f);
        }
        const float* gain = KIN(4);
        for (int m0 = gw; m0 < M_ALL; m0 += 2 * NGW) {
            const int m1 = m0 + NGW; const bool has1 = m1 < M_ALL; const int m1c = has1 ? m1 : m0;
            const float* xrow0 = (m0 < M_PROMPT) ? x_prompt + (size_t)m0 * DM : x_sample + (size_t)(m0 - M_PROMPT) * DM;
            const float* xrow1 = (m1c < M_PROMPT) ? x_prompt + (size_t)m1c * DM : x_sample + (size_t)(m1c - M_PROMPT) * DM;
            const float* prow0 = (m0 < M_PROMPT) ? p_prompt + (size_t)m0 * PLE : p_sample + (size_t)(m0 - M_PROMPT) * PLE;
            const float* prow1 = (m1c < M_PROMPT) ? p_prompt + (size_t)m1c * PLE : p_sample + (size_t)(m1c - M_PROMPT) * PLE;
            const f32x4* xr0 = (const f32x4*)xrow0 + lane; const f32x4* xr1 = (const f32x4*)xrow1 + lane;
            f32x4 v0[4], v1[4]; float s0 = 0.f, s1 = 0.f;
#pragma unroll
            for (int j = 0; j < 4; ++j) { v0[j] = xr0[64 * j]; v1[j] = xr1[64 * j]; }
            const f32x4 pv0 = ((const f32x4*)prow0)[lane], pv1 = ((const f32x4*)prow1)[lane];
#pragma unroll
            for (int j = 0; j < 4; ++j) { s0 += (v0[j].x * v0[j].x + v0[j].y * v0[j].y) + (v0[j].z * v0[j].z + v0[j].w * v0[j].w); s1 += (v1[j].x * v1[j].x + v1[j].y * v1[j].y) + (v1[j].z * v1[j].z + v1[j].w * v1[j].w); }
            const float rs0 = __builtin_amdgcn_rsqf(wave_sum(s0) * (1.f / DM) + 1e-6f), rs1 = __builtin_amdgcn_rsqf(wave_sum(s1) * (1.f / DM) + 1e-6f);
            unsigned long long* o80 = (unsigned long long*)(XNO + (size_t)m0 * DM) + lane; unsigned long long* o81 = (unsigned long long*)(XNO + (size_t)m1c * DM) + lane;
#pragma unroll
            for (int j = 0; j < 4; ++j) { const f32x4 g = ((const f32x4*)gain)[lane + 64 * j];
                o80[64 * j] = (unsigned long long)pk2(v0[j].x * rs0 * g.x, v0[j].y * rs0 * g.y) | ((unsigned long long)pk2(v0[j].z * rs0 * g.z, v0[j].w * rs0 * g.w) << 32);
                if (has1) o81[64 * j] = (unsigned long long)pk2(v1[j].x * rs1 * g.x, v1[j].y * rs1 * g.y) | ((unsigned long long)pk2(v1[j].z * rs1 * g.z, v1[j].w * rs1 * g.w) << 32); }
            ((unsigned long long*)(PB + (size_t)m0 * PLE))[lane] = (unsigned long long)pk2(pv0.x, pv0.y) | ((unsigned long long)pk2(pv0.z, pv0.w) << 32);
            if (has1) ((unsigned long long*)(PB + (size_t)m1 * PLE))[lane] = (unsigned long long)pk2(pv1.x, pv1.y) | ((unsigned long long)pk2(pv1.z, pv1.w) << 32);
        }
        for (int e = bx * (NWAVES * 64) + tid; e < M_ALL; e += G * NWAVES * 64) { ssq2[e] = 0.f; ssq3[e] = 0.f; ssq4[e] = 0.f; ssqA[e] = 0.f; ssqB[e] = 0.f; }
        for (int e = bx * (NWAVES * 64) + tid; e < 1024; e += G * NWAVES * 64) { const int pos = e >> 4, i = e & 15;
            const float freq = exp2f(-(float)i * (13.287712379549449f / 16.0f)); float s, c; sincos_cw((float)pos * freq, s, c); rope[e] = c; rope[1024 + e] = s; }
    }
    if (G > (1 << 24)) grid.sync();
    SEAM_BAR();

    {
        PHASE_PTRS(); bf16* const Win_t = (bf16*)(ws + WS_WIN);
        pg8::Gemm g{XNO, Win_t, M_ALL, NPROJ, DM}; pg8::StaticOrder S; S.init(M_ALL, NPROJ, G, bx);
        pg8::EpiProj E{PROJ, NPROJ, KIN(6), KIN(7), rope, C2};
        pg8::gemm_phase<pg8::EpiProj, pg8::StaticOrder, true, true>(L, g, S, E);
    }
    {
        PHASE_PTRS(); bf16* const PB = (bf16*)(ws + WS_PB); bf16* const Wple_t = (bf16*)(ws + WS_WPLE); bf16* const EB = (bf16*)(ws + WS_E);
        pg8::Gemm g{PB, Wple_t, M_ALL, DM, PLE}; pg8::StaticOrder S; S.init(M_ALL, DM, G, bx);
        pg8::EpiBf16Rs E{EB, DM, nullptr};
        pg8::gemm_phase<pg8::EpiBf16Rs, pg8::StaticOrder, true, true>(L, g, S, E);
    }
    SEAM_BAR();

    {
        PHASE_PTRS();
        const attn_body::bf16* Q = (const attn_body::bf16*)PROJ; const attn_body::bf16* K = Q + 512; const attn_body::bf16* V = Q + 640; attn_body::bf16* Ob = (attn_body::bf16*)XNO;
        for (int pair = vcu; pair < 256; pair += G) { const int b = pair >> 3, h = pair & 7;
            for (int qb = 0; qb < 8; ++qb) attn_body::attn_unit<8>((long)b * S_PROMPT, S_PROMPT / 64, h, h >> 2, qb, Q, K, V, Ob, ssqA, (char*)lds); }
        for (int su = vcu; su < 256; su += G) { const int pair = su >> 3, b = pair >> 3, h = pair & 7;
            for (int k = 0; k < 2; ++k) attn_body::attn_unit<8>((long)M_PROMPT + (long)b * S_SAMPLE, S_SAMPLE / 64, h, h >> 2, (su & 7) * 2 + k, Q, K, V, Ob, ssqA, (char*)lds); }
        __syncthreads();
        LAS float* Tb = (LAS float*)(L + NA_T_OFF + wave * NA_T_BYTES);
        LAS float* wsf = (LAS float*)(L + NA_WSF_OFF + wave * 256);
        for (int e = lane; e < na_body::T_FLOATS; e += 64) Tb[e] = 0.f;
        { const float* rpb = KIN(8) + wave * 15 * 31;
          for (int e = lane; e < 15 * 31; e += 64) { const int dr = e / 31, dc = e % 31; Tb[na_body::T_GUARD + dr * 32 + dc] = rpb[e] * LOG2E; } }
        LAS unsigned char* wl = L + wave * na_body::TILE_BYTES;
        const unsigned wl_addr = (unsigned)(uintptr_t)(lds + wave * na_body::TILE_BYTES);
#ifdef PROBE_NAX2
        for (int rep_ = 0; rep_ < 2; ++rep_)
#endif
        for (int bu = vcu; bu < 1280; bu += G) {
            int rowbase, rows, r;
            if (bu < 1024) { rowbase = (bu >> 5) * S_PROMPT; rows = 32; r = bu & 31; } else { const int s = bu - 1024; rowbase = M_PROMPT + (s >> 6) * S_SAMPLE; rows = 64; r = s & 63; }
#ifdef PROBE_NAX2
            na_body::na_unit(ws, (unsigned)WS_PROJ, (unsigned)WS_XNO, rep_ ? (unsigned)(800 * MiB) : (unsigned)WS_SSQB, rowbase, rows, r, wave, wl, wl_addr, Tb + na_body::T_GUARD, wsf);
#else
            na_body::na_unit(ws, (unsigned)WS_PROJ, (unsigned)WS_XNO, (unsigned)WS_SSQB, rowbase, rows, r, wave, wl, wl_addr, Tb + na_body::T_GUARD, wsf);
#endif
        }
    }
    SEAM_BAR();

    {
        PHASE_PTRS(); bf16* const Wout_t = (bf16*)(ws + WS_WOUT); bf16* const H1B = (bf16*)(ws + WS_H1B); const float* const x_prompt = KIN(0); const float* const x_sample = KIN(1);
        pg8::Gemm g{XNO, Wout_t, M_ALL, DM, DM}; pg8::StaticOrder S; S.init(M_ALL, DM, G, bx);
        pg8::EpiOutProj E{x_prompt, x_sample, M_PROMPT, H1B, ssq2, ssqA, ssqB};
        pg8::gemm_phase<pg8::EpiOutProj, pg8::StaticOrder, true, true>(L, g, S, E);
    }
    SEAM_BAR();

    {
        PHASE_PTRS(); bf16* const Wup_t = (bf16*)(ws + WS_WUP); bf16* const H1B = (bf16*)(ws + WS_H1B); bf16* const ACT = (bf16*)(ws + WS_ACT);
        constexpr int NM_UP = (M_ALL + 253) / 254;
        pg8::Gemm g{H1B - DM, Wup_t, NM_UP * 256, NUP, DM, (size_t)254 * DM * 2}; pg8::StaticOrder S; S.init(NM_UP * 256, NUP, G, bx);
        pg8::EpiConvGate E{ACT, ssq2, KIN(14), KIN(15), M_ALL, DFF};
        pg8::gemm_phase<pg8::EpiConvGate, pg8::StaticOrder, true, true>(L, g, S, E);
#ifdef PROBE_P5X2
        pg8::gemm_phase<pg8::EpiConvGate, pg8::StaticOrder, true, true>(L, g, S, E);
#endif
    }
    SEAM_BAR();

    {
        PHASE_PTRS(); bf16* const ACT = (bf16*)(ws + WS_ACT); bf16* const Wdown_t = (bf16*)(ws + WS_WDOWN); bf16* const H2B = (bf16*)(ws + WS_H2B); bf16* const H1B = (bf16*)(ws + WS_H1B);
        pg8::Gemm g{ACT, Wdown_t, M_ALL, DM, DFF}; pg8::StaticOrder S; S.init(M_ALL, DM, G, bx);
        pg8::EpiResB E{H1B, H2B, ssq3};
        pg8::gemm_phase<pg8::EpiResB, pg8::StaticOrder, true, true>(L, g, S, E);
    }
    SEAM_BAR();

    {
        PHASE_PTRS(); bf16* const H2B = (bf16*)(ws + WS_H2B); bf16* const Wgate_t = (bf16*)(ws + WS_WGATE); bf16* const EB = (bf16*)(ws + WS_E); bf16* const H3B = (bf16*)(ws + WS_H3B);
        pg8::Gemm g{H2B, Wgate_t, M_ALL, DM, DM}; pg8::StaticOrder S; S.init(M_ALL, DM, G, bx);
        pg8::EpiGate E{H2B, EB, H3B, ssq3, ssq4};
        pg8::gemm_phase<pg8::EpiGate, pg8::StaticOrder, true, true>(L, g, S, E);
    }
    SEAM_BAR();

    {
        PHASE_PTRS();
        const f32x4* fg = (const f32x4*)KIN(20) + lane;
        const f32x4 g0 = fg[0], g1 = fg[64], g2 = fg[128], g3 = fg[192];
        const bf16* const H3B = (const bf16*)(ws + WS_H3B);
        for (int m0 = gw; m0 < M_ALL; m0 += 2 * NGW) {
            const int m1 = m0 + NGW; const bool has1 = m1 < M_ALL; const int m1c = has1 ? m1 : m0;
            const v2u* hr0 = (const v2u*)(H3B + (size_t)m0 * DM) + lane; const v2u* hr1 = (const v2u*)(H3B + (size_t)m1c * DM) + lane;
            v2u a[4], b[4];
#pragma unroll
            for (int j = 0; j < 4; ++j) { a[j] = hr0[64 * j]; b[j] = hr1[64 * j]; }
            const float rs0 = __builtin_amdgcn_rsqf(ssq4[m0] * (1.f / DM) + 1e-6f), rs1 = __builtin_amdgcn_rsqf(ssq4[m1c] * (1.f / DM) + 1e-6f);
            f32x4* xr0 = (f32x4*)(out + (size_t)m0 * DM) + lane; f32x4* xr1 = (f32x4*)(out + (size_t)m1c * DM) + lane;
            const f32x4 gg[4] = {g0, g1, g2, g3};
#pragma unroll
            for (int j = 0; j < 4; ++j) { xr0[64 * j] = (f32x4){bflo(a[j].x), bfhi(a[j].x), bflo(a[j].y), bfhi(a[j].y)} * rs0 * gg[j];
                if (has1) xr1[64 * j] = (f32x4){bflo(b[j].x), bfhi(b[j].x), bflo(b[j].y), bfhi(b[j].y)} * rs1 * gg[j]; }
        }
    }
}

extern "C" void kernel_launch(void* const* d_in, const int* in_sizes, int n_in, void* d_out, int out_size, void* d_ws, size_t ws_size, hipStream_t stream) {
    static int grid = 0;
    if (grid == 0) {
        if (n_in != 21 || in_sizes[0] != M_PROMPT * DM || out_size != M_ALL * DM || ws_size < WS_END) { fprintf(stderr, "kernel_launch: unexpected shapes (n_in %d, in0 %d, out %d, ws %zu); nothing launched\n", n_in, n_in > 0 ? in_sizes[0] : -1, out_size, ws_size); grid = -1; return; }
        int dev = 0, cus = 0, per_cu = 0;
        if (hipGetDevice(&dev) != hipSuccess || hipDeviceGetAttribute(&cus, hipDeviceAttributeMultiprocessorCount, dev) != hipSuccess) { grid = -1; return; }
        if (hipFuncSetAttribute((const void*)hymba_fwd, hipFuncAttributeMaxDynamicSharedMemorySize, LDS_BYTES) != hipSuccess) { fprintf(stderr, "kernel_launch: hipFuncSetAttribute failed\n"); grid = -1; return; }
        if (hipOccupancyMaxActiveBlocksPerMultiprocessor(&per_cu, (const void*)hymba_fwd, NWAVES * 64, LDS_BYTES) != hipSuccess || per_cu < 1) { fprintf(stderr, "kernel_launch: occupancy query says %d blocks per CU\n", per_cu); (void)hipGetLastError(); }
        grid = cus;
    }
    if (grid < 0) return;
    if (hipMemsetAsync((unsigned char*)d_ws + WS_BAR, 0, BAR_BYTES, stream) != hipSuccess) { fprintf(stderr, "kernel_launch: hipMemsetAsync failed\n"); return; }
    Args a{};
    for (int i = 0; i < 21; ++i) a.in[i] = (const float*)d_in[i];
    a.out = (float*)d_out; a.ws = (unsigned char*)d_ws;
    void* kargs[] = {&a};
    const hipError_t e = hipLaunchCooperativeKernel((const void*)hymba_fwd, dim3(grid), dim3(NWAVES * 64), kargs, LDS_BYTES, stream);
    if (e != hipSuccess) fprintf(stderr, "kernel_launch: cooperative launch failed: %s (grid %d)\n", hipGetErrorString(e), grid);
}
```
